# Optimizing an MI355X kernel written in HIP

```python
import math
import jax
import jax.numpy as jnp
from jax import lax
import numpy as np

D_MODEL = 2048
BATCH = 16
SEQ = 2048
DEPTH = 2

N_MIXERS = 2
N_ATTN_LAYERS = (DEPTH + 1) // 2
N_MLSTM_LAYERS = DEPTH // 2

DILATED_PATTERNS = ((128, 1), (512, 4), (2048, 16))
N_DIL_GROUPS = 3
ATTN_HEADS = 8
HEAD_DIM = 128
ROT_DIM = HEAD_DIM // 4
ROPE_THETA = 500000.0
ATTN_BLOCK = 128
ATTN_QKV_COLS = N_DIL_GROUPS * 3 * ATTN_HEADS * HEAD_DIM

MLSTM_HEADS = 8
QK_DIM = 128
V_DIM = D_MODEL // MLSTM_HEADS
CONV_K = 4
MLSTM_CHUNK = 64
MLSTM_QK_COLS = 2 * MLSTM_HEADS * QK_DIM
MLSTM_V_COLS = MLSTM_HEADS * V_DIM
MLSTM_IN_COLS = MLSTM_QK_COLS + 2 * MLSTM_V_COLS + 2 * MLSTM_HEADS

N_EXPERTS = 16
N_EXPERT_GROUPS = 4
EXPERTS_PER_GROUP = N_EXPERTS // N_EXPERT_GROUPS
TOP_K = 2
D_EXPERT = 768
MOE_BLOCK = 128

ALPHA = (2 * DEPTH) ** 0.25
BETA = (8 * DEPTH) ** -0.25
LN_EPS = 1e-5
NEG = -1e30

kernel_name = 'hybrid_dilated_attn_mlstm_grouped_moe'


def layer_norm(x, g, b):
    xf = x.astype(jnp.float32)
    mu = xf.mean(-1, keepdims=True)
    var = jnp.square(xf - mu).mean(-1, keepdims=True)
    return ((xf - mu) * lax.rsqrt(var + LN_EPS) * g + b).astype(x.dtype)


def rope_tables(seq):
    inv_freq = ROPE_THETA ** (-jnp.arange(0, ROT_DIM, 2, dtype=jnp.float32) / ROT_DIM)
    ang = jnp.arange(seq, dtype=jnp.float32)[:, None] * inv_freq[None, :]
    ang = jnp.concatenate([ang, ang], -1)
    return jnp.cos(ang)[:, None, :], jnp.sin(ang)[:, None, :]


def apply_partial_rope(t, cos, sin):
    tr, tp = t[..., :ROT_DIM], t[..., ROT_DIM:]
    x1, x2 = tr[..., :ROT_DIM // 2], tr[..., ROT_DIM // 2:]
    rot = jnp.concatenate([-x2, x1], -1)
    tr = (tr * cos + rot * sin).astype(t.dtype)
    return jnp.concatenate([tr, tp], -1)


def banded_causal_attention(q, k, v, n_back):
    n, h, l, hd = q.shape
    nb = -(-l // ATTN_BLOCK)
    pad = nb * ATTN_BLOCK - l
    padw = ((0, 0), (0, 0), (0, pad), (0, 0))
    qb, kb, vb = (jnp.pad(t, padw).reshape(n, h, nb, ATTN_BLOCK, hd) for t in (q, k, v))

    def with_prev(t):
        prev = jnp.concatenate([jnp.zeros_like(t[:, :, :1]), t[:, :, :-1]], axis=2)
        return jnp.concatenate([prev, t], axis=3)

    kc, vc = with_prev(kb), with_prev(vb)
    s = jnp.einsum('nhbqd,nhbkd->nhbqk', qb, kc).astype(jnp.float32) * (hd ** -0.5)
    blk = jnp.arange(nb)[:, None, None]
    qpos = blk * ATTN_BLOCK + jnp.arange(ATTN_BLOCK)[None, :, None]
    kpos = (blk - 1) * ATTN_BLOCK + jnp.arange(2 * ATTN_BLOCK)[None, None, :]
    dist = qpos - kpos
    mask = (dist >= 0) & (dist <= n_back) & (kpos >= 0)
    s = jnp.where(mask, s, NEG)
    mx = s.max(-1, keepdims=True)
    p = jnp.exp(s - mx)
    den = p.sum(-1)
    o = jnp.einsum('nhbqk,nhbkd->nhbqd', p.astype(v.dtype), vc).astype(jnp.float32) / den[..., None]
    lse = mx[..., 0] + jnp.log(den)
    o = o.reshape(n, h, nb * ATTN_BLOCK, hd)[:, :, :l]
    lse = lse.reshape(n, h, nb * ATTN_BLOCK)[:, :, :l]
    return o, lse


def strided_window_attention(q, k, v, n_back, dilation):
    b, s, h, hd = q.shape
    l = s // dilation

    def gather(t):
        return t.reshape(b, l, dilation, h, hd).transpose(0, 2, 3, 1, 4).reshape(b * dilation, h, l, hd)

    o, lse = banded_causal_attention(gather(q), gather(k), gather(v), n_back)
    o = o.reshape(b, dilation, h, l, hd).transpose(0, 3, 1, 2, 4).reshape(b, s, h, hd)
    lse = lse.reshape(b, dilation, h, l).transpose(0, 3, 1, 2).reshape(b, s, h)
    return o, lse


def dilated_attention(x, w_qkv, w_o, cos, sin):
    b, s, _ = x.shape
    qkv = (x @ w_qkv).reshape(b, s, N_DIL_GROUPS, 3, ATTN_HEADS, HEAD_DIM)
    outs, lses = [], []
    for g, (window, dil) in enumerate(DILATED_PATTERNS):
        q = apply_partial_rope(qkv[:, :, g, 0], cos, sin)
        k = apply_partial_rope(qkv[:, :, g, 1], cos, sin)
        o, lse = strided_window_attention(q, k, qkv[:, :, g, 2], window // dil, dil)
        outs.append(o)
        lses.append(lse)
    wts = jax.nn.softmax(jnp.stack(lses), axis=0)
    o = jnp.einsum('gbsh,gbshd->bshd', wts, jnp.stack(outs))
    return o.reshape(b, s, ATTN_HEADS * HEAD_DIM).astype(x.dtype) @ w_o


def causal_depthwise_conv(t, w, bias):
    s = t.shape[1]
    tp = jnp.pad(t, ((0, 0), (CONV_K - 1, 0), (0, 0)))
    out = bias
    for j in range(CONV_K):
        out = out + tp[:, j:j + s] * w[j]
    return out


def mlstm_cell(q, k, v, log_i, log_f):
    b, s, h, dqk = q.shape
    dv = v.shape[-1]
    nc = s // MLSTM_CHUNK
    lc = MLSTM_CHUNK

    def chunks(t):
        return t.astype(jnp.float32).reshape((b, nc, lc, h) + t.shape[3:]).swapaxes(0, 1).swapaxes(2, 3)

    xs = (chunks(q), chunks(k), chunks(v), chunks(log_i), chunks(log_f))
    causal = jnp.tril(jnp.ones((lc, lc), dtype=bool))

    def step(carry, inp):
        c_state, n_state, m_state = carry
        qc, kc, vc, ic, fc = inp
        bcum = jnp.cumsum(fc, axis=-1)
        dmat = jnp.where(causal, bcum[..., :, None] - bcum[..., None, :] + ic[..., None, :], NEG)
        inter = bcum + m_state[..., None]
        m_t = jnp.maximum(inter, dmat.max(-1))
        a = jnp.einsum('bhtd,bhsd->bhts', qc, kc) * jnp.exp(dmat - m_t[..., None])
        w_inter = jnp.exp(inter - m_t)
        num = jnp.einsum('bhts,bhsv->bhtv', a, vc) + w_inter[..., None] * jnp.einsum('bhtd,bhdv->bhtv', qc, c_state)
        den = a.sum(-1) + w_inter * jnp.einsum('bhtd,bhd->bht', qc, n_state)
        h_out = num / jnp.maximum(jnp.abs(den), jnp.exp(-m_t))[..., None]
        b_last = bcum[..., -1]
        g = b_last[..., None] - bcum + ic
        m_new = jnp.maximum(b_last + m_state, g.max(-1))
        wk = jnp.exp(g - m_new[..., None])
        decay = jnp.exp(b_last + m_state - m_new)
        c_new = decay[..., None, None] * c_state + jnp.einsum('bhs,bhsd,bhsv->bhdv', wk, kc, vc)
        n_new = decay[..., None] * n_state + jnp.einsum('bhs,bhsd->bhd', wk, kc)
        return (c_new, n_new, m_new), h_out

    init = (jnp.zeros((b, h, dqk, dv), jnp.float32),
            jnp.zeros((b, h, dqk), jnp.float32),
            jnp.full((b, h), NEG, jnp.float32))
    _, hs = lax.scan(step, init, xs)
    return hs.swapaxes(2, 3).swapaxes(0, 1).reshape(b, s, h, dv)


def mlstm_mixer(x, w_in, b_gates, conv_w, conv_b, norm_g, w_out):
    b, s, _ = x.shape
    z = x @ w_in
    qk = jax.nn.silu(causal_depthwise_conv(z[..., :MLSTM_QK_COLS], conv_w, conv_b))
    half = MLSTM_QK_COLS // 2
    q = qk[..., :half].reshape(b, s, MLSTM_HEADS, QK_DIM)
    k = qk[..., half:].reshape(b, s, MLSTM_HEADS, QK_DIM) * (QK_DIM ** -0.5)
    v = z[..., MLSTM_QK_COLS:MLSTM_QK_COLS + MLSTM_V_COLS].reshape(b, s, MLSTM_HEADS, V_DIM)
    o_pre = z[..., MLSTM_QK_COLS + MLSTM_V_COLS:MLSTM_QK_COLS + 2 * MLSTM_V_COLS]
    gates = z[..., MLSTM_QK_COLS + 2 * MLSTM_V_COLS:].astype(jnp.float32) + b_gates
    log_i = gates[..., :MLSTM_HEADS]
    log_f = jax.nn.log_sigmoid(gates[..., MLSTM_HEADS:])
    hc = mlstm_cell(q, k, v, log_i, log_f)
    mu = hc.mean(-1, keepdims=True)
    var = jnp.square(hc - mu).mean(-1, keepdims=True)
    hn = (hc - mu) * lax.rsqrt(var + LN_EPS) * norm_g.reshape(MLSTM_HEADS, V_DIM)
    y = hn.reshape(b, s, MLSTM_V_COLS).astype(x.dtype) * jax.nn.sigmoid(o_pre)
    return y @ w_out


def grouped_moe(x, w_router, b_router, w_gate, w_up, w_down):
    b, s, d = x.shape
    xt = x.reshape(-1, d)
    t = xt.shape[0]
    logits = (xt @ w_router).astype(jnp.float32) + b_router
    probs = jax.nn.softmax(logits, axis=-1).reshape(t, N_EXPERT_GROUPS, EXPERTS_PER_GROUP)
    top_p, top_i = lax.top_k(probs, TOP_K)
    g_sel = jnp.argmax(top_p.sum(-1), axis=-1)
    sel_p = jnp.take_along_axis(top_p, g_sel[:, None, None], axis=1)[:, 0]
    sel_i = jnp.take_along_axis(top_i, g_sel[:, None, None], axis=1)[:, 0]
    gate = sel_p / sel_p.sum(-1, keepdims=True)
    expert = g_sel[:, None] * EXPERTS_PER_GROUP + sel_i
    a = t * TOP_K
    e_flat = expert.reshape(a)
    tok = jnp.repeat(jnp.arange(t), TOP_K)
    counts = jnp.zeros((N_EXPERTS,), jnp.int32).at[e_flat].add(1)
    padded = (counts + MOE_BLOCK - 1) // MOE_BLOCK * MOE_BLOCK
    ends = jnp.cumsum(padded)
    starts = ends - padded
    order = jnp.argsort(e_flat)
    e_sorted = e_flat[order]
    rank = jnp.arange(a) - (jnp.cumsum(counts) - counts)[e_sorted]
    dest = jnp.zeros((a,), jnp.int32).at[order].set(starts[e_sorted] + rank)
    rows = a + N_EXPERTS * MOE_BLOCK
    buf = jnp.zeros((rows, d), x.dtype).at[dest].set(xt[tok])
    n_blocks = rows // MOE_BLOCK
    block_expert = jnp.minimum(jnp.searchsorted(ends, jnp.arange(n_blocks) * MOE_BLOCK, side='right'), N_EXPERTS - 1)

    def expert_block(args):
        xb, e = args
        hb = jax.nn.silu(xb @ w_gate[e]) * (xb @ w_up[e])
        return hb @ w_down[e]

    out = lax.map(expert_block, (buf.reshape(n_blocks, MOE_BLOCK, d), block_expert)).reshape(rows, d)
    y = (out[dest].reshape(t, TOP_K, d) * gate[..., None].astype(x.dtype)).sum(1)
    return y.reshape(b, s, d)


def setup_inputs(seed: int = 0) -> dict:
    key = jax.random.key(seed)
    ks = jax.random.split(key, 24)

    def nrm(k, shape, scale):
        return jax.random.normal(k, shape, jnp.float32) * scale

    x = nrm(ks[0], (BATCH, SEQ, D_MODEL), 1.0)
    qkv_scale = jnp.array([1.0, 1.0, BETA], jnp.float32)[None, None, None, :, None]
    attn_w_qkv = (nrm(ks[1], (N_ATTN_LAYERS, D_MODEL, N_DIL_GROUPS, 3, ATTN_HEADS * HEAD_DIM), D_MODEL ** -0.5)
                  * qkv_scale).reshape(N_ATTN_LAYERS, D_MODEL, ATTN_QKV_COLS)
    attn_w_o = nrm(ks[2], (N_ATTN_LAYERS, ATTN_HEADS * HEAD_DIM, D_MODEL), (ATTN_HEADS * HEAD_DIM) ** -0.5 * BETA)
    col_scale = jnp.concatenate([jnp.ones((MLSTM_QK_COLS,), jnp.float32),
                                 jnp.full((MLSTM_V_COLS,), BETA, jnp.float32),
                                 jnp.ones((MLSTM_V_COLS + 2 * MLSTM_HEADS,), jnp.float32)])
    mlstm_w_in = nrm(ks[3], (N_MLSTM_LAYERS, D_MODEL, MLSTM_IN_COLS), D_MODEL ** -0.5) * col_scale
    i_bias = nrm(ks[4], (N_MLSTM_LAYERS, MLSTM_HEADS), 0.1)
    f_bias = jnp.linspace(3.0, 6.0, MLSTM_HEADS, dtype=jnp.float32)[None, :] + nrm(ks[5], (N_MLSTM_LAYERS, MLSTM_HEADS), 0.1)
    mlstm_b_gates = jnp.concatenate([i_bias, f_bias], axis=-1)
    mlstm_conv_w = nrm(ks[6], (N_MLSTM_LAYERS, CONV_K, MLSTM_QK_COLS), CONV_K ** -0.5)
    mlstm_conv_b = nrm(ks[7], (N_MLSTM_LAYERS, MLSTM_QK_COLS), 0.02)
    mlstm_norm_g = 1.0 + nrm(ks[8], (N_MLSTM_LAYERS, MLSTM_V_COLS), 0.02)
    mlstm_w_out = nrm(ks[9], (N_MLSTM_LAYERS, MLSTM_V_COLS, D_MODEL), MLSTM_V_COLS ** -0.5 * BETA)
    ln_mix_g = 1.0 + nrm(ks[10], (DEPTH, D_MODEL), 0.02)
    ln_mix_b = nrm(ks[11], (DEPTH, D_MODEL), 0.02)
    ln_ffn_g = 1.0 + nrm(ks[12], (DEPTH, D_MODEL), 0.02)
    ln_ffn_b = nrm(ks[13], (DEPTH, D_MODEL), 0.02)
    router_w = nrm(ks[14], (D_MODEL, N_EXPERTS), D_MODEL ** -0.5)
    router_b = nrm(ks[15], (N_EXPERTS,), 0.01)
    moe_w_gate = nrm(ks[16], (DEPTH, N_EXPERTS, D_MODEL, D_EXPERT), D_MODEL ** -0.5)
    moe_w_up = nrm(ks[17], (DEPTH, N_EXPERTS, D_MODEL, D_EXPERT), D_MODEL ** -0.5 * BETA)
    moe_w_down = nrm(ks[18], (DEPTH, N_EXPERTS, D_EXPERT, D_MODEL), D_EXPERT ** -0.5 * BETA)
    return {'x': x, 'attn_w_qkv': attn_w_qkv, 'attn_w_o': attn_w_o,
            'mlstm_w_in': mlstm_w_in, 'mlstm_b_gates': mlstm_b_gates,
            'mlstm_conv_w': mlstm_conv_w, 'mlstm_conv_b': mlstm_conv_b,
            'mlstm_norm_g': mlstm_norm_g, 'mlstm_w_out': mlstm_w_out,
            'ln_mix_g': ln_mix_g, 'ln_mix_b': ln_mix_b, 'ln_ffn_g': ln_ffn_g, 'ln_ffn_b': ln_ffn_b,
            'router_w': router_w, 'router_b': router_b,
            'moe_w_gate': moe_w_gate, 'moe_w_up': moe_w_up, 'moe_w_down': moe_w_down}


def reference(x, attn_w_qkv, attn_w_o, mlstm_w_in, mlstm_b_gates, mlstm_conv_w, mlstm_conv_b,
              mlstm_norm_g, mlstm_w_out, ln_mix_g, ln_mix_b, ln_ffn_g, ln_ffn_b,
              router_w, router_b, moe_w_gate, moe_w_up, moe_w_down):
    cos, sin = rope_tables(x.shape[1])
    cos, sin = cos.astype(x.dtype), sin.astype(x.dtype)
    for i in range(DEPTH):
        j = i // N_MIXERS
        if i % N_MIXERS == 0:
            mixed = dilated_attention(x, attn_w_qkv[j], attn_w_o[j], cos, sin)
        else:
            mixed = mlstm_mixer(x, mlstm_w_in[j], mlstm_b_gates[j], mlstm_conv_w[j], mlstm_conv_b[j],
                                mlstm_norm_g[j], mlstm_w_out[j])
        x = layer_norm(ALPHA * x + mixed, ln_mix_g[i], ln_mix_b[i])
        ffn = grouped_moe(x, router_w, router_b, moe_w_gate[i], moe_w_up[i], moe_w_down[i])
        x = layer_norm(ALPHA * x + ffn, ln_ffn_g[i], ln_ffn_b[i])
    return x
```

```cpp
#include <hip/hip_runtime.h>
#include <cstdio>
#include <cstdint>
namespace pg8 {
#define PG8_LAS __attribute__((address_space(3)))
typedef unsigned short bf16_t;
typedef short bf16x8 __attribute__((ext_vector_type(8)));
typedef float f32x4 __attribute__((ext_vector_type(4)));
typedef unsigned u32x4 __attribute__((ext_vector_type(4)));
constexpr int BM = 256, BK = 64, HALF = 128, HTB = HALF * BK * 2  , STAGE_BYTES = 8 * HTB, NXCD = 8, WGM = 8;

__host__ __device__ __forceinline__ int lds_byte(int r, int c) { const int st = (r >> 4) * 2 + (c >> 5), rr = r & 15, cc = c & 31, ob = rr * 64 + cc * 2; return st * 1024 + (ob ^ (((ob >> 9) & 1) << 5)); }
__host__ __device__ __forceinline__ void stage_rc(int b, int& R, int& C) { const int st = b / 1024, sb = b % 1024, swz = sb ^ (((sb >> 9) & 1) << 5); R = (st >> 1) * 16 + swz / 64; C = (st & 1) * 32 + (swz % 64) / 2; }
__host__ __device__ __forceinline__ int perm32(int rho) { const int n = rho >> 4, i = rho & 15; return 8 * (i >> 2) + 4 * n + (i & 3); }

struct Unit { int pm, pn; };
struct Gemm { const bf16_t* A; const bf16_t* Bt; int M, N, K; };

struct StaticOrder {
    int nM, nN, nwg, G, c;
    __host__ __device__ void init(int M, int N, int G_, int c_) { nM = M / BM; nN = N / BM; nwg = nM * nN; G = G_; c = c_; }
    __host__ __device__ bool next(int i, Unit& u) const {
        const long L = (long)i * G + c; if (L >= nwg) return false;
        int wgid = (int)L; { const int q = nwg / NXCD, r = nwg % NXCD, xcd = wgid % NXCD, off = wgid / NXCD; wgid = (xcd < r ? xcd * (q + 1) : r * (q + 1) + (xcd - r) * q) + off; }
        const int nig = WGM * nN, gid = wgid / nig, fm = gid * WGM, gsz = (nM - fm) < WGM ? (nM - fm) : WGM;
        u.pm = fm + ((wgid % nig) % gsz); u.pn = (wgid % nig) / gsz; return true;
    }
    __device__ __forceinline__ const char* pa(const Gemm& g, const Unit& u) const { return (const char*)g.A + (size_t)u.pm * ((size_t)BM * g.K * 2); }
    __device__ __forceinline__ const char* pb(const Gemm& g, const Unit& u) const { return (const char*)g.Bt + (size_t)u.pn * ((size_t)BM * g.K * 2); }
    static constexpr bool GATHER = false;
    __device__ __forceinline__ void prep() const {}
    __device__ __forceinline__ void aoffs(int, int, int, unsigned (&)[2][2]) const {}
    __device__ __forceinline__ void a_ready(const Unit&) const {}
    __device__ __forceinline__ void done(const Unit&) const {}
};

__device__ __forceinline__ unsigned cvt_pk_bf16(float lo, float hi) { unsigned r; asm volatile("v_cvt_pk_bf16_f32 %0, %1, %2" : "=v"(r) : "v"(lo), "v"(hi)); return r; }
typedef float f32x2 __attribute__((ext_vector_type(2)));
template <class Epi, class Sched, bool ALIGN_EPI = false, bool SP2 = false>
__device__ __forceinline__ void gemm_phase(PG8_LAS unsigned char* lds, const Gemm g, const Sched& S, const Epi& E) {
    const int tid = threadIdx.x, wid = __builtin_amdgcn_readfirstlane(tid >> 6), lane = tid & 63, wr = wid >> 2, wc = wid & 3, fr = lane & 15, fq = lane >> 4;
    const int K = g.K, nt = K / BK;
    unsigned voffA[2], voffB[2];
#pragma unroll
    for (int i = 0; i < 2; ++i) { int R, C; stage_rc(tid * 16 + i * 8192, R, C); const int Rb = Epi::PERM ? ((R & ~31) + perm32(R & 31)) : R;
        voffA[i] = (unsigned)(R * K + C) * 2u; voffB[i] = (unsigned)(Rb * K + C) * 2u; }
    const size_t kstep = (size_t)(BK * 2);
    const size_t hstep = (size_t)HALF * K * 2;
    const size_t tstep = 2 * hstep;
    const unsigned ldsw = (unsigned)wid * 1024u;
    const int aoff = lds_byte(wr * 64 + fr, fq * 8), boff = lds_byte(wc * 32 + fr, fq * 8);
#define PG8_SA(b, h) (((b) * 2 + (h)) * HTB)
#define PG8_SB(b, h) ((4 + (b) * 2 + (h)) * HTB)
#define PG8_STAGE(bufoff, gbase, voff) do { _Pragma("unroll") for (int _i = 0; _i < 2; ++_i) \
        __builtin_amdgcn_global_load_lds((const unsigned*)((const char*)(gbase) + (voff)[_i]), (PG8_LAS unsigned*)(lds + (bufoff) + ldsw + _i * 8192), 16, 0, 0); } while (0)
#define PG8_STAGE_A(bufoff, kptr, half, NXT) do { if constexpr (Sched::GATHER) { const unsigned vx_[2] = {(NXT) ? van[half][0] : va[half][0], (NXT) ? van[half][1] : va[half][1]}; PG8_STAGE(bufoff, kptr, vx_); } \
        else { PG8_STAGE(bufoff, (kptr) + ((half) ? hstep : 0), voffA); } } while (0)
#define PG8_LDA(dst, b, h) do { _Pragma("unroll") for (int m = 0; m < 4; ++m) _Pragma("unroll") for (int k = 0; k < 2; ++k) dst[m][k] = *(const PG8_LAS bf16x8*)(lds + PG8_SA(b, h) + aoff + m * 2048 + k * 1024); } while (0)
#define PG8_LDB(dst, b, h) do { _Pragma("unroll") for (int n = 0; n < 2; ++n) _Pragma("unroll") for (int k = 0; k < 2; ++k) dst[n][k] = *(const PG8_LAS bf16x8*)(lds + PG8_SB(b, h) + boff + n * 2048 + k * 1024); } while (0)
#define PG8_MMA(ai, bj, At, Bt) do { __builtin_amdgcn_s_setprio(1); _Pragma("unroll") for (int m = 0; m < 4; ++m) _Pragma("unroll") for (int n = 0; n < 2; ++n) _Pragma("unroll") for (int k = 0; k < 2; ++k) \
        acc[ai][bj][m][n] = __builtin_amdgcn_mfma_f32_16x16x32_bf16(Bt[n][k], At[m][k], acc[ai][bj][m][n], 0, 0, 0); __builtin_amdgcn_s_setprio(0); } while (0)
#define PG8_WAIT_V(n) asm volatile("s_waitcnt vmcnt(" #n ")" ::: "memory")
#define PG8_WAIT_L(n) asm volatile("s_waitcnt lgkmcnt(" #n ")" ::: "memory")
#define PG8_BAR __builtin_amdgcn_s_barrier()
#define PG8_SCHED __builtin_amdgcn_sched_barrier(0)
    Unit cur, nxt; int ui = 0;
    if (!S.next(0, cur)) return;
    S.prep();
    f32x4 acc[2][2][4][2];
#pragma unroll
    for (int a = 0; a < 2; ++a)
#pragma unroll
        for (int b = 0; b < 2; ++b)
#pragma unroll
            for (int m = 0; m < 4; ++m)
#pragma unroll
                for (int n = 0; n < 2; ++n) acc[a][b][m][n] = (f32x4){0.f, 0.f, 0.f, 0.f};
    bf16x8 At[4][2], B0[2][2], B1[2][2];
    const char* cA = S.pa(g, cur); const char* cB = S.pb(g, cur);
    unsigned va[2][2] = {{0u, 0u}, {0u, 0u}}, van[2][2] = {{0u, 0u}, {0u, 0u}};
    if constexpr (Sched::GATHER) { static_assert(SP2, "gathered A rows: SP2 loop only"); S.aoffs(0, K, tid, va); }
    S.a_ready(cur);
    if constexpr (SP2) {
        PG8_STAGE(PG8_SB(0, 0), cB, voffB); PG8_STAGE(PG8_SB(0, 1), cB + hstep, voffB); PG8_STAGE_A(PG8_SA(0, 0), cA, 0, false); PG8_STAGE_A(PG8_SA(0, 1), cA, 1, false);
        if (wr == 1) PG8_BAR;
        PG8_WAIT_V(2); PG8_BAR;
        PG8_STAGE(PG8_SB(1, 0), cB + kstep, voffB); PG8_STAGE_A(PG8_SA(1, 0), cA + kstep, 0, false); PG8_STAGE(PG8_SB(1, 1), cB + hstep + kstep, voffB);
        PG8_WAIT_V(6); PG8_BAR;
    } else {
        PG8_STAGE(PG8_SB(0, 0), cB, voffB); PG8_STAGE(PG8_SA(0, 0), cA, voffA); PG8_STAGE(PG8_SB(0, 1), cB + hstep, voffB); PG8_STAGE(PG8_SA(0, 1), cA + hstep, voffA);
        if (wr == 1) PG8_BAR;
        PG8_WAIT_V(4); PG8_BAR;
        PG8_STAGE(PG8_SB(1, 0), cB + kstep, voffB); PG8_STAGE(PG8_SA(1, 0), cA + kstep, voffA); PG8_STAGE(PG8_SB(1, 1), cB + hstep + kstep, voffB);
        PG8_WAIT_V(6); PG8_BAR;
    }
    for (;;) {
        const bool has_next = S.next(ui + 1, nxt);
        if constexpr (Sched::GATHER) { if (has_next) S.aoffs(ui + 1, K, tid, van); else { van[0][0] = va[0][0]; van[0][1] = va[0][1]; van[1][0] = va[1][0]; van[1][1] = va[1][1]; } }
        const char* nA = has_next ? S.pa(g, nxt) : cA; const char* nB = has_next ? S.pb(g, nxt) : cB;
        for (int t = 0; t < nt; t += 2) {
            const bool last = (t == nt - 2);
            const char* a1 = cA + (size_t)(t + 1) * kstep;
            const char* a2 = last ? nA : cA + (size_t)(t + 2) * kstep; const char* b2 = last ? nB : cB + (size_t)(t + 2) * kstep;
            const char* a3 = a2 + kstep; const char* b3 = b2 + kstep;
            if (last && has_next) S.a_ready(nxt);
            if constexpr (SP2) {
            PG8_LDB(B0, 0, 0); PG8_LDB(B1, 0, 1); PG8_SCHED; PG8_LDA(At, 0, 0); PG8_STAGE_A(PG8_SA(1, 1), a1, 1, false);
            PG8_WAIT_V(8); PG8_WAIT_L(0); PG8_BAR; PG8_MMA(0, 0, At, B0); PG8_MMA(0, 1, At, B1); PG8_BAR; PG8_SCHED;
            PG8_LDA(At, 0, 1); PG8_STAGE(PG8_SB(0, 0), b2, voffB); PG8_STAGE(PG8_SB(0, 1), b2 + hstep, voffB); PG8_STAGE_A(PG8_SA(0, 0), a2, 0, last);
            PG8_WAIT_V(8); PG8_WAIT_L(0); PG8_BAR; PG8_MMA(1, 0, At, B0); PG8_MMA(1, 1, At, B1); PG8_BAR; PG8_SCHED;
            PG8_LDB(B0, 1, 0); PG8_LDB(B1, 1, 1); PG8_SCHED; PG8_LDA(At, 1, 0); PG8_STAGE_A(PG8_SA(0, 1), a2, 1, last);
            PG8_WAIT_V(8); PG8_WAIT_L(0); PG8_BAR; PG8_MMA(0, 0, At, B0); PG8_MMA(0, 1, At, B1); PG8_BAR; PG8_SCHED;
            PG8_LDA(At, 1, 1); PG8_STAGE(PG8_SB(1, 0), b3, voffB); PG8_STAGE(PG8_SB(1, 1), b3 + hstep, voffB); PG8_STAGE_A(PG8_SA(1, 0), a3, 0, last);
            PG8_WAIT_V(8); PG8_WAIT_L(0); PG8_BAR; PG8_MMA(1, 0, At, B0); PG8_MMA(1, 1, At, B1); PG8_BAR; PG8_SCHED;
            } else {
            PG8_LDB(B0, 0, 0); PG8_SCHED; PG8_LDA(At, 0, 0); PG8_STAGE(PG8_SA(1, 1), a1 + hstep, voffA);
            PG8_WAIT_L(8); PG8_BAR; PG8_WAIT_L(0); PG8_MMA(0, 0, At, B0); PG8_BAR; PG8_SCHED;
            PG8_LDB(B1, 0, 1); PG8_STAGE(PG8_SB(0, 0), b2, voffB);
            PG8_BAR; PG8_WAIT_L(0); PG8_MMA(0, 1, At, B1); PG8_BAR;
            PG8_LDA(At, 0, 1); PG8_STAGE(PG8_SA(0, 0), a2, voffA);
            PG8_BAR; PG8_WAIT_L(0); PG8_MMA(1, 0, At, B0); PG8_BAR; PG8_SCHED;
            PG8_STAGE(PG8_SB(0, 1), b2 + hstep, voffB);
            PG8_WAIT_V(6); PG8_BAR; PG8_MMA(1, 1, At, B1); PG8_BAR;
            PG8_LDB(B0, 1, 0); PG8_SCHED; PG8_LDA(At, 1, 0); PG8_STAGE(PG8_SA(0, 1), a2 + hstep, voffA);
            PG8_WAIT_L(8); PG8_BAR; PG8_WAIT_L(0); PG8_MMA(0, 0, At, B0); PG8_BAR; PG8_SCHED;
            PG8_LDB(B1, 1, 1); PG8_STAGE(PG8_SB(1, 0), b3, voffB);
            PG8_BAR; PG8_WAIT_L(0); PG8_MMA(0, 1, At, B1); PG8_BAR;
            PG8_LDA(At, 1, 1); PG8_STAGE(PG8_SA(1, 0), a3, voffA);
            PG8_BAR; PG8_WAIT_L(0); PG8_MMA(1, 0, At, B0); PG8_BAR; PG8_SCHED;
            PG8_STAGE(PG8_SB(1, 1), b3 + hstep, voffB);
            PG8_WAIT_V(6); PG8_BAR; PG8_MMA(1, 1, At, B1); PG8_BAR;
            }
        }
        if constexpr (ALIGN_EPI) { if (wr == 0) PG8_BAR; }
        if constexpr (!Epi::AFTER_DRAIN) { E(acc, cur, wr, wc, fr, fq); S.done(cur); }
        if (!has_next) break;
#pragma unroll
        for (int a = 0; a < 2; ++a)
#pragma unroll
            for (int b = 0; b < 2; ++b)
#pragma unroll
                for (int m = 0; m < 4; ++m)
#pragma unroll
                    for (int n = 0; n < 2; ++n) acc[a][b][m][n] = (f32x4){0.f, 0.f, 0.f, 0.f};
        cur = nxt; cA = nA; cB = nB; ++ui;
        if constexpr (Sched::GATHER) { va[0][0] = van[0][0]; va[0][1] = van[0][1]; va[1][0] = van[1][0]; va[1][1] = van[1][1]; }
        if constexpr (ALIGN_EPI) { if (wr == 1) PG8_BAR; }
    }
    PG8_WAIT_V(0);
    if constexpr (!ALIGN_EPI) { if (wr == 0) PG8_BAR; }
    PG8_BAR;
    if constexpr (Epi::AFTER_DRAIN) { E.fused(acc, cur, wr, wc, fr, fq, lds, wid, lane); S.done(cur); }
#undef PG8_SA
#undef PG8_SB
#undef PG8_STAGE
#undef PG8_STAGE_A
#undef PG8_LDA
#undef PG8_LDB
#undef PG8_MMA
#undef PG8_WAIT_V
#undef PG8_WAIT_L
#undef PG8_BAR
#undef PG8_SCHED
}
}

#ifndef MK_ONE_LAUNCH
#define MK_ONE_LAUNCH 1
#endif
constexpr int NWAVES = 8, NTHR = 512;
constexpr int BATCH = 16, SEQ = 2048, T = BATCH * SEQ, D = 2048;
constexpr int QKV_N = 9216, NH = 8, HD = 128, OD = NH * HD;
constexpr int ZN = 6144, ZLD = 6160;
constexpr int NE = 16, DE = 768, GU_N = 2 * DE;
constexpr int MAXTILES = 272, MAXROWS = MAXTILES * 256;
constexpr float ALPHA = 1.41421356237309515f;
constexpr float LN_EPS = 1e-5f;
constexpr int NPHASE = 20;

constexpr size_t MiB = 1u << 20, KiB = 1u << 10;
constexpr size_t WS_CTL = 0, CTL_ZERO_BYTES = 256 * KiB;
constexpr size_t WS_ROPE = 1 * MiB;
constexpr size_t WS_EID = 1 * MiB + 256 * KiB;
constexpr size_t WS_EGATE = 1 * MiB + 512 * KiB;
constexpr size_t WS_ROWMAP = 1 * MiB + 768 * KiB;
constexpr size_t WS_HIST = 2 * MiB + 256 * KiB;
constexpr size_t WS_TILEE = 2 * MiB + 320 * KiB;
constexpr size_t WS_GATES = 3 * MiB;
constexpr size_t WS_WQKV = 6 * MiB, WS_WO = 42 * MiB, WS_WIN = 46 * MiB, WS_WOUT = 70 * MiB, WS_WGU = 78 * MiB, WS_WD = 174 * MiB;
constexpr size_t WS_XB = 222 * MiB;
constexpr size_t WS_R = 350 * MiB;
constexpr size_t WS_QKV = WS_R, WS_O = WS_R + 576 * MiB;
constexpr size_t WS_PRE = WS_R, WS_YB = WS_R;
constexpr size_t WS_XG = WS_R + 256 * MiB, WS_H = WS_R + 528 * MiB;
constexpr size_t WS_Z = WS_R, WS_QKC = WS_R + 384 * MiB, WS_HC = WS_R + 512 * MiB, WS_Y = WS_QKC;
constexpr size_t WS_END = 990 * MiB;
static_assert(WS_ROWMAP + (size_t)MAXROWS * 4 <= WS_HIST && WS_H + (size_t)MAXROWS * DE * 2 <= WS_END && WS_XG + (size_t)MAXROWS * D * 2 <= WS_H, "ws map");
constexpr int CW_TMO = 0, CW_BAR = 4096;

constexpr int RING_BYTES = 131072, LDSCTL_OFF = RING_BYTES, LDS_BYTES = 147456;
constexpr int LC_HIST = 0, LC_BAR = 64;

#define GAS __attribute__((address_space(1)))
#define LAS __attribute__((address_space(3)))
typedef unsigned short bf16;
typedef unsigned u32x4 __attribute__((ext_vector_type(4)));
typedef unsigned u32x2 __attribute__((ext_vector_type(2)));
typedef float f32x4 __attribute__((ext_vector_type(4)));
typedef float f32x2 __attribute__((ext_vector_type(2)));
#define LDS_WAIT() asm volatile("s_waitcnt lgkmcnt(0)" ::: "memory")
__device__ __forceinline__ unsigned f2bf(float f) { unsigned u = __builtin_bit_cast(unsigned, f); return (u + 0x7fffu + ((u >> 16) & 1u)) >> 16; }
__device__ __forceinline__ unsigned pk2(float lo, float hi) { return pg8::cvt_pk_bf16(lo, hi); }
__device__ __forceinline__ float bflo(unsigned u) { return __builtin_bit_cast(float, u << 16); }
__device__ __forceinline__ float bfhi(unsigned u) { return __builtin_bit_cast(float, u & 0xffff0000u); }
__device__ __forceinline__ float bf1(bf16 b) { return __builtin_bit_cast(float, (unsigned)b << 16); }
template <int CTRL> __device__ __forceinline__ float dpp0(float x) { return __builtin_bit_cast(float, __builtin_amdgcn_update_dpp(0, __builtin_bit_cast(int, x), CTRL, 0xf, 0xf, true)); }
template <int CTRL> __device__ __forceinline__ float dppx(float x) { return __builtin_bit_cast(float, __builtin_amdgcn_mov_dpp(__builtin_bit_cast(int, x), CTRL, 0xf, 0xf, true)); }
template <int CTRL, int ROWMASK> __device__ __forceinline__ float dpps(float x) { return __builtin_bit_cast(float, __builtin_amdgcn_update_dpp(__builtin_bit_cast(int, x), __builtin_bit_cast(int, x), CTRL, ROWMASK, 0xf, false)); }
__device__ __forceinline__ float prefix_sum64(float v) {
    v += dpp0<0x111>(v); v += dpp0<0x112>(v); v += dpp0<0x114>(v); v += dpp0<0x118>(v);
    v += __builtin_bit_cast(float, __builtin_amdgcn_update_dpp(0, __builtin_bit_cast(int, v), 0x142, 0xa, 0xf, false));
    v += __builtin_bit_cast(float, __builtin_amdgcn_update_dpp(0, __builtin_bit_cast(int, v), 0x143, 0xc, 0xf, false));
    return v;
}
__device__ __forceinline__ float prefix_max64(float v) {
    v = fmaxf(v, dpps<0x111, 0xf>(v)); v = fmaxf(v, dpps<0x112, 0xf>(v)); v = fmaxf(v, dpps<0x114, 0xf>(v)); v = fmaxf(v, dpps<0x118, 0xf>(v));
    v = fmaxf(v, dpps<0x142, 0xa>(v)); v = fmaxf(v, dpps<0x143, 0xc>(v));
    return v;
}
__device__ __forceinline__ float lane_bcast(float v, int l) { return __builtin_bit_cast(float, __builtin_amdgcn_readlane(__builtin_bit_cast(int, v), l)); }
__device__ __forceinline__ float wave_sum(float v) { return lane_bcast(prefix_sum64(v), 63); }
__device__ __forceinline__ float row16_sum(float v) { v += dppx<0xB1>(v); v += dppx<0x4E>(v); v += dppx<0x141>(v); v += dppx<0x128>(v); return v; }
__device__ __forceinline__ float lane_xor1(float v) { return dppx<0xB1>(v); }
__device__ __forceinline__ float lane_xor32(float v) { auto r = __builtin_amdgcn_permlane32_swap(__builtin_bit_cast(unsigned, v), __builtin_bit_cast(unsigned, v), false, false);
    return __builtin_bit_cast(float, (threadIdx.x & 32) ? r[0] : r[1]); }

#define XB_TMO      128
#define XB_XCNT(j)  (256  + 64 * (j))
#define XB_XSUB(j)  (1280 + 64 * (j))
#define XB_XGEN(j)  (2304 + 64 * (j))
#define XB_TOP      3328
#define XB_TOPGEN   3392
#define XCD_BAR_WORDS 3456
#define XB_SPIN_CAP (1u << 18)
__device__ __forceinline__ unsigned xb_ld(unsigned* p)              { return __hip_atomic_load(p, __ATOMIC_RELAXED, __HIP_MEMORY_SCOPE_AGENT); }
__device__ __forceinline__ unsigned xb_add(unsigned* p, unsigned v) { return __hip_atomic_fetch_add(p, v, __ATOMIC_RELAXED, __HIP_MEMORY_SCOPE_AGENT); }
__device__ __forceinline__ unsigned xb_xcc_id() { return (unsigned)__builtin_amdgcn_s_getreg((3 << 11) | 20) & 0xFu; }
#define XB_SPIN(cond, bar) do { unsigned _sp = 0; while (cond) { __builtin_amdgcn_s_sleep(1); \
    if ((++_sp & 255u) == 0u) { if (xb_ld(&(bar)[XB_TMO])) break; if (_sp > XB_SPIN_CAP) { atomicAdd(&(bar)[XB_TMO], 1u); break; } } } } while (0)
struct XcdBarrier { unsigned* bar; unsigned x; volatile LAS unsigned* st; };
__device__ __forceinline__ XcdBarrier xcd_barrier_post(unsigned* bar, volatile LAS unsigned* st) {
    XcdBarrier b; b.bar = bar; b.x = xb_xcc_id(); b.st = st;
    if (threadIdx.x == 0) (void)xb_add(&bar[XB_XCNT(b.x)], 1u);
    return b;
}
__device__ __forceinline__ void xcd_barrier_complete(unsigned* bar, unsigned x, unsigned& nloc, unsigned& nx) {
    const unsigned G = gridDim.x * gridDim.y * gridDim.z;
    unsigned sum, cnt, mine, sp = 0u;
    for (;;) {
        sum = 0u; cnt = 0u; mine = 0u;
#pragma unroll
        for (unsigned j = 0; j < 16; ++j) { const unsigned c = xb_ld(&bar[XB_XCNT(j)]); sum += c; cnt += (c > 0u) ? 1u : 0u; mine = (j == x) ? c : mine; }
        if (sum == G) break;
        __builtin_amdgcn_s_sleep(1);
        if ((++sp & 255u) == 0u) { if (xb_ld(&bar[XB_TMO])) break; if (sp > XB_SPIN_CAP) { atomicAdd(&bar[XB_TMO], 1u); break; } }
    }
    nloc = mine > 0u ? mine : 1u; nx = cnt > 0u ? cnt : 1u;
}
__device__ __forceinline__ void xcd_barrier(const XcdBarrier& b) {
    asm volatile("s_waitcnt vmcnt(0)" ::: "memory");
    __syncthreads();
    if (threadIdx.x == 0) {
        unsigned* bar = b.bar;
        __builtin_amdgcn_s_waitcnt(0);
        unsigned nloc = b.st[0], nx = b.st[1];
        if (nloc == 0u) { xcd_barrier_complete(bar, b.x, nloc, nx); b.st[0] = nloc; b.st[1] = nx; }
        const unsigned old = xb_add(&bar[XB_XSUB(b.x)], 1u);
        const unsigned gen = old / nloc;
        if (old + 1u == (gen + 1u) * nloc) {
            __builtin_amdgcn_fence(__ATOMIC_RELEASE, "agent");
            asm volatile("s_waitcnt vmcnt(0)" ::: "memory");
            const unsigned og = xb_add(&bar[XB_TOP], 1u);
            const unsigned tg = og / nx;
            if (og + 1u == (tg + 1u) * nx) xb_add(&bar[XB_TOPGEN], 1u);
            else XB_SPIN(xb_ld(&bar[XB_TOPGEN]) == tg, bar);
            __builtin_amdgcn_fence(__ATOMIC_ACQUIRE, "agent");
            xb_add(&bar[XB_XGEN(b.x)], 1u);
            asm volatile("s_waitcnt vmcnt(0)" ::: "memory");
        } else {
            XB_SPIN(xb_ld(&bar[XB_XGEN(b.x)]) == gen, bar);
            __builtin_amdgcn_fence(__ATOMIC_ACQUIRE, "agent");
            asm volatile("s_waitcnt vmcnt(0)" ::: "memory");
        }
    }
    __syncthreads();
}

struct Ctx { LAS unsigned char* lds; int tid, lane, wave, G, bid, gw, ngw, gtid, ngt; };

__device__ __forceinline__ void transpose_item(const float* W, int ldw, int K, bf16* WT, int row_off, int row_mul, LAS float* scr, int kb, int nb, int lane) {
    const int k0 = 64 * kb, n0 = 32 * nb;
    float tv[32]; const float* wp = W + (size_t)(k0 + (lane >> 5)) * ldw + n0 + (lane & 31);
#pragma unroll
    for (int i = 0; i < 32; ++i) tv[i] = wp[(size_t)(2 * i) * ldw];
#pragma unroll
    for (int i = 0; i < 32; ++i) scr[(2 * i + (lane >> 5)) * 33 + (lane & 31)] = tv[i];
    LDS_WAIT(); asm volatile("" ::: "memory");
    const int c = lane & 7;
#pragma unroll
    for (int j = 0; j < 4; ++j) { const int n = (lane >> 3) + 8 * j; const LAS float* s = scr + (8 * c) * 33 + n;
        u32x4 o; o.x = pk2(s[0 * 33], s[1 * 33]); o.y = pk2(s[2 * 33], s[3 * 33]); o.z = pk2(s[4 * 33], s[5 * 33]); o.w = pk2(s[6 * 33], s[7 * 33]);
        *(u32x4*)(WT + (size_t)(row_off + (n0 + n) * row_mul) * K + k0 + 8 * c) = o; }
    LDS_WAIT(); asm volatile("" ::: "memory");
}
__device__ __forceinline__ void conv_job(const Ctx& c, const float* W, int ldw, int K, int N, bf16* WT) {
    LAS float* scr = (LAS float*)(c.lds + c.wave * 16384);
    const int nblk = N / 32, items = (K / 64) * nblk;
    for (int it = c.gw; it < items; it += c.ngw) transpose_item(W, ldw, K, WT, 0, 1, scr, it / nblk, it % nblk, c.lane);
}
__device__ __forceinline__ void conv_moe(const Ctx& c, const float* Wg, const float* Wu, const float* Wd, bf16* WGU, bf16* WD, int gw0, int ngw0) {
    LAS float* scr = (LAS float*)(c.lds + c.wave * 16384);
    constexpr int PER = 768;
    for (int it = gw0; it < 3 * NE * PER; it += ngw0) {
        const int kind = it / (NE * PER), r = it % (NE * PER), e = r / PER, q = r % PER;
        if (kind < 2) transpose_item((kind == 0 ? Wg : Wu) + (size_t)e * D * DE, DE, D, WGU + (size_t)e * GU_N * D, kind, 2, scr, q / 24, q % 24, c.lane);
        else transpose_item(Wd + (size_t)e * DE * D, D, DE, WD + (size_t)e * D * DE, 0, 1, scr, q / 64, q % 64, c.lane);
    }
}
__device__ __forceinline__ void x_to_bf16(const Ctx& c, const float* x, bf16* XB) {
    for (size_t i = c.gtid; i < (size_t)T * D / 8; i += c.ngt) { const f32x4 a = ((const f32x4*)x)[2 * i], b = ((const f32x4*)x)[2 * i + 1];
        u32x4 o; o.x = pk2(a.x, a.y); o.y = pk2(a.z, a.w); o.z = pk2(b.x, b.y); o.w = pk2(b.z, b.w); ((u32x4*)XB)[i] = o; }
}
__device__ __forceinline__ void rope_table(const Ctx& c, f32x2* tab) {
    for (int i = c.gtid; i < SEQ * 16; i += c.ngt) { const int pos = i >> 4, j = i & 15;
        const float inv = powf(500000.0f, -(float)j / 16.0f); const float ang = (float)pos * inv;
        tab[i] = (f32x2){cosf(ang), sinf(ang)}; }
}

__device__ __forceinline__ void rope_pass(const Ctx& c, bf16* QKV, const f32x2* tab) {
    for (int idx = c.gtid; idx < T * 48; idx += c.ngt) {
        const int h = idx & 7, s = (idx >> 3) & 1, g = (idx >> 4) % 3, tok = idx / 48, pos = tok & (SEQ - 1);
        u32x4* p = (u32x4*)(QKV + (size_t)tok * QKV_N + g * 3072 + s * 1024 + h * HD);
        u32x4 a0 = p[0], a1 = p[1], b0 = p[2], b1 = p[3];
        const f32x2* tb = tab + pos * 16;
        unsigned x1[8] = {a0.x, a0.y, a0.z, a0.w, a1.x, a1.y, a1.z, a1.w}, x2[8] = {b0.x, b0.y, b0.z, b0.w, b1.x, b1.y, b1.z, b1.w};
        unsigned o1[8], o2[8];
#pragma unroll
        for (int k = 0; k < 8; ++k) { const f32x2 cs0 = tb[2 * k], cs1 = tb[2 * k + 1];
            const float u0 = bflo(x1[k]), u1 = bfhi(x1[k]), v0 = bflo(x2[k]), v1 = bfhi(x2[k]);
            o1[k] = pk2(u0 * cs0.x - v0 * cs0.y, u1 * cs1.x - v1 * cs1.y);
            o2[k] = pk2(v0 * cs0.x + u0 * cs0.y, v1 * cs1.x + u1 * cs1.y); }
        p[0] = (u32x4){o1[0], o1[1], o1[2], o1[3]}; p[1] = (u32x4){o1[4], o1[5], o1[6], o1[7]};
        p[2] = (u32x4){o2[0], o2[1], o2[2], o2[3]}; p[3] = (u32x4){o2[4], o2[5], o2[6], o2[7]};
    }
}

__device__ __forceinline__ void attn_naive(const Ctx& c, const bf16* QKV, bf16* O) {
    const int sub = c.gtid & 3;
    for (int q = c.gtid >> 2; q < T * NH; q += c.ngt >> 2) {
        const int tok = q >> 3, h = q & 7, b = tok >> 11, t = tok & (SEQ - 1);
        float m = -1e30f, l = 0.f; float o[32];
#pragma unroll
        for (int i = 0; i < 32; ++i) o[i] = 0.f;
        for (int g = 0; g < 3; ++g) {
            const int dil = g == 0 ? 1 : (g == 1 ? 4 : 16);
            const u32x4* qp = (const u32x4*)(QKV + (size_t)tok * QKV_N + g * 3072 + h * HD + sub * 32);
            float qf[32];
#pragma unroll
            for (int i = 0; i < 4; ++i) { const u32x4 w = qp[i]; qf[8 * i + 0] = bflo(w.x); qf[8 * i + 1] = bfhi(w.x); qf[8 * i + 2] = bflo(w.y); qf[8 * i + 3] = bfhi(w.y);
                qf[8 * i + 4] = bflo(w.z); qf[8 * i + 5] = bfhi(w.z); qf[8 * i + 6] = bflo(w.w); qf[8 * i + 7] = bfhi(w.w); }
            for (int i = 0; i <= 128; ++i) {
                const int pos = t - dil * i; const bool valid = pos >= 0; const int pc = valid ? pos : t;
                const bf16* rowp = QKV + (size_t)(b * SEQ + pc) * QKV_N + g * 3072 + h * HD + sub * 32;
                const u32x4* kp = (const u32x4*)(rowp + 1024); const u32x4* vp = (const u32x4*)(rowp + 2048);
                float dot = 0.f;
#pragma unroll
                for (int j = 0; j < 4; ++j) { const u32x4 w = kp[j];
                    dot += qf[8 * j + 0] * bflo(w.x) + qf[8 * j + 1] * bfhi(w.x) + qf[8 * j + 2] * bflo(w.y) + qf[8 * j + 3] * bfhi(w.y)
                         + qf[8 * j + 4] * bflo(w.z) + qf[8 * j + 5] * bfhi(w.z) + qf[8 * j + 6] * bflo(w.w) + qf[8 * j + 7] * bfhi(w.w); }
                dot += __shfl_xor(dot, 1); dot += __shfl_xor(dot, 2);
                float s = dot * 0.08838834764831845f; if (!valid) s = -__builtin_inff();
                const float mn = fmaxf(m, s), al = __expf(m - mn), p = __expf(s - mn);
                l = l * al + p; m = mn;
#pragma unroll
                for (int j = 0; j < 4; ++j) { const u32x4 w = vp[j];
                    o[8 * j + 0] = o[8 * j + 0] * al + p * bflo(w.x); o[8 * j + 1] = o[8 * j + 1] * al + p * bfhi(w.x);
                    o[8 * j + 2] = o[8 * j + 2] * al + p * bflo(w.y); o[8 * j + 3] = o[8 * j + 3] * al + p * bfhi(w.y);
                    o[8 * j + 4] = o[8 * j + 4] * al + p * bflo(w.z); o[8 * j + 5] = o[8 * j + 5] * al + p * bfhi(w.z);
                    o[8 * j + 6] = o[8 * j + 6] * al + p * bflo(w.w); o[8 * j + 7] = o[8 * j + 7] * al + p * bfhi(w.w); }
            }
        }
        const float rl = 1.f / l;
        u32x4* op = (u32x4*)(O + (size_t)tok * OD + h * HD + sub * 32);
#pragma unroll
        for (int j = 0; j < 4; ++j) op[j] = (u32x4){pk2(o[8 * j] * rl, o[8 * j + 1] * rl), pk2(o[8 * j + 2] * rl, o[8 * j + 3] * rl), pk2(o[8 * j + 4] * rl, o[8 * j + 5] * rl), pk2(o[8 * j + 6] * rl, o[8 * j + 7] * rl)};
    }
}

template <int SRC, bool FINAL>
__device__ __forceinline__ void ln_row(const Ctx& c, int row, f32x4 (&v)[8], const bf16* PRE, float* OUT, const bf16* YB, bf16* XB, const float* lng, const float* lnb) {
    if (SRC == 0) { const u32x2* p = (const u32x2*)(PRE + (size_t)row * D) + c.lane;
#pragma unroll
        for (int j = 0; j < 8; ++j) { const u32x2 a = p[64 * j]; v[j] = (f32x4){bflo(a.x), bfhi(a.x), bflo(a.y), bfhi(a.y)}; } }
    else { const u32x2* p = (const u32x2*)(XB + (size_t)row * D) + c.lane; const u32x2* y0 = (const u32x2*)(YB + (size_t)(2 * row) * D) + c.lane; const u32x2* y1 = y0 + D / 4;
#pragma unroll
        for (int j = 0; j < 8; ++j) { const u32x2 xf = p[64 * j], a = y0[64 * j], b = y1[64 * j];
            v[j] = (f32x4){ALPHA * bflo(xf.x) + bflo(a.x) + bflo(b.x), ALPHA * bfhi(xf.x) + bfhi(a.x) + bfhi(b.x), ALPHA * bflo(xf.y) + bflo(a.y) + bflo(b.y), ALPHA * bfhi(xf.y) + bfhi(a.y) + bfhi(b.y)}; } }
    float s = 0.f;
#pragma unroll
    for (int j = 0; j < 8; ++j) s += (v[j].x + v[j].y) + (v[j].z + v[j].w);
    const float mean = wave_sum(s) * (1.f / D); float s2 = 0.f;
#pragma unroll
    for (int j = 0; j < 8; ++j) { v[j] = v[j] - mean; s2 += (v[j].x * v[j].x + v[j].y * v[j].y) + (v[j].z * v[j].z + v[j].w * v[j].w); }
    const float rstd = 1.f / sqrtf(wave_sum(s2) * (1.f / D) + LN_EPS);
    f32x4* xo = (f32x4*)(OUT + (size_t)row * D) + c.lane; u32x2* bo = (u32x2*)(XB + (size_t)row * D) + c.lane;
#pragma unroll
    for (int j = 0; j < 8; ++j) { const f32x4 g = ((const f32x4*)lng)[64 * j + c.lane], b = ((const f32x4*)lnb)[64 * j + c.lane];
        v[j] = v[j] * rstd * g + b; if (FINAL) xo[64 * j] = v[j]; else bo[64 * j] = (u32x2){pk2(v[j].x, v[j].y), pk2(v[j].z, v[j].w)}; }
}
__device__ __forceinline__ float lane_xor16(float v) { auto r = __builtin_amdgcn_permlane16_swap(__builtin_bit_cast(unsigned, v), __builtin_bit_cast(unsigned, v), false, false);
    return __builtin_bit_cast(float, (threadIdx.x & 16) ? r[0] : r[1]); }
__device__ __forceinline__ float reduce16(float (&d)[16], int lane) {
    float a8[8], a4[4], a2[2];
    { const bool up = lane & 32;
#pragma unroll
      for (int e = 0; e < 8; ++e) { const float keep = up ? d[e + 8] : d[e], send = up ? d[e] : d[e + 8]; a8[e] = keep + lane_xor32(send); } }
    { const bool up = lane & 16;
#pragma unroll
      for (int e = 0; e < 4; ++e) { const float keep = up ? a8[e + 4] : a8[e], send = up ? a8[e] : a8[e + 4]; a4[e] = keep + lane_xor16(send); } }
    { const bool up = lane & 8;
#pragma unroll
      for (int e = 0; e < 2; ++e) { const float keep = up ? a4[e + 2] : a4[e], send = up ? a4[e] : a4[e + 2]; a2[e] = keep + dppx<0x128>(send); } }
    float a1; { const bool up = lane & 4; const float keep = up ? a2[1] : a2[0], send = up ? a2[0] : a2[1]; a1 = keep + dppx<0x141>(send); }
    a1 += dppx<0x4E>(a1); a1 += dppx<0xB1>(a1);
    return a1;
}
template <int SRC, int EXTRA, bool FINAL>
__device__ __forceinline__ void ln_pass(const Ctx& c, const bf16* PRE, float* OUT, const bf16* YB, bf16* XB, const float* lng, const float* lnb,
                                        const float* wsrc, int wld, int woff, const float* wbias, int* eid, float* egate, int* hist, float* gates_out) {
    LAS float* wT = (LAS float*)c.lds;
    LAS int* lh = (LAS int*)(c.lds + LDSCTL_OFF + LC_HIST);
    LAS float* lg = (LAS float*)(c.lds + LDSCTL_OFF + 1024) + c.wave * 64;
    if (EXTRA) { for (int idx = c.tid; idx < 16 * D; idx += NTHR) { const int k = idx >> 4, e = idx & 15; wT[e * D + k] = wsrc[(size_t)k * wld + woff + e]; } }
    const int myel = ((c.lane >> 5) & 1) * 8 + ((c.lane >> 4) & 1) * 4 + ((c.lane >> 3) & 1) * 2 + ((c.lane >> 2) & 1);
    for (int vb = c.bid; vb < 256; vb += c.G) {
        if (EXTRA == 1) { if (c.tid < 16) lh[c.tid] = 0; }
        __syncthreads();
        for (int i = 0; i < 8; ++i) {
            const int row0 = vb * 128 + c.wave * 16 + 2 * i;
            f32x4 va[8], vc[8];
            ln_row<SRC, FINAL>(c, row0, va, PRE, OUT, YB, XB, lng, lnb);
            ln_row<SRC, FINAL>(c, row0 + 1, vc, PRE, OUT, YB, XB, lng, lnb);
            if (EXTRA) {
                float da[16], dc[16];
#pragma unroll
                for (int e = 0; e < 16; ++e) { float a = 0.f, b = 0.f;
#pragma unroll
                    for (int j = 0; j < 8; ++j) { const f32x4 w = *(const LAS f32x4*)(wT + e * D + 256 * j + 4 * c.lane);
                        a += (va[j].x * w.x + va[j].y * w.y) + (va[j].z * w.z + va[j].w * w.w); b += (vc[j].x * w.x + vc[j].y * w.y) + (vc[j].z * w.z + vc[j].w * w.w); }
                    da[e] = a; dc[e] = b; }
                const float ra = reduce16(da, c.lane) + wbias[myel], rc = reduce16(dc, c.lane) + wbias[myel];
                if ((c.lane & 3) == 0) { lg[myel] = ra; lg[16 + myel] = rc; }
                LDS_WAIT(); asm volatile("" ::: "memory");
#pragma unroll
                for (int rr = 0; rr < 2; ++rr) { const int row = row0 + rr;
                    float dot[16];
#pragma unroll
                    for (int q = 0; q < 4; ++q) { const f32x4 t = *(const LAS f32x4*)(lg + 16 * rr + 4 * q); dot[4 * q] = t.x; dot[4 * q + 1] = t.y; dot[4 * q + 2] = t.z; dot[4 * q + 3] = t.w; }
                    if (EXTRA == 1) {
                        float mx = dot[0];
#pragma unroll
                        for (int e = 1; e < 16; ++e) mx = fmaxf(mx, dot[e]);
                        float p[16];
#pragma unroll
                        for (int e = 0; e < 16; ++e) p[e] = __expf(dot[e] - mx);
                        float bestsc = -1.f, bp1 = 0.f, bp2 = 0.f; int be1 = 0, be2 = 0;
#pragma unroll
                        for (int g = 0; g < 4; ++g) { const float a0 = p[4 * g], a1 = p[4 * g + 1], a2 = p[4 * g + 2], a3 = p[4 * g + 3];
                            int i1 = 0; float p1 = a0; if (a1 > p1) { p1 = a1; i1 = 1; } if (a2 > p1) { p1 = a2; i1 = 2; } if (a3 > p1) { p1 = a3; i1 = 3; }
                            int i2 = 0; float p2 = -1.f;
                            if (i1 != 0 && a0 > p2) { p2 = a0; i2 = 0; } if (i1 != 1 && a1 > p2) { p2 = a1; i2 = 1; } if (i1 != 2 && a2 > p2) { p2 = a2; i2 = 2; } if (i1 != 3 && a3 > p2) { p2 = a3; i2 = 3; }
                            const float sc = p1 + p2; if (sc > bestsc) { bestsc = sc; be1 = 4 * g + i1; be2 = 4 * g + i2; bp1 = p1; bp2 = p2; } }
                        if (c.lane == 0) { const float inv = 1.f / (bp1 + bp2); eid[2 * row] = be1; eid[2 * row + 1] = be2; egate[2 * row] = bp1 * inv; egate[2 * row + 1] = bp2 * inv;
                            __hip_atomic_fetch_add(lh + be1, 1, __ATOMIC_RELAXED, __HIP_MEMORY_SCOPE_WORKGROUP); __hip_atomic_fetch_add(lh + be2, 1, __ATOMIC_RELAXED, __HIP_MEMORY_SCOPE_WORKGROUP); }
                    } else {
                        float mine = 0.f;
#pragma unroll
                        for (int e = 0; e < 16; ++e) { if (c.lane == e) mine = dot[e]; }
                        if (c.lane >= 8) mine = fminf(mine, 0.f) - log1pf(expf(-fabsf(mine)));
                        if (c.lane < 16) gates_out[(size_t)row * 16 + c.lane] = mine;
                    }
                }
                asm volatile("" ::: "memory");
            }
        }
        __syncthreads();
        if (EXTRA == 1) { if (c.tid < 16) hist[vb * 16 + c.tid] = lh[c.tid]; }
    }
}

__device__ __forceinline__ void route2(const Ctx& c, const int* eid, const int* hist, int* rowmap, int* tile_e) {
    LAS int* sm = (LAS int*)c.lds;
    for (int vb = c.bid; vb < 256; vb += c.G) {
        __syncthreads();
        if (c.tid < 16) { int tot = 0, bef = 0; for (int b = 0; b < 256; ++b) { const int hv = hist[b * 16 + c.tid]; tot += hv; if (b < vb) bef += hv; } sm[c.tid] = tot; sm[16 + c.tid] = bef; }
        __syncthreads();
        if (c.tid < 16) { int st = 0; for (int e = 0; e < c.tid; ++e) st += (sm[e] + 255) >> 8; st <<= 8;
            int pos = st + sm[16 + c.tid];
            for (int i = 0; i < 256; ++i) { const int a = vb * 256 + i; if (eid[a] == c.tid) { rowmap[pos] = a; ++pos; } }
            if (vb == 0) { const int nt = (sm[c.tid] + 255) >> 8;
                for (int k = 0; k < nt; ++k) tile_e[(st >> 8) + k] = c.tid;
                for (int r = st + sm[c.tid]; r < st + nt * 256; ++r) rowmap[r] = -1;
                if (c.tid == 15) tile_e[MAXTILES] = (st >> 8) + nt; } }
    }
}
__device__ __forceinline__ void gather_rows(const Ctx& c, const bf16* XB, const int* rowmap, const int* tile_e, bf16* XG) {
    const int nrows = tile_e[MAXTILES] * 256;
    for (int r = c.gw; r < nrows; r += c.ngw) { const int a = rowmap[r]; u32x4* dst = (u32x4*)(XG + (size_t)r * D) + c.lane;
        if (a >= 0) { const u32x4* src = (const u32x4*)(XB + (size_t)(a >> 1) * D) + c.lane;
#pragma unroll
            for (int j = 0; j < 4; ++j) dst[64 * j] = src[64 * j]; }
        else {
#pragma unroll
            for (int j = 0; j < 4; ++j) dst[64 * j] = (u32x4){0u, 0u, 0u, 0u}; } }
}

constexpr int CONV_ROWS = 16;
__device__ __forceinline__ void conv_pass(const Ctx& c, const bf16* Z, const float* cw, const float* cb, bf16* QKC) {
    for (int idx = c.gtid; idx < (T / CONV_ROWS) * 256; idx += c.ngt) {
        const int c0 = (idx & 255) * 8, tok0 = (idx >> 8) * CONV_ROWS, t0 = tok0 & (SEQ - 1);
        float w[4][8], bias[8];
#pragma unroll
        for (int j = 0; j < 4; ++j) { const f32x4 w0 = *(const f32x4*)(cw + j * 2048 + c0), w1 = *(const f32x4*)(cw + j * 2048 + c0 + 4); w[j][0] = w0.x; w[j][1] = w0.y; w[j][2] = w0.z; w[j][3] = w0.w; w[j][4] = w1.x; w[j][5] = w1.y; w[j][6] = w1.z; w[j][7] = w1.w; }
        { const f32x4 b0 = *(const f32x4*)(cb + c0), b1 = *(const f32x4*)(cb + c0 + 4); bias[0] = b0.x; bias[1] = b0.y; bias[2] = b0.z; bias[3] = b0.w; bias[4] = b1.x; bias[5] = b1.y; bias[6] = b1.z; bias[7] = b1.w; }
        const float sc = c0 >= 1024 ? 0.08838834764831845f : 1.f;
        u32x4 zr[CONV_ROWS + 3];
#pragma unroll
        for (int r = 0; r < CONV_ROWS + 3; ++r) { const int tt = t0 - 3 + r; zr[r] = tt >= 0 ? *(const u32x4*)(Z + (size_t)(tok0 - 3 + r) * ZN + c0) : (u32x4){0u, 0u, 0u, 0u}; }
#pragma unroll
        for (int r = 0; r < CONV_ROWS; ++r) { float acc[8];
#pragma unroll
            for (int k = 0; k < 8; ++k) acc[k] = bias[k];
#pragma unroll
            for (int j = 0; j < 4; ++j) { const u32x4 z = zr[r + j];
                acc[0] += bflo(z.x) * w[j][0]; acc[1] += bfhi(z.x) * w[j][1]; acc[2] += bflo(z.y) * w[j][2]; acc[3] += bfhi(z.y) * w[j][3];
                acc[4] += bflo(z.z) * w[j][4]; acc[5] += bfhi(z.z) * w[j][5]; acc[6] += bflo(z.w) * w[j][6]; acc[7] += bfhi(z.w) * w[j][7]; }
#pragma unroll
            for (int k = 0; k < 8; ++k) acc[k] = acc[k] / (1.f + __expf(-acc[k])) * sc;
            *(u32x4*)(QKC + (size_t)(tok0 + r) * 2048 + c0) = (u32x4){pk2(acc[0], acc[1]), pk2(acc[2], acc[3]), pk2(acc[4], acc[5]), pk2(acc[6], acc[7])}; }
    }
}
__device__ __forceinline__ void mlstm_naive(const Ctx& c, const bf16* QKC, const bf16* Z, const float* GATES, bf16* HC) {
    LAS float* Qs = (LAS float*)c.lds; LAS float* Ks = Qs + 2048; LAS float* Vs = Ks + 2048; LAS float* LI = Vs + 2048; LAS float* LF = LI + 16; LAS float* DEN = LF + 16; LAS float* MEX = DEN + 16; LAS float* NUM = MEX + 16;
    const bool colthr = c.tid < 128, nthr = (c.wave == 2);
    for (int u = c.bid; u < 256; u += c.G) {
        const int b = u >> 4, h = (u >> 1) & 7, vh = u & 1;
        float C[128];
#pragma unroll
        for (int d = 0; d < 128; ++d) C[d] = 0.f;
        float m = -1e30f;
        for (int grp = 0; grp < 128; ++grp) {
            const int tok0 = b * SEQ + grp * 16;
#pragma unroll
            for (int k = 0; k < 12; ++k) { const int e = c.tid + NTHR * k, which = e >> 11, r = e & 2047, s = r >> 7, d = r & 127;
                const bf16* src = which == 0 ? QKC + (size_t)(tok0 + s) * 2048 + h * 128 + d : (which == 1 ? QKC + (size_t)(tok0 + s) * 2048 + 1024 + h * 128 + d : Z + (size_t)(tok0 + s) * ZN + 2048 + h * 256 + vh * 128 + d);
                Qs[e] = bf1(*src); }
            if (c.tid < 16) { LI[c.tid] = GATES[(size_t)(tok0 + c.tid) * 16 + h]; LF[c.tid] = GATES[(size_t)(tok0 + c.tid) * 16 + 8 + h]; }
            __syncthreads();
            if (colthr || nthr) {
                for (int s = 0; s < 16; ++s) {
                    const float lf = LF[s], li = LI[s], mn = fmaxf(lf + m, li), fd = __expf(lf + m - mn), iw = __expf(li - mn); m = mn;
                    const float vv = nthr ? 1.f : Vs[s * 128 + (c.tid & 127)]; const float kv = iw * vv; float acc = 0.f;
#pragma unroll
                    for (int d4 = 0; d4 < 32; ++d4) { const f32x4 k4 = *(const LAS f32x4*)(Ks + s * 128 + 4 * d4), q4 = *(const LAS f32x4*)(Qs + s * 128 + 4 * d4);
                        C[4 * d4 + 0] = fd * C[4 * d4 + 0] + kv * k4.x; acc += q4.x * C[4 * d4 + 0];
                        C[4 * d4 + 1] = fd * C[4 * d4 + 1] + kv * k4.y; acc += q4.y * C[4 * d4 + 1];
                        C[4 * d4 + 2] = fd * C[4 * d4 + 2] + kv * k4.z; acc += q4.z * C[4 * d4 + 2];
                        C[4 * d4 + 3] = fd * C[4 * d4 + 3] + kv * k4.w; acc += q4.w * C[4 * d4 + 3]; }
                    if (nthr) { if (c.lane == 0) { DEN[s] = acc; MEX[s] = __expf(-mn); } } else NUM[s * 128 + c.tid] = acc;
                }
            }
            __syncthreads();
            if (colthr) {
                for (int s = 0; s < 16; ++s) { const float hv = NUM[s * 128 + c.tid] / fmaxf(fabsf(DEN[s]), MEX[s]);
                    HC[(size_t)(tok0 + s) * 2048 + h * 256 + vh * 128 + c.tid] = (bf16)f2bf(hv); }
            }
        }
        __syncthreads();
    }
}
__device__ __forceinline__ void headnorm_pass(const Ctx& c, const bf16* HC, const bf16* Z, const float* ng, bf16* Y) {
    for (int it = c.gw; it < T * 2; it += c.ngw) { const int tok = it >> 1, h0 = (it & 1) * 4;
        u32x2 hw[4], ow[4]; f32x4 g[4];
#pragma unroll
        for (int q = 0; q < 4; ++q) { hw[q] = *((const u32x2*)(HC + (size_t)tok * 2048 + (h0 + q) * 256) + c.lane); ow[q] = *((const u32x2*)(Z + (size_t)tok * ZN + 4096 + (h0 + q) * 256) + c.lane); g[q] = *((const f32x4*)(ng + (h0 + q) * 256) + c.lane); }
#pragma unroll
        for (int q = 0; q < 4; ++q) {
            float x0 = bflo(hw[q].x), x1 = bfhi(hw[q].x), x2 = bflo(hw[q].y), x3 = bfhi(hw[q].y);
            const float mean = wave_sum((x0 + x1) + (x2 + x3)) * (1.f / 256.f); x0 -= mean; x1 -= mean; x2 -= mean; x3 -= mean;
            const float rstd = 1.f / sqrtf(wave_sum((x0 * x0 + x1 * x1) + (x2 * x2 + x3 * x3)) * (1.f / 256.f) + LN_EPS);
            const float y0 = x0 * rstd * g[q].x / (1.f + __expf(-bflo(ow[q].x))), y1 = x1 * rstd * g[q].y / (1.f + __expf(-bfhi(ow[q].x))), y2 = x2 * rstd * g[q].z / (1.f + __expf(-bflo(ow[q].y))), y3 = x3 * rstd * g[q].w / (1.f + __expf(-bfhi(ow[q].y)));
            *((u32x2*)(Y + (size_t)tok * 2048 + (h0 + q) * 256) + c.lane) = (u32x2){pk2(y0, y1), pk2(y2, y3)}; }
    }
}

namespace att {
typedef short bf16x8 __attribute__((ext_vector_type(8)));
typedef short s16x4 __attribute__((ext_vector_type(4)));
typedef float f32x16 __attribute__((ext_vector_type(16)));
constexpr float SCALE = 0.08838834764831845f, THR = 8.f;
constexpr int SHM = 16384;
#define KSWZ(row, colB) ((row) * 256 + ((colB) ^ (((row) & 7) << 4)))
#define SBAR() __builtin_amdgcn_sched_barrier(0)
__device__ __forceinline__ int v_st(int k, int c) { const int kk = (k & ~0xC) | ((k & 4) << 1) | ((k & 8) >> 1); return ((kk >> 3) * 4 + (c >> 5)) * 512 + ((kk & 7) * 32 + (c & 31)) * 2; }
__device__ __forceinline__ int v_rd_base(int lane) { return ((lane & 3) << 3) | (((lane >> 2) & 3) << 6) | (((lane >> 4) & 1) << 5) | (((lane >> 5) & 1) << 8); }
constexpr int v_rd_off(int d0, int ks, int half) { return d0 * 512 + ks * 4096 + half * 2048; }
__device__ __forceinline__ int crow(int r, int hi) { return (r & 3) + 8 * (r >> 2) + 4 * hi; }
__device__ __forceinline__ unsigned cvtpk(float lo, float hi) { unsigned r; asm volatile("v_cvt_pk_bf16_f32 %0, %1, %2" : "=v"(r) : "v"(lo), "v"(hi)); return r; }
__device__ __forceinline__ void mask_tile(f32x16& p0, f32x16& p1, int dq, unsigned W) {
    const float NEG = -__builtin_inff();
#pragma unroll
    for (int r = 0; r < 16; ++r) { const int cc = (r & 3) + 8 * (r >> 2);
        if ((unsigned)(dq - cc) >= W) p0[r] = NEG;
        if ((unsigned)(dq - cc - 32) >= W) p1[r] = NEG; }
}
__device__ __forceinline__ void partialSM(f32x16& p0, f32x16& p1, float& m_reg, float& mn, float& alpha) {
    float pmax = p0[0];
#pragma unroll
    for (int r = 1; r < 16; ++r) pmax = fmaxf(pmax, p0[r]);
#pragma unroll
    for (int r = 0; r < 16; ++r) pmax = fmaxf(pmax, p1[r]);
    { auto rr = __builtin_amdgcn_permlane32_swap(__float_as_uint(pmax), __float_as_uint(pmax), false, false);
      pmax = fmaxf(__uint_as_float(rr[0]), __uint_as_float(rr[1])); }
    constexpr float C2 = 1.4426950408889634f * SCALE;
    if (__builtin_expect(__all((pmax - m_reg) * SCALE <= THR), 1)) { mn = m_reg; alpha = 1.f; }
    else { mn = fmaxf(m_reg, pmax); alpha = __builtin_amdgcn_exp2f((m_reg - mn) * C2); m_reg = mn; }
    const float mnL = -mn * C2;
#pragma unroll
    for (int r = 0; r < 16; ++r) p0[r] = fmaf(p0[r], C2, mnL);
#pragma unroll
    for (int r = 0; r < 16; ++r) p1[r] = fmaf(p1[r], C2, mnL);
#pragma unroll
    for (int r = 0; r < 16; ++r) p0[r] = __builtin_amdgcn_exp2f(p0[r]);
}
__device__ __forceinline__ void finishSM(f32x16& p0, f32x16& p1, float alpha, float& l_reg, bf16x8& pa0, bf16x8& pa1, bf16x8& pa2, bf16x8& pa3) {
#pragma unroll
    for (int r = 0; r < 16; ++r) p1[r] = __builtin_amdgcn_exp2f(p1[r]);
    float ps = 0;
#pragma unroll
    for (int r = 0; r < 16; ++r) ps += p0[r];
#pragma unroll
    for (int r = 0; r < 16; ++r) ps += p1[r];
    { auto rr = __builtin_amdgcn_permlane32_swap(__float_as_uint(ps), __float_as_uint(ps), false, false);
      ps = __uint_as_float(rr[0]) + __uint_as_float(rr[1]); }
    l_reg = l_reg * alpha + ps;
#define PK4(P, B_, OUT) do { unsigned a0 = cvtpk(P[B_+0], P[B_+1]), a1 = cvtpk(P[B_+2], P[B_+3]);                          \
        unsigned b0 = cvtpk(P[B_+4], P[B_+5]), b1 = cvtpk(P[B_+6], P[B_+7]);                                             \
        auto r0 = __builtin_amdgcn_permlane32_swap(a0, b0, false, false); auto r1 = __builtin_amdgcn_permlane32_swap(a1, b1, false, false); \
        u32x4 w = {r0[0], r1[0], r0[1], r1[1]}; OUT = *reinterpret_cast<bf16x8*>(&w); } while (0)
    PK4(p0, 0, pa0); PK4(p0, 8, pa1); PK4(p1, 0, pa2); PK4(p1, 8, pa3);
#undef PK4
}
template <int KB>
__device__ __forceinline__ void qkt(f32x16& p0, f32x16& p1, const LAS char* K_lds, int r32, int hi, const bf16x8* qr) {
    p0 = f32x16{}; p1 = f32x16{};
    const LAS char* kb[4];
#pragma unroll
    for (int dd = 0; dd < 4; ++dd) kb[dd] = K_lds + KB * SHM + KSWZ(r32, (dd * 16 + hi * 8) * 2);
#pragma unroll
    for (int d0 = 0; d0 < 8; ++d0) { const LAS char* a = kb[d0 & 3] + (d0 >> 2) * 128;
        bf16x8 b0 = *reinterpret_cast<const LAS bf16x8*>(a);
        bf16x8 b1 = *reinterpret_cast<const LAS bf16x8*>(a + 32 * 256);
        p0 = __builtin_amdgcn_mfma_f32_32x32x16_bf16(b0, qr[d0], p0, 0, 0, 0);
        p1 = __builtin_amdgcn_mfma_f32_32x32x16_bf16(b1, qr[d0], p1, 0, 0, 0); }
}
template <int VB>
__device__ __forceinline__ void pv_tile(f32x16* o, int vb0, bf16x8 pa0, bf16x8 pa1, bf16x8 pa2, bf16x8 pa3) {
#define TRRD(dst, off) asm volatile("ds_read_b64_tr_b16 %0, %1 offset:%2" : "=&v"(dst) : "v"(vb0), "i"(off) : "memory")
#define PV_D0(d0) do { s16x4 l0, l1, l2, l3, h0, h1, h2, h3; constexpr int b_ = VB * SHM + v_rd_off(d0, 0, 0); \
        TRRD(l0, b_); TRRD(h0, b_ + 2048); TRRD(l1, b_ + 4096); TRRD(h1, b_ + 6144); TRRD(l2, b_ + 8192); TRRD(h2, b_ + 10240); TRRD(l3, b_ + 12288); TRRD(h3, b_ + 14336); \
        asm volatile("s_waitcnt lgkmcnt(0)" ::: "memory"); SBAR();   \
        o[d0] = __builtin_amdgcn_mfma_f32_32x32x16_bf16(pa0, (bf16x8){l0[0], l0[1], l0[2], l0[3], h0[0], h0[1], h0[2], h0[3]}, o[d0], 0, 0, 0);   \
        o[d0] = __builtin_amdgcn_mfma_f32_32x32x16_bf16(pa1, (bf16x8){l1[0], l1[1], l1[2], l1[3], h1[0], h1[1], h1[2], h1[3]}, o[d0], 0, 0, 0);   \
        o[d0] = __builtin_amdgcn_mfma_f32_32x32x16_bf16(pa2, (bf16x8){l2[0], l2[1], l2[2], l2[3], h2[0], h2[1], h2[2], h2[3]}, o[d0], 0, 0, 0);   \
        o[d0] = __builtin_amdgcn_mfma_f32_32x32x16_bf16(pa3, (bf16x8){l3[0], l3[1], l3[2], l3[3], h3[0], h3[1], h3[2], h3[3]}, o[d0], 0, 0, 0); } while (0)
    PV_D0(0); PV_D0(1); PV_D0(2); PV_D0(3);
#undef PV_D0
#undef TRRD
}
template <bool FINAL>
__device__ __forceinline__ void attn_phase(const Ctx& c, const bf16* QKV, bf16* OP, float* LSE, bf16* O) {
    const int half = c.wave >> 2, w4 = c.wave & 3, r32 = c.lane & 31, hi = c.lane >> 5, l = c.lane;
    LAS char* Vl = (LAS char*)c.lds + half * 65536; LAS char* Kl = Vl + 2 * SHM;
    LAS float* wl = (LAS float*)(c.lds + LDSCTL_OFF + 1024) + c.wave * 128; LAS float* al_l = wl + 96;
    const LAS float* wl4 = wl + 4 * hi;
    const int vb0 = (int)(unsigned)(uintptr_t)Vl + v_rd_base(c.lane);
    int krow[4], kcol[4], vrow[4], vcol[4];
#pragma unroll
    for (int j = 0; j < 4; ++j) { const int blk = 4 * w4 + j; krow[j] = 4 * blk + (l >> 4); kcol[j] = (((l & 15) ^ (krow[j] & 7)) * 16) + 2048;
        const int sub = 2 * blk + (l >> 5), kk = (sub >> 2) * 8 + ((l & 31) >> 2); vrow[j] = (kk & ~0xC) | ((kk & 4) << 1) | ((kk & 8) >> 1); vcol[j] = ((sub & 3) * 32 + (l & 3) * 8) * 2 + 4096; }
    constexpr int NUNITS = FINAL ? 1024 : 2048;
    for (int idx = c.bid; idx < NUNITS; idx += c.G) {
        const int hp = idx & 3, rj = (idx >> 2) & 15, b = (idx >> 6) & 15, g = FINAL ? 0 : 1 + (idx >> 10);
        const int h = 2 * hp + half, dil = 1 << (2 * g), nbm = (16 >> (2 * g)) - 1, jb = rj & nbm, r = rj >> (4 - 2 * g);
        const unsigned rs = (unsigned)dil * QKV_N * 2u;
        const char* base = (const char*)(QKV + ((size_t)b * SEQ + r) * QKV_N + g * 3072 + h * HD);
        const int q0 = 128 * jb + 32 * w4;
        bf16x8 qr[8];
#pragma unroll
        for (int d0 = 0; d0 < 8; ++d0) qr[d0] = *(const bf16x8*)(base + ((unsigned)(q0 + r32) * rs + (unsigned)(d0 * 32 + hi * 16)));
#define A_DMA(kb_, bf_) do { _Pragma("unroll") for (int j_ = 0; j_ < 4; ++j_) { \
            __builtin_amdgcn_global_load_lds((const unsigned*)(base + ((unsigned)((kb_) + krow[j_]) * rs + (unsigned)kcol[j_])), (LAS unsigned*)(Kl + (bf_) * SHM + (4 * w4 + j_) * 1024), 16, 0, 0); \
            __builtin_amdgcn_global_load_lds((const unsigned*)(base + ((unsigned)((kb_) + vrow[j_]) * rs + (unsigned)vcol[j_])), (LAS unsigned*)(Vl + (bf_) * SHM + (4 * w4 + j_) * 1024), 16, 0, 0); } } while (0)
        float m_reg = -1e30f, l_reg = 0.f; f32x16 o[4] = {};
        const int kt0 = jb == 0 ? 2 : 0, kb0 = 128 * (jb - 1);
        A_DMA(kb0 + 64 * kt0, 0);
        asm volatile("s_waitcnt vmcnt(0)" ::: "memory"); __syncthreads();
#define A_STEP(kt_, BUF) do { const int kb_ = kb0 + 64 * (kt_); \
            if ((kt_) < 3) A_DMA(kb_ + 64, (BUF) ^ 1);                                         \
            if (kb_ <= q0 + 31 && kb_ + 63 >= q0 - 128) { f32x16 p0, p1; float mn, alpha; bf16x8 pa0, pa1, pa2, pa3; \
                qkt<BUF>(p0, p1, Kl, r32, hi, qr); mask_tile(p0, p1, q0 + r32 - kb_ - 4 * hi, 129u); partialSM(p0, p1, m_reg, mn, alpha); \
                if (__any(alpha < 1.f)) { if (hi == 0) al_l[r32] = alpha; asm volatile("s_waitcnt lgkmcnt(0)" ::: "memory"); \
                    _Pragma("unroll") for (int d_ = 0; d_ < 4; ++d_) _Pragma("unroll") for (int r_ = 0; r_ < 16; ++r_) o[d_][r_] *= al_l[crow(r_, hi)]; } \
                finishSM(p0, p1, alpha, l_reg, pa0, pa1, pa2, pa3); SBAR(); pv_tile<BUF>(o, vb0, pa0, pa1, pa2, pa3); } \
            asm volatile("s_waitcnt vmcnt(0)" ::: "memory"); __syncthreads(); } while (0)
        for (int kt = kt0; kt < 4; kt += 2) { A_STEP(kt, 0); A_STEP(kt + 1, 1); }
#undef A_STEP
#undef A_DMA
        const float lse = m_reg * SCALE + __logf(l_reg);
        const unsigned tok0 = (unsigned)b * SEQ + r;
        if (hi == 0) { const unsigned tokq = tok0 + (unsigned)(q0 + r32) * dil; float w0 = 1.f / l_reg;
            if (FINAL) { const float l1 = LSE[tokq * 8u + h], l2 = LSE[((unsigned)T + tokq) * 8u + h]; const float M = fmaxf(lse, fmaxf(l1, l2));
                const float e0 = __expf(lse - M), e1 = __expf(l1 - M), e2 = __expf(l2 - M), inv = 1.f / (e0 + e1 + e2); w0 *= e0 * inv; wl[32 + r32] = e1 * inv; wl[64 + r32] = e2 * inv; }
            else LSE[((unsigned)(g - 1) * T + tokq) * 8u + h] = lse;
            wl[r32] = w0; }
        asm volatile("s_waitcnt lgkmcnt(0)" ::: "memory");
        LAS char* tile = Vl + (w4 < 2 ? SHM + w4 * 8192 : 3 * SHM + (w4 - 2) * 8192); LAS char* tile4 = tile + 4 * hi * 256 + r32 * 2;
#pragma unroll
        for (int r_ = 0; r_ < 16; ++r_) { const int orow = (r_ & 3) + 8 * (r_ >> 2); const float w0 = wl4[orow];
#pragma unroll
            for (int d0 = 0; d0 < 4; ++d0) { const float v = o[d0][r_] * w0; const float vn = lane_xor1(v);
                if ((r32 & 1) == 0) *(LAS unsigned*)(tile4 + orow * 256 + d0 * 64) = cvtpk(v, vn); } }
        asm volatile("s_waitcnt lgkmcnt(0)" ::: "memory");
#pragma unroll
        for (int i = 0; i < 8; ++i) { const int p = c.lane + 64 * i, row = p >> 4, ch = p & 15; const unsigned tok = tok0 + (unsigned)(q0 + row) * dil; const unsigned col8 = (unsigned)h * HD + ch * 8;
            const u32x4 x = *(const LAS u32x4*)(tile + row * 256 + ch * 16);
            if (FINAL) { const u32x4 pa = *(const u32x4*)(OP + (tok * (unsigned)OD + col8)), pb = *(const u32x4*)(OP + (((unsigned)T + tok) * (unsigned)OD + col8)); const float w1 = wl[32 + row], w2 = wl[64 + row];
                u32x4 y; y.x = cvtpk(bflo(x.x) + w1 * bflo(pa.x) + w2 * bflo(pb.x), bfhi(x.x) + w1 * bfhi(pa.x) + w2 * bfhi(pb.x)); y.y = cvtpk(bflo(x.y) + w1 * bflo(pa.y) + w2 * bflo(pb.y), bfhi(x.y) + w1 * bfhi(pa.y) + w2 * bfhi(pb.y));
                y.z = cvtpk(bflo(x.z) + w1 * bflo(pa.z) + w2 * bflo(pb.z), bfhi(x.z) + w1 * bfhi(pa.z) + w2 * bfhi(pb.z)); y.w = cvtpk(bflo(x.w) + w1 * bflo(pa.w) + w2 * bflo(pb.w), bfhi(x.w) + w1 * bfhi(pa.w) + w2 * bfhi(pb.w));
                *(u32x4*)(O + (tok * (unsigned)OD + col8)) = y; }
            else *(u32x4*)(OP + (((unsigned)(g - 1) * T + tok) * (unsigned)OD + col8)) = x; }
    }
}
#undef KSWZ
#undef SBAR
}

namespace mls {
using att::bf16x8; using att::s16x4; using att::f32x16; using att::v_st; using att::v_rd_base; using att::crow; using att::cvtpk;
constexpr int RSB = 272;
constexpr int L_QP = 0, L_KP = 17408, L_KTR = 34816, L_VTR = 51200, L_AM = 83968, L_RS = 93184, L_QN = 94208, L_WINT = 94464, L_MEXP = 94720, L_HDEN = 94976  ;
constexpr int AMB = 144;
#define TRRD(dst, addr, off) asm volatile("ds_read_b64_tr_b16 %0, %1 offset:%2" : "=&v"(dst) : "v"(addr), "i"(off) : "memory")
__device__ __forceinline__ void mlstm_phase(const Ctx& c, const bf16* QKC, const bf16* Z, const float* GATES, bf16* HC) {
    const int w = c.wave, l = c.lane, hi = l >> 5, r32 = l & 31, q4 = l >> 4, l15 = l & 15;
    LAS char* lds = (LAS char*)c.lds;
    const int vbK = (int)(unsigned)(uintptr_t)(lds + L_KTR) + v_rd_base(l);
    const int vbV = (int)(unsigned)(uintptr_t)(lds + L_VTR) + (w >> 2) * 16384 + (w & 3) * 512 + v_rd_base(l);
    LAS float* RS = (LAS float*)(lds + L_RS); LAS float* QN = (LAS float*)(lds + L_QN); LAS float* WINT = (LAS float*)(lds + L_WINT); LAS float* MEXP = (LAS float*)(lds + L_MEXP); LAS float* HDEN = (LAS float*)(lds + L_HDEN);
    const LAS float* wint_b = WINT + 4 * hi; const LAS float* hden_b = HDEN + 64 * w + 4 * hi;
    const LAS char* q_b = lds + L_QP + r32 * RSB + 8 * hi; const LAS char* am_b = lds + L_AM + r32 * AMB + 16 * hi;
    const LAS char* sq_b = lds + L_QP + ((16 * (w & 3)) + l15) * RSB + 16 * q4; const LAS char* sk_b = lds + L_KP + l15 * RSB + 16 * q4;
    const int hc_lane = 4 * hi * 2048 + 32 * w + r32;
    for (int unit = c.bid; unit < BATCH * 8; unit += c.G) {
        const int b = unit >> 3, h = unit & 7;
        f32x16 Ct[4] = {};
        float n0 = 0.f, n1 = 0.f, m_state = -1e30f;
        bf16x8 sq[2], sk[2], sv[4]; float g_li, g_lf;
#define M_LOAD(tok0_) do { \
            _Pragma("unroll") for (int i_ = 0; i_ < 2; ++i_) { const int p_ = c.tid + 512 * i_, row_ = p_ >> 4, c8_ = (p_ & 15) * 8; const bf16* s_ = QKC + (size_t)((tok0_) + row_) * 2048 + h * 128 + c8_; sq[i_] = *(const bf16x8*)s_; sk[i_] = *(const bf16x8*)(s_ + 1024); } \
            _Pragma("unroll") for (int i_ = 0; i_ < 4; ++i_) { const int p_ = c.tid + 512 * i_, row_ = p_ >> 5, c8_ = (p_ & 31) * 8; sv[i_] = *(const bf16x8*)(Z + (size_t)((tok0_) + row_) * ZN + 2048 + h * 256 + c8_); } \
            g_li = GATES[(size_t)((tok0_) + l) * 16 + h]; g_lf = GATES[(size_t)((tok0_) + l) * 16 + 8 + h]; } while (0)
        M_LOAD(b * SEQ);
        for (int ch = 0; ch < 32; ++ch) {
            const int tok0 = b * SEQ + ch * 64;
            const float bc = prefix_sum64(g_lf);
            const float a = g_li - bc, pm = prefix_max64(a);
            const float u = fmaxf(m_state, pm), winter = __expf(m_state - u);
            const float blast = lane_bcast(bc, 63), u63 = lane_bcast(u, 63);
            const float wk = __expf(a - u63), decay = __expf(m_state - u63), mexp = __expf(-(bc + u));
#pragma unroll
            for (int i = 0; i < 2; ++i) { const int p = c.tid + 512 * i, row = p >> 4, c8 = (p & 15) * 8;
                *(LAS bf16x8*)(lds + L_QP + row * RSB + c8 * 2) = sq[i]; *(LAS bf16x8*)(lds + L_KP + row * RSB + c8 * 2) = sk[i];
                const float wr_ = __shfl(wk, row); const u32x4 kw = *reinterpret_cast<const u32x4*>(&sk[i]);
                u32x4 o; o.x = cvtpk(bflo(kw.x) * wr_, bfhi(kw.x) * wr_); o.y = cvtpk(bflo(kw.y) * wr_, bfhi(kw.y) * wr_); o.z = cvtpk(bflo(kw.z) * wr_, bfhi(kw.z) * wr_); o.w = cvtpk(bflo(kw.w) * wr_, bfhi(kw.w) * wr_);
                *(LAS u32x4*)(lds + L_KTR + v_st(row, c8)) = o; }
#pragma unroll
            for (int i = 0; i < 4; ++i) { const int p = c.tid + 512 * i, row = p >> 5, c8 = (p & 31) * 8;
                *(LAS bf16x8*)(lds + L_VTR + (c8 >> 7) * 16384 + v_st(row, c8 & 127)) = sv[i]; }
            if (w == 0) { WINT[l] = winter; MEXP[l] = mexp; }
            if (ch + 1 < 32) M_LOAD(tok0 + 64);
            __syncthreads(); __builtin_amdgcn_sched_barrier(0);
#pragma unroll
            for (int i = 0; i < 8; ++i) { const unsigned qw = *(const LAS unsigned*)(lds + L_QP + (8 * w + i) * RSB + 4 * l); const float s_ = wave_sum(bflo(qw) * n0 + bfhi(qw) * n1); if (l == 0) QN[8 * w + i] = s_; }
            __builtin_amdgcn_sched_barrier(0);
            n0 *= decay; n1 *= decay;
#pragma unroll 8
            for (int s = 0; s < 64; ++s) { const unsigned kw = *(const LAS unsigned*)(lds + L_KP + s * RSB + 4 * l); const float ws_ = lane_bcast(wk, s); n0 += ws_ * bflo(kw); n1 += ws_ * bfhi(kw); }
            __builtin_amdgcn_sched_barrier(0);
            { const int ti = w & 3, si0 = 2 * (w >> 2);
#pragma unroll
              for (int sj = 0; sj < 2; ++sj) { const int si = si0 + sj; float av[4] = {0.f, 0.f, 0.f, 0.f};
                if (si <= ti) { f32x4 acc = {0.f, 0.f, 0.f, 0.f};
#pragma unroll
                    for (int kk = 0; kk < 4; ++kk) { const bf16x8 af = *(const LAS bf16x8*)(sq_b + 64 * kk), bfr = *(const LAS bf16x8*)(sk_b + (16 * si) * RSB + 64 * kk);
                        acc = __builtin_amdgcn_mfma_f32_16x16x32_bf16(af, bfr, acc, 0, 0, 0); }
                    const int s_ = 16 * si + l15; const float as_ = __shfl(a, s_);
#pragma unroll
                    for (int r = 0; r < 4; ++r) { const int t_ = 16 * ti + 4 * q4 + r; const float ut = __shfl(u, t_); av[r] = s_ <= t_ ? acc[r] * __expf(as_ - ut) : 0.f; } }
#pragma unroll
                for (int r = 0; r < 4; ++r) { const int t_ = 16 * ti + 4 * q4 + r; *(LAS unsigned short*)(lds + L_AM + t_ * AMB + (16 * si + l15) * 2) = (unsigned short)f2bf(av[r]);
                    const float rs_ = row16_sum(av[r]);
                    if (l15 == 0) RS[si * 64 + t_] = rs_; } } }
            __syncthreads(); __builtin_amdgcn_sched_barrier(0);
            { const float den = ((RS[l] + RS[64 + l]) + (RS[128 + l] + RS[192 + l])) + winter * QN[l]; HDEN[64 * w + l] = 1.f / fmaxf(fabsf(den), mexp); }
            bf16x8 vf[4];
            { s16x4 l0, l1, l2, l3, h0, h1, h2, h3;
              TRRD(l0, vbV, 0); TRRD(h0, vbV, 2048); TRRD(l1, vbV, 4096); TRRD(h1, vbV, 6144); TRRD(l2, vbV, 8192); TRRD(h2, vbV, 10240); TRRD(l3, vbV, 12288); TRRD(h3, vbV, 14336);
              asm volatile("s_waitcnt lgkmcnt(0)" ::: "memory"); __builtin_amdgcn_sched_barrier(0);
              vf[0] = (bf16x8){l0[0], l0[1], l0[2], l0[3], h0[0], h0[1], h0[2], h0[3]}; vf[1] = (bf16x8){l1[0], l1[1], l1[2], l1[3], h1[0], h1[1], h1[2], h1[3]};
              vf[2] = (bf16x8){l2[0], l2[1], l2[2], l2[3], h2[0], h2[1], h2[2], h2[3]}; vf[3] = (bf16x8){l3[0], l3[1], l3[2], l3[3], h3[0], h3[1], h3[2], h3[3]}; }
#pragma unroll
            for (int th = 0; th < 2; ++th) { f32x16 ai = {}, ac = {};
#pragma unroll
                for (int ks = 0; ks < 4; ++ks) { if (th == 0 && ks >= 2) continue; const bf16x8 af = *(const LAS bf16x8*)(am_b + 32 * th * AMB + 32 * ks); ai = __builtin_amdgcn_mfma_f32_32x32x16_bf16(af, vf[ks], ai, 0, 0, 0); }
#pragma unroll
                for (int db = 0; db < 4; ++db)
#pragma unroll
                    for (int s2 = 0; s2 < 2; ++s2) { const LAS char* qp = q_b + 32 * th * RSB + (32 * db + 16 * s2) * 2; const u32x2 x0 = *(const LAS u32x2*)qp, x1 = *(const LAS u32x2*)(qp + 16);
                        u32x4 o = {x0.x, x0.y, x1.x, x1.y};
                        u32x4 cw; cw.x = cvtpk(Ct[db][8 * s2 + 0], Ct[db][8 * s2 + 1]); cw.y = cvtpk(Ct[db][8 * s2 + 2], Ct[db][8 * s2 + 3]); cw.z = cvtpk(Ct[db][8 * s2 + 4], Ct[db][8 * s2 + 5]); cw.w = cvtpk(Ct[db][8 * s2 + 6], Ct[db][8 * s2 + 7]);
                        ac = __builtin_amdgcn_mfma_f32_32x32x16_bf16(*reinterpret_cast<bf16x8*>(&o), *reinterpret_cast<bf16x8*>(&cw), ac, 0, 0, 0); __builtin_amdgcn_sched_barrier(0); }
#pragma unroll
                for (int r = 0; r < 16; ++r) { const int tc = 32 * th + (r & 3) + 8 * (r >> 2); const float v = (ai[r] + wint_b[tc] * ac[r]) * hden_b[tc]; const float vn = lane_xor1(v);
                    bf16* rowp = HC + (size_t)(tok0 + tc) * 2048 + h * 256;
                    if ((r32 & 1) == 0) *(unsigned*)(rowp + hc_lane) = cvtpk(v, vn); } }
            __builtin_amdgcn_sched_barrier(0);
#pragma unroll
            for (int db = 0; db < 4; ++db) { s16x4 l0, l1, l2, l3, h0, h1, h2, h3;
                TRRD(l0, vbK, db * 512 + 0); TRRD(h0, vbK, db * 512 + 2048); TRRD(l1, vbK, db * 512 + 4096); TRRD(h1, vbK, db * 512 + 6144); TRRD(l2, vbK, db * 512 + 8192); TRRD(h2, vbK, db * 512 + 10240); TRRD(l3, vbK, db * 512 + 12288); TRRD(h3, vbK, db * 512 + 14336);
#pragma unroll
                for (int r = 0; r < 16; ++r) Ct[db][r] *= decay;
                asm volatile("s_waitcnt lgkmcnt(0)" ::: "memory"); __builtin_amdgcn_sched_barrier(0);
                Ct[db] = __builtin_amdgcn_mfma_f32_32x32x16_bf16((bf16x8){l0[0], l0[1], l0[2], l0[3], h0[0], h0[1], h0[2], h0[3]}, vf[0], Ct[db], 0, 0, 0);
                Ct[db] = __builtin_amdgcn_mfma_f32_32x32x16_bf16((bf16x8){l1[0], l1[1], l1[2], l1[3], h1[0], h1[1], h1[2], h1[3]}, vf[1], Ct[db], 0, 0, 0);
                Ct[db] = __builtin_amdgcn_mfma_f32_32x32x16_bf16((bf16x8){l2[0], l2[1], l2[2], l2[3], h2[0], h2[1], h2[2], h2[3]}, vf[2], Ct[db], 0, 0, 0);
                Ct[db] = __builtin_amdgcn_mfma_f32_32x32x16_bf16((bf16x8){l3[0], l3[1], l3[2], l3[3], h3[0], h3[1], h3[2], h3[3]}, vf[3], Ct[db], 0, 0, 0); }
            m_state = blast + u63;
            __syncthreads();
        }
        __syncthreads();
    }
#undef M_LOAD
}
#undef TRRD
}

#ifndef EPI_NT
#define EPI_NT 1
#endif
#if EPI_NT
#define EPI_ST(p, v) __builtin_nontemporal_store((v), (p))
#else
#define EPI_ST(p, v) (*(p) = (v))
#endif
namespace pg8 {
struct EpiStoreBf16 { static constexpr bool PERM = true, AFTER_DRAIN = false; bf16_t* O; int ldc;
    __device__ __forceinline__ void operator()(const f32x4 (&acc)[2][2][4][2], const Unit& u, int wr, int wc, int fr, int fq) const {
        const int row0 = u.pm * BM + wr * 64 + fr, col0 = u.pn * BM + wc * 32 + 8 * fq;
#pragma unroll
        for (int ai = 0; ai < 2; ++ai)
#pragma unroll
            for (int m = 0; m < 4; ++m) { bf16_t* rowp = O + (size_t)(row0 + ai * HALF + m * 16) * ldc + col0;
#pragma unroll
                for (int bj = 0; bj < 2; ++bj) { const f32x4 v0 = acc[ai][bj][m][0], v1 = acc[ai][bj][m][1];
                    u32x4 w; w.x = cvt_pk_bf16(v0[0], v0[1]); w.y = cvt_pk_bf16(v0[2], v0[3]); w.z = cvt_pk_bf16(v1[0], v1[1]); w.w = cvt_pk_bf16(v1[2], v1[3]);
                    EPI_ST((u32x4*)(rowp + bj * HALF), w); } }
    }
};
struct EpiQKV { static constexpr bool PERM = true, AFTER_DRAIN = false; bf16_t* O; int ldc; const float* tab;
    __device__ __forceinline__ void operator()(const f32x4 (&acc)[2][2][4][2], const Unit& u, int wr, int wc, int fr, int fq) const {
        const int row0 = u.pm * BM + wr * 64 + fr, col0 = u.pn * BM + wc * 32 + 8 * fq;
        const bool rot = ((u.pn >> 2) % 3) < 2 && wc == 0;
        const float* tb = tab + 16 * (fq & 1);
        f32x4 n0 = {1.f, 0.f, 1.f, 0.f}, n1 = n0, n2 = n0, n3 = n0;
        if (rot) { const f32x4* tp = (const f32x4*)(tb + (size_t)(row0 & 2047) * 32); n0 = tp[0]; n1 = tp[1]; n2 = tp[2]; n3 = tp[3]; }
#pragma unroll
        for (int ai = 0; ai < 2; ++ai)
#pragma unroll
            for (int m = 0; m < 4; ++m) { const int row = row0 + ai * HALF + m * 16; bf16_t* rowp = O + (size_t)row * ldc + col0;
                const f32x4 t0 = n0, t1 = n1, t2 = n2, t3 = n3;
                if (rot && (ai * 4 + m) < 7) { const int nrow = row0 + ((ai * 4 + m + 1) >> 2) * HALF + ((ai * 4 + m + 1) & 3) * 16; const f32x4* tp = (const f32x4*)(tb + (size_t)(nrow & 2047) * 32); n0 = tp[0]; n1 = tp[1]; n2 = tp[2]; n3 = tp[3]; }
                const f32x4 c0 = {t0[0], t0[2], t1[0], t1[2]}, c1 = {t2[0], t2[2], t3[0], t3[2]};
                f32x4 s0 = {t0[1], t0[3], t1[1], t1[3]}, s1 = {t2[1], t2[3], t3[1], t3[3]};
                if (fq < 2) { s0 = -s0; s1 = -s1; }
#pragma unroll
                for (int bj = 0; bj < 2; ++bj) { f32x4 v0 = acc[ai][bj][m][0], v1 = acc[ai][bj][m][1];
                    if (rot) { f32x4 p0, p1;
#pragma unroll
                        for (int k = 0; k < 4; ++k) { p0[k] = lane_xor32(v0[k]); p1[k] = lane_xor32(v1[k]); }
                        v0 = v0 * c0 + p0 * s0; v1 = v1 * c1 + p1 * s1; }
                    u32x4 w; w.x = cvt_pk_bf16(v0[0], v0[1]); w.y = cvt_pk_bf16(v0[2], v0[3]); w.z = cvt_pk_bf16(v1[0], v1[1]); w.w = cvt_pk_bf16(v1[2], v1[3]);
                    EPI_ST((u32x4*)(rowp + bj * HALF), w); } }
    }
};
template <bool RES_F32> struct EpiRes { static constexpr bool PERM = true, AFTER_DRAIN = false; const void* res; bf16_t* out; int ldc; float alpha;
    __device__ __forceinline__ void operator()(const f32x4 (&acc)[2][2][4][2], const Unit& u, int wr, int wc, int fr, int fq) const {
        const int row0 = u.pm * BM + wr * 64 + fr, col0 = u.pn * BM + wc * 32 + 8 * fq;
#pragma unroll
        for (int ai = 0; ai < 2; ++ai)
#pragma unroll
            for (int m = 0; m < 4; ++m) { const size_t off = (size_t)(row0 + ai * HALF + m * 16) * ldc + col0;
#pragma unroll
                for (int bj = 0; bj < 2; ++bj) { f32x4 r0, r1;
                    if (RES_F32) { r0 = *(const f32x4*)((const float*)res + off + bj * HALF); r1 = *(const f32x4*)((const float*)res + off + bj * HALF + 4); }
                    else { const u32x4 rw = *(const u32x4*)((const bf16_t*)res + off + bj * HALF);
                        r0 = (f32x4){__builtin_bit_cast(float, rw.x << 16), __builtin_bit_cast(float, rw.x & 0xffff0000u), __builtin_bit_cast(float, rw.y << 16), __builtin_bit_cast(float, rw.y & 0xffff0000u)};
                        r1 = (f32x4){__builtin_bit_cast(float, rw.z << 16), __builtin_bit_cast(float, rw.z & 0xffff0000u), __builtin_bit_cast(float, rw.w << 16), __builtin_bit_cast(float, rw.w & 0xffff0000u)}; }
                    const f32x4 v0 = r0 * alpha + acc[ai][bj][m][0], v1 = r1 * alpha + acc[ai][bj][m][1];
                    u32x4 w; w.x = cvt_pk_bf16(v0[0], v0[1]); w.y = cvt_pk_bf16(v0[2], v0[3]); w.z = cvt_pk_bf16(v1[0], v1[1]); w.w = cvt_pk_bf16(v1[2], v1[3]);
                    EPI_ST((u32x4*)(out + off + bj * HALF), w); } }
    }
};
struct EpiSwiGLU { static constexpr bool PERM = true, AFTER_DRAIN = false; bf16_t* H;
    __device__ __forceinline__ void operator()(const f32x4 (&acc)[2][2][4][2], const Unit& u, int wr, int wc, int fr, int fq) const {
        const int row0 = u.pm * BM + wr * 64 + fr, col0 = u.pn * 128 + wc * 16 + 4 * fq;
#pragma unroll
        for (int ai = 0; ai < 2; ++ai)
#pragma unroll
            for (int m = 0; m < 4; ++m) { bf16_t* rowp = H + (size_t)(row0 + ai * HALF + m * 16) * 768 + col0;
#pragma unroll
                for (int bj = 0; bj < 2; ++bj) { const f32x4 v0 = acc[ai][bj][m][0], v1 = acc[ai][bj][m][1];
                    const float h0 = v0[0] / (1.f + __expf(-v0[0])) * v0[1], h1 = v0[2] / (1.f + __expf(-v0[2])) * v0[3], h2 = v1[0] / (1.f + __expf(-v1[0])) * v1[1], h3 = v1[2] / (1.f + __expf(-v1[2])) * v1[3];
                    typedef unsigned u32x2v __attribute__((ext_vector_type(2))); u32x2v w; w.x = cvt_pk_bf16(h0, h1); w.y = cvt_pk_bf16(h2, h3);
                    EPI_ST((u32x2v*)(rowp + bj * 64), w); } }
    }
};
struct EpiDown { static constexpr bool PERM = true, AFTER_DRAIN = false; bf16_t* YB; const int* rowmap; const float* egate;
    __device__ __forceinline__ void operator()(const f32x4 (&acc)[2][2][4][2], const Unit& u, int wr, int wc, int fr, int fq) const {
        const int row0 = u.pm * BM + wr * 64 + fr, col0 = u.pn * BM + wc * 32 + 8 * fq;
#pragma unroll
        for (int ai = 0; ai < 2; ++ai)
#pragma unroll
            for (int m = 0; m < 4; ++m) { const int a = rowmap[row0 + ai * HALF + m * 16];
                if (a >= 0) { const float gt = egate[a]; bf16_t* rowp = YB + (size_t)a * 2048 + col0;
#pragma unroll
                    for (int bj = 0; bj < 2; ++bj) { const f32x4 v0 = acc[ai][bj][m][0] * gt, v1 = acc[ai][bj][m][1] * gt;
                        u32x4 w; w.x = cvt_pk_bf16(v0[0], v0[1]); w.y = cvt_pk_bf16(v0[2], v0[3]); w.z = cvt_pk_bf16(v1[0], v1[1]); w.w = cvt_pk_bf16(v1[2], v1[3]);
                        EPI_ST((u32x4*)(rowp + bj * HALF), w); } } }
    }
};
template <bool GATHER_> struct MoeOrder { static constexpr bool GATHER = GATHER_; static constexpr int MAXU = 8;
    int nN, G, c, nt; const int* tile_e; size_t exp_bytes; const int* rowmap; PG8_LAS int* tok;
    __device__ __forceinline__ bool next(int i, Unit& u) const { const long L = (long)i * G + c; if (L >= (long)nt * nN) return false; u.pm = (int)(L / nN); u.pn = (int)(L % nN); return true; }
    __device__ __forceinline__ const char* pa(const Gemm& g, const Unit& u) const { return GATHER_ ? (const char*)g.A : (const char*)g.A + (size_t)u.pm * ((size_t)BM * g.K * 2); }
    __device__ __forceinline__ const char* pb(const Gemm& g, const Unit& u) const { const int e = __builtin_amdgcn_readfirstlane(tok[MAXU * 256 + u.pm]); return (const char*)g.Bt + (size_t)e * exp_bytes + (size_t)u.pn * ((size_t)BM * g.K * 2); }
    __device__ __forceinline__ void prep() const {
        if ((int)threadIdx.x < nt) tok[MAXU * 256 + threadIdx.x] = tile_e[threadIdx.x];
        if (GATHER_) { for (int i = 0; i < MAXU; ++i) { Unit u; if (!next(i, u)) break; if (threadIdx.x < 256) { const int a = rowmap[u.pm * 256 + threadIdx.x]; tok[i * 256 + threadIdx.x] = (a < 0 ? 0 : a) >> 1; } } }
        asm volatile("s_waitcnt vmcnt(0) lgkmcnt(0)" ::: "memory"); __syncthreads();
    }
    __device__ __forceinline__ void aoffs(int ui, int K, int tid, unsigned (&out)[2][2]) const {
#pragma unroll
        for (int h = 0; h < 2; ++h)
#pragma unroll
            for (int i = 0; i < 2; ++i) { int R, C; stage_rc(tid * 16 + i * 8192, R, C); out[h][i] = (unsigned)tok[(ui & (MAXU - 1)) * 256 + h * 128 + R] * (unsigned)(K * 2) + (unsigned)(C * 2); }
    }
    __device__ __forceinline__ void a_ready(const Unit&) const {}
    __device__ __forceinline__ void done(const Unit&) const {}
};
}

struct Args { const float* in[18]; float* out; unsigned char* ws; int ph_lo, ph_hi; };
#ifdef ONLY_PH
#define IN(k) ((k) == ONLY_PH)
#else
#define IN(k) (lo <= (k) && (k) < hi)
#endif
#define BOTH(k) (IN(k) && IN((k) + 1))
#if MK_ONE_LAUNCH
#define SEAM() xcd_barrier(bar)
#else
#define SEAM() do {} while (0)
#endif
#ifndef REP_PH
#define REP_PH (-1)
#endif
#ifndef REP_PH2
#define REP_PH2 (-1)
#endif
#define PHASE(k, ...) if (IN(k)) { __VA_ARGS__; if ((k) == REP_PH || (k) == REP_PH2) { __syncthreads(); __VA_ARGS__; } if (BOTH(k)) SEAM(); }
#define WSP(T_, off) ((T_*)(ws + (off)))
#define GEMM_STATIC(EPI, A_, B_, N_, K_, ...) do { pg8::Gemm g{A_, B_, T, N_, K_}; pg8::StaticOrder S; S.init(T, N_, c.G, c.bid); EPI E{__VA_ARGS__}; pg8::gemm_phase<EPI, pg8::StaticOrder, true, true>(c.lds, g, S, E); } while (0)
#define GEMM_MOE(GATH, EPI, A_, B_, N_, K_, ...) do { pg8::Gemm g{A_, B_, MAXROWS, N_, K_}; pg8::MoeOrder<GATH> S{(N_) / 256, c.G, c.bid, __builtin_amdgcn_readfirstlane(WSP(int, WS_TILEE)[MAXTILES]), WSP(int, WS_TILEE), (size_t)(N_) * (K_) * 2, WSP(int, WS_ROWMAP), (LAS int*)(c.lds + LDSCTL_OFF + 5120)}; EPI E{__VA_ARGS__}; pg8::gemm_phase<EPI, pg8::MoeOrder<GATH>, true, true>(c.lds, g, S, E); } while (0)
enum { P_PRO = 0, P_QKV, P_ATTA, P_ATTB, P_WO, P_MOE0, P_WIN = P_MOE0 + 5, P_CONV, P_CELL, P_HN, P_WOUT, P_MOE1, P_END = P_MOE1 + 5 };
static_assert(P_END == NPHASE, "phase count");
template <int L>
__device__ __forceinline__ void moe_block(const Ctx& c, const Args& args, unsigned char* ws, const int lo, const int hi, const XcdBarrier& bar, const int base) {
    (void)bar; (void)lo; (void)hi;
    PHASE(base + 0, ln_pass<0, 1, false>(c, WSP(bf16, WS_PRE), nullptr, nullptr, WSP(bf16, WS_XB), args.in[9] + L * D, args.in[10] + L * D, args.in[13], 16, 0, args.in[14], WSP(int, WS_EID), WSP(float, WS_EGATE), WSP(int, WS_HIST), nullptr))
    PHASE(base + 1, route2(c, WSP(int, WS_EID), WSP(int, WS_HIST), WSP(int, WS_ROWMAP), WSP(int, WS_TILEE)))
    PHASE(base + 2, GEMM_MOE(true, pg8::EpiSwiGLU, WSP(bf16, WS_XB), WSP(bf16, WS_WGU), GU_N, D, WSP(bf16, WS_H)))
    PHASE(base + 3, GEMM_MOE(false, pg8::EpiDown, WSP(bf16, WS_H), WSP(bf16, WS_WD), D, DE, WSP(bf16, WS_YB), WSP(int, WS_ROWMAP), WSP(float, WS_EGATE)))
    if (L == 0) { PHASE(base + 4, ln_pass<1, 2, false>(c, nullptr, nullptr, WSP(bf16, WS_YB), WSP(bf16, WS_XB), args.in[11], args.in[12], args.in[3], ZLD, ZN, args.in[4], nullptr, nullptr, nullptr, WSP(float, WS_GATES))) }
    else { PHASE(base + 4, ln_pass<1, 0, true>(c, nullptr, args.out, WSP(bf16, WS_YB), WSP(bf16, WS_XB), args.in[11] + D, args.in[12] + D, nullptr, 0, 0, nullptr, nullptr, nullptr, nullptr, nullptr)) }
}
__global__ void __launch_bounds__(NTHR, 2) fwd(Args args) {
    extern __shared__ __attribute__((aligned(16))) unsigned char lds_raw[];
    Ctx c; c.lds = (LAS unsigned char*)lds_raw; c.tid = threadIdx.x; c.lane = c.tid & 63; c.wave = __builtin_amdgcn_readfirstlane(c.tid >> 6);
    c.G = gridDim.x; c.bid = blockIdx.x; c.gw = c.bid * NWAVES + c.wave; c.ngw = c.G * NWAVES; c.gtid = c.bid * NTHR + c.tid; c.ngt = c.G * NTHR;
    unsigned char* ws = args.ws;
    ((LAS unsigned*)(c.lds + LDSCTL_OFF))[c.tid] = 0u;
    __syncthreads();
#if MK_ONE_LAUNCH
    XcdBarrier bar = xcd_barrier_post((unsigned*)(ws + WS_CTL) + CW_BAR, (volatile LAS unsigned*)(c.lds + LDSCTL_OFF + LC_BAR));
#else
    XcdBarrier bar; bar.bar = nullptr; bar.x = 0; bar.st = nullptr;
#endif
    const int lo = args.ph_lo, hi = args.ph_hi; (void)lo; (void)hi;
    PHASE(P_PRO, conv_job(c, args.in[1], QKV_N, D, QKV_N, WSP(bf16, WS_WQKV)); conv_job(c, args.in[2], D, OD, D, WSP(bf16, WS_WO)); conv_job(c, args.in[3], ZLD, D, ZN, WSP(bf16, WS_WIN)); conv_job(c, args.in[8], D, D, D, WSP(bf16, WS_WOUT));
        conv_moe(c, args.in[15], args.in[16], args.in[17], WSP(bf16, WS_WGU), WSP(bf16, WS_WD), c.gw, c.ngw);
        x_to_bf16(c, args.in[0], WSP(bf16, WS_XB)); rope_table(c, WSP(f32x2, WS_ROPE)))
    PHASE(P_QKV, GEMM_STATIC(pg8::EpiQKV, WSP(bf16, WS_XB), WSP(bf16, WS_WQKV), QKV_N, D, WSP(bf16, WS_QKV), QKV_N, WSP(const float, WS_ROPE)))
    PHASE(P_ATTA, att::attn_phase<false>(c, WSP(const bf16, WS_QKV), WSP(bf16, WS_XB), WSP(float, WS_GATES), nullptr))
    PHASE(P_ATTB, att::attn_phase<true>(c, WSP(const bf16, WS_QKV), WSP(bf16, WS_XB), WSP(float, WS_GATES), WSP(bf16, WS_O)))
    PHASE(P_WO, GEMM_STATIC(pg8::EpiRes<true>, WSP(bf16, WS_O), WSP(bf16, WS_WO), D, OD, args.in[0], WSP(bf16, WS_PRE), D, ALPHA))
    moe_block<0>(c, args, ws, lo, hi, bar, P_MOE0);
    PHASE(P_WIN, GEMM_STATIC(pg8::EpiStoreBf16, WSP(bf16, WS_XB), WSP(bf16, WS_WIN), ZN, D, WSP(bf16, WS_Z), ZN))
    PHASE(P_CONV, conv_pass(c, WSP(const bf16, WS_Z), args.in[5], args.in[6], WSP(bf16, WS_QKC)))
    PHASE(P_CELL, mls::mlstm_phase(c, WSP(const bf16, WS_QKC), WSP(const bf16, WS_Z), WSP(const float, WS_GATES), WSP(bf16, WS_HC));
        if (c.G > 128) { if (c.bid >= 128) conv_moe(c, args.in[15] + (size_t)NE * D * DE, args.in[16] + (size_t)NE * D * DE, args.in[17] + (size_t)NE * D * DE, WSP(bf16, WS_WGU), WSP(bf16, WS_WD), (c.bid - 128) * NWAVES + c.wave, (c.G - 128) * NWAVES); }
        else conv_moe(c, args.in[15] + (size_t)NE * D * DE, args.in[16] + (size_t)NE * D * DE, args.in[17] + (size_t)NE * D * DE, WSP(bf16, WS_WGU), WSP(bf16, WS_WD), c.gw, c.ngw))
    PHASE(P_HN, headnorm_pass(c, WSP(const bf16, WS_HC), WSP(const bf16, WS_Z), args.in[7], WSP(bf16, WS_Y)))
    PHASE(P_WOUT, GEMM_STATIC(pg8::EpiRes<false>, WSP(bf16, WS_Y), WSP(bf16, WS_WOUT), D, D, WSP(bf16, WS_XB), WSP(bf16, WS_PRE), D, ALPHA))
    moe_block<1>(c, args, ws, lo, hi, bar, P_MOE1);
}
#undef IN
#undef BOTH

extern "C" void kernel_launch(void* const* d_in, const int* in_sizes, int n_in, void* d_out, int out_size, void* d_ws, size_t ws_size, hipStream_t stream) {
    static int grid = 0;
    if (grid == 0) {
        if (n_in != 18 || in_sizes[0] != T * D || out_size != T * D || ws_size < WS_END) { fprintf(stderr, "kernel_launch: unexpected shapes (n_in %d, in0 %d, out %d, ws %zu)\n", n_in, n_in > 0 ? in_sizes[0] : -1, out_size, ws_size); grid = -1; return; }
        int dev = 0, cus = 0;
        if (hipGetDevice(&dev) != hipSuccess || hipDeviceGetAttribute(&cus, hipDeviceAttributeMultiprocessorCount, dev) != hipSuccess) { grid = -1; return; }
        if (hipFuncSetAttribute((const void*)fwd, hipFuncAttributeMaxDynamicSharedMemorySize, LDS_BYTES) != hipSuccess) { fprintf(stderr, "kernel_launch: hipFuncSetAttribute failed\n"); grid = -1; return; }
        int per_cu = 0;
        if (hipOccupancyMaxActiveBlocksPerMultiprocessor(&per_cu, (const void*)fwd, NTHR, LDS_BYTES) != hipSuccess || per_cu < 1) fprintf(stderr, "kernel_launch: occupancy query says %d\n", per_cu);
        (void)hipGetLastError();
        grid = cus > 256 ? 256 : cus;
    }
    if (grid < 0) return;
    (void)hipMemsetAsync((char*)d_ws + WS_CTL, 0, CTL_ZERO_BYTES, stream);
    Args a{};
    for (int i = 0; i < 18; ++i) a.in[i] = (const float*)d_in[i];
    a.out = (float*)d_out; a.ws = (unsigned char*)d_ws;
#if MK_ONE_LAUNCH
    a.ph_lo = 0; a.ph_hi = NPHASE;
    hipLaunchKernelGGL(fwd, dim3(grid), dim3(NTHR), LDS_BYTES, stream, a);
#else
    for (int p = 0; p < NPHASE; ++p) { a.ph_lo = p; a.ph_hi = p + 1; hipLaunchKernelGGL(fwd, dim3(grid), dim3(NTHR), LDS_BYTES, stream, a); }
#endif
}
```

```cpp
#include <hip/hip_runtime.h>
#include <cstdio>
#include <cstdint>
namespace pg8 {
#define PG8_LAS __attribute__((address_space(3)))
typedef unsigned short bf16_t;
typedef short bf16x8 __attribute__((ext_vector_type(8)));
typedef float f32x4 __attribute__((ext_vector_type(4)));
typedef unsigned u32x4 __attribute__((ext_vector_type(4)));
constexpr int BM = 256, BK = 64, HALF = 128, HTB = HALF * BK * 2  , STAGE_BYTES = 8 * HTB, NXCD = 8, WGM = 8;

__host__ __device__ __forceinline__ int lds_byte(int r, int c) { const int st = (r >> 4) * 2 + (c >> 5), rr = r & 15, cc = c & 31, ob = rr * 64 + cc * 2; return st * 1024 + (ob ^ (((ob >> 9) & 1) << 5)); }
__host__ __device__ __forceinline__ void stage_rc(int b, int& R, int& C) { const int st = b / 1024, sb = b % 1024, swz = sb ^ (((sb >> 9) & 1) << 5); R = (st >> 1) * 16 + swz / 64; C = (st & 1) * 32 + (swz % 64) / 2; }
__host__ __device__ __forceinline__ int perm32(int rho) { const int n = rho >> 4, i = rho & 15; return 8 * (i >> 2) + 4 * n + (i & 3); }

struct Unit { int pm, pn, ui; };
struct Gemm { const bf16_t* A; const bf16_t* Bt; int M, N, K; };

struct StaticOrder {
    int nM, nN, nwg, G, c;
    __host__ __device__ void init(int M, int N, int G_, int c_) { nM = M / BM; nN = N / BM; nwg = nM * nN; G = G_; c = c_; }
    __host__ __device__ bool next(int i, Unit& u) const {
        const long L = (long)i * G + c; if (L >= nwg) return false;
        int wgid = (int)L; { const int q = nwg / NXCD, r = nwg % NXCD, xcd = wgid % NXCD, off = wgid / NXCD; wgid = (xcd < r ? xcd * (q + 1) : r * (q + 1) + (xcd - r) * q) + off; }
        const int nig = WGM * nN, gid = wgid / nig, fm = gid * WGM, gsz = (nM - fm) < WGM ? (nM - fm) : WGM;
        u.pm = fm + ((wgid % nig) % gsz); u.pn = (wgid % nig) / gsz; u.ui = i; return true;
    }
    __device__ __forceinline__ const char* pa(const Gemm& g, const Unit& u) const { return (const char*)g.A + (size_t)u.pm * ((size_t)BM * g.K * 2); }
    __device__ __forceinline__ const char* pb(const Gemm& g, const Unit& u) const { return (const char*)g.Bt + (size_t)u.pn * ((size_t)BM * g.K * 2); }
    static constexpr bool GATHER = false;
    __device__ __forceinline__ void prep() const {}
    __device__ __forceinline__ void aoffs(int, int, int, unsigned (&)[2][2]) const {}
    __device__ __forceinline__ void a_ready(const Unit&) const {}
    __device__ __forceinline__ void done(const Unit&) const {}
};

__device__ __forceinline__ unsigned cvt_pk_bf16(float lo, float hi) { unsigned r; asm volatile("v_cvt_pk_bf16_f32 %0, %1, %2" : "=v"(r) : "v"(lo), "v"(hi)); return r; }
typedef float f32x2 __attribute__((ext_vector_type(2)));
template <class Epi, class Sched, bool ALIGN_EPI = false, bool SP2 = false>
__device__ __forceinline__ void gemm_phase(PG8_LAS unsigned char* lds, const Gemm g, const Sched& S, const Epi& E) {
    const int tid = threadIdx.x, wid = __builtin_amdgcn_readfirstlane(tid >> 6), lane = tid & 63, wr = wid >> 2, wc = wid & 3, fr = lane & 15, fq = lane >> 4;
    const int K = g.K, nt = K / BK;
    unsigned voffA[2], voffB[2];
#pragma unroll
    for (int i = 0; i < 2; ++i) { int R, C; stage_rc(tid * 16 + i * 8192, R, C); const int Rb = Epi::PERM ? ((R & ~31) + perm32(R & 31)) : R;
        voffA[i] = (unsigned)(R * K + C) * 2u; voffB[i] = (unsigned)(((int)Epi::WIDE == 2 ? ((R >> 5) * 64 + 16 * (perm32(R & 31) >> 3) + (perm32(R & 31) & 7)) : (int)Epi::WIDE == 1 ? ((R >> 5) * 64 + perm32(R & 31)) : Rb) * K + C) * 2u; }
    const size_t kstep = (size_t)(BK * 2);
    const size_t hstep = (size_t)HALF * K * 2;
    const size_t hstepB = (int)Epi::WIDE == 2 ? (size_t)8 * K * 2 : (int)Epi::WIDE == 1 ? (size_t)32 * K * 2 : hstep;
    const size_t tstep = 2 * hstep;
    const unsigned ldsw = (unsigned)wid * 1024u;
    const int aoff = lds_byte(wr * 64 + fr, fq * 8), boff = lds_byte(wc * 32 + fr, fq * 8);
#define PG8_SA(b, h) (((b) * 2 + (h)) * HTB)
#define PG8_SB(b, h) ((4 + (b) * 2 + (h)) * HTB)
#define PG8_STAGE(bufoff, gbase, voff) do { _Pragma("unroll") for (int _i = 0; _i < 2; ++_i) \
        __builtin_amdgcn_global_load_lds((const unsigned*)((const char*)(gbase) + (voff)[_i]), (PG8_LAS unsigned*)(lds + (bufoff) + ldsw + _i * 8192), 16, 0, 0); } while (0)
#define PG8_STAGE_A(bufoff, kptr, half, NXT) do { if constexpr (Sched::GATHER) { const unsigned vx_[2] = {(NXT) ? van[half][0] : va[half][0], (NXT) ? van[half][1] : va[half][1]}; PG8_STAGE(bufoff, kptr, vx_); } \
        else { PG8_STAGE(bufoff, (kptr) + ((half) ? hstep : 0), voffA); } } while (0)
#define PG8_LDA(dst, b, h) do { _Pragma("unroll") for (int m = 0; m < 4; ++m) _Pragma("unroll") for (int k = 0; k < 2; ++k) dst[m][k] = *(const PG8_LAS bf16x8*)(lds + PG8_SA(b, h) + aoff + m * 2048 + k * 1024); } while (0)
#define PG8_LDB(dst, b, h) do { _Pragma("unroll") for (int n = 0; n < 2; ++n) _Pragma("unroll") for (int k = 0; k < 2; ++k) dst[n][k] = *(const PG8_LAS bf16x8*)(lds + PG8_SB(b, h) + boff + n * 2048 + k * 1024); } while (0)
#define PG8_MMA(ai, bj, At, Bt) do { __builtin_amdgcn_s_setprio(1); _Pragma("unroll") for (int m = 0; m < 4; ++m) _Pragma("unroll") for (int n = 0; n < 2; ++n) _Pragma("unroll") for (int k = 0; k < 2; ++k) \
        acc[ai][bj][m][n] = __builtin_amdgcn_mfma_f32_16x16x32_bf16(Bt[n][k], At[m][k], acc[ai][bj][m][n], 0, 0, 0); __builtin_amdgcn_s_setprio(0); } while (0)
#define PG8_WAIT_V(n) asm volatile("s_waitcnt vmcnt(" #n ")" ::: "memory")
#define PG8_WAIT_L(n) asm volatile("s_waitcnt lgkmcnt(" #n ")" ::: "memory")
#define PG8_BAR __builtin_amdgcn_s_barrier()
#define PG8_SCHED __builtin_amdgcn_sched_barrier(0)
    Unit cur, nxt; int ui = 0;
    if (!S.next(0, cur)) return;
    S.prep();
    f32x4 acc[2][2][4][2];
#pragma unroll
    for (int a = 0; a < 2; ++a)
#pragma unroll
        for (int b = 0; b < 2; ++b)
#pragma unroll
            for (int m = 0; m < 4; ++m)
#pragma unroll
                for (int n = 0; n < 2; ++n) acc[a][b][m][n] = (f32x4){0.f, 0.f, 0.f, 0.f};
    bf16x8 At[4][2], B0[2][2], B1[2][2];
    const char* cA = S.pa(g, cur); const char* cB = S.pb(g, cur);
    unsigned va[2][2] = {{0u, 0u}, {0u, 0u}}, van[2][2] = {{0u, 0u}, {0u, 0u}};
    static_assert(SP2 || !Epi::WIDE, "WIDE epilogues: SP2 loop only");
    if constexpr (Sched::GATHER) { static_assert(SP2, "gathered A rows: SP2 loop only"); S.aoffs(0, K, tid, va); }
    S.a_ready(cur);
    if constexpr (SP2) {
        PG8_STAGE(PG8_SB(0, 0), cB, voffB); PG8_STAGE(PG8_SB(0, 1), cB + hstepB, voffB); PG8_STAGE_A(PG8_SA(0, 0), cA, 0, false); PG8_STAGE_A(PG8_SA(0, 1), cA, 1, false);
        if (wr == 1) PG8_BAR;
        PG8_WAIT_V(2); PG8_BAR;
        PG8_STAGE(PG8_SB(1, 0), cB + kstep, voffB); PG8_STAGE_A(PG8_SA(1, 0), cA + kstep, 0, false); PG8_STAGE(PG8_SB(1, 1), cB + hstepB + kstep, voffB);
        PG8_WAIT_V(6); PG8_BAR;
    } else {
        PG8_STAGE(PG8_SB(0, 0), cB, voffB); PG8_STAGE(PG8_SA(0, 0), cA, voffA); PG8_STAGE(PG8_SB(0, 1), cB + hstep, voffB); PG8_STAGE(PG8_SA(0, 1), cA + hstep, voffA);
        if (wr == 1) PG8_BAR;
        PG8_WAIT_V(4); PG8_BAR;
        PG8_STAGE(PG8_SB(1, 0), cB + kstep, voffB); PG8_STAGE(PG8_SA(1, 0), cA + kstep, voffA); PG8_STAGE(PG8_SB(1, 1), cB + hstep + kstep, voffB);
        PG8_WAIT_V(6); PG8_BAR;
    }
    for (;;) {
        const bool has_next = S.next(ui + 1, nxt);
        if constexpr (Sched::GATHER) { if (has_next) S.aoffs(ui + 1, K, tid, van); else { van[0][0] = va[0][0]; van[0][1] = va[0][1]; van[1][0] = va[1][0]; van[1][1] = va[1][1]; } }
        const char* nA = has_next ? S.pa(g, nxt) : cA; const char* nB = has_next ? S.pb(g, nxt) : cB;
        for (int t = 0; t < nt; t += 2) {
            const bool last = (t == nt - 2);
            const char* a1 = cA + (size_t)(t + 1) * kstep;
            const char* a2 = last ? nA : cA + (size_t)(t + 2) * kstep; const char* b2 = last ? nB : cB + (size_t)(t + 2) * kstep;
            const char* a3 = a2 + kstep; const char* b3 = b2 + kstep;
            if (last && has_next) S.a_ready(nxt);
            if constexpr (SP2) {
            PG8_LDB(B0, 0, 0); PG8_LDB(B1, 0, 1); PG8_SCHED; PG8_LDA(At, 0, 0); PG8_STAGE_A(PG8_SA(1, 1), a1, 1, false);
            PG8_WAIT_V(8); PG8_WAIT_L(0); PG8_BAR; PG8_MMA(0, 0, At, B0); PG8_MMA(0, 1, At, B1); PG8_BAR; PG8_SCHED;
            PG8_LDA(At, 0, 1); PG8_STAGE(PG8_SB(0, 0), b2, voffB); PG8_STAGE(PG8_SB(0, 1), b2 + hstepB, voffB); PG8_STAGE_A(PG8_SA(0, 0), a2, 0, last);
            PG8_WAIT_V(8); PG8_WAIT_L(0); PG8_BAR; PG8_MMA(1, 0, At, B0); PG8_MMA(1, 1, At, B1); PG8_BAR; PG8_SCHED;
            PG8_LDB(B0, 1, 0); PG8_LDB(B1, 1, 1); PG8_SCHED; PG8_LDA(At, 1, 0); PG8_STAGE_A(PG8_SA(0, 1), a2, 1, last);
            PG8_WAIT_V(8); PG8_WAIT_L(0); PG8_BAR; PG8_MMA(0, 0, At, B0); PG8_MMA(0, 1, At, B1); PG8_BAR; PG8_SCHED;
            PG8_LDA(At, 1, 1); PG8_STAGE(PG8_SB(1, 0), b3, voffB); PG8_STAGE(PG8_SB(1, 1), b3 + hstepB, voffB); PG8_STAGE_A(PG8_SA(1, 0), a3, 0, last);
            PG8_WAIT_V(8); PG8_WAIT_L(0); PG8_BAR; PG8_MMA(1, 0, At, B0); PG8_MMA(1, 1, At, B1); PG8_BAR; PG8_SCHED;
            } else {
            PG8_LDB(B0, 0, 0); PG8_SCHED; PG8_LDA(At, 0, 0); PG8_STAGE(PG8_SA(1, 1), a1 + hstep, voffA);
            PG8_WAIT_L(8); PG8_BAR; PG8_WAIT_L(0); PG8_MMA(0, 0, At, B0); PG8_BAR; PG8_SCHED;
            PG8_LDB(B1, 0, 1); PG8_STAGE(PG8_SB(0, 0), b2, voffB);
            PG8_BAR; PG8_WAIT_L(0); PG8_MMA(0, 1, At, B1); PG8_BAR;
            PG8_LDA(At, 0, 1); PG8_STAGE(PG8_SA(0, 0), a2, voffA);
            PG8_BAR; PG8_WAIT_L(0); PG8_MMA(1, 0, At, B0); PG8_BAR; PG8_SCHED;
            PG8_STAGE(PG8_SB(0, 1), b2 + hstep, voffB);
            PG8_WAIT_V(6); PG8_BAR; PG8_MMA(1, 1, At, B1); PG8_BAR;
            PG8_LDB(B0, 1, 0); PG8_SCHED; PG8_LDA(At, 1, 0); PG8_STAGE(PG8_SA(0, 1), a2 + hstep, voffA);
            PG8_WAIT_L(8); PG8_BAR; PG8_WAIT_L(0); PG8_MMA(0, 0, At, B0); PG8_BAR; PG8_SCHED;
            PG8_LDB(B1, 1, 1); PG8_STAGE(PG8_SB(1, 0), b3, voffB);
            PG8_BAR; PG8_WAIT_L(0); PG8_MMA(0, 1, At, B1); PG8_BAR;
            PG8_LDA(At, 1, 1); PG8_STAGE(PG8_SA(1, 0), a3, voffA);
            PG8_BAR; PG8_WAIT_L(0); PG8_MMA(1, 0, At, B0); PG8_BAR; PG8_SCHED;
            PG8_STAGE(PG8_SB(1, 1), b3 + hstep, voffB);
            PG8_WAIT_V(6); PG8_BAR; PG8_MMA(1, 1, At, B1); PG8_BAR;
            }
        }
        if constexpr (ALIGN_EPI) { if (wr == 0) PG8_BAR; }
        if constexpr (!Epi::AFTER_DRAIN) { E(acc, cur, wr, wc, fr, fq); S.done(cur); }
        if (!has_next) break;
#pragma unroll
        for (int a = 0; a < 2; ++a)
#pragma unroll
            for (int b = 0; b < 2; ++b)
#pragma unroll
                for (int m = 0; m < 4; ++m)
#pragma unroll
                    for (int n = 0; n < 2; ++n) acc[a][b][m][n] = (f32x4){0.f, 0.f, 0.f, 0.f};
        cur = nxt; cA = nA; cB = nB; ++ui;
        if constexpr (Sched::GATHER) { va[0][0] = van[0][0]; va[0][1] = van[0][1]; va[1][0] = van[1][0]; va[1][1] = van[1][1]; }
        if constexpr (ALIGN_EPI) { if (wr == 1) PG8_BAR; }
    }
    PG8_WAIT_V(0);
    if constexpr (!ALIGN_EPI) { if (wr == 0) PG8_BAR; }
    PG8_BAR;
    if constexpr (Epi::AFTER_DRAIN) { E.fused(acc, cur, wr, wc, fr, fq, lds, wid, lane); S.done(cur); }
#undef PG8_SA
#undef PG8_SB
#undef PG8_STAGE
#undef PG8_STAGE_A
#undef PG8_LDA
#undef PG8_LDB
#undef PG8_MMA
#undef PG8_WAIT_V
#undef PG8_WAIT_L
#undef PG8_BAR
#undef PG8_SCHED
}
}

#ifndef MK_ONE_LAUNCH
#define MK_ONE_LAUNCH 1
#endif
constexpr int NWAVES = 8, NTHR = 512;
constexpr int BATCH = 16, SEQ = 2048, T = BATCH * SEQ, D = 2048;
constexpr int QKV_N = 9216, NH = 8, HD = 128, OD = NH * HD;
constexpr int ZN = 6144, ZLD = 6160;
constexpr int NE = 16, DE = 768, GU_N = 2 * DE;
constexpr int MAXTILES = 272, MAXROWS = MAXTILES * 256;
constexpr float ALPHA = 1.41421356237309515f;
constexpr float LN_EPS = 1e-5f;
constexpr int NPHASE = 20;

constexpr size_t MiB = 1u << 20, KiB = 1u << 10;
constexpr size_t WS_CTL = 0, CTL_ZERO_BYTES = 256 * KiB;
constexpr size_t WS_ROPE = 1 * MiB;
constexpr size_t WS_EID = 1 * MiB + 256 * KiB;
constexpr size_t WS_EGATE = 1 * MiB + 512 * KiB;
constexpr size_t WS_ROWMAP = 1 * MiB + 768 * KiB;
constexpr size_t WS_HIST = 2 * MiB + 256 * KiB;
constexpr size_t WS_TILEE = 2 * MiB + 320 * KiB;
constexpr size_t WS_GATES = 3 * MiB;
constexpr size_t WS_WQKV = 6 * MiB, WS_WO = 42 * MiB, WS_WIN = 46 * MiB, WS_WOUT = 70 * MiB, WS_WGU = 78 * MiB, WS_WD = 174 * MiB;
constexpr size_t WS_XB = 222 * MiB;
constexpr size_t WS_R = 350 * MiB;
constexpr size_t WS_QKV = WS_R, WS_O = WS_R + 576 * MiB;
constexpr size_t WS_PRE = WS_R, WS_YB = WS_R;
constexpr size_t WS_XG = WS_R + 256 * MiB, WS_H = WS_R + 528 * MiB;
constexpr size_t WS_Z = WS_R, WS_QKC = WS_R + 384 * MiB, WS_HC = WS_R + 512 * MiB, WS_Y = WS_QKC;
constexpr size_t WS_END = 990 * MiB;
static_assert(WS_ROWMAP + (size_t)MAXROWS * 4 <= WS_HIST && WS_H + (size_t)MAXROWS * DE * 2 <= WS_END && WS_XG + (size_t)MAXROWS * D * 2 <= WS_H, "ws map");
constexpr int CW_TMO = 0, CW_BAR = 4096, CW_CONVQ = 8192;

constexpr int RING_BYTES = 131072, LDSCTL_OFF = RING_BYTES, LDS_BYTES = 147456;
constexpr int LC_HIST = 0, LC_BAR = 64;

#define GAS __attribute__((address_space(1)))
#define LAS __attribute__((address_space(3)))
typedef unsigned short bf16;
typedef unsigned u32x4 __attribute__((ext_vector_type(4)));
typedef unsigned u32x2 __attribute__((ext_vector_type(2)));
typedef float f32x4 __attribute__((ext_vector_type(4)));
typedef float f32x2 __attribute__((ext_vector_type(2)));
#define LDS_WAIT() asm volatile("s_waitcnt lgkmcnt(0)" ::: "memory")
__device__ __forceinline__ unsigned f2bf(float f) { unsigned u = __builtin_bit_cast(unsigned, f); return (u + 0x7fffu + ((u >> 16) & 1u)) >> 16; }
__device__ __forceinline__ unsigned pk2(float lo, float hi) { return pg8::cvt_pk_bf16(lo, hi); }
__device__ __forceinline__ float bflo(unsigned u) { return __builtin_bit_cast(float, u << 16); }
__device__ __forceinline__ float bfhi(unsigned u) { return __builtin_bit_cast(float, u & 0xffff0000u); }
__device__ __forceinline__ float bf1(bf16 b) { return __builtin_bit_cast(float, (unsigned)b << 16); }
template <int CTRL> __device__ __forceinline__ float dpp0(float x) { return __builtin_bit_cast(float, __builtin_amdgcn_update_dpp(0, __builtin_bit_cast(int, x), CTRL, 0xf, 0xf, true)); }
template <int CTRL> __device__ __forceinline__ float dppx(float x) { return __builtin_bit_cast(float, __builtin_amdgcn_mov_dpp(__builtin_bit_cast(int, x), CTRL, 0xf, 0xf, true)); }
template <int CTRL, int ROWMASK> __device__ __forceinline__ float dpps(float x) { return __builtin_bit_cast(float, __builtin_amdgcn_update_dpp(__builtin_bit_cast(int, x), __builtin_bit_cast(int, x), CTRL, ROWMASK, 0xf, false)); }
__device__ __forceinline__ float prefix_sum64(float v) {
    v += dpp0<0x111>(v); v += dpp0<0x112>(v); v += dpp0<0x114>(v); v += dpp0<0x118>(v);
    v += __builtin_bit_cast(float, __builtin_amdgcn_update_dpp(0, __builtin_bit_cast(int, v), 0x142, 0xa, 0xf, false));
    v += __builtin_bit_cast(float, __builtin_amdgcn_update_dpp(0, __builtin_bit_cast(int, v), 0x143, 0xc, 0xf, false));
    return v;
}
__device__ __forceinline__ float prefix_max64(float v) {
    v = fmaxf(v, dpps<0x111, 0xf>(v)); v = fmaxf(v, dpps<0x112, 0xf>(v)); v = fmaxf(v, dpps<0x114, 0xf>(v)); v = fmaxf(v, dpps<0x118, 0xf>(v));
    v = fmaxf(v, dpps<0x142, 0xa>(v)); v = fmaxf(v, dpps<0x143, 0xc>(v));
    return v;
}
__device__ __forceinline__ float lane_bcast(float v, int l) { return __builtin_bit_cast(float, __builtin_amdgcn_readlane(__builtin_bit_cast(int, v), l)); }
__device__ __forceinline__ float wave_sum(float v) { return lane_bcast(prefix_sum64(v), 63); }
__device__ __forceinline__ float row16_sum(float v) { v += dppx<0xB1>(v); v += dppx<0x4E>(v); v += dppx<0x141>(v); v += dppx<0x128>(v); return v; }
__device__ __forceinline__ float lane_xor1(float v) { return dppx<0xB1>(v); }
__device__ __forceinline__ float lane_xor32(float v) { auto r = __builtin_amdgcn_permlane32_swap(__builtin_bit_cast(unsigned, v), __builtin_bit_cast(unsigned, v), false, false);
    return __builtin_bit_cast(float, (threadIdx.x & 32) ? r[0] : r[1]); }

#define XB_TMO      128
#define XB_XCNT(j)  (256  + 64 * (j))
#define XB_XSUB(j)  (1280 + 64 * (j))
#define XB_XGEN(j)  (2304 + 64 * (j))
#define XB_TOP      3328
#define XB_TOPGEN   3392
#define XCD_BAR_WORDS 3456
#define XB_SPIN_CAP (1u << 18)
__device__ __forceinline__ unsigned xb_ld(unsigned* p)              { return __hip_atomic_load(p, __ATOMIC_RELAXED, __HIP_MEMORY_SCOPE_AGENT); }
__device__ __forceinline__ unsigned xb_add(unsigned* p, unsigned v) { return __hip_atomic_fetch_add(p, v, __ATOMIC_RELAXED, __HIP_MEMORY_SCOPE_AGENT); }
__device__ __forceinline__ unsigned xb_xcc_id() { return (unsigned)__builtin_amdgcn_s_getreg((3 << 11) | 20) & 0xFu; }
#define XB_SPIN(cond, bar) do { unsigned _sp = 0; while (cond) { __builtin_amdgcn_s_sleep(1); \
    if ((++_sp & 255u) == 0u) { if (xb_ld(&(bar)[XB_TMO])) break; if (_sp > XB_SPIN_CAP) { atomicAdd(&(bar)[XB_TMO], 1u); break; } } } } while (0)
struct XcdBarrier { unsigned* bar; unsigned x; volatile LAS unsigned* st; };
__device__ __forceinline__ XcdBarrier xcd_barrier_post(unsigned* bar, volatile LAS unsigned* st) {
    XcdBarrier b; b.bar = bar; b.x = xb_xcc_id(); b.st = st;
    if (threadIdx.x == 0) (void)xb_add(&bar[XB_XCNT(b.x)], 1u);
    return b;
}
__device__ __forceinline__ void xcd_barrier_complete(unsigned* bar, unsigned x, unsigned& nloc, unsigned& nx) {
    const unsigned G = gridDim.x * gridDim.y * gridDim.z;
    unsigned sum, cnt, mine, sp = 0u;
    for (;;) {
        sum = 0u; cnt = 0u; mine = 0u;
#pragma unroll
        for (unsigned j = 0; j < 16; ++j) { const unsigned c = xb_ld(&bar[XB_XCNT(j)]); sum += c; cnt += (c > 0u) ? 1u : 0u; mine = (j == x) ? c : mine; }
        if (sum == G) break;
        __builtin_amdgcn_s_sleep(1);
        if ((++sp & 255u) == 0u) { if (xb_ld(&bar[XB_TMO])) break; if (sp > XB_SPIN_CAP) { atomicAdd(&bar[XB_TMO], 1u); break; } }
    }
    nloc = mine > 0u ? mine : 1u; nx = cnt > 0u ? cnt : 1u;
}
__device__ __forceinline__ void xcd_barrier(const XcdBarrier& b) {
    asm volatile("s_waitcnt vmcnt(0)" ::: "memory");
    __syncthreads();
    if (threadIdx.x == 0) {
        unsigned* bar = b.bar;
        __builtin_amdgcn_s_waitcnt(0);
        unsigned nloc = b.st[0], nx = b.st[1];
        if (nloc == 0u) { xcd_barrier_complete(bar, b.x, nloc, nx); b.st[0] = nloc; b.st[1] = nx; }
        const unsigned old = xb_add(&bar[XB_XSUB(b.x)], 1u);
        const unsigned gen = old / nloc;
        if (old + 1u == (gen + 1u) * nloc) {
            __builtin_amdgcn_fence(__ATOMIC_RELEASE, "agent");
            asm volatile("s_waitcnt vmcnt(0)" ::: "memory");
            const unsigned og = xb_add(&bar[XB_TOP], 1u);
            const unsigned tg = og / nx;
            if (og + 1u == (tg + 1u) * nx) xb_add(&bar[XB_TOPGEN], 1u);
            else XB_SPIN(xb_ld(&bar[XB_TOPGEN]) == tg, bar);
            __builtin_amdgcn_fence(__ATOMIC_ACQUIRE, "agent");
            xb_add(&bar[XB_XGEN(b.x)], 1u);
            asm volatile("s_waitcnt vmcnt(0)" ::: "memory");
        } else {
            XB_SPIN(xb_ld(&bar[XB_XGEN(b.x)]) == gen, bar);
            __builtin_amdgcn_fence(__ATOMIC_ACQUIRE, "agent");
            asm volatile("s_waitcnt vmcnt(0)" ::: "memory");
        }
    }
    __syncthreads();
}

struct Ctx { LAS unsigned char* lds; int tid, lane, wave, G, bid, gw, ngw, gtid, ngt; };

struct TrDesc { const float* wp; bf16* dst; int ldw, K, row_mul; };
__device__ __forceinline__ void tr_mk(TrDesc& d, const float* W, int ldw, int K, bf16* WT, int row_off, int row_mul, int kb, int nb, int lane) {
    const int k0 = 64 * kb, n0 = 32 * nb; d.wp = W + (size_t)(k0 + (lane >> 5)) * ldw + n0 + (lane & 31); d.dst = WT + (size_t)(row_off + n0 * row_mul) * K + k0; d.ldw = ldw; d.K = K; d.row_mul = row_mul; }
__device__ __forceinline__ void tr_load(const TrDesc& d, float (&tv)[32]) {
#pragma unroll
    for (int i = 0; i < 32; ++i) tv[i] = __builtin_nontemporal_load(d.wp + (size_t)(2 * i) * d.ldw); }
__device__ __forceinline__ void tr_store(const TrDesc& d, const float (&tv)[32], LAS float* scr, int lane) {
#pragma unroll
    for (int i = 0; i < 32; ++i) scr[(2 * i + (lane >> 5)) * 33 + (lane & 31)] = tv[i];
    LDS_WAIT(); asm volatile("" ::: "memory");
    const int c = lane & 7;
#pragma unroll
    for (int j = 0; j < 4; ++j) { const int n = (lane >> 3) + 8 * j; const LAS float* s_ = scr + (8 * c) * 33 + n;
        u32x4 o; o.x = pk2(s_[0 * 33], s_[1 * 33]); o.y = pk2(s_[2 * 33], s_[3 * 33]); o.z = pk2(s_[4 * 33], s_[5 * 33]); o.w = pk2(s_[6 * 33], s_[7 * 33]);
        *(u32x4*)(d.dst + (size_t)(n * d.row_mul) * d.K + 8 * c) = o; }
    LDS_WAIT(); asm volatile("" ::: "memory");
}
#define TR_PIPELINE(first_, stride_, end_, MK_) do { LAS float* scr_ = (LAS float*)(c.lds + c.wave * 16384); TrDesc cur_, nxt_; float ta_[32], tb_[32]; int it_ = (first_); \
        if (it_ < (end_)) { MK_(cur_, it_); tr_load(cur_, ta_); } \
        for (; it_ < (end_); it_ += (stride_)) { const int itn_ = it_ + (stride_); const bool hn_ = itn_ < (end_); if (hn_) { MK_(nxt_, itn_); tr_load(nxt_, tb_); } \
            tr_store(cur_, ta_, scr_, c.lane); if (hn_) { cur_ = nxt_; _Pragma("unroll") for (int q_ = 0; q_ < 32; ++q_) ta_[q_] = tb_[q_]; } } } while (0)
__device__ __forceinline__ void conv_job(const Ctx& c, const float* W, int ldw, int K, int N, bf16* WT) {
    const int nblk = N / 32, items = (K / 64) * nblk;
#define MK_JOB(d_, it2_) tr_mk(d_, W, ldw, K, WT, 0, 1, (it2_) / nblk, (it2_) % nblk, c.lane)
    TR_PIPELINE(c.gw, c.ngw, items, MK_JOB);
#undef MK_JOB
}
constexpr int CONV_MOE_ITEMS = 3 * NE * 768;
__device__ __forceinline__ void conv_moe_mk(TrDesc& d, int it, const float* Wg, const float* Wu, const float* Wd, bf16* WGU, bf16* WD, int lane) {
    constexpr int PER = 768; const int kind = it / (NE * PER), r = it % (NE * PER), e = r / PER, q = r % PER;
    if (kind < 2) tr_mk(d, (kind == 0 ? Wg : Wu) + (size_t)e * D * DE, DE, D, WGU + (size_t)e * GU_N * D, kind, 2, q / 24, q % 24, lane);
    else tr_mk(d, Wd + (size_t)e * DE * D, D, DE, WD + (size_t)e * D * DE, 0, 1, q / 64, q % 64, lane);
}
__device__ __forceinline__ void conv_moe(const Ctx& c, const float* Wg, const float* Wu, const float* Wd, bf16* WGU, bf16* WD, int gw0, int ngw0, int end = CONV_MOE_ITEMS) {
#define MK_MOE(d_, it2_) conv_moe_mk(d_, it2_, Wg, Wu, Wd, WGU, WD, c.lane)
    TR_PIPELINE(gw0, ngw0, end, MK_MOE);
#undef MK_MOE
}
__device__ __forceinline__ void x_to_bf16(const Ctx& c, const float* x, bf16* XB) {
    for (size_t i = c.gtid; i < (size_t)T * D / 8; i += c.ngt) { const f32x4 a = __builtin_nontemporal_load((const f32x4*)x + 2 * i), b = __builtin_nontemporal_load((const f32x4*)x + 2 * i + 1);
        u32x4 o; o.x = pk2(a.x, a.y); o.y = pk2(a.z, a.w); o.z = pk2(b.x, b.y); o.w = pk2(b.z, b.w); ((u32x4*)XB)[i] = o; }
}
__device__ __forceinline__ void rope_table(const Ctx& c, f32x2* tab) {
    for (int i = c.gtid; i < SEQ * 16; i += c.ngt) { const int pos = i >> 4, j = i & 15;
        const float inv = powf(500000.0f, -(float)j / 16.0f); const float ang = (float)pos * inv;
        tab[i] = (f32x2){cosf(ang), sinf(ang)}; }
}

__device__ __forceinline__ void rope_pass(const Ctx& c, bf16* QKV, const f32x2* tab) {
    for (int idx = c.gtid; idx < T * 48; idx += c.ngt) {
        const int h = idx & 7, s = (idx >> 3) & 1, g = (idx >> 4) % 3, tok = idx / 48, pos = tok & (SEQ - 1);
        u32x4* p = (u32x4*)(QKV + (size_t)tok * QKV_N + g * 3072 + s * 1024 + h * HD);
        u32x4 a0 = p[0], a1 = p[1], b0 = p[2], b1 = p[3];
        const f32x2* tb = tab + pos * 16;
        unsigned x1[8] = {a0.x, a0.y, a0.z, a0.w, a1.x, a1.y, a1.z, a1.w}, x2[8] = {b0.x, b0.y, b0.z, b0.w, b1.x, b1.y, b1.z, b1.w};
        unsigned o1[8], o2[8];
#pragma unroll
        for (int k = 0; k < 8; ++k) { const f32x2 cs0 = tb[2 * k], cs1 = tb[2 * k + 1];
            const float u0 = bflo(x1[k]), u1 = bfhi(x1[k]), v0 = bflo(x2[k]), v1 = bfhi(x2[k]);
            o1[k] = pk2(u0 * cs0.x - v0 * cs0.y, u1 * cs1.x - v1 * cs1.y);
            o2[k] = pk2(v0 * cs0.x + u0 * cs0.y, v1 * cs1.x + u1 * cs1.y); }
        p[0] = (u32x4){o1[0], o1[1], o1[2], o1[3]}; p[1] = (u32x4){o1[4], o1[5], o1[6], o1[7]};
        p[2] = (u32x4){o2[0], o2[1], o2[2], o2[3]}; p[3] = (u32x4){o2[4], o2[5], o2[6], o2[7]};
    }
}

__device__ __forceinline__ void attn_naive(const Ctx& c, const bf16* QKV, bf16* O) {
    const int sub = c.gtid & 3;
    for (int q = c.gtid >> 2; q < T * NH; q += c.ngt >> 2) {
        const int tok = q >> 3, h = q & 7, b = tok >> 11, t = tok & (SEQ - 1);
        float m = -1e30f, l = 0.f; float o[32];
#pragma unroll
        for (int i = 0; i < 32; ++i) o[i] = 0.f;
        for (int g = 0; g < 3; ++g) {
            const int dil = g == 0 ? 1 : (g == 1 ? 4 : 16);
            const u32x4* qp = (const u32x4*)(QKV + (size_t)tok * QKV_N + g * 3072 + h * HD + sub * 32);
            float qf[32];
#pragma unroll
            for (int i = 0; i < 4; ++i) { const u32x4 w = qp[i]; qf[8 * i + 0] = bflo(w.x); qf[8 * i + 1] = bfhi(w.x); qf[8 * i + 2] = bflo(w.y); qf[8 * i + 3] = bfhi(w.y);
                qf[8 * i + 4] = bflo(w.z); qf[8 * i + 5] = bfhi(w.z); qf[8 * i + 6] = bflo(w.w); qf[8 * i + 7] = bfhi(w.w); }
            for (int i = 0; i <= 128; ++i) {
                const int pos = t - dil * i; const bool valid = pos >= 0; const int pc = valid ? pos : t;
                const bf16* rowp = QKV + (size_t)(b * SEQ + pc) * QKV_N + g * 3072 + h * HD + sub * 32;
                const u32x4* kp = (const u32x4*)(rowp + 1024); const u32x4* vp = (const u32x4*)(rowp + 2048);
                float dot = 0.f;
#pragma unroll
                for (int j = 0; j < 4; ++j) { const u32x4 w = kp[j];
                    dot += qf[8 * j + 0] * bflo(w.x) + qf[8 * j + 1] * bfhi(w.x) + qf[8 * j + 2] * bflo(w.y) + qf[8 * j + 3] * bfhi(w.y)
                         + qf[8 * j + 4] * bflo(w.z) + qf[8 * j + 5] * bfhi(w.z) + qf[8 * j + 6] * bflo(w.w) + qf[8 * j + 7] * bfhi(w.w); }
                dot += __shfl_xor(dot, 1); dot += __shfl_xor(dot, 2);
                float s = dot * 0.08838834764831845f; if (!valid) s = -__builtin_inff();
                const float mn = fmaxf(m, s), al = __expf(m - mn), p = __expf(s - mn);
                l = l * al + p; m = mn;
#pragma unroll
                for (int j = 0; j < 4; ++j) { const u32x4 w = vp[j];
                    o[8 * j + 0] = o[8 * j + 0] * al + p * bflo(w.x); o[8 * j + 1] = o[8 * j + 1] * al + p * bfhi(w.x);
                    o[8 * j + 2] = o[8 * j + 2] * al + p * bflo(w.y); o[8 * j + 3] = o[8 * j + 3] * al + p * bfhi(w.y);
                    o[8 * j + 4] = o[8 * j + 4] * al + p * bflo(w.z); o[8 * j + 5] = o[8 * j + 5] * al + p * bfhi(w.z);
                    o[8 * j + 6] = o[8 * j + 6] * al + p * bflo(w.w); o[8 * j + 7] = o[8 * j + 7] * al + p * bfhi(w.w); }
            }
        }
        const float rl = 1.f / l;
        u32x4* op = (u32x4*)(O + (size_t)tok * OD + h * HD + sub * 32);
#pragma unroll
        for (int j = 0; j < 4; ++j) op[j] = (u32x4){pk2(o[8 * j] * rl, o[8 * j + 1] * rl), pk2(o[8 * j + 2] * rl, o[8 * j + 3] * rl), pk2(o[8 * j + 4] * rl, o[8 * j + 5] * rl), pk2(o[8 * j + 6] * rl, o[8 * j + 7] * rl)};
    }
}

template <int SRC, bool FINAL>
__device__ __forceinline__ void ln_row(const Ctx& c, int row, f32x4 (&v)[8], const bf16* PRE, float* OUT, const bf16* YB, bf16* XB, const float* lng, const float* lnb, const float* EG) {
    if (SRC == 0) { const u32x2* p = (const u32x2*)(PRE + (size_t)row * D) + c.lane;
#pragma unroll
        for (int j = 0; j < 8; ++j) { const u32x2 a = p[64 * j]; v[j] = (f32x4){bflo(a.x), bfhi(a.x), bflo(a.y), bfhi(a.y)}; } }
    else { const u32x2* p = (const u32x2*)(XB + (size_t)row * D) + c.lane; const unsigned* y0 = (const unsigned*)((const unsigned char*)YB + (size_t)(2 * row) * D) + c.lane; const unsigned* y1 = y0 + D / 4;
        const float g0 = EG[2 * row] * 0.0625f, g1 = EG[2 * row + 1] * 0.0625f;
#pragma unroll
        for (int j = 0; j < 8; ++j) { const u32x2 xf = p[64 * j]; const int a = (int)y0[64 * j], b = (int)y1[64 * j];
            v[j] = (f32x4){ALPHA * bflo(xf.x) + g0 * __builtin_amdgcn_cvt_f32_fp8(a, 0) + g1 * __builtin_amdgcn_cvt_f32_fp8(b, 0), ALPHA * bfhi(xf.x) + g0 * __builtin_amdgcn_cvt_f32_fp8(a, 1) + g1 * __builtin_amdgcn_cvt_f32_fp8(b, 1),
                           ALPHA * bflo(xf.y) + g0 * __builtin_amdgcn_cvt_f32_fp8(a, 2) + g1 * __builtin_amdgcn_cvt_f32_fp8(b, 2), ALPHA * bfhi(xf.y) + g0 * __builtin_amdgcn_cvt_f32_fp8(a, 3) + g1 * __builtin_amdgcn_cvt_f32_fp8(b, 3)}; } }
    float s = 0.f;
#pragma unroll
    for (int j = 0; j < 8; ++j) s += (v[j].x + v[j].y) + (v[j].z + v[j].w);
    const float mean = wave_sum(s) * (1.f / D); float s2 = 0.f;
#pragma unroll
    for (int j = 0; j < 8; ++j) { v[j] = v[j] - mean; s2 += (v[j].x * v[j].x + v[j].y * v[j].y) + (v[j].z * v[j].z + v[j].w * v[j].w); }
    const float rstd = 1.f / sqrtf(wave_sum(s2) * (1.f / D) + LN_EPS);
    f32x4* xo = (f32x4*)(OUT + (size_t)row * D) + c.lane; u32x2* bo = (u32x2*)(XB + (size_t)row * D) + c.lane;
#pragma unroll
    for (int j = 0; j < 8; ++j) { const f32x4 g = ((const f32x4*)lng)[64 * j + c.lane], b = ((const f32x4*)lnb)[64 * j + c.lane];
        v[j] = v[j] * rstd * g + b; if (FINAL) xo[64 * j] = v[j]; else bo[64 * j] = (u32x2){pk2(v[j].x, v[j].y), pk2(v[j].z, v[j].w)}; }
}
__device__ __forceinline__ float lane_xor16(float v) { auto r = __builtin_amdgcn_permlane16_swap(__builtin_bit_cast(unsigned, v), __builtin_bit_cast(unsigned, v), false, false);
    return __builtin_bit_cast(float, (threadIdx.x & 16) ? r[0] : r[1]); }
__device__ __forceinline__ float reduce16(float (&d)[16], int lane) {
    float a8[8], a4[4], a2[2];
    { const bool up = lane & 32;
#pragma unroll
      for (int e = 0; e < 8; ++e) { const float keep = up ? d[e + 8] : d[e], send = up ? d[e] : d[e + 8]; a8[e] = keep + lane_xor32(send); } }
    { const bool up = lane & 16;
#pragma unroll
      for (int e = 0; e < 4; ++e) { const float keep = up ? a8[e + 4] : a8[e], send = up ? a8[e] : a8[e + 4]; a4[e] = keep + lane_xor16(send); } }
    { const bool up = lane & 8;
#pragma unroll
      for (int e = 0; e < 2; ++e) { const float keep = up ? a4[e + 2] : a4[e], send = up ? a4[e] : a4[e + 2]; a2[e] = keep + dppx<0x128>(send); } }
    float a1; { const bool up = lane & 4; const float keep = up ? a2[1] : a2[0], send = up ? a2[0] : a2[1]; a1 = keep + dppx<0x141>(send); }
    a1 += dppx<0x4E>(a1); a1 += dppx<0xB1>(a1);
    return a1;
}
template <int SRC, int EXTRA, bool FINAL>
__device__ __forceinline__ void ln_pass(const Ctx& c, const bf16* PRE, float* OUT, const bf16* YB, bf16* XB, const float* lng, const float* lnb,
                                        const float* wsrc, int wld, int woff, const float* wbias, int* eid, float* egate, int* hist, float* gates_out) {
    LAS char* wl = (LAS char*)c.lds;
    LAS int* lh = (LAS int*)(c.lds + LDSCTL_OFF + LC_HIST);
    LAS float* lg = (LAS float*)(c.lds + LDSCTL_OFF + 5120) + c.wave * 256;
    if (EXTRA) {
#pragma unroll 1
        for (int it = 0; it < 4; ++it) { float wv[16];
#pragma unroll
            for (int q = 0; q < 16; ++q) { const int idx = c.tid + NTHR * (16 * it + q); wv[q] = wsrc[(size_t)(idx >> 4) * wld + woff + (idx & 15)]; }
#pragma unroll
            for (int q = 0; q < 16; ++q) { const int idx = c.tid + NTHR * (16 * it + q), k = idx >> 4, e = idx & 15;
                const unsigned hb = f2bf(wv[q]); const float hf = __builtin_bit_cast(float, hb << 16); const unsigned lb = f2bf(wv[q] - hf);
                const int off = e * 4096 + ((((k >> 3) ^ e) & 255) << 4) + (k & 7) * 2;
                *(LAS unsigned short*)(wl + off) = (unsigned short)hb; *(LAS unsigned short*)(wl + 65536 + off) = (unsigned short)lb; } } }
    const int l15 = c.lane & 15, q4 = c.lane >> 4;
    for (int vb = c.bid; vb < 256; vb += c.G) {
        if (EXTRA == 1) { if (c.tid < 16) lh[c.tid] = 0; }
        __syncthreads();
        const int rowb = vb * 128 + c.wave * 16;
        if (SRC == 0 && !FINAL) {
            f32x4 gv[8], bv[8];
#pragma unroll
            for (int j = 0; j < 8; ++j) { gv[j] = ((const f32x4*)lng)[64 * j + c.lane]; bv[j] = ((const f32x4*)lnb)[64 * j + c.lane]; }
            u32x2 ra[2][8], rn[2][8];
#pragma unroll
            for (int q = 0; q < 2; ++q) { const u32x2* p = (const u32x2*)(PRE + (size_t)(rowb + q) * D) + c.lane;
#pragma unroll
                for (int j = 0; j < 8; ++j) ra[q][j] = p[64 * j]; }
            for (int i = 0; i < 8; ++i) {
                if (i < 7) {
#pragma unroll
                    for (int q = 0; q < 2; ++q) { const u32x2* p = (const u32x2*)(PRE + (size_t)(rowb + 2 * i + 2 + q) * D) + c.lane;
#pragma unroll
                        for (int j = 0; j < 8; ++j) rn[q][j] = p[64 * j]; } }
#pragma unroll
                for (int q = 0; q < 2; ++q) { const int row = rowb + 2 * i + q; f32x4 v[8]; float s_ = 0.f;
#pragma unroll
                    for (int j = 0; j < 8; ++j) { const u32x2 a = ra[q][j]; v[j] = (f32x4){bflo(a.x), bfhi(a.x), bflo(a.y), bfhi(a.y)}; s_ += (v[j].x + v[j].y) + (v[j].z + v[j].w); }
                    const float mean = wave_sum(s_) * (1.f / D); float s2 = 0.f;
#pragma unroll
                    for (int j = 0; j < 8; ++j) { v[j] = v[j] - mean; s2 += (v[j].x * v[j].x + v[j].y * v[j].y) + (v[j].z * v[j].z + v[j].w * v[j].w); }
                    const float rstd = 1.f / sqrtf(wave_sum(s2) * (1.f / D) + LN_EPS);
                    u32x2* bo = (u32x2*)(XB + (size_t)row * D) + c.lane;
#pragma unroll
                    for (int j = 0; j < 8; ++j) { const f32x4 y = v[j] * rstd * gv[j] + bv[j]; bo[64 * j] = (u32x2){pk2(y.x, y.y), pk2(y.z, y.w)}; } }
#pragma unroll
                for (int q = 0; q < 2; ++q)
#pragma unroll
                    for (int j = 0; j < 8; ++j) ra[q][j] = rn[q][j];
            }
        } else if (SRC == 1) {
            f32x4 gv[8], bv[8];
#pragma unroll
            for (int j = 0; j < 8; ++j) { gv[j] = ((const f32x4*)lng)[64 * j + c.lane]; bv[j] = ((const f32x4*)lnb)[64 * j + c.lane]; }
            u32x2 rx[3][8]; unsigned ry0[3][8], ry1[3][8]; float rg0[3], rg1[3];
#define LN_LOAD1(slot_, row_) do { const u32x2* p_ = (const u32x2*)(XB + (size_t)(row_) * D) + c.lane; const unsigned* y0_ = (const unsigned*)((const unsigned char*)YB + (size_t)(2 * (row_)) * D) + c.lane; const unsigned* y1_ = y0_ + D / 4; \
                rg0[slot_] = egate[2 * (row_)] * 0.0625f; rg1[slot_] = egate[2 * (row_) + 1] * 0.0625f; \
                _Pragma("unroll") for (int j = 0; j < 8; ++j) { rx[slot_][j] = p_[64 * j]; ry0[slot_][j] = y0_[64 * j]; ry1[slot_][j] = y1_[64 * j]; } } while (0)
            LN_LOAD1(0, rowb); LN_LOAD1(1, rowb + 1); LN_LOAD1(2, rowb + 2);
            for (int i = 0; i < 16; ++i) { const int row = rowb + i; f32x4 v[8]; float s_ = 0.f; const float g0 = rg0[0], g1 = rg1[0];
#pragma unroll
                for (int j = 0; j < 8; ++j) { const u32x2 xf = rx[0][j]; const int a = (int)ry0[0][j], b = (int)ry1[0][j];
                    v[j] = (f32x4){ALPHA * bflo(xf.x) + g0 * __builtin_amdgcn_cvt_f32_fp8(a, 0) + g1 * __builtin_amdgcn_cvt_f32_fp8(b, 0), ALPHA * bfhi(xf.x) + g0 * __builtin_amdgcn_cvt_f32_fp8(a, 1) + g1 * __builtin_amdgcn_cvt_f32_fp8(b, 1),
                                   ALPHA * bflo(xf.y) + g0 * __builtin_amdgcn_cvt_f32_fp8(a, 2) + g1 * __builtin_amdgcn_cvt_f32_fp8(b, 2), ALPHA * bfhi(xf.y) + g0 * __builtin_amdgcn_cvt_f32_fp8(a, 3) + g1 * __builtin_amdgcn_cvt_f32_fp8(b, 3)};
                    s_ += (v[j].x + v[j].y) + (v[j].z + v[j].w); }
#pragma unroll
                for (int j = 0; j < 8; ++j) { rx[0][j] = rx[1][j]; ry0[0][j] = ry0[1][j]; ry1[0][j] = ry1[1][j]; rx[1][j] = rx[2][j]; ry0[1][j] = ry0[2][j]; ry1[1][j] = ry1[2][j]; }
                rg0[0] = rg0[1]; rg1[0] = rg1[1]; rg0[1] = rg0[2]; rg1[1] = rg1[2];
                if (i + 3 < 16) LN_LOAD1(2, rowb + i + 3);
                const float mean = wave_sum(s_) * (1.f / D); float s2 = 0.f;
#pragma unroll
                for (int j = 0; j < 8; ++j) { v[j] = v[j] - mean; s2 += (v[j].x * v[j].x + v[j].y * v[j].y) + (v[j].z * v[j].z + v[j].w * v[j].w); }
                const float rstd = 1.f / sqrtf(wave_sum(s2) * (1.f / D) + LN_EPS);
                f32x4* xo = (f32x4*)(OUT + (size_t)row * D) + c.lane; u32x2* bo = (u32x2*)(XB + (size_t)row * D) + c.lane;
#pragma unroll
                for (int j = 0; j < 8; ++j) { const f32x4 y = v[j] * rstd * gv[j] + bv[j]; if (FINAL) xo[64 * j] = y; else bo[64 * j] = (u32x2){pk2(y.x, y.y), pk2(y.z, y.w)}; } }
#undef LN_LOAD1
        } else
        for (int i = 0; i < 8; ++i) { f32x4 va[8], vc[8];
            ln_row<SRC, FINAL>(c, rowb + 2 * i, va, PRE, OUT, YB, XB, lng, lnb, egate);
            ln_row<SRC, FINAL>(c, rowb + 2 * i + 1, vc, PRE, OUT, YB, XB, lng, lnb, egate); }
        if (EXTRA) {
            asm volatile("s_waitcnt vmcnt(0)" ::: "memory");
            __builtin_amdgcn_fence(__ATOMIC_ACQUIRE, "agent");
            pg8::f32x4 acc = {0.f, 0.f, 0.f, 0.f};
            const bf16* arow = XB + (size_t)(rowb + l15) * D + 8 * q4; const LAS char* wrow = wl + l15 * 4096;
#pragma unroll 16
            for (int kk = 0; kk < 64; ++kk) { const pg8::bf16x8 a = *(const pg8::bf16x8*)(arow + 32 * kk);
                const int ch = (((4 * kk + q4) ^ l15) & 255) << 4;
                const pg8::bf16x8 bh = *(const LAS pg8::bf16x8*)(wrow + ch), bl = *(const LAS pg8::bf16x8*)(wrow + 65536 + ch);
                acc = __builtin_amdgcn_mfma_f32_16x16x32_bf16(a, bh, acc, 0, 0, 0); acc = __builtin_amdgcn_mfma_f32_16x16x32_bf16(a, bl, acc, 0, 0, 0); }
            const float bias = wbias[l15];
            if (EXTRA == 2) {
#pragma unroll
                for (int r = 0; r < 4; ++r) { float val = acc[r] + bias; if (l15 >= 8) val = fminf(val, 0.f) - log1pf(expf(-fabsf(val))); gates_out[(size_t)(rowb + 4 * q4 + r) * 16 + l15] = val; }
            } else {
#pragma unroll
                for (int r = 0; r < 4; ++r) lg[(4 * q4 + r) * 16 + l15] = acc[r] + bias;
                LDS_WAIT(); asm volatile("" ::: "memory");
                if (c.lane < 16) { const int row = rowb + c.lane; float dot[16];
#pragma unroll
                    for (int q = 0; q < 4; ++q) { const f32x4 t = *(const LAS f32x4*)(lg + 16 * c.lane + 4 * q); dot[4 * q] = t.x; dot[4 * q + 1] = t.y; dot[4 * q + 2] = t.z; dot[4 * q + 3] = t.w; }
                    float mx = dot[0];
#pragma unroll
                    for (int e = 1; e < 16; ++e) mx = fmaxf(mx, dot[e]);
                    float p[16];
#pragma unroll
                    for (int e = 0; e < 16; ++e) p[e] = __expf(dot[e] - mx);
                    float bestsc = -1.f, bp1 = 0.f, bp2 = 0.f; int be1 = 0, be2 = 0;
#pragma unroll
                    for (int g = 0; g < 4; ++g) { const float a0 = p[4 * g], a1 = p[4 * g + 1], a2 = p[4 * g + 2], a3 = p[4 * g + 3];
                        int i1 = 0; float p1 = a0; if (a1 > p1) { p1 = a1; i1 = 1; } if (a2 > p1) { p1 = a2; i1 = 2; } if (a3 > p1) { p1 = a3; i1 = 3; }
                        int i2 = 0; float p2 = -1.f;
                        if (i1 != 0 && a0 > p2) { p2 = a0; i2 = 0; } if (i1 != 1 && a1 > p2) { p2 = a1; i2 = 1; } if (i1 != 2 && a2 > p2) { p2 = a2; i2 = 2; } if (i1 != 3 && a3 > p2) { p2 = a3; i2 = 3; }
                        const float sc = p1 + p2; if (sc > bestsc) { bestsc = sc; be1 = 4 * g + i1; be2 = 4 * g + i2; bp1 = p1; bp2 = p2; } }
                    const float inv = 1.f / (bp1 + bp2); eid[2 * row] = be1; eid[2 * row + 1] = be2; egate[2 * row] = bp1 * inv; egate[2 * row + 1] = bp2 * inv;
                    __hip_atomic_fetch_add(lh + be1, 1, __ATOMIC_RELAXED, __HIP_MEMORY_SCOPE_WORKGROUP); __hip_atomic_fetch_add(lh + be2, 1, __ATOMIC_RELAXED, __HIP_MEMORY_SCOPE_WORKGROUP); }
            }
        }
        __syncthreads();
        if (EXTRA == 1) { if (c.tid < 16) hist[vb * 16 + c.tid] = lh[c.tid]; }
    }
}

__device__ __forceinline__ void route2(const Ctx& c, const int* eid, const int* hist, int* rowmap, int* tile_e) {
    LAS int* sm = (LAS int*)c.lds;
    for (int vb = c.bid; vb < 256; vb += c.G) {
        __syncthreads();
        if (c.tid < 16) { int tot = 0, bef = 0; for (int b = 0; b < 256; ++b) { const int hv = hist[b * 16 + c.tid]; tot += hv; if (b < vb) bef += hv; } sm[c.tid] = tot; sm[16 + c.tid] = bef; }
        __syncthreads();
        if (c.tid < 16) { int st = 0; for (int e = 0; e < c.tid; ++e) st += (sm[e] + 255) >> 8; st <<= 8;
            int pos = st + sm[16 + c.tid];
            for (int i = 0; i < 256; ++i) { const int a = vb * 256 + i; if (eid[a] == c.tid) { rowmap[pos] = a; ++pos; } }
            if (vb == 0) { const int nt = (sm[c.tid] + 255) >> 8;
                for (int k = 0; k < nt; ++k) tile_e[(st >> 8) + k] = c.tid;
                for (int r = st + sm[c.tid]; r < st + nt * 256; ++r) rowmap[r] = -1;
                if (c.tid == 15) tile_e[MAXTILES] = (st >> 8) + nt; } }
    }
}
__device__ __forceinline__ void gather_rows(const Ctx& c, const bf16* XB, const int* rowmap, const int* tile_e, bf16* XG) {
    const int nrows = tile_e[MAXTILES] * 256;
    for (int r = c.gw; r < nrows; r += c.ngw) { const int a = rowmap[r]; u32x4* dst = (u32x4*)(XG + (size_t)r * D) + c.lane;
        if (a >= 0) { const u32x4* src = (const u32x4*)(XB + (size_t)(a >> 1) * D) + c.lane;
#pragma unroll
            for (int j = 0; j < 4; ++j) dst[64 * j] = src[64 * j]; }
        else {
#pragma unroll
            for (int j = 0; j < 4; ++j) dst[64 * j] = (u32x4){0u, 0u, 0u, 0u}; } }
}

__device__ __forceinline__ void fp8x8_to_f32(u32x2 w, float (&o)[8]) { const int a = (int)w.x, b = (int)w.y;
    o[0] = __builtin_amdgcn_cvt_f32_fp8(a, 0) * 0.0625f; o[1] = __builtin_amdgcn_cvt_f32_fp8(a, 1) * 0.0625f; o[2] = __builtin_amdgcn_cvt_f32_fp8(a, 2) * 0.0625f; o[3] = __builtin_amdgcn_cvt_f32_fp8(a, 3) * 0.0625f;
    o[4] = __builtin_amdgcn_cvt_f32_fp8(b, 0) * 0.0625f; o[5] = __builtin_amdgcn_cvt_f32_fp8(b, 1) * 0.0625f; o[6] = __builtin_amdgcn_cvt_f32_fp8(b, 2) * 0.0625f; o[7] = __builtin_amdgcn_cvt_f32_fp8(b, 3) * 0.0625f; }

constexpr int CONV_ROWS = 16;
__device__ __forceinline__ void conv_pass(const Ctx& c, const unsigned char* Z, const float* cw, const float* cb, bf16* QKC) {
    constexpr int NITEMS = (T / CONV_ROWS) * 256;
    const int c0 = (c.gtid & 255) * 8;
    float w[4][8], bias[8];
#pragma unroll
    for (int j = 0; j < 4; ++j) { const f32x4 w0 = *(const f32x4*)(cw + j * 2048 + c0), w1 = *(const f32x4*)(cw + j * 2048 + c0 + 4); w[j][0] = w0.x; w[j][1] = w0.y; w[j][2] = w0.z; w[j][3] = w0.w; w[j][4] = w1.x; w[j][5] = w1.y; w[j][6] = w1.z; w[j][7] = w1.w; }
    { const f32x4 b0 = *(const f32x4*)(cb + c0), b1 = *(const f32x4*)(cb + c0 + 4); bias[0] = b0.x; bias[1] = b0.y; bias[2] = b0.z; bias[3] = b0.w; bias[4] = b1.x; bias[5] = b1.y; bias[6] = b1.z; bias[7] = b1.w; }
    const float sc = c0 >= 1024 ? 0.08838834764831845f : 1.f;
    u32x2 zr[CONV_ROWS + 3], zn[CONV_ROWS + 3];
#define CONV_LOAD(ZR, idx_) do { const int tok0_ = ((idx_) >> 8) * CONV_ROWS, t0_ = tok0_ & (SEQ - 1); _Pragma("unroll") for (int r = 0; r < CONV_ROWS + 3; ++r) { const int tt = t0_ - 3 + r; ZR[r] = tt >= 0 ? *(const u32x2*)(Z + (size_t)(tok0_ - 3 + r) * ZN + c0) : (u32x2){0u, 0u}; } } while (0)
    if (c.gtid < NITEMS) CONV_LOAD(zr, c.gtid);
    for (int idx = c.gtid; idx < NITEMS; idx += c.ngt) { const int tok0 = (idx >> 8) * CONV_ROWS;
        if (idx + c.ngt < NITEMS) CONV_LOAD(zn, idx + c.ngt);
#pragma unroll
        for (int r = 0; r < CONV_ROWS; ++r) { float acc[8];
#pragma unroll
            for (int k = 0; k < 8; ++k) acc[k] = bias[k];
#pragma unroll
            for (int j = 0; j < 4; ++j) { float zf[8]; fp8x8_to_f32(zr[r + j], zf);
#pragma unroll
                for (int k = 0; k < 8; ++k) acc[k] += zf[k] * w[j][k]; }
#pragma unroll
            for (int k = 0; k < 8; ++k) acc[k] = acc[k] / (1.f + __expf(-acc[k])) * sc;
            *(u32x4*)(QKC + (size_t)(tok0 + r) * 2048 + c0) = (u32x4){pk2(acc[0], acc[1]), pk2(acc[2], acc[3]), pk2(acc[4], acc[5]), pk2(acc[6], acc[7])}; }
#pragma unroll
        for (int r = 0; r < CONV_ROWS + 3; ++r) zr[r] = zn[r];
    }
#undef CONV_LOAD
}
__device__ __forceinline__ void mlstm_naive(const Ctx& c, const bf16* QKC, const bf16* Z, const float* GATES, bf16* HC) {
    LAS float* Qs = (LAS float*)c.lds; LAS float* Ks = Qs + 2048; LAS float* Vs = Ks + 2048; LAS float* LI = Vs + 2048; LAS float* LF = LI + 16; LAS float* DEN = LF + 16; LAS float* MEX = DEN + 16; LAS float* NUM = MEX + 16;
    const bool colthr = c.tid < 128, nthr = (c.wave == 2);
    for (int u = c.bid; u < 256; u += c.G) {
        const int b = u >> 4, h = (u >> 1) & 7, vh = u & 1;
        float C[128];
#pragma unroll
        for (int d = 0; d < 128; ++d) C[d] = 0.f;
        float m = -1e30f;
        for (int grp = 0; grp < 128; ++grp) {
            const int tok0 = b * SEQ + grp * 16;
#pragma unroll
            for (int k = 0; k < 12; ++k) { const int e = c.tid + NTHR * k, which = e >> 11, r = e & 2047, s = r >> 7, d = r & 127;
                const bf16* src = which == 0 ? QKC + (size_t)(tok0 + s) * 2048 + h * 128 + d : (which == 1 ? QKC + (size_t)(tok0 + s) * 2048 + 1024 + h * 128 + d : Z + (size_t)(tok0 + s) * ZN + 2048 + h * 256 + vh * 128 + d);
                Qs[e] = bf1(*src); }
            if (c.tid < 16) { LI[c.tid] = GATES[(size_t)(tok0 + c.tid) * 16 + h]; LF[c.tid] = GATES[(size_t)(tok0 + c.tid) * 16 + 8 + h]; }
            __syncthreads();
            if (colthr || nthr) {
                for (int s = 0; s < 16; ++s) {
                    const float lf = LF[s], li = LI[s], mn = fmaxf(lf + m, li), fd = __expf(lf + m - mn), iw = __expf(li - mn); m = mn;
                    const float vv = nthr ? 1.f : Vs[s * 128 + (c.tid & 127)]; const float kv = iw * vv; float acc = 0.f;
#pragma unroll
                    for (int d4 = 0; d4 < 32; ++d4) { const f32x4 k4 = *(const LAS f32x4*)(Ks + s * 128 + 4 * d4), q4 = *(const LAS f32x4*)(Qs + s * 128 + 4 * d4);
                        C[4 * d4 + 0] = fd * C[4 * d4 + 0] + kv * k4.x; acc += q4.x * C[4 * d4 + 0];
                        C[4 * d4 + 1] = fd * C[4 * d4 + 1] + kv * k4.y; acc += q4.y * C[4 * d4 + 1];
                        C[4 * d4 + 2] = fd * C[4 * d4 + 2] + kv * k4.z; acc += q4.z * C[4 * d4 + 2];
                        C[4 * d4 + 3] = fd * C[4 * d4 + 3] + kv * k4.w; acc += q4.w * C[4 * d4 + 3]; }
                    if (nthr) { if (c.lane == 0) { DEN[s] = acc; MEX[s] = __expf(-mn); } } else NUM[s * 128 + c.tid] = acc;
                }
            }
            __syncthreads();
            if (colthr) {
                for (int s = 0; s < 16; ++s) { const float hv = NUM[s * 128 + c.tid] / fmaxf(fabsf(DEN[s]), MEX[s]);
                    HC[(size_t)(tok0 + s) * 2048 + h * 256 + vh * 128 + c.tid] = (bf16)f2bf(hv); }
            }
        }
        __syncthreads();
    }
}
__device__ __forceinline__ void headnorm_pass(const Ctx& c, const bf16* HC, const unsigned char* Z, const float* ng, bf16* Y) {
    const int half = c.lane >> 5, l32 = c.lane & 31;
    f32x4 ga[4], gb[4];
#pragma unroll
    for (int p = 0; p < 4; ++p) { const float* gp = ng + (2 * p + half) * 256 + 8 * l32; ga[p] = *(const f32x4*)gp; gb[p] = *(const f32x4*)(gp + 4); }
    u32x4 hw[4], hn[4]; u32x2 ow[4], on[4];
#define HN_LOAD(HW, OW, tok_) do { _Pragma("unroll") for (int p = 0; p < 4; ++p) { HW[p] = *(const u32x4*)(HC + (size_t)(tok_) * 2048 + (2 * p + half) * 256 + 8 * l32); OW[p] = *(const u32x2*)(Z + (size_t)(tok_) * ZN + 4096 + (2 * p + half) * 256 + 8 * l32); } } while (0)
    if (c.gw < T) HN_LOAD(hw, ow, c.gw);
    for (int tok = c.gw; tok < T; tok += c.ngw) {
        if (tok + c.ngw < T) HN_LOAD(hn, on, tok + c.ngw);
#pragma unroll
        for (int p = 0; p < 4; ++p) {
            float x[8] = {bflo(hw[p].x), bfhi(hw[p].x), bflo(hw[p].y), bfhi(hw[p].y), bflo(hw[p].z), bfhi(hw[p].z), bflo(hw[p].w), bfhi(hw[p].w)};
            const float ps = prefix_sum64(((x[0] + x[1]) + (x[2] + x[3])) + ((x[4] + x[5]) + (x[6] + x[7]))); const float lo = lane_bcast(ps, 31), al = lane_bcast(ps, 63);
            const float mean = (half ? al - lo : lo) * (1.f / 256.f); float q = 0.f;
#pragma unroll
            for (int k = 0; k < 8; ++k) { x[k] -= mean; q += x[k] * x[k]; }
            const float pq = prefix_sum64(q); const float qlo = lane_bcast(pq, 31), qal = lane_bcast(pq, 63);
            const float rstd = 1.f / sqrtf((half ? qal - qlo : qlo) * (1.f / 256.f) + LN_EPS);
            float o[8]; fp8x8_to_f32(ow[p], o);
            const float gk[8] = {ga[p].x, ga[p].y, ga[p].z, ga[p].w, gb[p].x, gb[p].y, gb[p].z, gb[p].w}; float y[8];
#pragma unroll
            for (int k = 0; k < 8; ++k) y[k] = x[k] * rstd * gk[k] / (1.f + __expf(-o[k]));
            *(u32x4*)(Y + (size_t)tok * 2048 + (2 * p + half) * 256 + 8 * l32) = (u32x4){pk2(y[0], y[1]), pk2(y[2], y[3]), pk2(y[4], y[5]), pk2(y[6], y[7])}; }
#pragma unroll
        for (int p = 0; p < 4; ++p) { hw[p] = hn[p]; ow[p] = on[p]; }
    }
#undef HN_LOAD
}

namespace att {
typedef short bf16x8 __attribute__((ext_vector_type(8)));
typedef short s16x4 __attribute__((ext_vector_type(4)));
typedef float f32x16 __attribute__((ext_vector_type(16)));
constexpr float SCALE = 0.08838834764831845f, THR = 8.f;
constexpr int SHM = 16384;
#define KSWZ(row, colB) ((row) * 256 + ((colB) ^ (((row) & 7) << 4)))
#define SBAR() __builtin_amdgcn_sched_barrier(0)
__device__ __forceinline__ int v_st(int k, int c) { const int kk = (k & ~0xC) | ((k & 4) << 1) | ((k & 8) >> 1); return ((kk >> 3) * 4 + (c >> 5)) * 512 + ((kk & 7) * 32 + (c & 31)) * 2; }
__device__ __forceinline__ int v_rd_base(int lane) { return ((lane & 3) << 3) | (((lane >> 2) & 3) << 6) | (((lane >> 4) & 1) << 5) | (((lane >> 5) & 1) << 8); }
constexpr int v_rd_off(int d0, int ks, int half) { return d0 * 512 + ks * 4096 + half * 2048; }
__device__ __forceinline__ int crow(int r, int hi) { return (r & 3) + 8 * (r >> 2) + 4 * hi; }
__device__ __forceinline__ unsigned cvtpk(float lo, float hi) { unsigned r; asm volatile("v_cvt_pk_bf16_f32 %0, %1, %2" : "=v"(r) : "v"(lo), "v"(hi)); return r; }
__device__ __forceinline__ void mask_tile(f32x16& p0, f32x16& p1, int dq, unsigned W) {
    const float NEG = -__builtin_inff();
#pragma unroll
    for (int r = 0; r < 16; ++r) { const int cc = (r & 3) + 8 * (r >> 2);
        if ((unsigned)(dq - cc) >= W) p0[r] = NEG;
        if ((unsigned)(dq - cc - 32) >= W) p1[r] = NEG; }
}
__device__ __forceinline__ void partialSM(f32x16& p0, f32x16& p1, float& m_reg, float& mn, float& alpha) {
    float pmax = p0[0];
#pragma unroll
    for (int r = 1; r < 16; ++r) pmax = fmaxf(pmax, p0[r]);
#pragma unroll
    for (int r = 0; r < 16; ++r) pmax = fmaxf(pmax, p1[r]);
    { auto rr = __builtin_amdgcn_permlane32_swap(__float_as_uint(pmax), __float_as_uint(pmax), false, false);
      pmax = fmaxf(__uint_as_float(rr[0]), __uint_as_float(rr[1])); }
    constexpr float C2 = 1.4426950408889634f * SCALE;
    if (__builtin_expect(__all((pmax - m_reg) * SCALE <= THR), 1)) { mn = m_reg; alpha = 1.f; }
    else { mn = fmaxf(m_reg, pmax); alpha = __builtin_amdgcn_exp2f((m_reg - mn) * C2); m_reg = mn; }
    const float mnL = -mn * C2;
#pragma unroll
    for (int r = 0; r < 16; ++r) p0[r] = fmaf(p0[r], C2, mnL);
#pragma unroll
    for (int r = 0; r < 16; ++r) p1[r] = fmaf(p1[r], C2, mnL);
#pragma unroll
    for (int r = 0; r < 16; ++r) p0[r] = __builtin_amdgcn_exp2f(p0[r]);
}
__device__ __forceinline__ void finishSM(f32x16& p0, f32x16& p1, float alpha, float& l_reg, bf16x8& pa0, bf16x8& pa1, bf16x8& pa2, bf16x8& pa3) {
#pragma unroll
    for (int r = 0; r < 16; ++r) p1[r] = __builtin_amdgcn_exp2f(p1[r]);
    float ps = 0;
#pragma unroll
    for (int r = 0; r < 16; ++r) ps += p0[r];
#pragma unroll
    for (int r = 0; r < 16; ++r) ps += p1[r];
    { auto rr = __builtin_amdgcn_permlane32_swap(__float_as_uint(ps), __float_as_uint(ps), false, false);
      ps = __uint_as_float(rr[0]) + __uint_as_float(rr[1]); }
    l_reg = l_reg * alpha + ps;
#define PK4(P, B_, OUT) do { unsigned a0 = cvtpk(P[B_+0], P[B_+1]), a1 = cvtpk(P[B_+2], P[B_+3]);                          \
        unsigned b0 = cvtpk(P[B_+4], P[B_+5]), b1 = cvtpk(P[B_+6], P[B_+7]);                                             \
        auto r0 = __builtin_amdgcn_permlane32_swap(a0, b0, false, false); auto r1 = __builtin_amdgcn_permlane32_swap(a1, b1, false, false); \
        u32x4 w = {r0[0], r1[0], r0[1], r1[1]}; OUT = *reinterpret_cast<bf16x8*>(&w); } while (0)
    PK4(p0, 0, pa0); PK4(p0, 8, pa1); PK4(p1, 0, pa2); PK4(p1, 8, pa3);
#undef PK4
}
template <int KB>
__device__ __forceinline__ void qkt(f32x16& p0, f32x16& p1, const LAS char* K_lds, int r32, int hi, const bf16x8* qr) {
    p0 = f32x16{}; p1 = f32x16{};
    const LAS char* kb[4];
#pragma unroll
    for (int dd = 0; dd < 4; ++dd) kb[dd] = K_lds + KB * SHM + KSWZ(r32, (dd * 16 + hi * 8) * 2);
#pragma unroll
    for (int d0 = 0; d0 < 8; ++d0) { const LAS char* a = kb[d0 & 3] + (d0 >> 2) * 128;
        bf16x8 b0 = *reinterpret_cast<const LAS bf16x8*>(a);
        bf16x8 b1 = *reinterpret_cast<const LAS bf16x8*>(a + 32 * 256);
        p0 = __builtin_amdgcn_mfma_f32_32x32x16_bf16(b0, qr[d0], p0, 0, 0, 0);
        p1 = __builtin_amdgcn_mfma_f32_32x32x16_bf16(b1, qr[d0], p1, 0, 0, 0); }
}
template <int VB>
__device__ __forceinline__ void pv_tile(f32x16* o, int vb0, bf16x8 pa0, bf16x8 pa1, bf16x8 pa2, bf16x8 pa3) {
#define TRRD(dst, off) asm volatile("ds_read_b64_tr_b16 %0, %1 offset:%2" : "=&v"(dst) : "v"(vb0), "i"(off) : "memory")
#define PV_D0(d0) do { s16x4 l0, l1, l2, l3, h0, h1, h2, h3; constexpr int b_ = VB * SHM + v_rd_off(d0, 0, 0); \
        TRRD(l0, b_); TRRD(h0, b_ + 2048); TRRD(l1, b_ + 4096); TRRD(h1, b_ + 6144); TRRD(l2, b_ + 8192); TRRD(h2, b_ + 10240); TRRD(l3, b_ + 12288); TRRD(h3, b_ + 14336); \
        asm volatile("s_waitcnt lgkmcnt(0)" ::: "memory"); SBAR();   \
        o[d0] = __builtin_amdgcn_mfma_f32_32x32x16_bf16(pa0, (bf16x8){l0[0], l0[1], l0[2], l0[3], h0[0], h0[1], h0[2], h0[3]}, o[d0], 0, 0, 0);   \
        o[d0] = __builtin_amdgcn_mfma_f32_32x32x16_bf16(pa1, (bf16x8){l1[0], l1[1], l1[2], l1[3], h1[0], h1[1], h1[2], h1[3]}, o[d0], 0, 0, 0);   \
        o[d0] = __builtin_amdgcn_mfma_f32_32x32x16_bf16(pa2, (bf16x8){l2[0], l2[1], l2[2], l2[3], h2[0], h2[1], h2[2], h2[3]}, o[d0], 0, 0, 0);   \
        o[d0] = __builtin_amdgcn_mfma_f32_32x32x16_bf16(pa3, (bf16x8){l3[0], l3[1], l3[2], l3[3], h3[0], h3[1], h3[2], h3[3]}, o[d0], 0, 0, 0); } while (0)
    PV_D0(0); PV_D0(1); PV_D0(2); PV_D0(3);
#undef PV_D0
#undef TRRD
}
template <bool FINAL>
__device__ __forceinline__ void attn_phase(const Ctx& c, const bf16* QKV, bf16* OP, float* LSE, bf16* O) {
    const int half = c.wave >> 2, w4 = c.wave & 3, r32 = c.lane & 31, hi = c.lane >> 5, l = c.lane;
    LAS char* Vl = (LAS char*)c.lds + half * 65536; LAS char* Kl = Vl + 2 * SHM;
    LAS float* wl = (LAS float*)(c.lds + LDSCTL_OFF + 1024) + c.wave * 128; LAS float* al_l = wl + 96;
    const LAS float* wl4 = wl + 4 * hi;
    const int vb0 = (int)(unsigned)(uintptr_t)Vl + v_rd_base(c.lane);
    int krow[4], kcol[4], vrow[4], vcol[4];
#pragma unroll
    for (int j = 0; j < 4; ++j) { const int blk = 4 * w4 + j; krow[j] = 4 * blk + (l >> 4); kcol[j] = (((l & 15) ^ (krow[j] & 7)) * 16) + 2048;
        const int sub = 2 * blk + (l >> 5), kk = (sub >> 2) * 8 + ((l & 31) >> 2); vrow[j] = (kk & ~0xC) | ((kk & 4) << 1) | ((kk & 8) >> 1); vcol[j] = ((sub & 3) * 32 + (l & 3) * 8) * 2 + 4096; }
    constexpr int NUNITS = FINAL ? 1024 : 2048;
    for (int idx = c.bid; idx < NUNITS; idx += c.G) {
        const int hp = idx & 3, rj = (idx >> 2) & 15, b = (idx >> 6) & 15, g = FINAL ? 0 : 1 + (idx >> 10);
        const int h = 2 * hp + half, dil = 1 << (2 * g), nbm = (16 >> (2 * g)) - 1, jb = rj & nbm, r = rj >> (4 - 2 * g);
        const unsigned rs = (unsigned)dil * QKV_N * 2u;
        const char* base = (const char*)(QKV + ((size_t)b * SEQ + r) * QKV_N + g * 3072 + h * HD);
        const int q0 = 128 * jb + 32 * w4;
        bf16x8 qr[8];
#pragma unroll
        for (int d0 = 0; d0 < 8; ++d0) qr[d0] = *(const bf16x8*)(base + ((unsigned)(q0 + r32) * rs + (unsigned)(d0 * 32 + hi * 16)));
#define A_DMA(kb_, bf_) do { _Pragma("unroll") for (int j_ = 0; j_ < 4; ++j_) { \
            __builtin_amdgcn_global_load_lds((const unsigned*)(base + ((unsigned)((kb_) + krow[j_]) * rs + (unsigned)kcol[j_])), (LAS unsigned*)(Kl + (bf_) * SHM + (4 * w4 + j_) * 1024), 16, 0, 0); \
            __builtin_amdgcn_global_load_lds((const unsigned*)(base + ((unsigned)((kb_) + vrow[j_]) * rs + (unsigned)vcol[j_])), (LAS unsigned*)(Vl + (bf_) * SHM + (4 * w4 + j_) * 1024), 16, 0, 0); } } while (0)
        float m_reg = -1e30f, l_reg = 0.f; f32x16 o[4] = {};
        const int kt0 = jb == 0 ? 2 : 0, kb0 = 128 * (jb - 1);
        A_DMA(kb0 + 64 * kt0, 0);
        asm volatile("s_waitcnt vmcnt(0)" ::: "memory"); __syncthreads();
#define A_STEP(kt_, BUF) do { const int kb_ = kb0 + 64 * (kt_); \
            if ((kt_) < 3) A_DMA(kb_ + 64, (BUF) ^ 1);                                         \
            if (kb_ <= q0 + 31 && kb_ + 63 >= q0 - 128) { f32x16 p0, p1; float mn, alpha; bf16x8 pa0, pa1, pa2, pa3; \
                qkt<BUF>(p0, p1, Kl, r32, hi, qr); mask_tile(p0, p1, q0 + r32 - kb_ - 4 * hi, 129u); partialSM(p0, p1, m_reg, mn, alpha); \
                if (__any(alpha < 1.f)) { if (hi == 0) al_l[r32] = alpha; asm volatile("s_waitcnt lgkmcnt(0)" ::: "memory"); \
                    _Pragma("unroll") for (int d_ = 0; d_ < 4; ++d_) _Pragma("unroll") for (int r_ = 0; r_ < 16; ++r_) o[d_][r_] *= al_l[crow(r_, hi)]; } \
                finishSM(p0, p1, alpha, l_reg, pa0, pa1, pa2, pa3); SBAR(); pv_tile<BUF>(o, vb0, pa0, pa1, pa2, pa3); } \
            asm volatile("s_waitcnt vmcnt(0)" ::: "memory"); __syncthreads(); } while (0)
        for (int kt = kt0; kt < 4; kt += 2) { A_STEP(kt, 0); A_STEP(kt + 1, 1); }
#undef A_STEP
#undef A_DMA
        const float lse = m_reg * SCALE + __logf(l_reg);
        const unsigned tok0 = (unsigned)b * SEQ + r;
        if (hi == 0) { const unsigned tokq = tok0 + (unsigned)(q0 + r32) * dil; float w0 = 1.f / l_reg;
            if (FINAL) { const float l1 = LSE[tokq * 8u + h], l2 = LSE[((unsigned)T + tokq) * 8u + h]; const float M = fmaxf(lse, fmaxf(l1, l2));
                const float e0 = __expf(lse - M), e1 = __expf(l1 - M), e2 = __expf(l2 - M), inv = 1.f / (e0 + e1 + e2); w0 *= e0 * inv; wl[32 + r32] = e1 * inv; wl[64 + r32] = e2 * inv; }
            else LSE[((unsigned)(g - 1) * T + tokq) * 8u + h] = lse;
            wl[r32] = w0; }
        asm volatile("s_waitcnt lgkmcnt(0)" ::: "memory");
        LAS char* tile = Vl + (w4 < 2 ? SHM + w4 * 8192 : 3 * SHM + (w4 - 2) * 8192); LAS char* tile4 = tile + 4 * hi * 256 + r32 * 2;
#pragma unroll
        for (int r_ = 0; r_ < 16; ++r_) { const int orow = (r_ & 3) + 8 * (r_ >> 2); const float w0 = wl4[orow];
#pragma unroll
            for (int d0 = 0; d0 < 4; ++d0) { const float v = o[d0][r_] * w0; const float vn = lane_xor1(v);
                if ((r32 & 1) == 0) *(LAS unsigned*)(tile4 + orow * 256 + d0 * 64) = cvtpk(v, vn); } }
        asm volatile("s_waitcnt lgkmcnt(0)" ::: "memory");
#pragma unroll
        for (int i = 0; i < 8; ++i) { const int p = c.lane + 64 * i, row = p >> 4, ch = p & 15; const unsigned tok = tok0 + (unsigned)(q0 + row) * dil; const unsigned col8 = (unsigned)h * HD + ch * 8;
            const u32x4 x = *(const LAS u32x4*)(tile + row * 256 + ch * 16);
            if (FINAL) { const u32x4 pa = *(const u32x4*)(OP + (tok * (unsigned)OD + col8)), pb = *(const u32x4*)(OP + (((unsigned)T + tok) * (unsigned)OD + col8)); const float w1 = wl[32 + row], w2 = wl[64 + row];
                u32x4 y; y.x = cvtpk(bflo(x.x) + w1 * bflo(pa.x) + w2 * bflo(pb.x), bfhi(x.x) + w1 * bfhi(pa.x) + w2 * bfhi(pb.x)); y.y = cvtpk(bflo(x.y) + w1 * bflo(pa.y) + w2 * bflo(pb.y), bfhi(x.y) + w1 * bfhi(pa.y) + w2 * bfhi(pb.y));
                y.z = cvtpk(bflo(x.z) + w1 * bflo(pa.z) + w2 * bflo(pb.z), bfhi(x.z) + w1 * bfhi(pa.z) + w2 * bfhi(pb.z)); y.w = cvtpk(bflo(x.w) + w1 * bflo(pa.w) + w2 * bflo(pb.w), bfhi(x.w) + w1 * bfhi(pa.w) + w2 * bfhi(pb.w));
                *(u32x4*)(O + (tok * (unsigned)OD + col8)) = y; }
            else *(u32x4*)(OP + (((unsigned)(g - 1) * T + tok) * (unsigned)OD + col8)) = x; }
    }
}
#undef KSWZ
#undef SBAR
}

namespace mls {
using att::bf16x8; using att::s16x4; using att::f32x16; using att::v_st; using att::v_rd_base; using att::crow; using att::cvtpk;
constexpr int RSB = 272;
constexpr int L_QP = 0, L_KP = 17408, L_KTR = 34816, L_VTR = 51200, L_AM = 83968, L_RS = 93184, L_QN = 94208, L_WINT = 94464, L_MEXP = 94720, L_HDEN = 94976  , L_NV = 97024  , L_UV = 98048, L_AV = 98560  ;
constexpr int AMB = 144;
#define TRRD(dst, addr, off) asm volatile("ds_read_b64_tr_b16 %0, %1 offset:%2" : "=&v"(dst) : "v"(addr), "i"(off) : "memory")
template <int SKIP>
__device__ __forceinline__ void mlstm_phase(const Ctx& c, const bf16* QKC, const unsigned char* Z, const float* GATES, bf16* HC) {
    const int w = c.wave;
    LAS char* lds = (LAS char*)c.lds;
    LAS float* RS = (LAS float*)(lds + L_RS); LAS float* QN = (LAS float*)(lds + L_QN); LAS float* WINT = (LAS float*)(lds + L_WINT);     LAS float* HDEN = (LAS float*)(lds + L_HDEN);
    LAS float* UV = (LAS float*)(lds + L_UV); LAS float* AV = (LAS float*)(lds + L_AV);
    for (int unit = c.bid; unit < BATCH * 8; unit += c.G) {
        const int b = unit >> 3, h = unit & 7;
        f32x16 Ct[4] = {};
        float n0 = 0.f, n1 = 0.f, m_state = -1e30f;
        bf16x8 sq[2], sk[2]; u32x2 sv[4]; float g_li, g_lf;
#define M_LOAD(tok0_) do { \
            _Pragma("unroll") for (int i_ = 0; i_ < 2; ++i_) { const int p_ = tid_ + 512 * i_, row_ = p_ >> 4, c8_ = (p_ & 15) * 8; const bf16* s_ = QKC + (size_t)((tok0_) + row_) * 2048 + h * 128 + c8_; sq[i_] = *(const bf16x8*)s_; sk[i_] = *(const bf16x8*)(s_ + 1024); } \
            g_li = GATES[(size_t)((tok0_) + (tid_ & 63)) * 16 + h]; g_lf = GATES[(size_t)((tok0_) + (tid_ & 63)) * 16 + 8 + h]; } while (0)
#define M_LOADV(tok0_) do { \
            _Pragma("unroll") for (int i_ = 0; i_ < 4; ++i_) { const int p_ = tid_ + 512 * i_, row_ = p_ >> 5, c8_ = (p_ & 31) * 8; sv[i_] = *(const u32x2*)(Z + (size_t)((tok0_) + row_) * ZN + 2048 + h * 256 + c8_); } } while (0)
        int tid_ = c.tid; asm volatile("" : "+v"(tid_));
        M_LOAD(b * SEQ); M_LOADV(b * SEQ);
        if (w == 5) *(LAS f32x2*)(lds + L_NV + 512 + 8 * c.lane) = (f32x2){0.f, 0.f};
        for (int ch = 0; ch < 32; ++ch) {
            const int tok0 = b * SEQ + ch * 64;
            tid_ = c.tid; asm volatile("" : "+v"(tid_));
            const int l = tid_ & 63, hi = l >> 5, r32 = l & 31, q4 = l >> 4, l15 = l & 15;
            const int vbK = (int)(unsigned)(uintptr_t)(lds + L_KTR) + v_rd_base(l);
            const int vbV = (int)(unsigned)(uintptr_t)(lds + L_VTR) + (w >> 2) * 16384 + (w & 3) * 512 + v_rd_base(l);
            const LAS float* uv_b = UV + 16 * (w & 3) + 4 * q4; const LAS float* as_b = AV + 32 * (w >> 2) + l15;
            LAS char* am_w = lds + L_AM + (16 * (w & 3) + 4 * q4) * AMB + (32 * (w >> 2) + l15) * 2; LAS float* rs_w = RS + 128 * (w >> 2) + 16 * (w & 3) + 4 * q4;
            const LAS float* wint_b = WINT + 4 * hi; const LAS float* hden_b = HDEN + 64 * w + 4 * hi;
            const LAS char* q_b = lds + L_QP + r32 * RSB + 8 * hi; const LAS char* am_b = lds + L_AM + r32 * AMB + 16 * hi;
            const LAS char* sq_b = lds + L_QP + ((16 * (w & 3)) + l15) * RSB + 16 * q4; const LAS char* sk_b = lds + L_KP + l15 * RSB + 16 * q4;
            const int hc_lane = 4 * hi * 2048 + 32 * w + r32;
            const float bc = (SKIP & 64) ? g_lf : prefix_sum64(g_lf);
            const float a = g_li - bc, pm = (SKIP & 64) ? a : prefix_max64(a);
            const float u = fmaxf(m_state, pm), winter = __expf(m_state - u);
            const float blast = lane_bcast(bc, 63), u63 = lane_bcast(u, 63);
            const float wk = __expf(a - u63), decay = __expf(m_state - u63), mexp = __expf(-(bc + u));
            if (!(SKIP & 128)) {
#pragma unroll
            for (int i = 0; i < 2; ++i) { const int p = tid_ + 512 * i, row = p >> 4, c8 = (p & 15) * 8;
                *(LAS bf16x8*)(lds + L_QP + row * RSB + c8 * 2) = sq[i]; *(LAS bf16x8*)(lds + L_KP + row * RSB + c8 * 2) = sk[i];
                const float wr_ = __shfl(wk, row); const u32x4 kw = *reinterpret_cast<const u32x4*>(&sk[i]);
                u32x4 o; o.x = cvtpk(bflo(kw.x) * wr_, bfhi(kw.x) * wr_); o.y = cvtpk(bflo(kw.y) * wr_, bfhi(kw.y) * wr_); o.z = cvtpk(bflo(kw.z) * wr_, bfhi(kw.z) * wr_); o.w = cvtpk(bflo(kw.w) * wr_, bfhi(kw.w) * wr_);
                *(LAS u32x4*)(lds + L_KTR + v_st(row, c8)) = o; }
#pragma unroll
            for (int i = 0; i < 4; ++i) { const int p = tid_ + 512 * i, row = p >> 5, c8 = (p & 31) * 8;
                float vf_[8]; fp8x8_to_f32(sv[i], vf_); *(LAS u32x4*)(lds + L_VTR + (c8 >> 7) * 16384 + v_st(row, c8 & 127)) = (u32x4){cvtpk(vf_[0], vf_[1]), cvtpk(vf_[2], vf_[3]), cvtpk(vf_[4], vf_[5]), cvtpk(vf_[6], vf_[7])}; }
            }
            if (w == 0) { WINT[(ch & 1) * 64 + l] = winter; UV[(ch & 1) * 64 + l] = u; AV[(ch & 1) * 64 + l] = a; }
            if (!(SKIP & 32)) { if (ch + 1 < 32) { M_LOAD(tok0 + 64); M_LOADV(tok0 + 64); } }
            __syncthreads(); __builtin_amdgcn_sched_barrier(0);
            if (!(SKIP & 1)) {
                if (w == 4) { const LAS char* qrow = lds + L_QP + l * RSB; const LAS f32x4* nv = (const LAS f32x4*)(lds + L_NV + ((ch + 1) & 1) * 512);
                    float p0 = 0.f, p1 = 0.f;
#pragma unroll 2
                    for (int d8 = 0; d8 < 16; ++d8) { const u32x4 q = *(const LAS u32x4*)(qrow + 16 * d8); const f32x4 na = nv[2 * d8], nb = nv[2 * d8 + 1];
                        p0 += (bflo(q.x) * na.x + bfhi(q.x) * na.y) + (bflo(q.y) * na.z + bfhi(q.y) * na.w); p1 += (bflo(q.z) * nb.x + bfhi(q.z) * nb.y) + (bflo(q.w) * nb.z + bfhi(q.w) * nb.w); }
                    QN[l] = p0 + p1; }
                if (w == 5) { const LAS char* kb = lds + L_KTR + (l >> 4) * 512 + (l & 15) * 4;
                    float p0 = 0.f, p1 = 0.f;
#pragma unroll 2
                    for (int a_ = 0; a_ < 8; ++a_) {
                        const unsigned k0 = *(const LAS unsigned*)(kb + a_ * 2048 + 0), k1 = *(const LAS unsigned*)(kb + a_ * 2048 + 64), k2 = *(const LAS unsigned*)(kb + a_ * 2048 + 128), k3 = *(const LAS unsigned*)(kb + a_ * 2048 + 192);
                        const unsigned k4 = *(const LAS unsigned*)(kb + a_ * 2048 + 256), k5 = *(const LAS unsigned*)(kb + a_ * 2048 + 320), k6 = *(const LAS unsigned*)(kb + a_ * 2048 + 384), k7 = *(const LAS unsigned*)(kb + a_ * 2048 + 448);
                        p0 += ((bflo(k0) + bflo(k4)) + (bflo(k1) + bflo(k5))) + ((bflo(k2) + bflo(k6)) + (bflo(k3) + bflo(k7))); p1 += ((bfhi(k0) + bfhi(k4)) + (bfhi(k1) + bfhi(k5))) + ((bfhi(k2) + bfhi(k6)) + (bfhi(k3) + bfhi(k7))); }
                    n0 = n0 * decay + p0; n1 = n1 * decay + p1;
                    *(LAS f32x2*)(lds + L_NV + (ch & 1) * 512 + 8 * l) = (f32x2){n0, n1}; }
            }
            __builtin_amdgcn_sched_barrier(0);
            if (!(SKIP & 2)) { const int ti = w & 3, si0 = 2 * (w >> 2);
              const f32x4 ut4 = *(const LAS f32x4*)(uv_b + (ch & 1) * 64);
#pragma unroll
              for (int sj = 0; sj < 2; ++sj) { const int si = si0 + sj; float av[4] = {0.f, 0.f, 0.f, 0.f};
                if (si <= ti) { f32x4 acc = {0.f, 0.f, 0.f, 0.f};
#pragma unroll
                    for (int kk = 0; kk < 4; ++kk) { const bf16x8 af = *(const LAS bf16x8*)(sq_b + 64 * kk), bfr = *(const LAS bf16x8*)(sk_b + (16 * si) * RSB + 64 * kk);
                        acc = __builtin_amdgcn_mfma_f32_16x16x32_bf16(af, bfr, acc, 0, 0, 0); }
                    const float as_ = as_b[(ch & 1) * 64 + 16 * sj]; const int dts = 16 * (ti - si) + 4 * q4 - l15;
#pragma unroll
                    for (int r = 0; r < 4; ++r) av[r] = (dts + r >= 0) ? acc[r] * __expf(as_ - ut4[r]) : 0.f; }
#pragma unroll
                for (int r = 0; r < 4; ++r) { *(LAS unsigned short*)(am_w + r * AMB + sj * 32) = (unsigned short)f2bf(av[r]);
                    const float rs_ = row16_sum(av[r]);
                    if (l15 == 0) rs_w[sj * 64 + r] = rs_; } } }
            __builtin_amdgcn_sched_barrier(0);
            bf16x8 vf[4];
            { s16x4 l0, l1, l2, l3, h0, h1, h2, h3;
              TRRD(l0, vbV, 0); TRRD(h0, vbV, 2048); TRRD(l1, vbV, 4096); TRRD(h1, vbV, 6144); TRRD(l2, vbV, 8192); TRRD(h2, vbV, 10240); TRRD(l3, vbV, 12288); TRRD(h3, vbV, 14336);
              asm volatile("s_waitcnt lgkmcnt(0)" ::: "memory"); __builtin_amdgcn_sched_barrier(0);
              vf[0] = (bf16x8){l0[0], l0[1], l0[2], l0[3], h0[0], h0[1], h0[2], h0[3]}; vf[1] = (bf16x8){l1[0], l1[1], l1[2], l1[3], h1[0], h1[1], h1[2], h1[3]};
              vf[2] = (bf16x8){l2[0], l2[1], l2[2], l2[3], h2[0], h2[1], h2[2], h2[3]}; vf[3] = (bf16x8){l3[0], l3[1], l3[2], l3[3], h3[0], h3[1], h3[2], h3[3]}; }
            f32x16 ac[2] = {};
            if (!(SKIP & 4))
#pragma unroll
            for (int db = 0; db < 4; ++db)
#pragma unroll
                for (int s2 = 0; s2 < 2; ++s2) {
                    u32x4 cw; cw.x = cvtpk(Ct[db][8 * s2 + 0], Ct[db][8 * s2 + 1]); cw.y = cvtpk(Ct[db][8 * s2 + 2], Ct[db][8 * s2 + 3]); cw.z = cvtpk(Ct[db][8 * s2 + 4], Ct[db][8 * s2 + 5]); cw.w = cvtpk(Ct[db][8 * s2 + 6], Ct[db][8 * s2 + 7]);
#pragma unroll
                    for (int th = 0; th < 2; ++th) { const LAS char* qp = q_b + 32 * th * RSB + (32 * db + 16 * s2) * 2; const u32x2 x0 = *(const LAS u32x2*)qp, x1 = *(const LAS u32x2*)(qp + 16);
                        u32x4 o = {x0.x, x0.y, x1.x, x1.y}; ac[th] = __builtin_amdgcn_mfma_f32_32x32x16_bf16(*reinterpret_cast<bf16x8*>(&o), *reinterpret_cast<bf16x8*>(&cw), ac[th], 0, 0, 0); } }
            if (!(SKIP & 8))
#pragma unroll
            for (int db = 0; db < 4; ++db) { s16x4 l0, l1, l2, l3, h0, h1, h2, h3;
                TRRD(l0, vbK, db * 512 + 0); TRRD(h0, vbK, db * 512 + 2048); TRRD(l1, vbK, db * 512 + 4096); TRRD(h1, vbK, db * 512 + 6144); TRRD(l2, vbK, db * 512 + 8192); TRRD(h2, vbK, db * 512 + 10240); TRRD(l3, vbK, db * 512 + 12288); TRRD(h3, vbK, db * 512 + 14336);
#pragma unroll
                for (int r = 0; r < 16; ++r) Ct[db][r] *= decay;
                asm volatile("s_waitcnt lgkmcnt(0)" ::: "memory"); __builtin_amdgcn_sched_barrier(0);
                Ct[db] = __builtin_amdgcn_mfma_f32_32x32x16_bf16((bf16x8){l0[0], l0[1], l0[2], l0[3], h0[0], h0[1], h0[2], h0[3]}, vf[0], Ct[db], 0, 0, 0);
                Ct[db] = __builtin_amdgcn_mfma_f32_32x32x16_bf16((bf16x8){l1[0], l1[1], l1[2], l1[3], h1[0], h1[1], h1[2], h1[3]}, vf[1], Ct[db], 0, 0, 0);
                Ct[db] = __builtin_amdgcn_mfma_f32_32x32x16_bf16((bf16x8){l2[0], l2[1], l2[2], l2[3], h2[0], h2[1], h2[2], h2[3]}, vf[2], Ct[db], 0, 0, 0);
                Ct[db] = __builtin_amdgcn_mfma_f32_32x32x16_bf16((bf16x8){l3[0], l3[1], l3[2], l3[3], h3[0], h3[1], h3[2], h3[3]}, vf[3], Ct[db], 0, 0, 0); }
            m_state = blast + u63;
            __syncthreads(); __builtin_amdgcn_sched_barrier(0);
            if (!(SKIP & 16)) {
            { const float den = ((RS[l] + RS[64 + l]) + (RS[128 + l] + RS[192 + l])) + winter * QN[l]; HDEN[64 * w + l] = 1.f / fmaxf(fabsf(den), mexp); }
            const LAS float* wint_c = wint_b + (ch & 1) * 64;
#pragma unroll
            for (int th = 0; th < 2; ++th) { f32x16 ai = {};
#pragma unroll
                for (int ks = 0; ks < 4; ++ks) { if (th == 0 && ks >= 2) continue; const bf16x8 af = *(const LAS bf16x8*)(am_b + 32 * th * AMB + 32 * ks); ai = __builtin_amdgcn_mfma_f32_32x32x16_bf16(af, vf[ks], ai, 0, 0, 0); }
#pragma unroll
                for (int r = 0; r < 16; ++r) { const int tc = 32 * th + (r & 3) + 8 * (r >> 2); const float v = (ai[r] + wint_c[tc] * ac[th][r]) * hden_b[tc]; const float vn = lane_xor1(v);
                    bf16* rowp = HC + (size_t)(tok0 + tc) * 2048 + h * 256;
                    if ((r32 & 1) == 0) *(unsigned*)(rowp + hc_lane) = cvtpk(v, vn); } }
            }
        }
        __syncthreads();
    }
#undef M_LOAD
#undef M_LOADV
}
#undef TRRD
}

#ifndef GEMM_SP2
#define GEMM_SP2 true
#endif
#ifndef GEMM_ALIGN
#define GEMM_ALIGN true
#endif
#ifndef EPI_NT
#define EPI_NT 1
#endif
#if EPI_NT
#define EPI_ST(p, v) __builtin_nontemporal_store((v), (p))
#else
#define EPI_ST(p, v) (*(p) = (v))
#endif
namespace pg8 {
struct EpiStoreBf16 { static constexpr bool PERM = true, AFTER_DRAIN = false, WIDE = false; bf16_t* O; int ldc;
    __device__ __forceinline__ void operator()(const f32x4 (&acc)[2][2][4][2], const Unit& u, int wr, int wc, int fr, int fq) const {
        const int row0 = u.pm * BM + wr * 64 + fr, col0 = u.pn * BM + wc * 32 + 8 * fq;
#pragma unroll
        for (int ai = 0; ai < 2; ++ai)
#pragma unroll
            for (int m = 0; m < 4; ++m) { bf16_t* rowp = O + (size_t)(row0 + ai * HALF + m * 16) * ldc + col0;
#pragma unroll
                for (int bj = 0; bj < 2; ++bj) { const f32x4 v0 = acc[ai][bj][m][0], v1 = acc[ai][bj][m][1];
                    u32x4 w; w.x = cvt_pk_bf16(v0[0], v0[1]); w.y = cvt_pk_bf16(v0[2], v0[3]); w.z = cvt_pk_bf16(v1[0], v1[1]); w.w = cvt_pk_bf16(v1[2], v1[3]);
                    EPI_ST((u32x4*)(rowp + bj * HALF), w); } }
    }
};
struct EpiStoreFp8 { static constexpr bool PERM = true, AFTER_DRAIN = false; static constexpr int WIDE = 2; unsigned char* O; int ldc;
    __device__ __forceinline__ void operator()(const f32x4 (&acc)[2][2][4][2], const Unit& u, int wr, int wc, int fr, int fq) const {
        unsigned char* tb = O + (size_t)(u.pm * BM) * ldc + u.pn * BM; const unsigned lo = (unsigned)((wr * 64 + fr) * ldc + wc * 64 + 16 * fq);
#pragma unroll
        for (int ai = 0; ai < 2; ++ai)
#pragma unroll
            for (int m = 0; m < 4; ++m) { u32x4 w; unsigned pw[2][2];
#pragma unroll
                for (int bj = 0; bj < 2; ++bj) { const f32x4 v0 = acc[ai][bj][m][0] * 16.f, v1 = acc[ai][bj][m][1] * 16.f;
                    int t0 = __builtin_amdgcn_cvt_pk_fp8_f32(v0[0], v0[1], 0, false); t0 = __builtin_amdgcn_cvt_pk_fp8_f32(v0[2], v0[3], t0, true);
                    int t1 = __builtin_amdgcn_cvt_pk_fp8_f32(v1[0], v1[1], 0, false); t1 = __builtin_amdgcn_cvt_pk_fp8_f32(v1[2], v1[3], t1, true);
                    pw[bj][0] = (unsigned)t0; pw[bj][1] = (unsigned)t1; }
                w.x = pw[0][0]; w.y = pw[0][1]; w.z = pw[1][0]; w.w = pw[1][1];
                EPI_ST((u32x4*)(tb + (size_t)((ai * HALF + m * 16) * ldc) + lo), w); }
    }
};
struct EpiQKV { static constexpr bool PERM = true, AFTER_DRAIN = false, WIDE = false; bf16_t* O; int ldc; const float* tab;
    __device__ __forceinline__ void operator()(const f32x4 (&acc)[2][2][4][2], const Unit& u, int wr, int wc, int fr, int fq) const {
        const int row0 = u.pm * BM + wr * 64 + fr, col0 = u.pn * BM + wc * 32 + 8 * fq;
        const bool rot = ((u.pn >> 2) % 3) < 2 && wc == 0;
        const float* tb = tab + 16 * (fq & 1);
        f32x4 n0 = {1.f, 0.f, 1.f, 0.f}, n1 = n0, n2 = n0, n3 = n0;
        if (rot) { const f32x4* tp = (const f32x4*)(tb + (size_t)(row0 & 2047) * 32); n0 = tp[0]; n1 = tp[1]; n2 = tp[2]; n3 = tp[3]; }
#pragma unroll
        for (int ai = 0; ai < 2; ++ai)
#pragma unroll
            for (int m = 0; m < 4; ++m) { const int row = row0 + ai * HALF + m * 16; bf16_t* rowp = O + (size_t)row * ldc + col0;
                const f32x4 t0 = n0, t1 = n1, t2 = n2, t3 = n3;
                if (rot && (ai * 4 + m) < 7) { const int nrow = row0 + ((ai * 4 + m + 1) >> 2) * HALF + ((ai * 4 + m + 1) & 3) * 16; const f32x4* tp = (const f32x4*)(tb + (size_t)(nrow & 2047) * 32); n0 = tp[0]; n1 = tp[1]; n2 = tp[2]; n3 = tp[3]; }
                const f32x4 c0 = {t0[0], t0[2], t1[0], t1[2]}, c1 = {t2[0], t2[2], t3[0], t3[2]};
                f32x4 s0 = {t0[1], t0[3], t1[1], t1[3]}, s1 = {t2[1], t2[3], t3[1], t3[3]};
                if (fq < 2) { s0 = -s0; s1 = -s1; }
#pragma unroll
                for (int bj = 0; bj < 2; ++bj) { f32x4 v0 = acc[ai][bj][m][0], v1 = acc[ai][bj][m][1];
                    if (rot) { f32x4 p0, p1;
#pragma unroll
                        for (int k = 0; k < 4; ++k) { p0[k] = lane_xor32(v0[k]); p1[k] = lane_xor32(v1[k]); }
                        v0 = v0 * c0 + p0 * s0; v1 = v1 * c1 + p1 * s1; }
                    u32x4 w; w.x = cvt_pk_bf16(v0[0], v0[1]); w.y = cvt_pk_bf16(v0[2], v0[3]); w.z = cvt_pk_bf16(v1[0], v1[1]); w.w = cvt_pk_bf16(v1[2], v1[3]);
                    EPI_ST((u32x4*)(rowp + bj * HALF), w); } }
    }
};
template <bool RES_F32> struct EpiRes { static constexpr bool PERM = true, AFTER_DRAIN = false, WIDE = false; const void* res; bf16_t* out; int ldc; float alpha;
    __device__ __forceinline__ void operator()(const f32x4 (&acc)[2][2][4][2], const Unit& u, int wr, int wc, int fr, int fq) const {
        const int row0 = u.pm * BM + wr * 64 + fr, col0 = u.pn * BM + wc * 32 + 8 * fq;
#pragma unroll
        for (int ai = 0; ai < 2; ++ai)
#pragma unroll
            for (int m = 0; m < 4; ++m) { const size_t off = (size_t)(row0 + ai * HALF + m * 16) * ldc + col0;
#pragma unroll
                for (int bj = 0; bj < 2; ++bj) { f32x4 r0, r1;
                    if (RES_F32) { r0 = *(const f32x4*)((const float*)res + off + bj * HALF); r1 = *(const f32x4*)((const float*)res + off + bj * HALF + 4); }
                    else { const u32x4 rw = *(const u32x4*)((const bf16_t*)res + off + bj * HALF);
                        r0 = (f32x4){__builtin_bit_cast(float, rw.x << 16), __builtin_bit_cast(float, rw.x & 0xffff0000u), __builtin_bit_cast(float, rw.y << 16), __builtin_bit_cast(float, rw.y & 0xffff0000u)};
                        r1 = (f32x4){__builtin_bit_cast(float, rw.z << 16), __builtin_bit_cast(float, rw.z & 0xffff0000u), __builtin_bit_cast(float, rw.w << 16), __builtin_bit_cast(float, rw.w & 0xffff0000u)}; }
                    const f32x4 v0 = r0 * alpha + acc[ai][bj][m][0], v1 = r1 * alpha + acc[ai][bj][m][1];
                    u32x4 w; w.x = cvt_pk_bf16(v0[0], v0[1]); w.y = cvt_pk_bf16(v0[2], v0[3]); w.z = cvt_pk_bf16(v1[0], v1[1]); w.w = cvt_pk_bf16(v1[2], v1[3]);
                    EPI_ST((u32x4*)(out + off + bj * HALF), w); } }
    }
};
struct EpiSwiGLU { static constexpr bool PERM = true, AFTER_DRAIN = false, WIDE = false; bf16_t* H;
    __device__ __forceinline__ void operator()(const f32x4 (&acc)[2][2][4][2], const Unit& u, int wr, int wc, int fr, int fq) const {
        const int row0 = u.pm * BM + wr * 64 + fr, col0 = u.pn * 128 + wc * 16 + 4 * fq;
#pragma unroll
        for (int ai = 0; ai < 2; ++ai)
#pragma unroll
            for (int m = 0; m < 4; ++m) { bf16_t* rowp = H + (size_t)(row0 + ai * HALF + m * 16) * 768 + col0;
#pragma unroll
                for (int bj = 0; bj < 2; ++bj) { const f32x4 v0 = acc[ai][bj][m][0], v1 = acc[ai][bj][m][1];
                    const float h0 = v0[0] / (1.f + __expf(-v0[0])) * v0[1], h1 = v0[2] / (1.f + __expf(-v0[2])) * v0[3], h2 = v1[0] / (1.f + __expf(-v1[0])) * v1[1], h3 = v1[2] / (1.f + __expf(-v1[2])) * v1[3];
                    typedef unsigned u32x2v __attribute__((ext_vector_type(2))); u32x2v w; w.x = cvt_pk_bf16(h0, h1); w.y = cvt_pk_bf16(h2, h3);
                    EPI_ST((u32x2v*)(rowp + bj * 64), w); } }
    }
};
__device__ __forceinline__ unsigned ror8u(unsigned v) { return (unsigned)__builtin_amdgcn_mov_dpp((int)v, 0x128, 0xf, 0xf, true); }
template <bool STORE = true> struct EpiDownT { static constexpr bool PERM = true, AFTER_DRAIN = false, WIDE = true; unsigned char* YB8; const PG8_LAS int* atab;
    __device__ __forceinline__ void operator()(const f32x4 (&acc)[2][2][4][2], const Unit& u, int wr, int wc, int fr, int fq) const {
        typedef unsigned u32x2v __attribute__((ext_vector_type(2)));
        const bool up = fr >= 8; const unsigned ca = (unsigned)(u.pn * BM + wc * 64 + (up ? 32 : 0) + 8 * fq), cb = ca ^ 32u;
        const PG8_LAS int* at = atab + u.ui * 256 + wr * 64 + (fr & 7);
#pragma unroll
        for (int ai = 0; ai < 2; ++ai)
#pragma unroll
            for (int m = 0; m < 4; ++m) { u32x2v p[2];
#pragma unroll
                for (int bj = 0; bj < 2; ++bj) { const f32x4 v0 = acc[ai][bj][m][0] * 16.f, v1 = acc[ai][bj][m][1] * 16.f;
                    int t0 = __builtin_amdgcn_cvt_pk_fp8_f32(v0[0], v0[1], 0, false); t0 = __builtin_amdgcn_cvt_pk_fp8_f32(v0[2], v0[3], t0, true);
                    int t1 = __builtin_amdgcn_cvt_pk_fp8_f32(v1[0], v1[1], 0, false); t1 = __builtin_amdgcn_cvt_pk_fp8_f32(v1[2], v1[3], t1, true);
                    p[bj].x = (unsigned)t0; p[bj].y = (unsigned)t1; }
                const u32x2v x = {ror8u(p[1].x), ror8u(p[1].y)};
                const int aA = at[ai * HALF + m * 16], aB = at[ai * HALF + m * 16 + 8];
                const u32x2v dA = up ? x : p[0], dB = up ? p[0] : x;
                if (STORE) { if (aA >= 0) EPI_ST((u32x2v*)(YB8 + (size_t)aA * 2048 + ca), dA); if (aB >= 0) EPI_ST((u32x2v*)(YB8 + (size_t)aB * 2048 + cb), dB); }
                else asm volatile("" :: "v"(dA.x), "v"(dA.y), "v"(dB.x), "v"(dB.y)); }
    }
};
typedef EpiDownT<true> EpiDown;
template <bool GATHER_> struct MoeOrder { static constexpr bool GATHER = GATHER_; static constexpr int MAXU = 9;
    int nN, G, c, nt; const int* tile_e; size_t exp_bytes; const int* rowmap; PG8_LAS int* tok;
    __device__ __forceinline__ bool next(int i, Unit& u) const { const long L = (long)i * G + c; if (L >= (long)nt * nN) return false; u.pm = (int)(L / nN); u.pn = (int)(L % nN); u.ui = i; return true; }
    __device__ __forceinline__ const char* pa(const Gemm& g, const Unit& u) const { return GATHER_ ? (const char*)g.A : (const char*)g.A + (size_t)u.pm * ((size_t)BM * g.K * 2); }
    __device__ __forceinline__ const char* pb(const Gemm& g, const Unit& u) const { const int e = __builtin_amdgcn_readfirstlane(tok[MAXU * 256 + u.pm]); return (const char*)g.Bt + (size_t)e * exp_bytes + (size_t)u.pn * ((size_t)BM * g.K * 2); }
    __device__ __forceinline__ void prep() const {
        if ((int)threadIdx.x < nt) tok[MAXU * 256 + threadIdx.x] = tile_e[threadIdx.x];
        for (int i = 0; i < MAXU; ++i) { Unit u; if (!next(i, u)) break; if (threadIdx.x < 256) tok[i * 256 + threadIdx.x] = rowmap[u.pm * 256 + threadIdx.x]; }
        asm volatile("s_waitcnt vmcnt(0) lgkmcnt(0)" ::: "memory"); __syncthreads();
    }
    __device__ __forceinline__ void aoffs(int ui, int K, int tid, unsigned (&out)[2][2]) const {
#pragma unroll
        for (int h = 0; h < 2; ++h)
#pragma unroll
            for (int i = 0; i < 2; ++i) { int R, C; stage_rc(tid * 16 + i * 8192, R, C); const int a = tok[ui * 256 + h * 128 + R]; out[h][i] = (unsigned)((a < 0 ? 0 : a) >> 1) * (unsigned)(K * 2) + (unsigned)(C * 2); }
    }
    __device__ __forceinline__ void a_ready(const Unit&) const {}
    __device__ __forceinline__ void done(const Unit&) const {}
};
}

struct Args { const float* in[18]; float* out; unsigned char* ws; int ph_lo, ph_hi; };
#ifdef ONLY_PH
#define IN(k) ((k) == ONLY_PH)
#else
#define IN(k) (lo <= (k) && (k) < hi)
#endif
#define BOTH(k) (IN(k) && IN((k) + 1))
#if MK_ONE_LAUNCH
#define SEAM() xcd_barrier(bar)
#else
#define SEAM() do {} while (0)
#endif
#ifndef REP_PH
#define REP_PH (-1)
#endif
#ifndef REP_PH2
#define REP_PH2 (-1)
#endif
#ifdef TS_PROBE
#define TS_STAMP(k) do { if (blockIdx.x == 0 && threadIdx.x == 0) __hip_atomic_store((unsigned long long*)(ws + WS_CTL + 65536) + (k), __builtin_amdgcn_s_memrealtime(), __ATOMIC_RELAXED, __HIP_MEMORY_SCOPE_AGENT); } while (0)
#define PHASE(k, ...) if (IN(k)) { __VA_ARGS__; SEAM(); TS_STAMP((k) + 1); }
#else
#define PHASE(k, ...) if (IN(k)) { __VA_ARGS__; if ((k) == REP_PH || (k) == REP_PH2) { __syncthreads(); __VA_ARGS__; } if (BOTH(k)) SEAM(); }
#endif
#define WSP(T_, off) ((T_*)(ws + (off)))
#ifndef MOE_XCD_ORDER
#define MOE_XCD_ORDER 1
#endif
#if MOE_XCD_ORDER
#define MOE_CU(c) (((c).G % 8 == 0) ? ((c).bid % 8) * ((c).G / 8) + (c).bid / 8 : (c).bid)
#else
#define MOE_CU(c) ((c).bid)
#endif
#define GEMM_STATIC(EPI, A_, B_, N_, K_, ...) do { pg8::Gemm g{A_, B_, T, N_, K_}; pg8::StaticOrder S; S.init(T, N_, c.G, c.bid); EPI E{__VA_ARGS__}; pg8::gemm_phase<EPI, pg8::StaticOrder, GEMM_ALIGN, GEMM_SP2>(c.lds, g, S, E); } while (0)
#define GEMM_MOE(GATH, EPI, A_, B_, N_, K_, ...) do { pg8::Gemm g{A_, B_, MAXROWS, N_, K_}; pg8::MoeOrder<GATH> S{(N_) / 256, c.G, MOE_CU(c), __builtin_amdgcn_readfirstlane(WSP(int, WS_TILEE)[MAXTILES]), WSP(int, WS_TILEE), (size_t)(N_) * (K_) * 2, WSP(int, WS_ROWMAP), (LAS int*)(c.lds + LDSCTL_OFF + 5120)}; EPI E{__VA_ARGS__}; pg8::gemm_phase<EPI, pg8::MoeOrder<GATH>, GEMM_ALIGN, true>(c.lds, g, S, E); } while (0)
enum { P_PRO = 0, P_QKV, P_ATTA, P_ATTB, P_WO, P_MOE0, P_WIN = P_MOE0 + 5, P_CONV, P_CELL, P_HN, P_WOUT, P_MOE1, P_END = P_MOE1 + 5 };
static_assert(P_END == NPHASE, "phase count");
template <int L>
__device__ __forceinline__ void moe_block(const Ctx& c, const Args& args, unsigned char* ws, const int lo, const int hi, const XcdBarrier& bar, const int base) {
    (void)bar; (void)lo; (void)hi;
    PHASE(base + 0, ln_pass<0, 1, false>(c, WSP(bf16, WS_PRE), nullptr, nullptr, WSP(bf16, WS_XB), args.in[9] + L * D, args.in[10] + L * D, args.in[13], 16, 0, args.in[14], WSP(int, WS_EID), WSP(float, WS_EGATE), WSP(int, WS_HIST), nullptr))
    PHASE(base + 1, route2(c, WSP(int, WS_EID), WSP(int, WS_HIST), WSP(int, WS_ROWMAP), WSP(int, WS_TILEE)))
    PHASE(base + 2, GEMM_MOE(true, pg8::EpiSwiGLU, WSP(bf16, WS_XB), WSP(bf16, WS_WGU), GU_N, D, WSP(bf16, WS_H)))
#ifdef DOWN_NOSTORE_PROBE
    if (IN(base + 3)) { GEMM_MOE(false, pg8::EpiDownT<false>, WSP(bf16, WS_H), WSP(bf16, WS_WD), D, DE, WSP(unsigned char, WS_YB), (const LAS int*)(c.lds + LDSCTL_OFF + 5120)); __syncthreads(); }
#endif
    PHASE(base + 3, GEMM_MOE(false, pg8::EpiDown, WSP(bf16, WS_H), WSP(bf16, WS_WD), D, DE, WSP(unsigned char, WS_YB), (const LAS int*)(c.lds + LDSCTL_OFF + 5120)))
    if (L == 0) { PHASE(base + 4, ln_pass<1, 2, false>(c, nullptr, nullptr, WSP(bf16, WS_YB), WSP(bf16, WS_XB), args.in[11], args.in[12], args.in[3], ZLD, ZN, args.in[4], nullptr, WSP(float, WS_EGATE), nullptr, WSP(float, WS_GATES))) }
    else { PHASE(base + 4, ln_pass<1, 0, true>(c, nullptr, args.out, WSP(bf16, WS_YB), WSP(bf16, WS_XB), args.in[11] + D, args.in[12] + D, nullptr, 0, 0, nullptr, nullptr, WSP(float, WS_EGATE), nullptr, nullptr)) }
}
__global__ void __launch_bounds__(NTHR, 2) fwd(Args args) {
    extern __shared__ __attribute__((aligned(16))) unsigned char lds_raw[];
    Ctx c; c.lds = (LAS unsigned char*)lds_raw; c.tid = threadIdx.x; c.lane = c.tid & 63; c.wave = __builtin_amdgcn_readfirstlane(c.tid >> 6);
    c.G = gridDim.x; c.bid = blockIdx.x; c.gw = c.bid * NWAVES + c.wave; c.ngw = c.G * NWAVES; c.gtid = c.bid * NTHR + c.tid; c.ngt = c.G * NTHR;
    unsigned char* ws = args.ws;
    ((LAS unsigned*)(c.lds + LDSCTL_OFF))[c.tid] = 0u;
    __syncthreads();
#if MK_ONE_LAUNCH
    XcdBarrier bar = xcd_barrier_post((unsigned*)(ws + WS_CTL) + CW_BAR, (volatile LAS unsigned*)(c.lds + LDSCTL_OFF + LC_BAR));
#else
    XcdBarrier bar; bar.bar = nullptr; bar.x = 0; bar.st = nullptr;
#endif
    const int lo = args.ph_lo, hi = args.ph_hi; (void)lo; (void)hi;
#ifdef TS_PROBE
    SEAM(); TS_STAMP(0);
#endif
    PHASE(P_PRO, conv_job(c, args.in[1], QKV_N, D, QKV_N, WSP(bf16, WS_WQKV)); conv_job(c, args.in[2], D, OD, D, WSP(bf16, WS_WO)); conv_job(c, args.in[3], ZLD, D, ZN, WSP(bf16, WS_WIN)); conv_job(c, args.in[8], D, D, D, WSP(bf16, WS_WOUT));
        conv_moe(c, args.in[15], args.in[16], args.in[17], WSP(bf16, WS_WGU), WSP(bf16, WS_WD), c.gw, c.ngw);
        x_to_bf16(c, args.in[0], WSP(bf16, WS_XB)); rope_table(c, WSP(f32x2, WS_ROPE)))
    PHASE(P_QKV, GEMM_STATIC(pg8::EpiQKV, WSP(bf16, WS_XB), WSP(bf16, WS_WQKV), QKV_N, D, WSP(bf16, WS_QKV), QKV_N, WSP(const float, WS_ROPE)))
    PHASE(P_ATTA, att::attn_phase<false>(c, WSP(const bf16, WS_QKV), WSP(bf16, WS_XB), WSP(float, WS_GATES), nullptr))
    PHASE(P_ATTB, att::attn_phase<true>(c, WSP(const bf16, WS_QKV), WSP(bf16, WS_XB), WSP(float, WS_GATES), WSP(bf16, WS_O)))
    PHASE(P_WO, GEMM_STATIC(pg8::EpiRes<true>, WSP(bf16, WS_O), WSP(bf16, WS_WO), D, OD, args.in[0], WSP(bf16, WS_PRE), D, ALPHA))
    moe_block<0>(c, args, ws, lo, hi, bar, P_MOE0);
    PHASE(P_WIN, GEMM_STATIC(pg8::EpiStoreFp8, WSP(bf16, WS_XB), WSP(bf16, WS_WIN), ZN, D, WSP(unsigned char, WS_Z), ZN))
    PHASE(P_CONV, conv_pass(c, WSP(const unsigned char, WS_Z), args.in[5], args.in[6], WSP(bf16, WS_QKC)))
    PHASE(P_CELL,
#if defined(MLS_SKIP)
        mls::mlstm_phase<MLS_SKIP>(c, WSP(const bf16, WS_QKC), WSP(const unsigned char, WS_Z), WSP(const float, WS_GATES), WSP(bf16, WS_HC)); __syncthreads();
#endif
        mls::mlstm_phase<0>(c, WSP(const bf16, WS_QKC), WSP(const unsigned char, WS_Z), WSP(const float, WS_GATES), WSP(bf16, WS_HC));
#if 0
        mls::mlstm_phase<0>(c, WSP(const bf16, WS_QKC), WSP(const unsigned char, WS_Z), WSP(const float, WS_GATES), WSP(bf16, WS_HC));
#endif
        if (c.G > 128) { if (c.bid >= 128) conv_moe(c, args.in[15] + (size_t)NE * D * DE, args.in[16] + (size_t)NE * D * DE, args.in[17] + (size_t)NE * D * DE, WSP(bf16, WS_WGU), WSP(bf16, WS_WD), (c.bid - 128) * NWAVES + c.wave, (c.G - 128) * NWAVES); }
        else conv_moe(c, args.in[15] + (size_t)NE * D * DE, args.in[16] + (size_t)NE * D * DE, args.in[17] + (size_t)NE * D * DE, WSP(bf16, WS_WGU), WSP(bf16, WS_WD), c.gw, c.ngw);
        )
    PHASE(P_HN, headnorm_pass(c, WSP(const bf16, WS_HC), WSP(const unsigned char, WS_Z), args.in[7], WSP(bf16, WS_Y)))
    PHASE(P_WOUT, GEMM_STATIC(pg8::EpiRes<false>, WSP(bf16, WS_Y), WSP(bf16, WS_WOUT), D, D, WSP(bf16, WS_XB), WSP(bf16, WS_PRE), D, ALPHA))
    moe_block<1>(c, args, ws, lo, hi, bar, P_MOE1);
#ifdef TS_PROBE
    {
        SEAM();
        const unsigned long long* ts = (const unsigned long long*)(ws + WS_CTL + 65536);
        const unsigned long long t0 = __hip_atomic_load(ts + TS_PROBE, __ATOMIC_RELAXED, __HIP_MEMORY_SCOPE_AGENT), t1 = __hip_atomic_load(ts + TS_PROBE + 1, __ATOMIC_RELAXED, __HIP_MEMORY_SCOPE_AGENT), t2 = __hip_atomic_load(ts + TS_PROBE + 2, __ATOMIC_RELAXED, __HIP_MEMORY_SCOPE_AGENT);
        const float k1 = (float)(t1 - t0) * 0.001f;
        const float k2 = (TS_PROBE + 2 <= NPHASE) ? (float)(t2 - t1) * 10.0f : 0.f;
        for (size_t i = c.gtid; i < (size_t)T * D; i += c.ngt) args.out[i] = k1;
        SEAM();
        if (c.gtid == 0) args.out[0] = k2;
    }
#endif
}
#undef IN
#undef BOTH

extern "C" void kernel_launch(void* const* d_in, const int* in_sizes, int n_in, void* d_out, int out_size, void* d_ws, size_t ws_size, hipStream_t stream) {
    static int grid = 0;
    if (grid == 0) {
        if (n_in != 18 || in_sizes[0] != T * D || out_size != T * D || ws_size < WS_END) { fprintf(stderr, "kernel_launch: unexpected shapes (n_in %d, in0 %d, out %d, ws %zu)\n", n_in, n_in > 0 ? in_sizes[0] : -1, out_size, ws_size); grid = -1; return; }
        int dev = 0, cus = 0;
        if (hipGetDevice(&dev) != hipSuccess || hipDeviceGetAttribute(&cus, hipDeviceAttributeMultiprocessorCount, dev) != hipSuccess) { grid = -1; return; }
        if (hipFuncSetAttribute((const void*)fwd, hipFuncAttributeMaxDynamicSharedMemorySize, LDS_BYTES) != hipSuccess) { fprintf(stderr, "kernel_launch: hipFuncSetAttribute failed\n"); grid = -1; return; }
        int per_cu = 0;
        if (hipOccupancyMaxActiveBlocksPerMultiprocessor(&per_cu, (const void*)fwd, NTHR, LDS_BYTES) != hipSuccess || per_cu < 1) fprintf(stderr, "kernel_launch: occupancy query says %d\n", per_cu);
        (void)hipGetLastError();
        grid = cus > 256 ? 256 : cus;
    }
    if (grid < 0) return;
    (void)hipMemsetAsync((char*)d_ws + WS_CTL, 0, CTL_ZERO_BYTES, stream);
    Args a{};
    for (int i = 0; i < 18; ++i) a.in[i] = (const float*)d_in[i];
    a.out = (float*)d_out; a.ws = (unsigned char*)d_ws;
#if MK_ONE_LAUNCH
    a.ph_lo = 0; a.ph_hi = NPHASE;
    hipLaunchKernelGGL(fwd, dim3(grid), dim3(NTHR), LDS_BYTES, stream, a);
#else
    for (int p = 0; p < NPHASE; ++p) { a.ph_lo = p; a.ph_hi = p + 1; hipLaunchKernelGGL(fwd, dim3(grid), dim3(NTHR), LDS_BYTES, stream, a); }
#endif
}
```

```cpp
#include <hip/hip_runtime.h>
#include <cstdio>
#include <cstdint>
namespace pg8 {
#define PG8_LAS __attribute__((address_space(3)))
typedef unsigned short bf16_t;
typedef short bf16x8 __attribute__((ext_vector_type(8)));
typedef float f32x4 __attribute__((ext_vector_type(4)));
typedef unsigned u32x4 __attribute__((ext_vector_type(4)));
constexpr int BM = 256, BK = 64, HALF = 128, HTB = HALF * BK * 2  , STAGE_BYTES = 8 * HTB, NXCD = 8, WGM = 8;

__host__ __device__ __forceinline__ int lds_byte(int r, int c) { const int st = (r >> 4) * 2 + (c >> 5), rr = r & 15, cc = c & 31, ob = rr * 64 + cc * 2; return st * 1024 + (ob ^ (((ob >> 9) & 1) << 5)); }
__host__ __device__ __forceinline__ void stage_rc(int b, int& R, int& C) { const int st = b / 1024, sb = b % 1024, swz = sb ^ (((sb >> 9) & 1) << 5); R = (st >> 1) * 16 + swz / 64; C = (st & 1) * 32 + (swz % 64) / 2; }
__host__ __device__ __forceinline__ int perm32(int rho) { const int n = rho >> 4, i = rho & 15; return 8 * (i >> 2) + 4 * n + (i & 3); }

struct Unit { int pm, pn, ui; };
struct Gemm { const bf16_t* A; const bf16_t* Bt; int M, N, K; };

struct StaticOrder {
    int nM, nN, nwg, G, c;
    __host__ __device__ void init(int M, int N, int G_, int c_) { nM = M / BM; nN = N / BM; nwg = nM * nN; G = G_; c = c_; }
    __host__ __device__ bool next(int i, Unit& u) const {
        const long L = (long)i * G + c; if (L >= nwg) return false;
        int wgid = (int)L; { const int q = nwg / NXCD, r = nwg % NXCD, xcd = wgid % NXCD, off = wgid / NXCD; wgid = (xcd < r ? xcd * (q + 1) : r * (q + 1) + (xcd - r) * q) + off; }
        const int nig = WGM * nN, gid = wgid / nig, fm = gid * WGM, gsz = (nM - fm) < WGM ? (nM - fm) : WGM;
        u.pm = fm + ((wgid % nig) % gsz); u.pn = (wgid % nig) / gsz; u.ui = i; return true;
    }
    __device__ __forceinline__ const char* pa(const Gemm& g, const Unit& u) const { return (const char*)g.A + (size_t)u.pm * ((size_t)BM * g.K * 2); }
    __device__ __forceinline__ const char* pb(const Gemm& g, const Unit& u) const { return (const char*)g.Bt + (size_t)u.pn * ((size_t)BM * g.K * 2); }
    static constexpr bool GATHER = false;
    __device__ __forceinline__ void prep() const {}
    __device__ __forceinline__ void aoffs(int, int, int, unsigned (&)[2][2]) const {}
    __device__ __forceinline__ void a_ready(const Unit&) const {}
    __device__ __forceinline__ void done(const Unit&) const {}
};

__device__ __forceinline__ unsigned cvt_pk_bf16(float lo, float hi) { unsigned r; asm volatile("v_cvt_pk_bf16_f32 %0, %1, %2" : "=v"(r) : "v"(lo), "v"(hi)); return r; }
typedef float f32x2 __attribute__((ext_vector_type(2)));
template <class Epi, class Sched, bool ALIGN_EPI = false, bool SP2 = false>
__device__ __forceinline__ void gemm_phase(PG8_LAS unsigned char* lds, const Gemm g, const Sched& S, const Epi& E) {
    const int tid = threadIdx.x, wid = __builtin_amdgcn_readfirstlane(tid >> 6), lane = tid & 63, wr = wid >> 2, wc = wid & 3, fr = lane & 15, fq = lane >> 4;
    const int K = g.K, nt = K / BK;
    unsigned voffA[2], voffB[2];
#pragma unroll
    for (int i = 0; i < 2; ++i) { int R, C; stage_rc(tid * 16 + i * 8192, R, C); const int Rb = Epi::PERM ? ((R & ~31) + perm32(R & 31)) : R;
        voffA[i] = (unsigned)(R * K + C) * 2u; voffB[i] = (unsigned)(((int)Epi::WIDE == 2 ? ((R >> 5) * 64 + 16 * (perm32(R & 31) >> 3) + (perm32(R & 31) & 7)) : (int)Epi::WIDE == 1 ? ((R >> 5) * 64 + perm32(R & 31)) : Rb) * K + C) * 2u; }
    const size_t kstep = (size_t)(BK * 2);
    const size_t hstep = (size_t)HALF * K * 2;
    const size_t hstepB = (int)Epi::WIDE == 2 ? (size_t)8 * K * 2 : (int)Epi::WIDE == 1 ? (size_t)32 * K * 2 : hstep;
    const size_t tstep = 2 * hstep;
    const unsigned ldsw = (unsigned)wid * 1024u;
    const int aoff = lds_byte(wr * 64 + fr, fq * 8), boff = lds_byte(wc * 32 + fr, fq * 8);
#define PG8_SA(b, h) (((b) * 2 + (h)) * HTB)
#define PG8_SB(b, h) ((4 + (b) * 2 + (h)) * HTB)
#define PG8_STAGE(bufoff, gbase, voff) do { _Pragma("unroll") for (int _i = 0; _i < 2; ++_i) \
        __builtin_amdgcn_global_load_lds((const unsigned*)((const char*)(gbase) + (voff)[_i]), (PG8_LAS unsigned*)(lds + (bufoff) + ldsw + _i * 8192), 16, 0, 0); } while (0)
#define PG8_STAGE_A(bufoff, kptr, half, NXT) do { if constexpr (Sched::GATHER) { const unsigned vx_[2] = {(NXT) ? van[half][0] : va[half][0], (NXT) ? van[half][1] : va[half][1]}; PG8_STAGE(bufoff, kptr, vx_); } \
        else { PG8_STAGE(bufoff, (kptr) + ((half) ? hstep : 0), voffA); } } while (0)
#define PG8_LDA(dst, b, h) do { _Pragma("unroll") for (int m = 0; m < 4; ++m) _Pragma("unroll") for (int k = 0; k < 2; ++k) dst[m][k] = *(const PG8_LAS bf16x8*)(lds + PG8_SA(b, h) + aoff + m * 2048 + k * 1024); } while (0)
#define PG8_LDB(dst, b, h) do { _Pragma("unroll") for (int n = 0; n < 2; ++n) _Pragma("unroll") for (int k = 0; k < 2; ++k) dst[n][k] = *(const PG8_LAS bf16x8*)(lds + PG8_SB(b, h) + boff + n * 2048 + k * 1024); } while (0)
#define PG8_MMA(ai, bj, At, Bt) do { __builtin_amdgcn_s_setprio(1); _Pragma("unroll") for (int m = 0; m < 4; ++m) _Pragma("unroll") for (int n = 0; n < 2; ++n) _Pragma("unroll") for (int k = 0; k < 2; ++k) \
        acc[ai][bj][m][n] = __builtin_amdgcn_mfma_f32_16x16x32_bf16(Bt[n][k], At[m][k], acc[ai][bj][m][n], 0, 0, 0); __builtin_amdgcn_s_setprio(0); } while (0)
#define PG8_WAIT_V(n) asm volatile("s_waitcnt vmcnt(" #n ")" ::: "memory")
#define PG8_WAIT_L(n) asm volatile("s_waitcnt lgkmcnt(" #n ")" ::: "memory")
#define PG8_BAR __builtin_amdgcn_s_barrier()
#define PG8_SCHED __builtin_amdgcn_sched_barrier(0)
    Unit cur, nxt; int ui = 0;
    if (!S.next(0, cur)) return;
    S.prep();
    f32x4 acc[2][2][4][2];
#pragma unroll
    for (int a = 0; a < 2; ++a)
#pragma unroll
        for (int b = 0; b < 2; ++b)
#pragma unroll
            for (int m = 0; m < 4; ++m)
#pragma unroll
                for (int n = 0; n < 2; ++n) acc[a][b][m][n] = (f32x4){0.f, 0.f, 0.f, 0.f};
    bf16x8 At[4][2], B0[2][2], B1[2][2];
    const char* cA = S.pa(g, cur); const char* cB = S.pb(g, cur);
    unsigned va[2][2] = {{0u, 0u}, {0u, 0u}}, van[2][2] = {{0u, 0u}, {0u, 0u}};
    static_assert(SP2 || !Epi::WIDE, "WIDE epilogues: SP2 loop only");
    if constexpr (Sched::GATHER) { static_assert(SP2, "gathered A rows: SP2 loop only"); S.aoffs(0, K, tid, va); }
    S.a_ready(cur);
    if constexpr (SP2) {
        PG8_STAGE(PG8_SB(0, 0), cB, voffB); PG8_STAGE(PG8_SB(0, 1), cB + hstepB, voffB); PG8_STAGE_A(PG8_SA(0, 0), cA, 0, false); PG8_STAGE_A(PG8_SA(0, 1), cA, 1, false);
        if (wr == 1) PG8_BAR;
        PG8_WAIT_V(2); PG8_BAR;
        PG8_STAGE(PG8_SB(1, 0), cB + kstep, voffB); PG8_STAGE_A(PG8_SA(1, 0), cA + kstep, 0, false); PG8_STAGE(PG8_SB(1, 1), cB + hstepB + kstep, voffB);
        PG8_WAIT_V(6); PG8_BAR;
    } else {
        PG8_STAGE(PG8_SB(0, 0), cB, voffB); PG8_STAGE(PG8_SA(0, 0), cA, voffA); PG8_STAGE(PG8_SB(0, 1), cB + hstep, voffB); PG8_STAGE(PG8_SA(0, 1), cA + hstep, voffA);
        if (wr == 1) PG8_BAR;
        PG8_WAIT_V(4); PG8_BAR;
        PG8_STAGE(PG8_SB(1, 0), cB + kstep, voffB); PG8_STAGE(PG8_SA(1, 0), cA + kstep, voffA); PG8_STAGE(PG8_SB(1, 1), cB + hstep + kstep, voffB);
        PG8_WAIT_V(6); PG8_BAR;
    }
    for (;;) {
        const bool has_next = S.next(ui + 1, nxt);
        if constexpr (Sched::GATHER) { if (has_next) S.aoffs(ui + 1, K, tid, van); else { van[0][0] = va[0][0]; van[0][1] = va[0][1]; van[1][0] = va[1][0]; van[1][1] = va[1][1]; } }
        const char* nA = has_next ? S.pa(g, nxt) : cA; const char* nB = has_next ? S.pb(g, nxt) : cB;
        for (int t = 0; t < nt; t += 2) {
            const bool last = (t == nt - 2);
            const char* a1 = cA + (size_t)(t + 1) * kstep;
            const char* a2 = last ? nA : cA + (size_t)(t + 2) * kstep; const char* b2 = last ? nB : cB + (size_t)(t + 2) * kstep;
            const char* a3 = a2 + kstep; const char* b3 = b2 + kstep;
            if (last && has_next) S.a_ready(nxt);
            if constexpr (SP2) {
            PG8_LDB(B0, 0, 0); PG8_LDB(B1, 0, 1); PG8_SCHED; PG8_LDA(At, 0, 0); PG8_STAGE_A(PG8_SA(1, 1), a1, 1, false);
            PG8_WAIT_V(8); PG8_WAIT_L(0); PG8_BAR; PG8_MMA(0, 0, At, B0); PG8_MMA(0, 1, At, B1); PG8_BAR; PG8_SCHED;
            PG8_LDA(At, 0, 1); PG8_STAGE(PG8_SB(0, 0), b2, voffB); PG8_STAGE(PG8_SB(0, 1), b2 + hstepB, voffB); PG8_STAGE_A(PG8_SA(0, 0), a2, 0, last);
            PG8_WAIT_V(8); PG8_WAIT_L(0); PG8_BAR; PG8_MMA(1, 0, At, B0); PG8_MMA(1, 1, At, B1); PG8_BAR; PG8_SCHED;
            PG8_LDB(B0, 1, 0); PG8_LDB(B1, 1, 1); PG8_SCHED; PG8_LDA(At, 1, 0); PG8_STAGE_A(PG8_SA(0, 1), a2, 1, last);
            PG8_WAIT_V(8); PG8_WAIT_L(0); PG8_BAR; PG8_MMA(0, 0, At, B0); PG8_MMA(0, 1, At, B1); PG8_BAR; PG8_SCHED;
            PG8_LDA(At, 1, 1); PG8_STAGE(PG8_SB(1, 0), b3, voffB); PG8_STAGE(PG8_SB(1, 1), b3 + hstepB, voffB); PG8_STAGE_A(PG8_SA(1, 0), a3, 0, last);
            PG8_WAIT_V(8); PG8_WAIT_L(0); PG8_BAR; PG8_MMA(1, 0, At, B0); PG8_MMA(1, 1, At, B1); PG8_BAR; PG8_SCHED;
            } else {
            PG8_LDB(B0, 0, 0); PG8_SCHED; PG8_LDA(At, 0, 0); PG8_STAGE(PG8_SA(1, 1), a1 + hstep, voffA);
            PG8_WAIT_L(8); PG8_BAR; PG8_WAIT_L(0); PG8_MMA(0, 0, At, B0); PG8_BAR; PG8_SCHED;
            PG8_LDB(B1, 0, 1); PG8_STAGE(PG8_SB(0, 0), b2, voffB);
            PG8_BAR; PG8_WAIT_L(0); PG8_MMA(0, 1, At, B1); PG8_BAR;
            PG8_LDA(At, 0, 1); PG8_STAGE(PG8_SA(0, 0), a2, voffA);
            PG8_BAR; PG8_WAIT_L(0); PG8_MMA(1, 0, At, B0); PG8_BAR; PG8_SCHED;
            PG8_STAGE(PG8_SB(0, 1), b2 + hstep, voffB);
            PG8_WAIT_V(6); PG8_BAR; PG8_MMA(1, 1, At, B1); PG8_BAR;
            PG8_LDB(B0, 1, 0); PG8_SCHED; PG8_LDA(At, 1, 0); PG8_STAGE(PG8_SA(0, 1), a2 + hstep, voffA);
            PG8_WAIT_L(8); PG8_BAR; PG8_WAIT_L(0); PG8_MMA(0, 0, At, B0); PG8_BAR; PG8_SCHED;
            PG8_LDB(B1, 1, 1); PG8_STAGE(PG8_SB(1, 0), b3, voffB);
            PG8_BAR; PG8_WAIT_L(0); PG8_MMA(0, 1, At, B1); PG8_BAR;
            PG8_LDA(At, 1, 1); PG8_STAGE(PG8_SA(1, 0), a3, voffA);
            PG8_BAR; PG8_WAIT_L(0); PG8_MMA(1, 0, At, B0); PG8_BAR; PG8_SCHED;
            PG8_STAGE(PG8_SB(1, 1), b3 + hstep, voffB);
            PG8_WAIT_V(6); PG8_BAR; PG8_MMA(1, 1, At, B1); PG8_BAR;
            }
        }
        if constexpr (ALIGN_EPI) { if (wr == 0) PG8_BAR; }
        if constexpr (!Epi::AFTER_DRAIN) { E(acc, cur, wr, wc, fr, fq); S.done(cur); }
        if (!has_next) break;
#pragma unroll
        for (int a = 0; a < 2; ++a)
#pragma unroll
            for (int b = 0; b < 2; ++b)
#pragma unroll
                for (int m = 0; m < 4; ++m)
#pragma unroll
                    for (int n = 0; n < 2; ++n) acc[a][b][m][n] = (f32x4){0.f, 0.f, 0.f, 0.f};
        cur = nxt; cA = nA; cB = nB; ++ui;
        if constexpr (Sched::GATHER) { va[0][0] = van[0][0]; va[0][1] = van[0][1]; va[1][0] = van[1][0]; va[1][1] = van[1][1]; }
        if constexpr (ALIGN_EPI) { if (wr == 1) PG8_BAR; }
    }
    PG8_WAIT_V(0);
    if constexpr (!ALIGN_EPI) { if (wr == 0) PG8_BAR; }
    PG8_BAR;
    if constexpr (Epi::AFTER_DRAIN) { E.fused(acc, cur, wr, wc, fr, fq, lds, wid, lane); S.done(cur); }
#undef PG8_SA
#undef PG8_SB
#undef PG8_STAGE
#undef PG8_STAGE_A
#undef PG8_LDA
#undef PG8_LDB
#undef PG8_MMA
#undef PG8_WAIT_V
#undef PG8_WAIT_L
#undef PG8_BAR
#undef PG8_SCHED
}
}

#ifndef MK_ONE_LAUNCH
#define MK_ONE_LAUNCH 1
#endif
constexpr int NWAVES = 8, NTHR = 512;
constexpr int BATCH = 16, SEQ = 2048, T = BATCH * SEQ, D = 2048;
constexpr int QKV_N = 9216, NH = 8, HD = 128, OD = NH * HD;
constexpr int ZN = 6144, ZLD = 6160;
constexpr int NE = 16, DE = 768, GU_N = 2 * DE;
constexpr int MAXTILES = 272, MAXROWS = MAXTILES * 256;
constexpr float ALPHA = 1.41421356237309515f;
constexpr float LN_EPS = 1e-5f;
constexpr int NPHASE = 18;
constexpr int ECAP = 32768;

constexpr size_t MiB = 1u << 20, KiB = 1u << 10;
constexpr size_t WS_CTL = 0, CTL_ZERO_BYTES = 256 * KiB;
constexpr size_t WS_ROPE = 1 * MiB;
constexpr size_t WS_EID = 1 * MiB + 256 * KiB;
constexpr size_t WS_EGATE = 1 * MiB + 512 * KiB;
constexpr size_t WS_ROWMAP = 1 * MiB + 768 * KiB;
constexpr size_t WS_HIST = 2 * MiB + 256 * KiB;
constexpr size_t WS_TILEE = 2 * MiB + 320 * KiB;
constexpr size_t WS_GATES = 3 * MiB;
constexpr size_t WS_WQKV = 6 * MiB, WS_WO = 42 * MiB, WS_WIN = 46 * MiB, WS_WOUT = 70 * MiB, WS_WGU = 78 * MiB, WS_WD = 174 * MiB;
constexpr size_t WS_XB = 222 * MiB;
constexpr size_t WS_R = 350 * MiB;
constexpr size_t WS_QKV = WS_R, WS_O = WS_R + 576 * MiB;
constexpr size_t WS_PRE = WS_R, WS_YB = WS_R;
constexpr size_t WS_XG = WS_R + 256 * MiB, WS_H = WS_R + 528 * MiB;
constexpr size_t WS_Z = WS_R, WS_QKC = WS_R + 384 * MiB, WS_HC = WS_R + 512 * MiB, WS_Y = WS_QKC;
constexpr size_t WS_RM2 = 990 * MiB;
constexpr size_t WS_END = 992 * MiB;
static_assert(WS_ROWMAP + (size_t)MAXROWS * 4 <= WS_HIST && WS_H + (size_t)MAXROWS * DE * 2 <= WS_RM2 && WS_RM2 + (size_t)16 * ECAP * 4 <= WS_END && WS_XG + (size_t)MAXROWS * D * 2 <= WS_H, "ws map");
constexpr int CW_TMO = 0, CW_BAR = 4096, CW_CONVQ = 8192, CW_CUR = 12288;

constexpr int RING_BYTES = 131072, LDSCTL_OFF = RING_BYTES, LDS_BYTES = 147456;
constexpr int LC_HIST = 0, LC_BAR = 64;

#define GAS __attribute__((address_space(1)))
#define LAS __attribute__((address_space(3)))
typedef unsigned short bf16;
typedef unsigned u32x4 __attribute__((ext_vector_type(4)));
typedef unsigned u32x2 __attribute__((ext_vector_type(2)));
typedef float f32x4 __attribute__((ext_vector_type(4)));
typedef float f32x2 __attribute__((ext_vector_type(2)));
#define LDS_WAIT() asm volatile("s_waitcnt lgkmcnt(0)" ::: "memory")
__device__ __forceinline__ unsigned f2bf(float f) { unsigned u = __builtin_bit_cast(unsigned, f); return (u + 0x7fffu + ((u >> 16) & 1u)) >> 16; }
__device__ __forceinline__ unsigned pk2(float lo, float hi) { return pg8::cvt_pk_bf16(lo, hi); }
__device__ __forceinline__ float bflo(unsigned u) { return __builtin_bit_cast(float, u << 16); }
__device__ __forceinline__ float bfhi(unsigned u) { return __builtin_bit_cast(float, u & 0xffff0000u); }
__device__ __forceinline__ float bf1(bf16 b) { return __builtin_bit_cast(float, (unsigned)b << 16); }
template <int CTRL> __device__ __forceinline__ float dpp0(float x) { return __builtin_bit_cast(float, __builtin_amdgcn_update_dpp(0, __builtin_bit_cast(int, x), CTRL, 0xf, 0xf, true)); }
template <int CTRL> __device__ __forceinline__ float dppx(float x) { return __builtin_bit_cast(float, __builtin_amdgcn_mov_dpp(__builtin_bit_cast(int, x), CTRL, 0xf, 0xf, true)); }
template <int CTRL, int ROWMASK> __device__ __forceinline__ float dpps(float x) { return __builtin_bit_cast(float, __builtin_amdgcn_update_dpp(__builtin_bit_cast(int, x), __builtin_bit_cast(int, x), CTRL, ROWMASK, 0xf, false)); }
__device__ __forceinline__ float prefix_sum64(float v) {
    v += dpp0<0x111>(v); v += dpp0<0x112>(v); v += dpp0<0x114>(v); v += dpp0<0x118>(v);
    v += __builtin_bit_cast(float, __builtin_amdgcn_update_dpp(0, __builtin_bit_cast(int, v), 0x142, 0xa, 0xf, false));
    v += __builtin_bit_cast(float, __builtin_amdgcn_update_dpp(0, __builtin_bit_cast(int, v), 0x143, 0xc, 0xf, false));
    return v;
}
__device__ __forceinline__ float prefix_max64(float v) {
    v = fmaxf(v, dpps<0x111, 0xf>(v)); v = fmaxf(v, dpps<0x112, 0xf>(v)); v = fmaxf(v, dpps<0x114, 0xf>(v)); v = fmaxf(v, dpps<0x118, 0xf>(v));
    v = fmaxf(v, dpps<0x142, 0xa>(v)); v = fmaxf(v, dpps<0x143, 0xc>(v));
    return v;
}
__device__ __forceinline__ float lane_bcast(float v, int l) { return __builtin_bit_cast(float, __builtin_amdgcn_readlane(__builtin_bit_cast(int, v), l)); }
__device__ __forceinline__ float wave_sum(float v) { return lane_bcast(prefix_sum64(v), 63); }
__device__ __forceinline__ float row16_sum(float v) { v += dppx<0xB1>(v); v += dppx<0x4E>(v); v += dppx<0x141>(v); v += dppx<0x128>(v); return v; }
__device__ __forceinline__ float lane_xor1(float v) { return dppx<0xB1>(v); }
__device__ __forceinline__ float lane_xor32(float v) { auto r = __builtin_amdgcn_permlane32_swap(__builtin_bit_cast(unsigned, v), __builtin_bit_cast(unsigned, v), false, false);
    return __builtin_bit_cast(float, (threadIdx.x & 32) ? r[0] : r[1]); }

#define XB_TMO      128
#define XB_XCNT(j)  (256  + 64 * (j))
#define XB_XSUB(j)  (1280 + 64 * (j))
#define XB_XGEN(j)  (2304 + 64 * (j))
#define XB_TOP      3328
#define XB_TOPGEN   3392
#define XCD_BAR_WORDS 3456
#define XB_SPIN_CAP (1u << 18)
__device__ __forceinline__ unsigned xb_ld(unsigned* p)              { return __hip_atomic_load(p, __ATOMIC_RELAXED, __HIP_MEMORY_SCOPE_AGENT); }
__device__ __forceinline__ unsigned xb_add(unsigned* p, unsigned v) { return __hip_atomic_fetch_add(p, v, __ATOMIC_RELAXED, __HIP_MEMORY_SCOPE_AGENT); }
__device__ __forceinline__ unsigned xb_xcc_id() { return (unsigned)__builtin_amdgcn_s_getreg((3 << 11) | 20) & 0xFu; }
#define XB_SPIN(cond, bar) do { unsigned _sp = 0; while (cond) { __builtin_amdgcn_s_sleep(1); \
    if ((++_sp & 255u) == 0u) { if (xb_ld(&(bar)[XB_TMO])) break; if (_sp > XB_SPIN_CAP) { atomicAdd(&(bar)[XB_TMO], 1u); break; } } } } while (0)
struct XcdBarrier { unsigned* bar; unsigned x; volatile LAS unsigned* st; };
__device__ __forceinline__ XcdBarrier xcd_barrier_post(unsigned* bar, volatile LAS unsigned* st) {
    XcdBarrier b; b.bar = bar; b.x = xb_xcc_id(); b.st = st;
    if (threadIdx.x == 0) (void)xb_add(&bar[XB_XCNT(b.x)], 1u);
    return b;
}
__device__ __forceinline__ void xcd_barrier_complete(unsigned* bar, unsigned x, unsigned& nloc, unsigned& nx) {
    const unsigned G = gridDim.x * gridDim.y * gridDim.z;
    unsigned sum, cnt, mine, sp = 0u;
    for (;;) {
        sum = 0u; cnt = 0u; mine = 0u;
#pragma unroll
        for (unsigned j = 0; j < 16; ++j) { const unsigned c = xb_ld(&bar[XB_XCNT(j)]); sum += c; cnt += (c > 0u) ? 1u : 0u; mine = (j == x) ? c : mine; }
        if (sum == G) break;
        __builtin_amdgcn_s_sleep(1);
        if ((++sp & 255u) == 0u) { if (xb_ld(&bar[XB_TMO])) break; if (sp > XB_SPIN_CAP) { atomicAdd(&bar[XB_TMO], 1u); break; } }
    }
    nloc = mine > 0u ? mine : 1u; nx = cnt > 0u ? cnt : 1u;
}
__device__ __forceinline__ void xcd_barrier(const XcdBarrier& b) {
    asm volatile("s_waitcnt vmcnt(0)" ::: "memory");
    __syncthreads();
    if (threadIdx.x == 0) {
        unsigned* bar = b.bar;
        __builtin_amdgcn_s_waitcnt(0);
        unsigned nloc = b.st[0], nx = b.st[1];
        if (nloc == 0u) { xcd_barrier_complete(bar, b.x, nloc, nx); b.st[0] = nloc; b.st[1] = nx; }
        const unsigned old = xb_add(&bar[XB_XSUB(b.x)], 1u);
        const unsigned gen = old / nloc;
        if (old + 1u == (gen + 1u) * nloc) {
            __builtin_amdgcn_fence(__ATOMIC_RELEASE, "agent");
            asm volatile("s_waitcnt vmcnt(0)" ::: "memory");
            const unsigned og = xb_add(&bar[XB_TOP], 1u);
            const unsigned tg = og / nx;
            if (og + 1u == (tg + 1u) * nx) xb_add(&bar[XB_TOPGEN], 1u);
            else XB_SPIN(xb_ld(&bar[XB_TOPGEN]) == tg, bar);
            __builtin_amdgcn_fence(__ATOMIC_ACQUIRE, "agent");
            xb_add(&bar[XB_XGEN(b.x)], 1u);
            asm volatile("s_waitcnt vmcnt(0)" ::: "memory");
        } else {
            XB_SPIN(xb_ld(&bar[XB_XGEN(b.x)]) == gen, bar);
            __builtin_amdgcn_fence(__ATOMIC_ACQUIRE, "agent");
            asm volatile("s_waitcnt vmcnt(0)" ::: "memory");
        }
    }
    __syncthreads();
}

struct Ctx { LAS unsigned char* lds; int tid, lane, wave, G, bid, gw, ngw, gtid, ngt; };

struct TrDesc { const float* wp; bf16* dst; int ldw, K, row_mul; };
__device__ __forceinline__ void tr_mk(TrDesc& d, const float* W, int ldw, int K, bf16* WT, int row_off, int row_mul, int kb, int nb, int lane) {
    const int k0 = 64 * kb, n0 = 32 * nb; d.wp = W + (size_t)(k0 + (lane >> 5)) * ldw + n0 + (lane & 31); d.dst = WT + (size_t)(row_off + n0 * row_mul) * K + k0; d.ldw = ldw; d.K = K; d.row_mul = row_mul; }
__device__ __forceinline__ void tr_load(const TrDesc& d, float (&tv)[32]) {
#pragma unroll
    for (int i = 0; i < 32; ++i) tv[i] = d.wp[(size_t)(2 * i) * d.ldw]; }
__device__ __forceinline__ void tr_store(const TrDesc& d, const float (&tv)[32], LAS float* scr, int lane) {
#pragma unroll
    for (int i = 0; i < 32; ++i) scr[(2 * i + (lane >> 5)) * 33 + (lane & 31)] = tv[i];
    LDS_WAIT(); asm volatile("" ::: "memory");
    const int c = lane & 7;
#pragma unroll
    for (int j = 0; j < 4; ++j) { const int n = (lane >> 3) + 8 * j; const LAS float* s_ = scr + (8 * c) * 33 + n;
        u32x4 o; o.x = pk2(s_[0 * 33], s_[1 * 33]); o.y = pk2(s_[2 * 33], s_[3 * 33]); o.z = pk2(s_[4 * 33], s_[5 * 33]); o.w = pk2(s_[6 * 33], s_[7 * 33]);
        *(u32x4*)(d.dst + (size_t)(n * d.row_mul) * d.K + 8 * c) = o; }
    LDS_WAIT(); asm volatile("" ::: "memory");
}
#define TR_PIPELINE(first_, stride_, end_, MK_) do { LAS float* scr_ = (LAS float*)(c.lds + c.wave * 16384); TrDesc cur_, nxt_; float ta_[32], tb_[32]; int it_ = (first_); \
        if (it_ < (end_)) { MK_(cur_, it_); tr_load(cur_, ta_); } \
        for (; it_ < (end_); it_ += (stride_)) { const int itn_ = it_ + (stride_); const bool hn_ = itn_ < (end_); if (hn_) { MK_(nxt_, itn_); tr_load(nxt_, tb_); } \
            tr_store(cur_, ta_, scr_, c.lane); if (hn_) { cur_ = nxt_; _Pragma("unroll") for (int q_ = 0; q_ < 32; ++q_) ta_[q_] = tb_[q_]; } } } while (0)
__device__ __forceinline__ void conv_job(const Ctx& c, const float* W, int ldw, int K, int N, bf16* WT) {
    const int nblk = N / 32, items = (K / 64) * nblk;
#define MK_JOB(d_, it2_) tr_mk(d_, W, ldw, K, WT, 0, 1, (it2_) / nblk, (it2_) % nblk, c.lane)
    TR_PIPELINE(c.gw, c.ngw, items, MK_JOB);
#undef MK_JOB
}
constexpr int CONV_MOE_ITEMS = 3 * NE * 768;
__device__ __forceinline__ void conv_moe_mk(TrDesc& d, int it, const float* Wg, const float* Wu, const float* Wd, bf16* WGU, bf16* WD, int lane) {
    constexpr int PER = 768; const int kind = it / (NE * PER), r = it % (NE * PER), e = r / PER, q = r % PER;
    if (kind < 2) tr_mk(d, (kind == 0 ? Wg : Wu) + (size_t)e * D * DE, DE, D, WGU + (size_t)e * GU_N * D, kind, 2, q / 24, q % 24, lane);
    else tr_mk(d, Wd + (size_t)e * DE * D, D, DE, WD + (size_t)e * D * DE, 0, 1, q / 64, q % 64, lane);
}
__device__ __forceinline__ void conv_moe(const Ctx& c, const float* Wg, const float* Wu, const float* Wd, bf16* WGU, bf16* WD, int gw0, int ngw0, int end = CONV_MOE_ITEMS) {
#define MK_MOE(d_, it2_) conv_moe_mk(d_, it2_, Wg, Wu, Wd, WGU, WD, c.lane)
    TR_PIPELINE(gw0, ngw0, end, MK_MOE);
#undef MK_MOE
}
__device__ __forceinline__ void x_to_bf16(const Ctx& c, const float* x, bf16* XB) {
    for (size_t i = c.gtid; i < (size_t)T * D / 8; i += c.ngt) { const f32x4 a = ((const f32x4*)x)[2 * i], b = ((const f32x4*)x)[2 * i + 1];
        u32x4 o; o.x = pk2(a.x, a.y); o.y = pk2(a.z, a.w); o.z = pk2(b.x, b.y); o.w = pk2(b.z, b.w); ((u32x4*)XB)[i] = o; }
}
__device__ __forceinline__ void rope_table(const Ctx& c, f32x2* tab) {
    for (int i = c.gtid; i < SEQ * 16; i += c.ngt) { const int pos = i >> 4, j = i & 15;
        const float inv = powf(500000.0f, -(float)j / 16.0f); const float ang = (float)pos * inv;
        tab[i] = (f32x2){cosf(ang), sinf(ang)}; }
}

__device__ __forceinline__ void rope_pass(const Ctx& c, bf16* QKV, const f32x2* tab) {
    for (int idx = c.gtid; idx < T * 48; idx += c.ngt) {
        const int h = idx & 7, s = (idx >> 3) & 1, g = (idx >> 4) % 3, tok = idx / 48, pos = tok & (SEQ - 1);
        u32x4* p = (u32x4*)(QKV + (size_t)tok * QKV_N + g * 3072 + s * 1024 + h * HD);
        u32x4 a0 = p[0], a1 = p[1], b0 = p[2], b1 = p[3];
        const f32x2* tb = tab + pos * 16;
        unsigned x1[8] = {a0.x, a0.y, a0.z, a0.w, a1.x, a1.y, a1.z, a1.w}, x2[8] = {b0.x, b0.y, b0.z, b0.w, b1.x, b1.y, b1.z, b1.w};
        unsigned o1[8], o2[8];
#pragma unroll
        for (int k = 0; k < 8; ++k) { const f32x2 cs0 = tb[2 * k], cs1 = tb[2 * k + 1];
            const float u0 = bflo(x1[k]), u1 = bfhi(x1[k]), v0 = bflo(x2[k]), v1 = bfhi(x2[k]);
            o1[k] = pk2(u0 * cs0.x - v0 * cs0.y, u1 * cs1.x - v1 * cs1.y);
            o2[k] = pk2(v0 * cs0.x + u0 * cs0.y, v1 * cs1.x + u1 * cs1.y); }
        p[0] = (u32x4){o1[0], o1[1], o1[2], o1[3]}; p[1] = (u32x4){o1[4], o1[5], o1[6], o1[7]};
        p[2] = (u32x4){o2[0], o2[1], o2[2], o2[3]}; p[3] = (u32x4){o2[4], o2[5], o2[6], o2[7]};
    }
}

__device__ __forceinline__ void attn_naive(const Ctx& c, const bf16* QKV, bf16* O) {
    const int sub = c.gtid & 3;
    for (int q = c.gtid >> 2; q < T * NH; q += c.ngt >> 2) {
        const int tok = q >> 3, h = q & 7, b = tok >> 11, t = tok & (SEQ - 1);
        float m = -1e30f, l = 0.f; float o[32];
#pragma unroll
        for (int i = 0; i < 32; ++i) o[i] = 0.f;
        for (int g = 0; g < 3; ++g) {
            const int dil = g == 0 ? 1 : (g == 1 ? 4 : 16);
            const u32x4* qp = (const u32x4*)(QKV + (size_t)tok * QKV_N + g * 3072 + h * HD + sub * 32);
            float qf[32];
#pragma unroll
            for (int i = 0; i < 4; ++i) { const u32x4 w = qp[i]; qf[8 * i + 0] = bflo(w.x); qf[8 * i + 1] = bfhi(w.x); qf[8 * i + 2] = bflo(w.y); qf[8 * i + 3] = bfhi(w.y);
                qf[8 * i + 4] = bflo(w.z); qf[8 * i + 5] = bfhi(w.z); qf[8 * i + 6] = bflo(w.w); qf[8 * i + 7] = bfhi(w.w); }
            for (int i = 0; i <= 128; ++i) {
                const int pos = t - dil * i; const bool valid = pos >= 0; const int pc = valid ? pos : t;
                const bf16* rowp = QKV + (size_t)(b * SEQ + pc) * QKV_N + g * 3072 + h * HD + sub * 32;
                const u32x4* kp = (const u32x4*)(rowp + 1024); const u32x4* vp = (const u32x4*)(rowp + 2048);
                float dot = 0.f;
#pragma unroll
                for (int j = 0; j < 4; ++j) { const u32x4 w = kp[j];
                    dot += qf[8 * j + 0] * bflo(w.x) + qf[8 * j + 1] * bfhi(w.x) + qf[8 * j + 2] * bflo(w.y) + qf[8 * j + 3] * bfhi(w.y)
                         + qf[8 * j + 4] * bflo(w.z) + qf[8 * j + 5] * bfhi(w.z) + qf[8 * j + 6] * bflo(w.w) + qf[8 * j + 7] * bfhi(w.w); }
                dot += __shfl_xor(dot, 1); dot += __shfl_xor(dot, 2);
                float s = dot * 0.08838834764831845f; if (!valid) s = -__builtin_inff();
                const float mn = fmaxf(m, s), al = __expf(m - mn), p = __expf(s - mn);
                l = l * al + p; m = mn;
#pragma unroll
                for (int j = 0; j < 4; ++j) { const u32x4 w = vp[j];
                    o[8 * j + 0] = o[8 * j + 0] * al + p * bflo(w.x); o[8 * j + 1] = o[8 * j + 1] * al + p * bfhi(w.x);
                    o[8 * j + 2] = o[8 * j + 2] * al + p * bflo(w.y); o[8 * j + 3] = o[8 * j + 3] * al + p * bfhi(w.y);
                    o[8 * j + 4] = o[8 * j + 4] * al + p * bflo(w.z); o[8 * j + 5] = o[8 * j + 5] * al + p * bfhi(w.z);
                    o[8 * j + 6] = o[8 * j + 6] * al + p * bflo(w.w); o[8 * j + 7] = o[8 * j + 7] * al + p * bfhi(w.w); }
            }
        }
        const float rl = 1.f / l;
        u32x4* op = (u32x4*)(O + (size_t)tok * OD + h * HD + sub * 32);
#pragma unroll
        for (int j = 0; j < 4; ++j) op[j] = (u32x4){pk2(o[8 * j] * rl, o[8 * j + 1] * rl), pk2(o[8 * j + 2] * rl, o[8 * j + 3] * rl), pk2(o[8 * j + 4] * rl, o[8 * j + 5] * rl), pk2(o[8 * j + 6] * rl, o[8 * j + 7] * rl)};
    }
}

template <int SRC, bool FINAL>
__device__ __forceinline__ void ln_row(const Ctx& c, int row, f32x4 (&v)[8], const bf16* PRE, float* OUT, const bf16* YB, bf16* XB, const float* lng, const float* lnb, const float* EG) {
    if (SRC == 0) { const u32x2* p = (const u32x2*)(PRE + (size_t)row * D) + c.lane;
#pragma unroll
        for (int j = 0; j < 8; ++j) { const u32x2 a = p[64 * j]; v[j] = (f32x4){bflo(a.x), bfhi(a.x), bflo(a.y), bfhi(a.y)}; } }
    else { const u32x2* p = (const u32x2*)(XB + (size_t)row * D) + c.lane; const unsigned* y0 = (const unsigned*)((const unsigned char*)YB + (size_t)(2 * row) * D) + c.lane; const unsigned* y1 = y0 + D / 4;
        const float g0 = EG[2 * row] * 0.0625f, g1 = EG[2 * row + 1] * 0.0625f;
#pragma unroll
        for (int j = 0; j < 8; ++j) { const u32x2 xf = p[64 * j]; const int a = (int)y0[64 * j], b = (int)y1[64 * j];
            v[j] = (f32x4){ALPHA * bflo(xf.x) + g0 * __builtin_amdgcn_cvt_f32_fp8(a, 0) + g1 * __builtin_amdgcn_cvt_f32_fp8(b, 0), ALPHA * bfhi(xf.x) + g0 * __builtin_amdgcn_cvt_f32_fp8(a, 1) + g1 * __builtin_amdgcn_cvt_f32_fp8(b, 1),
                           ALPHA * bflo(xf.y) + g0 * __builtin_amdgcn_cvt_f32_fp8(a, 2) + g1 * __builtin_amdgcn_cvt_f32_fp8(b, 2), ALPHA * bfhi(xf.y) + g0 * __builtin_amdgcn_cvt_f32_fp8(a, 3) + g1 * __builtin_amdgcn_cvt_f32_fp8(b, 3)}; } }
    float s = 0.f;
#pragma unroll
    for (int j = 0; j < 8; ++j) s += (v[j].x + v[j].y) + (v[j].z + v[j].w);
    const float mean = wave_sum(s) * (1.f / D); float s2 = 0.f;
#pragma unroll
    for (int j = 0; j < 8; ++j) { v[j] = v[j] - mean; s2 += (v[j].x * v[j].x + v[j].y * v[j].y) + (v[j].z * v[j].z + v[j].w * v[j].w); }
    const float rstd = 1.f / sqrtf(wave_sum(s2) * (1.f / D) + LN_EPS);
    f32x4* xo = (f32x4*)(OUT + (size_t)row * D) + c.lane; u32x2* bo = (u32x2*)(XB + (size_t)row * D) + c.lane;
#pragma unroll
    for (int j = 0; j < 8; ++j) { const f32x4 g = ((const f32x4*)lng)[64 * j + c.lane], b = ((const f32x4*)lnb)[64 * j + c.lane];
        v[j] = v[j] * rstd * g + b; if (FINAL) xo[64 * j] = v[j]; else bo[64 * j] = (u32x2){pk2(v[j].x, v[j].y), pk2(v[j].z, v[j].w)}; }
}
__device__ __forceinline__ float lane_xor16(float v) { auto r = __builtin_amdgcn_permlane16_swap(__builtin_bit_cast(unsigned, v), __builtin_bit_cast(unsigned, v), false, false);
    return __builtin_bit_cast(float, (threadIdx.x & 16) ? r[0] : r[1]); }
__device__ __forceinline__ float reduce16(float (&d)[16], int lane) {
    float a8[8], a4[4], a2[2];
    { const bool up = lane & 32;
#pragma unroll
      for (int e = 0; e < 8; ++e) { const float keep = up ? d[e + 8] : d[e], send = up ? d[e] : d[e + 8]; a8[e] = keep + lane_xor32(send); } }
    { const bool up = lane & 16;
#pragma unroll
      for (int e = 0; e < 4; ++e) { const float keep = up ? a8[e + 4] : a8[e], send = up ? a8[e] : a8[e + 4]; a4[e] = keep + lane_xor16(send); } }
    { const bool up = lane & 8;
#pragma unroll
      for (int e = 0; e < 2; ++e) { const float keep = up ? a4[e + 2] : a4[e], send = up ? a4[e] : a4[e + 2]; a2[e] = keep + dppx<0x128>(send); } }
    float a1; { const bool up = lane & 4; const float keep = up ? a2[1] : a2[0], send = up ? a2[0] : a2[1]; a1 = keep + dppx<0x141>(send); }
    a1 += dppx<0x4E>(a1); a1 += dppx<0xB1>(a1);
    return a1;
}
template <int SRC, int EXTRA, bool FINAL>
__device__ __forceinline__ void ln_pass(const Ctx& c, const bf16* PRE, float* OUT, const bf16* YB, bf16* XB, const float* lng, const float* lnb,
                                        const float* wsrc, int wld, int woff, const float* wbias, int* rowmap2, float* egate, unsigned* cursor, float* gates_out) {
    LAS char* wl = (LAS char*)c.lds;
    LAS int* lh = (LAS int*)(c.lds + LDSCTL_OFF + LC_HIST);
    LAS float* lg = (LAS float*)(c.lds + LDSCTL_OFF + 5120) + c.wave * 256;
    if (EXTRA) {
#pragma unroll 1
        for (int it = 0; it < 4; ++it) { float wv[16];
#pragma unroll
            for (int q = 0; q < 16; ++q) { const int idx = c.tid + NTHR * (16 * it + q); wv[q] = wsrc[(size_t)(idx >> 4) * wld + woff + (idx & 15)]; }
#pragma unroll
            for (int q = 0; q < 16; ++q) { const int idx = c.tid + NTHR * (16 * it + q), k = idx >> 4, e = idx & 15;
                const unsigned hb = f2bf(wv[q]); const float hf = __builtin_bit_cast(float, hb << 16); const unsigned lb = f2bf(wv[q] - hf);
                const int off = e * 4096 + ((((k >> 3) ^ e) & 255) << 4) + (k & 7) * 2;
                *(LAS unsigned short*)(wl + off) = (unsigned short)hb; *(LAS unsigned short*)(wl + 65536 + off) = (unsigned short)lb; } } }
    const int l15 = c.lane & 15, q4 = c.lane >> 4;
    for (int vb = c.bid; vb < 256; vb += c.G) {
        if (EXTRA == 1) { if (c.tid < 16) lh[c.tid] = 0; }
        __syncthreads();
        const int rowb = vb * 128 + c.wave * 16;
        int rt_e1 = 0, rt_e2 = 0, rt_r1 = 0, rt_r2 = 0;
        if (SRC == 0 && !FINAL) {
            f32x4 gv[8], bv[8];
#pragma unroll
            for (int j = 0; j < 8; ++j) { gv[j] = ((const f32x4*)lng)[64 * j + c.lane]; bv[j] = ((const f32x4*)lnb)[64 * j + c.lane]; }
            u32x2 ra[2][8], rn[2][8];
#pragma unroll
            for (int q = 0; q < 2; ++q) { const u32x2* p = (const u32x2*)(PRE + (size_t)(rowb + q) * D) + c.lane;
#pragma unroll
                for (int j = 0; j < 8; ++j) ra[q][j] = p[64 * j]; }
            for (int i = 0; i < 8; ++i) {
                if (i < 7) {
#pragma unroll
                    for (int q = 0; q < 2; ++q) { const u32x2* p = (const u32x2*)(PRE + (size_t)(rowb + 2 * i + 2 + q) * D) + c.lane;
#pragma unroll
                        for (int j = 0; j < 8; ++j) rn[q][j] = p[64 * j]; } }
#pragma unroll
                for (int q = 0; q < 2; ++q) { const int row = rowb + 2 * i + q; f32x4 v[8]; float s_ = 0.f;
#pragma unroll
                    for (int j = 0; j < 8; ++j) { const u32x2 a = ra[q][j]; v[j] = (f32x4){bflo(a.x), bfhi(a.x), bflo(a.y), bfhi(a.y)}; s_ += (v[j].x + v[j].y) + (v[j].z + v[j].w); }
                    const float mean = wave_sum(s_) * (1.f / D); float s2 = 0.f;
#pragma unroll
                    for (int j = 0; j < 8; ++j) { v[j] = v[j] - mean; s2 += (v[j].x * v[j].x + v[j].y * v[j].y) + (v[j].z * v[j].z + v[j].w * v[j].w); }
                    const float rstd = 1.f / sqrtf(wave_sum(s2) * (1.f / D) + LN_EPS);
                    u32x2* bo = (u32x2*)(XB + (size_t)row * D) + c.lane;
#pragma unroll
                    for (int j = 0; j < 8; ++j) { const f32x4 y = v[j] * rstd * gv[j] + bv[j]; bo[64 * j] = (u32x2){pk2(y.x, y.y), pk2(y.z, y.w)}; } }
#pragma unroll
                for (int q = 0; q < 2; ++q)
#pragma unroll
                    for (int j = 0; j < 8; ++j) ra[q][j] = rn[q][j];
            }
        } else if (SRC == 1) {
            f32x4 gv[8], bv[8];
#pragma unroll
            for (int j = 0; j < 8; ++j) { gv[j] = ((const f32x4*)lng)[64 * j + c.lane]; bv[j] = ((const f32x4*)lnb)[64 * j + c.lane]; }
            u32x2 rx[3][8]; unsigned ry0[3][8], ry1[3][8]; float rg0[3], rg1[3];
#define LN_LOAD1(slot_, row_) do { const u32x2* p_ = (const u32x2*)(XB + (size_t)(row_) * D) + c.lane; const unsigned* y0_ = (const unsigned*)((const unsigned char*)YB + (size_t)(2 * (row_)) * D) + c.lane; const unsigned* y1_ = y0_ + D / 4; \
                rg0[slot_] = egate[2 * (row_)] * 0.0625f; rg1[slot_] = egate[2 * (row_) + 1] * 0.0625f; \
                _Pragma("unroll") for (int j = 0; j < 8; ++j) { rx[slot_][j] = p_[64 * j]; ry0[slot_][j] = y0_[64 * j]; ry1[slot_][j] = y1_[64 * j]; } } while (0)
            LN_LOAD1(0, rowb); LN_LOAD1(1, rowb + 1); LN_LOAD1(2, rowb + 2);
            for (int i = 0; i < 16; ++i) { const int row = rowb + i; f32x4 v[8]; float s_ = 0.f; const float g0 = rg0[0], g1 = rg1[0];
#pragma unroll
                for (int j = 0; j < 8; ++j) { const u32x2 xf = rx[0][j]; const int a = (int)ry0[0][j], b = (int)ry1[0][j];
                    v[j] = (f32x4){ALPHA * bflo(xf.x) + g0 * __builtin_amdgcn_cvt_f32_fp8(a, 0) + g1 * __builtin_amdgcn_cvt_f32_fp8(b, 0), ALPHA * bfhi(xf.x) + g0 * __builtin_amdgcn_cvt_f32_fp8(a, 1) + g1 * __builtin_amdgcn_cvt_f32_fp8(b, 1),
                                   ALPHA * bflo(xf.y) + g0 * __builtin_amdgcn_cvt_f32_fp8(a, 2) + g1 * __builtin_amdgcn_cvt_f32_fp8(b, 2), ALPHA * bfhi(xf.y) + g0 * __builtin_amdgcn_cvt_f32_fp8(a, 3) + g1 * __builtin_amdgcn_cvt_f32_fp8(b, 3)};
                    s_ += (v[j].x + v[j].y) + (v[j].z + v[j].w); }
#pragma unroll
                for (int j = 0; j < 8; ++j) { rx[0][j] = rx[1][j]; ry0[0][j] = ry0[1][j]; ry1[0][j] = ry1[1][j]; rx[1][j] = rx[2][j]; ry0[1][j] = ry0[2][j]; ry1[1][j] = ry1[2][j]; }
                rg0[0] = rg0[1]; rg1[0] = rg1[1]; rg0[1] = rg0[2]; rg1[1] = rg1[2];
                if (i + 3 < 16) LN_LOAD1(2, rowb + i + 3);
                const float mean = wave_sum(s_) * (1.f / D); float s2 = 0.f;
#pragma unroll
                for (int j = 0; j < 8; ++j) { v[j] = v[j] - mean; s2 += (v[j].x * v[j].x + v[j].y * v[j].y) + (v[j].z * v[j].z + v[j].w * v[j].w); }
                const float rstd = 1.f / sqrtf(wave_sum(s2) * (1.f / D) + LN_EPS);
                f32x4* xo = (f32x4*)(OUT + (size_t)row * D) + c.lane; u32x2* bo = (u32x2*)(XB + (size_t)row * D) + c.lane;
#pragma unroll
                for (int j = 0; j < 8; ++j) { const f32x4 y = v[j] * rstd * gv[j] + bv[j]; if (FINAL) xo[64 * j] = y; else bo[64 * j] = (u32x2){pk2(y.x, y.y), pk2(y.z, y.w)}; } }
#undef LN_LOAD1
        } else
        for (int i = 0; i < 8; ++i) { f32x4 va[8], vc[8];
            ln_row<SRC, FINAL>(c, rowb + 2 * i, va, PRE, OUT, YB, XB, lng, lnb, egate);
            ln_row<SRC, FINAL>(c, rowb + 2 * i + 1, vc, PRE, OUT, YB, XB, lng, lnb, egate); }
        if (EXTRA) {
            asm volatile("s_waitcnt vmcnt(0)" ::: "memory");
            __builtin_amdgcn_fence(__ATOMIC_ACQUIRE, "agent");
            pg8::f32x4 acc = {0.f, 0.f, 0.f, 0.f};
            const bf16* arow = XB + (size_t)(rowb + l15) * D + 8 * q4; const LAS char* wrow = wl + l15 * 4096;
#pragma unroll 16
            for (int kk = 0; kk < 64; ++kk) { const pg8::bf16x8 a = *(const pg8::bf16x8*)(arow + 32 * kk);
                const int ch = (((4 * kk + q4) ^ l15) & 255) << 4;
                const pg8::bf16x8 bh = *(const LAS pg8::bf16x8*)(wrow + ch), bl = *(const LAS pg8::bf16x8*)(wrow + 65536 + ch);
                acc = __builtin_amdgcn_mfma_f32_16x16x32_bf16(a, bh, acc, 0, 0, 0); acc = __builtin_amdgcn_mfma_f32_16x16x32_bf16(a, bl, acc, 0, 0, 0); }
            const float bias = wbias[l15];
            if (EXTRA == 2) {
#pragma unroll
                for (int r = 0; r < 4; ++r) { float val = acc[r] + bias; if (l15 >= 8) val = fminf(val, 0.f) - log1pf(expf(-fabsf(val))); gates_out[(size_t)(rowb + 4 * q4 + r) * 16 + l15] = val; }
            } else {
#pragma unroll
                for (int r = 0; r < 4; ++r) lg[(4 * q4 + r) * 16 + l15] = acc[r] + bias;
                LDS_WAIT(); asm volatile("" ::: "memory");
                if (c.lane < 16) { const int row = rowb + c.lane; float dot[16];
#pragma unroll
                    for (int q = 0; q < 4; ++q) { const f32x4 t = *(const LAS f32x4*)(lg + 16 * c.lane + 4 * q); dot[4 * q] = t.x; dot[4 * q + 1] = t.y; dot[4 * q + 2] = t.z; dot[4 * q + 3] = t.w; }
                    float mx = dot[0];
#pragma unroll
                    for (int e = 1; e < 16; ++e) mx = fmaxf(mx, dot[e]);
                    float p[16];
#pragma unroll
                    for (int e = 0; e < 16; ++e) p[e] = __expf(dot[e] - mx);
                    float bestsc = -1.f, bp1 = 0.f, bp2 = 0.f; int be1 = 0, be2 = 0;
#pragma unroll
                    for (int g = 0; g < 4; ++g) { const float a0 = p[4 * g], a1 = p[4 * g + 1], a2 = p[4 * g + 2], a3 = p[4 * g + 3];
                        int i1 = 0; float p1 = a0; if (a1 > p1) { p1 = a1; i1 = 1; } if (a2 > p1) { p1 = a2; i1 = 2; } if (a3 > p1) { p1 = a3; i1 = 3; }
                        int i2 = 0; float p2 = -1.f;
                        if (i1 != 0 && a0 > p2) { p2 = a0; i2 = 0; } if (i1 != 1 && a1 > p2) { p2 = a1; i2 = 1; } if (i1 != 2 && a2 > p2) { p2 = a2; i2 = 2; } if (i1 != 3 && a3 > p2) { p2 = a3; i2 = 3; }
                        const float sc = p1 + p2; if (sc > bestsc) { bestsc = sc; be1 = 4 * g + i1; be2 = 4 * g + i2; bp1 = p1; bp2 = p2; } }
                    const float inv = 1.f / (bp1 + bp2); egate[2 * row] = bp1 * inv; egate[2 * row + 1] = bp2 * inv; rt_e1 = be1; rt_e2 = be2;
                    rt_r1 = __hip_atomic_fetch_add(lh + be1, 1, __ATOMIC_RELAXED, __HIP_MEMORY_SCOPE_WORKGROUP); rt_r2 = __hip_atomic_fetch_add(lh + be2, 1, __ATOMIC_RELAXED, __HIP_MEMORY_SCOPE_WORKGROUP); }
            }
        }
        __syncthreads();
        if (EXTRA == 1) {
            LAS int* lbase = (LAS int*)(c.lds + LDSCTL_OFF + 13312);
            if (c.tid < 16) lbase[c.tid] = (int)__hip_atomic_fetch_add(cursor + c.tid, (unsigned)lh[c.tid], __ATOMIC_RELAXED, __HIP_MEMORY_SCOPE_AGENT);
            __syncthreads();
            if (c.lane < 16) { const int row = rowb + c.lane; rowmap2[rt_e1 * ECAP + lbase[rt_e1] + rt_r1] = 2 * row; rowmap2[rt_e2 * ECAP + lbase[rt_e2] + rt_r2] = 2 * row + 1; }
        }
    }
}

__device__ __forceinline__ void gather_rows(const Ctx& c, const bf16* XB, const int* rowmap, const int* tile_e, bf16* XG) {
    const int nrows = tile_e[MAXTILES] * 256;
    for (int r = c.gw; r < nrows; r += c.ngw) { const int a = rowmap[r]; u32x4* dst = (u32x4*)(XG + (size_t)r * D) + c.lane;
        if (a >= 0) { const u32x4* src = (const u32x4*)(XB + (size_t)(a >> 1) * D) + c.lane;
#pragma unroll
            for (int j = 0; j < 4; ++j) dst[64 * j] = src[64 * j]; }
        else {
#pragma unroll
            for (int j = 0; j < 4; ++j) dst[64 * j] = (u32x4){0u, 0u, 0u, 0u}; } }
}

__device__ __forceinline__ void fp8x8_to_f32(u32x2 w, float (&o)[8]) { const int a = (int)w.x, b = (int)w.y;
    o[0] = __builtin_amdgcn_cvt_f32_fp8(a, 0) * 0.0625f; o[1] = __builtin_amdgcn_cvt_f32_fp8(a, 1) * 0.0625f; o[2] = __builtin_amdgcn_cvt_f32_fp8(a, 2) * 0.0625f; o[3] = __builtin_amdgcn_cvt_f32_fp8(a, 3) * 0.0625f;
    o[4] = __builtin_amdgcn_cvt_f32_fp8(b, 0) * 0.0625f; o[5] = __builtin_amdgcn_cvt_f32_fp8(b, 1) * 0.0625f; o[6] = __builtin_amdgcn_cvt_f32_fp8(b, 2) * 0.0625f; o[7] = __builtin_amdgcn_cvt_f32_fp8(b, 3) * 0.0625f; }

constexpr int CONV_ROWS = 16;
__device__ __forceinline__ void conv_pass(const Ctx& c, const unsigned char* Z, const float* cw, const float* cb, bf16* QKC) {
    constexpr int NITEMS = (T / CONV_ROWS) * 256;
    const int c0 = (c.gtid & 255) * 8;
    float w[4][8], bias[8];
#pragma unroll
    for (int j = 0; j < 4; ++j) { const f32x4 w0 = *(const f32x4*)(cw + j * 2048 + c0), w1 = *(const f32x4*)(cw + j * 2048 + c0 + 4); w[j][0] = w0.x; w[j][1] = w0.y; w[j][2] = w0.z; w[j][3] = w0.w; w[j][4] = w1.x; w[j][5] = w1.y; w[j][6] = w1.z; w[j][7] = w1.w; }
    { const f32x4 b0 = *(const f32x4*)(cb + c0), b1 = *(const f32x4*)(cb + c0 + 4); bias[0] = b0.x; bias[1] = b0.y; bias[2] = b0.z; bias[3] = b0.w; bias[4] = b1.x; bias[5] = b1.y; bias[6] = b1.z; bias[7] = b1.w; }
    const float sc = c0 >= 1024 ? 0.08838834764831845f : 1.f;
    u32x2 zr[CONV_ROWS + 3], zn[CONV_ROWS + 3];
#define CONV_LOAD(ZR, idx_) do { const int tok0_ = ((idx_) >> 8) * CONV_ROWS, t0_ = tok0_ & (SEQ - 1); _Pragma("unroll") for (int r = 0; r < CONV_ROWS + 3; ++r) { const int tt = t0_ - 3 + r; ZR[r] = tt >= 0 ? *(const u32x2*)(Z + (size_t)(tok0_ - 3 + r) * ZN + c0) : (u32x2){0u, 0u}; } } while (0)
    if (c.gtid < NITEMS) CONV_LOAD(zr, c.gtid);
    for (int idx = c.gtid; idx < NITEMS; idx += c.ngt) { const int tok0 = (idx >> 8) * CONV_ROWS;
        if (idx + c.ngt < NITEMS) CONV_LOAD(zn, idx + c.ngt);
#pragma unroll
        for (int r = 0; r < CONV_ROWS; ++r) { float acc[8];
#pragma unroll
            for (int k = 0; k < 8; ++k) acc[k] = bias[k];
#pragma unroll
            for (int j = 0; j < 4; ++j) { float zf[8]; fp8x8_to_f32(zr[r + j], zf);
#pragma unroll
                for (int k = 0; k < 8; ++k) acc[k] += zf[k] * w[j][k]; }
#pragma unroll
            for (int k = 0; k < 8; ++k) acc[k] = acc[k] / (1.f + __expf(-acc[k])) * sc;
            *(u32x4*)(QKC + (size_t)(tok0 + r) * 2048 + c0) = (u32x4){pk2(acc[0], acc[1]), pk2(acc[2], acc[3]), pk2(acc[4], acc[5]), pk2(acc[6], acc[7])}; }
#pragma unroll
        for (int r = 0; r < CONV_ROWS + 3; ++r) zr[r] = zn[r];
    }
#undef CONV_LOAD
}
__device__ __forceinline__ void mlstm_naive(const Ctx& c, const bf16* QKC, const bf16* Z, const float* GATES, bf16* HC) {
    LAS float* Qs = (LAS float*)c.lds; LAS float* Ks = Qs + 2048; LAS float* Vs = Ks + 2048; LAS float* LI = Vs + 2048; LAS float* LF = LI + 16; LAS float* DEN = LF + 16; LAS float* MEX = DEN + 16; LAS float* NUM = MEX + 16;
    const bool colthr = c.tid < 128, nthr = (c.wave == 2);
    for (int u = c.bid; u < 256; u += c.G) {
        const int b = u >> 4, h = (u >> 1) & 7, vh = u & 1;
        float C[128];
#pragma unroll
        for (int d = 0; d < 128; ++d) C[d] = 0.f;
        float m = -1e30f;
        for (int grp = 0; grp < 128; ++grp) {
            const int tok0 = b * SEQ + grp * 16;
#pragma unroll
            for (int k = 0; k < 12; ++k) { const int e = c.tid + NTHR * k, which = e >> 11, r = e & 2047, s = r >> 7, d = r & 127;
                const bf16* src = which == 0 ? QKC + (size_t)(tok0 + s) * 2048 + h * 128 + d : (which == 1 ? QKC + (size_t)(tok0 + s) * 2048 + 1024 + h * 128 + d : Z + (size_t)(tok0 + s) * ZN + 2048 + h * 256 + vh * 128 + d);
                Qs[e] = bf1(*src); }
            if (c.tid < 16) { LI[c.tid] = GATES[(size_t)(tok0 + c.tid) * 16 + h]; LF[c.tid] = GATES[(size_t)(tok0 + c.tid) * 16 + 8 + h]; }
            __syncthreads();
            if (colthr || nthr) {
                for (int s = 0; s < 16; ++s) {
                    const float lf = LF[s], li = LI[s], mn = fmaxf(lf + m, li), fd = __expf(lf + m - mn), iw = __expf(li - mn); m = mn;
                    const float vv = nthr ? 1.f : Vs[s * 128 + (c.tid & 127)]; const float kv = iw * vv; float acc = 0.f;
#pragma unroll
                    for (int d4 = 0; d4 < 32; ++d4) { const f32x4 k4 = *(const LAS f32x4*)(Ks + s * 128 + 4 * d4), q4 = *(const LAS f32x4*)(Qs + s * 128 + 4 * d4);
                        C[4 * d4 + 0] = fd * C[4 * d4 + 0] + kv * k4.x; acc += q4.x * C[4 * d4 + 0];
                        C[4 * d4 + 1] = fd * C[4 * d4 + 1] + kv * k4.y; acc += q4.y * C[4 * d4 + 1];
                        C[4 * d4 + 2] = fd * C[4 * d4 + 2] + kv * k4.z; acc += q4.z * C[4 * d4 + 2];
                        C[4 * d4 + 3] = fd * C[4 * d4 + 3] + kv * k4.w; acc += q4.w * C[4 * d4 + 3]; }
                    if (nthr) { if (c.lane == 0) { DEN[s] = acc; MEX[s] = __expf(-mn); } } else NUM[s * 128 + c.tid] = acc;
                }
            }
            __syncthreads();
            if (colthr) {
                for (int s = 0; s < 16; ++s) { const float hv = NUM[s * 128 + c.tid] / fmaxf(fabsf(DEN[s]), MEX[s]);
                    HC[(size_t)(tok0 + s) * 2048 + h * 256 + vh * 128 + c.tid] = (bf16)f2bf(hv); }
            }
        }
        __syncthreads();
    }
}
__device__ __forceinline__ void headnorm_pass(const Ctx& c, const bf16* HC, const unsigned char* Z, const float* ng, bf16* Y) {
    const int half = c.lane >> 5, l32 = c.lane & 31;
    f32x4 ga[4], gb[4];
#pragma unroll
    for (int p = 0; p < 4; ++p) { const float* gp = ng + (2 * p + half) * 256 + 8 * l32; ga[p] = *(const f32x4*)gp; gb[p] = *(const f32x4*)(gp + 4); }
    u32x4 hw[4], hn[4]; u32x2 ow[4], on[4];
#define HN_LOAD(HW, OW, tok_) do { _Pragma("unroll") for (int p = 0; p < 4; ++p) { HW[p] = *(const u32x4*)(HC + (size_t)(tok_) * 2048 + (2 * p + half) * 256 + 8 * l32); OW[p] = *(const u32x2*)(Z + (size_t)(tok_) * ZN + 4096 + (2 * p + half) * 256 + 8 * l32); } } while (0)
    if (c.gw < T) HN_LOAD(hw, ow, c.gw);
    for (int tok = c.gw; tok < T; tok += c.ngw) {
        if (tok + c.ngw < T) HN_LOAD(hn, on, tok + c.ngw);
#pragma unroll
        for (int p = 0; p < 4; ++p) {
            float x[8] = {bflo(hw[p].x), bfhi(hw[p].x), bflo(hw[p].y), bfhi(hw[p].y), bflo(hw[p].z), bfhi(hw[p].z), bflo(hw[p].w), bfhi(hw[p].w)};
            const float ps = prefix_sum64(((x[0] + x[1]) + (x[2] + x[3])) + ((x[4] + x[5]) + (x[6] + x[7]))); const float lo = lane_bcast(ps, 31), al = lane_bcast(ps, 63);
            const float mean = (half ? al - lo : lo) * (1.f / 256.f); float q = 0.f;
#pragma unroll
            for (int k = 0; k < 8; ++k) { x[k] -= mean; q += x[k] * x[k]; }
            const float pq = prefix_sum64(q); const float qlo = lane_bcast(pq, 31), qal = lane_bcast(pq, 63);
            const float rstd = 1.f / sqrtf((half ? qal - qlo : qlo) * (1.f / 256.f) + LN_EPS);
            float o[8]; fp8x8_to_f32(ow[p], o);
            const float gk[8] = {ga[p].x, ga[p].y, ga[p].z, ga[p].w, gb[p].x, gb[p].y, gb[p].z, gb[p].w}; float y[8];
#pragma unroll
            for (int k = 0; k < 8; ++k) y[k] = x[k] * rstd * gk[k] / (1.f + __expf(-o[k]));
            *(u32x4*)(Y + (size_t)tok * 2048 + (2 * p + half) * 256 + 8 * l32) = (u32x4){pk2(y[0], y[1]), pk2(y[2], y[3]), pk2(y[4], y[5]), pk2(y[6], y[7])}; }
#pragma unroll
        for (int p = 0; p < 4; ++p) { hw[p] = hn[p]; ow[p] = on[p]; }
    }
#undef HN_LOAD
}

namespace att {
typedef short bf16x8 __attribute__((ext_vector_type(8)));
typedef short s16x4 __attribute__((ext_vector_type(4)));
typedef float f32x16 __attribute__((ext_vector_type(16)));
constexpr float SCALE = 0.08838834764831845f, THR = 8.f;
constexpr int SHM = 16384;
#define KSWZ(row, colB) ((row) * 256 + ((colB) ^ (((row) & 7) << 4)))
#define SBAR() __builtin_amdgcn_sched_barrier(0)
__device__ __forceinline__ int v_st(int k, int c) { const int kk = (k & ~0xC) | ((k & 4) << 1) | ((k & 8) >> 1); return ((kk >> 3) * 4 + (c >> 5)) * 512 + ((kk & 7) * 32 + (c & 31)) * 2; }
__device__ __forceinline__ int v_rd_base(int lane) { return ((lane & 3) << 3) | (((lane >> 2) & 3) << 6) | (((lane >> 4) & 1) << 5) | (((lane >> 5) & 1) << 8); }
constexpr int v_rd_off(int d0, int ks, int half) { return d0 * 512 + ks * 4096 + half * 2048; }
__device__ __forceinline__ int crow(int r, int hi) { return (r & 3) + 8 * (r >> 2) + 4 * hi; }
__device__ __forceinline__ unsigned cvtpk(float lo, float hi) { unsigned r; asm volatile("v_cvt_pk_bf16_f32 %0, %1, %2" : "=v"(r) : "v"(lo), "v"(hi)); return r; }
__device__ __forceinline__ void mask_tile(f32x16& p0, f32x16& p1, int dq, unsigned W) {
    const float NEG = -__builtin_inff();
#pragma unroll
    for (int r = 0; r < 16; ++r) { const int cc = (r & 3) + 8 * (r >> 2);
        if ((unsigned)(dq - cc) >= W) p0[r] = NEG;
        if ((unsigned)(dq - cc - 32) >= W) p1[r] = NEG; }
}
__device__ __forceinline__ void partialSM(f32x16& p0, f32x16& p1, float& m_reg, float& mn, float& alpha) {
    float pmax = p0[0];
#pragma unroll
    for (int r = 1; r < 16; ++r) pmax = fmaxf(pmax, p0[r]);
#pragma unroll
    for (int r = 0; r < 16; ++r) pmax = fmaxf(pmax, p1[r]);
    { auto rr = __builtin_amdgcn_permlane32_swap(__float_as_uint(pmax), __float_as_uint(pmax), false, false);
      pmax = fmaxf(__uint_as_float(rr[0]), __uint_as_float(rr[1])); }
    constexpr float C2 = 1.4426950408889634f * SCALE;
    if (__builtin_expect(__all((pmax - m_reg) * SCALE <= THR), 1)) { mn = m_reg; alpha = 1.f; }
    else { mn = fmaxf(m_reg, pmax); alpha = __builtin_amdgcn_exp2f((m_reg - mn) * C2); m_reg = mn; }
    const float mnL = -mn * C2;
#pragma unroll
    for (int r = 0; r < 16; ++r) p0[r] = fmaf(p0[r], C2, mnL);
#pragma unroll
    for (int r = 0; r < 16; ++r) p1[r] = fmaf(p1[r], C2, mnL);
#pragma unroll
    for (int r = 0; r < 16; ++r) p0[r] = __builtin_amdgcn_exp2f(p0[r]);
}
__device__ __forceinline__ void finishSM(f32x16& p0, f32x16& p1, float alpha, float& l_reg, bf16x8& pa0, bf16x8& pa1, bf16x8& pa2, bf16x8& pa3) {
#pragma unroll
    for (int r = 0; r < 16; ++r) p1[r] = __builtin_amdgcn_exp2f(p1[r]);
    float ps = 0;
#pragma unroll
    for (int r = 0; r < 16; ++r) ps += p0[r];
#pragma unroll
    for (int r = 0; r < 16; ++r) ps += p1[r];
    { auto rr = __builtin_amdgcn_permlane32_swap(__float_as_uint(ps), __float_as_uint(ps), false, false);
      ps = __uint_as_float(rr[0]) + __uint_as_float(rr[1]); }
    l_reg = l_reg * alpha + ps;
#define PK4(P, B_, OUT) do { unsigned a0 = cvtpk(P[B_+0], P[B_+1]), a1 = cvtpk(P[B_+2], P[B_+3]);                          \
        unsigned b0 = cvtpk(P[B_+4], P[B_+5]), b1 = cvtpk(P[B_+6], P[B_+7]);                                             \
        auto r0 = __builtin_amdgcn_permlane32_swap(a0, b0, false, false); auto r1 = __builtin_amdgcn_permlane32_swap(a1, b1, false, false); \
        u32x4 w = {r0[0], r1[0], r0[1], r1[1]}; OUT = *reinterpret_cast<bf16x8*>(&w); } while (0)
    PK4(p0, 0, pa0); PK4(p0, 8, pa1); PK4(p1, 0, pa2); PK4(p1, 8, pa3);
#undef PK4
}
template <int KB>
__device__ __forceinline__ void qkt(f32x16& p0, f32x16& p1, const LAS char* K_lds, int r32, int hi, const bf16x8* qr) {
    p0 = f32x16{}; p1 = f32x16{};
    const LAS char* kb[4];
#pragma unroll
    for (int dd = 0; dd < 4; ++dd) kb[dd] = K_lds + KB * SHM + KSWZ(r32, (dd * 16 + hi * 8) * 2);
#pragma unroll
    for (int d0 = 0; d0 < 8; ++d0) { const LAS char* a = kb[d0 & 3] + (d0 >> 2) * 128;
        bf16x8 b0 = *reinterpret_cast<const LAS bf16x8*>(a);
        bf16x8 b1 = *reinterpret_cast<const LAS bf16x8*>(a + 32 * 256);
        p0 = __builtin_amdgcn_mfma_f32_32x32x16_bf16(b0, qr[d0], p0, 0, 0, 0);
        p1 = __builtin_amdgcn_mfma_f32_32x32x16_bf16(b1, qr[d0], p1, 0, 0, 0); }
}
template <int VB>
__device__ __forceinline__ void pv_tile(f32x16* o, int vb0, bf16x8 pa0, bf16x8 pa1, bf16x8 pa2, bf16x8 pa3) {
#define TRRD(dst, off) asm volatile("ds_read_b64_tr_b16 %0, %1 offset:%2" : "=&v"(dst) : "v"(vb0), "i"(off) : "memory")
#define PV_D0(d0) do { s16x4 l0, l1, l2, l3, h0, h1, h2, h3; constexpr int b_ = VB * SHM + v_rd_off(d0, 0, 0); \
        TRRD(l0, b_); TRRD(h0, b_ + 2048); TRRD(l1, b_ + 4096); TRRD(h1, b_ + 6144); TRRD(l2, b_ + 8192); TRRD(h2, b_ + 10240); TRRD(l3, b_ + 12288); TRRD(h3, b_ + 14336); \
        asm volatile("s_waitcnt lgkmcnt(0)" ::: "memory"); SBAR();   \
        o[d0] = __builtin_amdgcn_mfma_f32_32x32x16_bf16(pa0, (bf16x8){l0[0], l0[1], l0[2], l0[3], h0[0], h0[1], h0[2], h0[3]}, o[d0], 0, 0, 0);   \
        o[d0] = __builtin_amdgcn_mfma_f32_32x32x16_bf16(pa1, (bf16x8){l1[0], l1[1], l1[2], l1[3], h1[0], h1[1], h1[2], h1[3]}, o[d0], 0, 0, 0);   \
        o[d0] = __builtin_amdgcn_mfma_f32_32x32x16_bf16(pa2, (bf16x8){l2[0], l2[1], l2[2], l2[3], h2[0], h2[1], h2[2], h2[3]}, o[d0], 0, 0, 0);   \
        o[d0] = __builtin_amdgcn_mfma_f32_32x32x16_bf16(pa3, (bf16x8){l3[0], l3[1], l3[2], l3[3], h3[0], h3[1], h3[2], h3[3]}, o[d0], 0, 0, 0); } while (0)
    PV_D0(0); PV_D0(1); PV_D0(2); PV_D0(3);
#undef PV_D0
#undef TRRD
}
template <bool FINAL>
__device__ __forceinline__ void attn_phase(const Ctx& c, const bf16* QKV, bf16* OP, float* LSE, bf16* O) {
    const int half = c.wave >> 2, w4 = c.wave & 3, r32 = c.lane & 31, hi = c.lane >> 5, l = c.lane;
    LAS char* Vl = (LAS char*)c.lds + half * 65536; LAS char* Kl = Vl + 2 * SHM;
    LAS float* wl = (LAS float*)(c.lds + LDSCTL_OFF + 1024) + c.wave * 128; LAS float* al_l = wl + 96;
    const LAS float* wl4 = wl + 4 * hi;
    const int vb0 = (int)(unsigned)(uintptr_t)Vl + v_rd_base(c.lane);
    int krow[4], kcol[4], vrow[4], vcol[4];
#pragma unroll
    for (int j = 0; j < 4; ++j) { const int blk = 4 * w4 + j; krow[j] = 4 * blk + (l >> 4); kcol[j] = (((l & 15) ^ (krow[j] & 7)) * 16) + 2048;
        const int sub = 2 * blk + (l >> 5), kk = (sub >> 2) * 8 + ((l & 31) >> 2); vrow[j] = (kk & ~0xC) | ((kk & 4) << 1) | ((kk & 8) >> 1); vcol[j] = ((sub & 3) * 32 + (l & 3) * 8) * 2 + 4096; }
    constexpr int NUNITS = FINAL ? 1024 : 2048;
    for (int idx = c.bid; idx < NUNITS; idx += c.G) {
        const int hp = idx & 3, rj = (idx >> 2) & 15, b = (idx >> 6) & 15, g = FINAL ? 0 : 1 + (idx >> 10);
        const int h = 2 * hp + half, dil = 1 << (2 * g), nbm = (16 >> (2 * g)) - 1, jb = rj & nbm, r = rj >> (4 - 2 * g);
        const unsigned rs = (unsigned)dil * QKV_N * 2u;
        const char* base = (const char*)(QKV + ((size_t)b * SEQ + r) * QKV_N + g * 3072 + h * HD);
        const int q0 = 128 * jb + 32 * w4;
        bf16x8 qr[8];
#pragma unroll
        for (int d0 = 0; d0 < 8; ++d0) qr[d0] = *(const bf16x8*)(base + ((unsigned)(q0 + r32) * rs + (unsigned)(d0 * 32 + hi * 16)));
#define A_DMA(kb_, bf_) do { _Pragma("unroll") for (int j_ = 0; j_ < 4; ++j_) { \
            __builtin_amdgcn_global_load_lds((const unsigned*)(base + ((unsigned)((kb_) + krow[j_]) * rs + (unsigned)kcol[j_])), (LAS unsigned*)(Kl + (bf_) * SHM + (4 * w4 + j_) * 1024), 16, 0, 0); \
            __builtin_amdgcn_global_load_lds((const unsigned*)(base + ((unsigned)((kb_) + vrow[j_]) * rs + (unsigned)vcol[j_])), (LAS unsigned*)(Vl + (bf_) * SHM + (4 * w4 + j_) * 1024), 16, 0, 0); } } while (0)
        float m_reg = -1e30f, l_reg = 0.f; f32x16 o[4] = {};
        const int kt0 = jb == 0 ? 2 : 0, kb0 = 128 * (jb - 1);
        A_DMA(kb0 + 64 * kt0, 0);
        asm volatile("s_waitcnt vmcnt(0)" ::: "memory"); __syncthreads();
#define A_STEP(kt_, BUF) do { const int kb_ = kb0 + 64 * (kt_); \
            if ((kt_) < 3) A_DMA(kb_ + 64, (BUF) ^ 1);                                         \
            if (kb_ <= q0 + 31 && kb_ + 63 >= q0 - 128) { f32x16 p0, p1; float mn, alpha; bf16x8 pa0, pa1, pa2, pa3; \
                qkt<BUF>(p0, p1, Kl, r32, hi, qr); mask_tile(p0, p1, q0 + r32 - kb_ - 4 * hi, 129u); partialSM(p0, p1, m_reg, mn, alpha); \
                if (__any(alpha < 1.f)) { if (hi == 0) al_l[r32] = alpha; asm volatile("s_waitcnt lgkmcnt(0)" ::: "memory"); \
                    _Pragma("unroll") for (int d_ = 0; d_ < 4; ++d_) _Pragma("unroll") for (int r_ = 0; r_ < 16; ++r_) o[d_][r_] *= al_l[crow(r_, hi)]; } \
                finishSM(p0, p1, alpha, l_reg, pa0, pa1, pa2, pa3); SBAR(); pv_tile<BUF>(o, vb0, pa0, pa1, pa2, pa3); } \
            asm volatile("s_waitcnt vmcnt(0)" ::: "memory"); __syncthreads(); } while (0)
        for (int kt = kt0; kt < 4; kt += 2) { A_STEP(kt, 0); A_STEP(kt + 1, 1); }
#undef A_STEP
#undef A_DMA
        const float lse = m_reg * SCALE + __logf(l_reg);
        const unsigned tok0 = (unsigned)b * SEQ + r;
        if (hi == 0) { const unsigned tokq = tok0 + (unsigned)(q0 + r32) * dil; float w0 = 1.f / l_reg;
            if (FINAL) { const float l1 = LSE[tokq * 8u + h], l2 = LSE[((unsigned)T + tokq) * 8u + h]; const float M = fmaxf(lse, fmaxf(l1, l2));
                const float e0 = __expf(lse - M), e1 = __expf(l1 - M), e2 = __expf(l2 - M), inv = 1.f / (e0 + e1 + e2); w0 *= e0 * inv; wl[32 + r32] = e1 * inv; wl[64 + r32] = e2 * inv; }
            else LSE[((unsigned)(g - 1) * T + tokq) * 8u + h] = lse;
            wl[r32] = w0; }
        asm volatile("s_waitcnt lgkmcnt(0)" ::: "memory");
        LAS char* tile = Vl + (w4 < 2 ? SHM + w4 * 8192 : 3 * SHM + (w4 - 2) * 8192); LAS char* tile4 = tile + 4 * hi * 256 + r32 * 2;
#pragma unroll
        for (int r_ = 0; r_ < 16; ++r_) { const int orow = (r_ & 3) + 8 * (r_ >> 2); const float w0 = wl4[orow];
#pragma unroll
            for (int d0 = 0; d0 < 4; ++d0) { const float v = o[d0][r_] * w0; const float vn = lane_xor1(v);
                if ((r32 & 1) == 0) *(LAS unsigned*)(tile4 + orow * 256 + d0 * 64) = cvtpk(v, vn); } }
        asm volatile("s_waitcnt lgkmcnt(0)" ::: "memory");
#pragma unroll
        for (int i = 0; i < 8; ++i) { const int p = c.lane + 64 * i, row = p >> 4, ch = p & 15; const unsigned tok = tok0 + (unsigned)(q0 + row) * dil; const unsigned col8 = (unsigned)h * HD + ch * 8;
            const u32x4 x = *(const LAS u32x4*)(tile + row * 256 + ch * 16);
            if (FINAL) { const u32x4 pa = *(const u32x4*)(OP + (tok * (unsigned)OD + col8)), pb = *(const u32x4*)(OP + (((unsigned)T + tok) * (unsigned)OD + col8)); const float w1 = wl[32 + row], w2 = wl[64 + row];
                u32x4 y; y.x = cvtpk(bflo(x.x) + w1 * bflo(pa.x) + w2 * bflo(pb.x), bfhi(x.x) + w1 * bfhi(pa.x) + w2 * bfhi(pb.x)); y.y = cvtpk(bflo(x.y) + w1 * bflo(pa.y) + w2 * bflo(pb.y), bfhi(x.y) + w1 * bfhi(pa.y) + w2 * bfhi(pb.y));
                y.z = cvtpk(bflo(x.z) + w1 * bflo(pa.z) + w2 * bflo(pb.z), bfhi(x.z) + w1 * bfhi(pa.z) + w2 * bfhi(pb.z)); y.w = cvtpk(bflo(x.w) + w1 * bflo(pa.w) + w2 * bflo(pb.w), bfhi(x.w) + w1 * bfhi(pa.w) + w2 * bfhi(pb.w));
                *(u32x4*)(O + (tok * (unsigned)OD + col8)) = y; }
            else *(u32x4*)(OP + (((unsigned)(g - 1) * T + tok) * (unsigned)OD + col8)) = x; }
    }
}
#undef KSWZ
#undef SBAR
}

namespace mls {
using att::bf16x8; using att::s16x4; using att::f32x16; using att::v_st; using att::v_rd_base; using att::crow; using att::cvtpk;
constexpr int RSB = 272;
constexpr int L_QP = 0, L_KP = 17408, L_KTR = 34816, L_VTR = 51200, L_AM = 83968, L_RS = 93184, L_QN = 94208, L_WINT = 94464, L_MEXP = 94720, L_HDEN = 94976  , L_NV = 97024  , L_UV = 98048, L_AV = 98560  ;
constexpr int AMB = 144;
#define TRRD(dst, addr, off) asm volatile("ds_read_b64_tr_b16 %0, %1 offset:%2" : "=&v"(dst) : "v"(addr), "i"(off) : "memory")
template <int SKIP>
__device__ __forceinline__ void mlstm_phase(const Ctx& c, const bf16* QKC, const unsigned char* Z, const float* GATES, bf16* HC) {
    const int w = c.wave;
    LAS char* lds = (LAS char*)c.lds;
    LAS float* RS = (LAS float*)(lds + L_RS); LAS float* QN = (LAS float*)(lds + L_QN); LAS float* WINT = (LAS float*)(lds + L_WINT);     LAS float* HDEN = (LAS float*)(lds + L_HDEN);
    LAS float* UV = (LAS float*)(lds + L_UV); LAS float* AV = (LAS float*)(lds + L_AV);
    for (int unit = c.bid; unit < BATCH * 8; unit += c.G) {
        const int b = unit >> 3, h = unit & 7;
        f32x16 Ct[4] = {};
        float n0 = 0.f, n1 = 0.f, m_state = -1e30f;
        bf16x8 sq[2], sk[2]; u32x2 sv[4]; float g_li, g_lf;
#define M_LOAD(tok0_) do { \
            _Pragma("unroll") for (int i_ = 0; i_ < 2; ++i_) { const int p_ = tid_ + 512 * i_, row_ = p_ >> 4, c8_ = (p_ & 15) * 8; const bf16* s_ = QKC + (size_t)((tok0_) + row_) * 2048 + h * 128 + c8_; sq[i_] = *(const bf16x8*)s_; sk[i_] = *(const bf16x8*)(s_ + 1024); } \
            g_li = GATES[(size_t)((tok0_) + (tid_ & 63)) * 16 + h]; g_lf = GATES[(size_t)((tok0_) + (tid_ & 63)) * 16 + 8 + h]; } while (0)
#define M_LOADV(tok0_) do { \
            _Pragma("unroll") for (int i_ = 0; i_ < 4; ++i_) { const int p_ = tid_ + 512 * i_, row_ = p_ >> 5, c8_ = (p_ & 31) * 8; sv[i_] = *(const u32x2*)(Z + (size_t)((tok0_) + row_) * ZN + 2048 + h * 256 + c8_); } } while (0)
        int tid_ = c.tid; asm volatile("" : "+v"(tid_));
        M_LOAD(b * SEQ); M_LOADV(b * SEQ);
        if (w == 5) *(LAS f32x2*)(lds + L_NV + 512 + 8 * c.lane) = (f32x2){0.f, 0.f};
        for (int ch = 0; ch < 32; ++ch) {
            const int tok0 = b * SEQ + ch * 64;
            tid_ = c.tid; asm volatile("" : "+v"(tid_));
            const int l = tid_ & 63, hi = l >> 5, r32 = l & 31, q4 = l >> 4, l15 = l & 15;
            const int vbK = (int)(unsigned)(uintptr_t)(lds + L_KTR) + v_rd_base(l);
            const int vbV = (int)(unsigned)(uintptr_t)(lds + L_VTR) + (w >> 2) * 16384 + (w & 3) * 512 + v_rd_base(l);
            const LAS float* uv_b = UV + 16 * (w & 3) + 4 * q4; const LAS float* as_b = AV + 32 * (w >> 2) + l15;
            LAS char* am_w = lds + L_AM + (16 * (w & 3) + 4 * q4) * AMB + (32 * (w >> 2) + l15) * 2; LAS float* rs_w = RS + 128 * (w >> 2) + 16 * (w & 3) + 4 * q4;
            const LAS float* wint_b = WINT + 4 * hi; const LAS float* hden_b = HDEN + 64 * w + 4 * hi;
            const LAS char* q_b = lds + L_QP + r32 * RSB + 8 * hi; const LAS char* am_b = lds + L_AM + r32 * AMB + 16 * hi;
            const LAS char* sq_b = lds + L_QP + ((16 * (w & 3)) + l15) * RSB + 16 * q4; const LAS char* sk_b = lds + L_KP + l15 * RSB + 16 * q4;
            const int hc_lane = 4 * hi * 2048 + 32 * w + r32;
            const float bc = (SKIP & 64) ? g_lf : prefix_sum64(g_lf);
            const float a = g_li - bc, pm = (SKIP & 64) ? a : prefix_max64(a);
            const float u = fmaxf(m_state, pm), winter = __expf(m_state - u);
            const float blast = lane_bcast(bc, 63), u63 = lane_bcast(u, 63);
            const float wk = __expf(a - u63), decay = __expf(m_state - u63), mexp = __expf(-(bc + u));
            if (!(SKIP & 128)) {
#pragma unroll
            for (int i = 0; i < 2; ++i) { const int p = tid_ + 512 * i, row = p >> 4, c8 = (p & 15) * 8;
                *(LAS bf16x8*)(lds + L_QP + row * RSB + c8 * 2) = sq[i]; *(LAS bf16x8*)(lds + L_KP + row * RSB + c8 * 2) = sk[i];
                const float wr_ = __shfl(wk, row); const u32x4 kw = *reinterpret_cast<const u32x4*>(&sk[i]);
                u32x4 o; o.x = cvtpk(bflo(kw.x) * wr_, bfhi(kw.x) * wr_); o.y = cvtpk(bflo(kw.y) * wr_, bfhi(kw.y) * wr_); o.z = cvtpk(bflo(kw.z) * wr_, bfhi(kw.z) * wr_); o.w = cvtpk(bflo(kw.w) * wr_, bfhi(kw.w) * wr_);
                *(LAS u32x4*)(lds + L_KTR + v_st(row, c8)) = o; }
#pragma unroll
            for (int i = 0; i < 4; ++i) { const int p = tid_ + 512 * i, row = p >> 5, c8 = (p & 31) * 8;
                float vf_[8]; fp8x8_to_f32(sv[i], vf_); *(LAS u32x4*)(lds + L_VTR + (c8 >> 7) * 16384 + v_st(row, c8 & 127)) = (u32x4){cvtpk(vf_[0], vf_[1]), cvtpk(vf_[2], vf_[3]), cvtpk(vf_[4], vf_[5]), cvtpk(vf_[6], vf_[7])}; }
            }
            if (w == 0) { WINT[(ch & 1) * 64 + l] = winter; UV[(ch & 1) * 64 + l] = u; AV[(ch & 1) * 64 + l] = a; }
            if (!(SKIP & 32)) { if (ch + 1 < 32) { M_LOAD(tok0 + 64); M_LOADV(tok0 + 64); } }
            __syncthreads(); __builtin_amdgcn_sched_barrier(0);
            if (!(SKIP & 1)) {
                if (w == 4) { const LAS char* qrow = lds + L_QP + l * RSB; const LAS f32x4* nv = (const LAS f32x4*)(lds + L_NV + ((ch + 1) & 1) * 512);
                    float p0 = 0.f, p1 = 0.f;
#pragma unroll 2
                    for (int d8 = 0; d8 < 16; ++d8) { const u32x4 q = *(const LAS u32x4*)(qrow + 16 * d8); const f32x4 na = nv[2 * d8], nb = nv[2 * d8 + 1];
                        p0 += (bflo(q.x) * na.x + bfhi(q.x) * na.y) + (bflo(q.y) * na.z + bfhi(q.y) * na.w); p1 += (bflo(q.z) * nb.x + bfhi(q.z) * nb.y) + (bflo(q.w) * nb.z + bfhi(q.w) * nb.w); }
                    QN[l] = p0 + p1; }
                if (w == 5) { const LAS char* kb = lds + L_KTR + (l >> 4) * 512 + (l & 15) * 4;
                    float p0 = 0.f, p1 = 0.f;
#pragma unroll 2
                    for (int a_ = 0; a_ < 8; ++a_) {
                        const unsigned k0 = *(const LAS unsigned*)(kb + a_ * 2048 + 0), k1 = *(const LAS unsigned*)(kb + a_ * 2048 + 64), k2 = *(const LAS unsigned*)(kb + a_ * 2048 + 128), k3 = *(const LAS unsigned*)(kb + a_ * 2048 + 192);
                        const unsigned k4 = *(const LAS unsigned*)(kb + a_ * 2048 + 256), k5 = *(const LAS unsigned*)(kb + a_ * 2048 + 320), k6 = *(const LAS unsigned*)(kb + a_ * 2048 + 384), k7 = *(const LAS unsigned*)(kb + a_ * 2048 + 448);
                        p0 += ((bflo(k0) + bflo(k4)) + (bflo(k1) + bflo(k5))) + ((bflo(k2) + bflo(k6)) + (bflo(k3) + bflo(k7))); p1 += ((bfhi(k0) + bfhi(k4)) + (bfhi(k1) + bfhi(k5))) + ((bfhi(k2) + bfhi(k6)) + (bfhi(k3) + bfhi(k7))); }
                    n0 = n0 * decay + p0; n1 = n1 * decay + p1;
                    *(LAS f32x2*)(lds + L_NV + (ch & 1) * 512 + 8 * l) = (f32x2){n0, n1}; }
            }
            __builtin_amdgcn_sched_barrier(0);
            if (!(SKIP & 2)) { const int ti = w & 3, si0 = 2 * (w >> 2);
              const f32x4 ut4 = *(const LAS f32x4*)(uv_b + (ch & 1) * 64);
#pragma unroll
              for (int sj = 0; sj < 2; ++sj) { const int si = si0 + sj; float av[4] = {0.f, 0.f, 0.f, 0.f};
                if (si <= ti) { f32x4 acc = {0.f, 0.f, 0.f, 0.f};
#pragma unroll
                    for (int kk = 0; kk < 4; ++kk) { const bf16x8 af = *(const LAS bf16x8*)(sq_b + 64 * kk), bfr = *(const LAS bf16x8*)(sk_b + (16 * si) * RSB + 64 * kk);
                        acc = __builtin_amdgcn_mfma_f32_16x16x32_bf16(af, bfr, acc, 0, 0, 0); }
                    const float as_ = as_b[(ch & 1) * 64 + 16 * sj]; const int dts = 16 * (ti - si) + 4 * q4 - l15;
#pragma unroll
                    for (int r = 0; r < 4; ++r) av[r] = (dts + r >= 0) ? acc[r] * __expf(as_ - ut4[r]) : 0.f; }
#pragma unroll
                for (int r = 0; r < 4; ++r) { *(LAS unsigned short*)(am_w + r * AMB + sj * 32) = (unsigned short)f2bf(av[r]);
                    const float rs_ = row16_sum(av[r]);
                    if (l15 == 0) rs_w[sj * 64 + r] = rs_; } } }
            __builtin_amdgcn_sched_barrier(0);
            bf16x8 vf[4];
            { s16x4 l0, l1, l2, l3, h0, h1, h2, h3;
              TRRD(l0, vbV, 0); TRRD(h0, vbV, 2048); TRRD(l1, vbV, 4096); TRRD(h1, vbV, 6144); TRRD(l2, vbV, 8192); TRRD(h2, vbV, 10240); TRRD(l3, vbV, 12288); TRRD(h3, vbV, 14336);
              asm volatile("s_waitcnt lgkmcnt(0)" ::: "memory"); __builtin_amdgcn_sched_barrier(0);
              vf[0] = (bf16x8){l0[0], l0[1], l0[2], l0[3], h0[0], h0[1], h0[2], h0[3]}; vf[1] = (bf16x8){l1[0], l1[1], l1[2], l1[3], h1[0], h1[1], h1[2], h1[3]};
              vf[2] = (bf16x8){l2[0], l2[1], l2[2], l2[3], h2[0], h2[1], h2[2], h2[3]}; vf[3] = (bf16x8){l3[0], l3[1], l3[2], l3[3], h3[0], h3[1], h3[2], h3[3]}; }
            f32x16 ac[2] = {};
            if (!(SKIP & 4))
#pragma unroll
            for (int db = 0; db < 4; ++db)
#pragma unroll
                for (int s2 = 0; s2 < 2; ++s2) {
                    u32x4 cw; cw.x = cvtpk(Ct[db][8 * s2 + 0], Ct[db][8 * s2 + 1]); cw.y = cvtpk(Ct[db][8 * s2 + 2], Ct[db][8 * s2 + 3]); cw.z = cvtpk(Ct[db][8 * s2 + 4], Ct[db][8 * s2 + 5]); cw.w = cvtpk(Ct[db][8 * s2 + 6], Ct[db][8 * s2 + 7]);
#pragma unroll
                    for (int th = 0; th < 2; ++th) { const LAS char* qp = q_b + 32 * th * RSB + (32 * db + 16 * s2) * 2; const u32x2 x0 = *(const LAS u32x2*)qp, x1 = *(const LAS u32x2*)(qp + 16);
                        u32x4 o = {x0.x, x0.y, x1.x, x1.y}; ac[th] = __builtin_amdgcn_mfma_f32_32x32x16_bf16(*reinterpret_cast<bf16x8*>(&o), *reinterpret_cast<bf16x8*>(&cw), ac[th], 0, 0, 0); } }
            if (!(SKIP & 8))
#pragma unroll
            for (int db = 0; db < 4; ++db) { s16x4 l0, l1, l2, l3, h0, h1, h2, h3;
                TRRD(l0, vbK, db * 512 + 0); TRRD(h0, vbK, db * 512 + 2048); TRRD(l1, vbK, db * 512 + 4096); TRRD(h1, vbK, db * 512 + 6144); TRRD(l2, vbK, db * 512 + 8192); TRRD(h2, vbK, db * 512 + 10240); TRRD(l3, vbK, db * 512 + 12288); TRRD(h3, vbK, db * 512 + 14336);
#pragma unroll
                for (int r = 0; r < 16; ++r) Ct[db][r] *= decay;
                asm volatile("s_waitcnt lgkmcnt(0)" ::: "memory"); __builtin_amdgcn_sched_barrier(0);
                Ct[db] = __builtin_amdgcn_mfma_f32_32x32x16_bf16((bf16x8){l0[0], l0[1], l0[2], l0[3], h0[0], h0[1], h0[2], h0[3]}, vf[0], Ct[db], 0, 0, 0);
                Ct[db] = __builtin_amdgcn_mfma_f32_32x32x16_bf16((bf16x8){l1[0], l1[1], l1[2], l1[3], h1[0], h1[1], h1[2], h1[3]}, vf[1], Ct[db], 0, 0, 0);
                Ct[db] = __builtin_amdgcn_mfma_f32_32x32x16_bf16((bf16x8){l2[0], l2[1], l2[2], l2[3], h2[0], h2[1], h2[2], h2[3]}, vf[2], Ct[db], 0, 0, 0);
                Ct[db] = __builtin_amdgcn_mfma_f32_32x32x16_bf16((bf16x8){l3[0], l3[1], l3[2], l3[3], h3[0], h3[1], h3[2], h3[3]}, vf[3], Ct[db], 0, 0, 0); }
            m_state = blast + u63;
            __syncthreads(); __builtin_amdgcn_sched_barrier(0);
            if (!(SKIP & 16)) {
            { const float den = ((RS[l] + RS[64 + l]) + (RS[128 + l] + RS[192 + l])) + winter * QN[l]; HDEN[64 * w + l] = 1.f / fmaxf(fabsf(den), mexp); }
            const LAS float* wint_c = wint_b + (ch & 1) * 64;
#pragma unroll
            for (int th = 0; th < 2; ++th) { f32x16 ai = {};
#pragma unroll
                for (int ks = 0; ks < 4; ++ks) { if (th == 0 && ks >= 2) continue; const bf16x8 af = *(const LAS bf16x8*)(am_b + 32 * th * AMB + 32 * ks); ai = __builtin_amdgcn_mfma_f32_32x32x16_bf16(af, vf[ks], ai, 0, 0, 0); }
#pragma unroll
                for (int r = 0; r < 16; ++r) { const int tc = 32 * th + (r & 3) + 8 * (r >> 2); const float v = (ai[r] + wint_c[tc] * ac[th][r]) * hden_b[tc]; const float vn = lane_xor1(v);
                    bf16* rowp = HC + (size_t)(tok0 + tc) * 2048 + h * 256;
                    if ((r32 & 1) == 0) *(unsigned*)(rowp + hc_lane) = cvtpk(v, vn); } }
            }
        }
        __syncthreads();
    }
#undef M_LOAD
#undef M_LOADV
}
#undef TRRD
}

#ifndef GEMM_SP2
#define GEMM_SP2 true
#endif
#ifndef GEMM_ALIGN
#define GEMM_ALIGN true
#endif
#ifndef EPI_NT
#define EPI_NT 1
#endif
#if EPI_NT
#define EPI_ST(p, v) __builtin_nontemporal_store((v), (p))
#else
#define EPI_ST(p, v) (*(p) = (v))
#endif
namespace pg8 {
struct EpiStoreBf16 { static constexpr bool PERM = true, AFTER_DRAIN = false, WIDE = false; bf16_t* O; int ldc;
    __device__ __forceinline__ void operator()(const f32x4 (&acc)[2][2][4][2], const Unit& u, int wr, int wc, int fr, int fq) const {
        const int row0 = u.pm * BM + wr * 64 + fr, col0 = u.pn * BM + wc * 32 + 8 * fq;
#pragma unroll
        for (int ai = 0; ai < 2; ++ai)
#pragma unroll
            for (int m = 0; m < 4; ++m) { bf16_t* rowp = O + (size_t)(row0 + ai * HALF + m * 16) * ldc + col0;
#pragma unroll
                for (int bj = 0; bj < 2; ++bj) { const f32x4 v0 = acc[ai][bj][m][0], v1 = acc[ai][bj][m][1];
                    u32x4 w; w.x = cvt_pk_bf16(v0[0], v0[1]); w.y = cvt_pk_bf16(v0[2], v0[3]); w.z = cvt_pk_bf16(v1[0], v1[1]); w.w = cvt_pk_bf16(v1[2], v1[3]);
                    EPI_ST((u32x4*)(rowp + bj * HALF), w); } }
    }
};
struct EpiStoreFp8 { static constexpr bool PERM = true, AFTER_DRAIN = false; static constexpr int WIDE = 2; unsigned char* O; int ldc;
    __device__ __forceinline__ void operator()(const f32x4 (&acc)[2][2][4][2], const Unit& u, int wr, int wc, int fr, int fq) const {
        unsigned char* tb = O + (size_t)(u.pm * BM) * ldc + u.pn * BM; const unsigned lo = (unsigned)((wr * 64 + fr) * ldc + wc * 64 + 16 * fq);
#pragma unroll
        for (int ai = 0; ai < 2; ++ai)
#pragma unroll
            for (int m = 0; m < 4; ++m) { u32x4 w; unsigned pw[2][2];
#pragma unroll
                for (int bj = 0; bj < 2; ++bj) { const f32x4 v0 = acc[ai][bj][m][0] * 16.f, v1 = acc[ai][bj][m][1] * 16.f;
                    int t0 = __builtin_amdgcn_cvt_pk_fp8_f32(v0[0], v0[1], 0, false); t0 = __builtin_amdgcn_cvt_pk_fp8_f32(v0[2], v0[3], t0, true);
                    int t1 = __builtin_amdgcn_cvt_pk_fp8_f32(v1[0], v1[1], 0, false); t1 = __builtin_amdgcn_cvt_pk_fp8_f32(v1[2], v1[3], t1, true);
                    pw[bj][0] = (unsigned)t0; pw[bj][1] = (unsigned)t1; }
                w.x = pw[0][0]; w.y = pw[0][1]; w.z = pw[1][0]; w.w = pw[1][1];
                EPI_ST((u32x4*)(tb + (size_t)((ai * HALF + m * 16) * ldc) + lo), w); }
    }
};
struct EpiQKV { static constexpr bool PERM = true, AFTER_DRAIN = false, WIDE = false; bf16_t* O; int ldc; const float* tab;
    __device__ __forceinline__ void operator()(const f32x4 (&acc)[2][2][4][2], const Unit& u, int wr, int wc, int fr, int fq) const {
        const int row0 = u.pm * BM + wr * 64 + fr, col0 = u.pn * BM + wc * 32 + 8 * fq;
        const bool rot = ((u.pn >> 2) % 3) < 2 && wc == 0;
        const float* tb = tab + 16 * (fq & 1);
        f32x4 n0 = {1.f, 0.f, 1.f, 0.f}, n1 = n0, n2 = n0, n3 = n0;
        if (rot) { const f32x4* tp = (const f32x4*)(tb + (size_t)(row0 & 2047) * 32); n0 = tp[0]; n1 = tp[1]; n2 = tp[2]; n3 = tp[3]; }
#pragma unroll
        for (int ai = 0; ai < 2; ++ai)
#pragma unroll
            for (int m = 0; m < 4; ++m) { const int row = row0 + ai * HALF + m * 16; bf16_t* rowp = O + (size_t)row * ldc + col0;
                const f32x4 t0 = n0, t1 = n1, t2 = n2, t3 = n3;
                if (rot && (ai * 4 + m) < 7) { const int nrow = row0 + ((ai * 4 + m + 1) >> 2) * HALF + ((ai * 4 + m + 1) & 3) * 16; const f32x4* tp = (const f32x4*)(tb + (size_t)(nrow & 2047) * 32); n0 = tp[0]; n1 = tp[1]; n2 = tp[2]; n3 = tp[3]; }
                const f32x4 c0 = {t0[0], t0[2], t1[0], t1[2]}, c1 = {t2[0], t2[2], t3[0], t3[2]};
                f32x4 s0 = {t0[1], t0[3], t1[1], t1[3]}, s1 = {t2[1], t2[3], t3[1], t3[3]};
                if (fq < 2) { s0 = -s0; s1 = -s1; }
#pragma unroll
                for (int bj = 0; bj < 2; ++bj) { f32x4 v0 = acc[ai][bj][m][0], v1 = acc[ai][bj][m][1];
                    if (rot) { f32x4 p0, p1;
#pragma unroll
                        for (int k = 0; k < 4; ++k) { p0[k] = lane_xor32(v0[k]); p1[k] = lane_xor32(v1[k]); }
                        v0 = v0 * c0 + p0 * s0; v1 = v1 * c1 + p1 * s1; }
                    u32x4 w; w.x = cvt_pk_bf16(v0[0], v0[1]); w.y = cvt_pk_bf16(v0[2], v0[3]); w.z = cvt_pk_bf16(v1[0], v1[1]); w.w = cvt_pk_bf16(v1[2], v1[3]);
                    EPI_ST((u32x4*)(rowp + bj * HALF), w); } }
    }
};
template <bool RES_F32> struct EpiRes { static constexpr bool PERM = true, AFTER_DRAIN = false, WIDE = false; const void* res; bf16_t* out; int ldc; float alpha;
    __device__ __forceinline__ void operator()(const f32x4 (&acc)[2][2][4][2], const Unit& u, int wr, int wc, int fr, int fq) const {
        const int row0 = u.pm * BM + wr * 64 + fr, col0 = u.pn * BM + wc * 32 + 8 * fq;
#pragma unroll
        for (int ai = 0; ai < 2; ++ai)
#pragma unroll
            for (int m = 0; m < 4; ++m) { const size_t off = (size_t)(row0 + ai * HALF + m * 16) * ldc + col0;
#pragma unroll
                for (int bj = 0; bj < 2; ++bj) { f32x4 r0, r1;
                    if (RES_F32) { r0 = *(const f32x4*)((const float*)res + off + bj * HALF); r1 = *(const f32x4*)((const float*)res + off + bj * HALF + 4); }
                    else { const u32x4 rw = *(const u32x4*)((const bf16_t*)res + off + bj * HALF);
                        r0 = (f32x4){__builtin_bit_cast(float, rw.x << 16), __builtin_bit_cast(float, rw.x & 0xffff0000u), __builtin_bit_cast(float, rw.y << 16), __builtin_bit_cast(float, rw.y & 0xffff0000u)};
                        r1 = (f32x4){__builtin_bit_cast(float, rw.z << 16), __builtin_bit_cast(float, rw.z & 0xffff0000u), __builtin_bit_cast(float, rw.w << 16), __builtin_bit_cast(float, rw.w & 0xffff0000u)}; }
                    const f32x4 v0 = r0 * alpha + acc[ai][bj][m][0], v1 = r1 * alpha + acc[ai][bj][m][1];
                    u32x4 w; w.x = cvt_pk_bf16(v0[0], v0[1]); w.y = cvt_pk_bf16(v0[2], v0[3]); w.z = cvt_pk_bf16(v1[0], v1[1]); w.w = cvt_pk_bf16(v1[2], v1[3]);
                    EPI_ST((u32x4*)(out + off + bj * HALF), w); } }
    }
};
struct EpiSwiGLU { static constexpr bool PERM = true, AFTER_DRAIN = false, WIDE = false; bf16_t* H;
    __device__ __forceinline__ void operator()(const f32x4 (&acc)[2][2][4][2], const Unit& u, int wr, int wc, int fr, int fq) const {
        const int row0 = u.pm * BM + wr * 64 + fr, col0 = u.pn * 128 + wc * 16 + 4 * fq;
#pragma unroll
        for (int ai = 0; ai < 2; ++ai)
#pragma unroll
            for (int m = 0; m < 4; ++m) { bf16_t* rowp = H + (size_t)(row0 + ai * HALF + m * 16) * 768 + col0;
#pragma unroll
                for (int bj = 0; bj < 2; ++bj) { const f32x4 v0 = acc[ai][bj][m][0], v1 = acc[ai][bj][m][1];
                    const float h0 = v0[0] / (1.f + __expf(-v0[0])) * v0[1], h1 = v0[2] / (1.f + __expf(-v0[2])) * v0[3], h2 = v1[0] / (1.f + __expf(-v1[0])) * v1[1], h3 = v1[2] / (1.f + __expf(-v1[2])) * v1[3];
                    typedef unsigned u32x2v __attribute__((ext_vector_type(2))); u32x2v w; w.x = cvt_pk_bf16(h0, h1); w.y = cvt_pk_bf16(h2, h3);
                    EPI_ST((u32x2v*)(rowp + bj * 64), w); } }
    }
};
__device__ __forceinline__ unsigned ror8u(unsigned v) { return (unsigned)__builtin_amdgcn_mov_dpp((int)v, 0x128, 0xf, 0xf, true); }
template <bool STORE = true> struct EpiDownT { static constexpr bool PERM = true, AFTER_DRAIN = false, WIDE = true; unsigned char* YB8; const PG8_LAS int* atab;
    __device__ __forceinline__ void operator()(const f32x4 (&acc)[2][2][4][2], const Unit& u, int wr, int wc, int fr, int fq) const {
        typedef unsigned u32x2v __attribute__((ext_vector_type(2)));
        const bool up = fr >= 8; const unsigned ca = (unsigned)(u.pn * BM + wc * 64 + (up ? 32 : 0) + 8 * fq), cb = ca ^ 32u;
        const PG8_LAS int* at = atab + u.ui * 256 + wr * 64 + (fr & 7);
#pragma unroll
        for (int ai = 0; ai < 2; ++ai)
#pragma unroll
            for (int m = 0; m < 4; ++m) { u32x2v p[2];
#pragma unroll
                for (int bj = 0; bj < 2; ++bj) { const f32x4 v0 = acc[ai][bj][m][0] * 16.f, v1 = acc[ai][bj][m][1] * 16.f;
                    int t0 = __builtin_amdgcn_cvt_pk_fp8_f32(v0[0], v0[1], 0, false); t0 = __builtin_amdgcn_cvt_pk_fp8_f32(v0[2], v0[3], t0, true);
                    int t1 = __builtin_amdgcn_cvt_pk_fp8_f32(v1[0], v1[1], 0, false); t1 = __builtin_amdgcn_cvt_pk_fp8_f32(v1[2], v1[3], t1, true);
                    p[bj].x = (unsigned)t0; p[bj].y = (unsigned)t1; }
                const u32x2v x = {ror8u(p[1].x), ror8u(p[1].y)};
                const int aA = at[ai * HALF + m * 16], aB = at[ai * HALF + m * 16 + 8];
                const u32x2v dA = up ? x : p[0], dB = up ? p[0] : x;
                if (STORE) { if (aA >= 0) EPI_ST((u32x2v*)(YB8 + (size_t)aA * 2048 + ca), dA); if (aB >= 0) EPI_ST((u32x2v*)(YB8 + (size_t)aB * 2048 + cb), dB); }
                else asm volatile("" :: "v"(dA.x), "v"(dA.y), "v"(dB.x), "v"(dB.y)); }
    }
};
typedef EpiDownT<true> EpiDown;
template <bool GATHER_> struct MoeOrder { static constexpr bool GATHER = GATHER_; static constexpr int MAXU = 9;
    int nN, G, c, nt; const unsigned* cnt; size_t exp_bytes; const int* rowmap; PG8_LAS int* tok;
    static __device__ __forceinline__ int tiles(const unsigned* cnt) { int n = 0; for (int e = 0; e < 16; ++e) n += (int)(cnt[e] + 255u) >> 8; return n; }
    __device__ __forceinline__ bool next(int i, Unit& u) const { const long L = (long)i * G + c; if (L >= (long)nt * nN) return false; u.pm = (int)(L / nN); u.pn = (int)(L % nN); u.ui = i; return true; }
    __device__ __forceinline__ const char* pa(const Gemm& g, const Unit& u) const { return GATHER_ ? (const char*)g.A : (const char*)g.A + (size_t)u.pm * ((size_t)BM * g.K * 2); }
    __device__ __forceinline__ const char* pb(const Gemm& g, const Unit& u) const { const int e = __builtin_amdgcn_readfirstlane(tok[MAXU * 256 + u.pm]) & 15; return (const char*)g.Bt + (size_t)e * exp_bytes + (size_t)u.pn * ((size_t)BM * g.K * 2); }
    __device__ __forceinline__ void prep() const {
        if (threadIdx.x < 16) { const int e = threadIdx.x; int pm = 0; for (int q = 0; q < e; ++q) pm += (int)(cnt[q] + 255u) >> 8;
            const int ce = (int)cnt[e];
            for (int k = 0; k * 256 < ce; ++k) { const int rem = ce - k * 256; tok[MAXU * 256 + pm + k] = e | (k << 4) | ((rem > 256 ? 256 : rem) << 12); } }
        __syncthreads();
        for (int i = 0; i < MAXU; ++i) { Unit u; if (!next(i, u)) break; if (threadIdx.x < 256) { const int w = tok[MAXU * 256 + u.pm]; tok[i * 256 + threadIdx.x] = ((int)threadIdx.x < (w >> 12)) ? rowmap[(w & 15) * ECAP + ((w >> 4) & 255) * 256 + (int)threadIdx.x] : -1; } }
        asm volatile("s_waitcnt vmcnt(0) lgkmcnt(0)" ::: "memory"); __syncthreads();
    }
    __device__ __forceinline__ void aoffs(int ui, int K, int tid, unsigned (&out)[2][2]) const {
#pragma unroll
        for (int h = 0; h < 2; ++h)
#pragma unroll
            for (int i = 0; i < 2; ++i) { int R, C; stage_rc(tid * 16 + i * 8192, R, C); const int a = tok[ui * 256 + h * 128 + R]; out[h][i] = (unsigned)((a < 0 ? 0 : a) >> 1) * (unsigned)(K * 2) + (unsigned)(C * 2); }
    }
    __device__ __forceinline__ void a_ready(const Unit&) const {}
    __device__ __forceinline__ void done(const Unit&) const {}
};
}

struct Args { const float* in[18]; float* out; unsigned char* ws; int ph_lo, ph_hi; };
#ifdef ONLY_PH
#define IN(k) ((k) == ONLY_PH)
#else
#define IN(k) (lo <= (k) && (k) < hi)
#endif
#define BOTH(k) (IN(k) && IN((k) + 1))
#if MK_ONE_LAUNCH
#define SEAM() xcd_barrier(bar)
#else
#define SEAM() do {} while (0)
#endif
#ifndef REP_PH
#define REP_PH (-1)
#endif
#ifndef REP_PH2
#define REP_PH2 (-1)
#endif
#ifdef TS_PROBE
#define TS_STAMP(k) do { if (blockIdx.x == 0 && threadIdx.x == 0) __hip_atomic_store((unsigned long long*)(ws + WS_CTL + 65536) + (k), __builtin_amdgcn_s_memrealtime(), __ATOMIC_RELAXED, __HIP_MEMORY_SCOPE_AGENT); } while (0)
#define PHASE(k, ...) if (IN(k)) { __VA_ARGS__; SEAM(); TS_STAMP((k) + 1); }
#else
#define PHASE(k, ...) if (IN(k)) { __VA_ARGS__; if ((k) == REP_PH || (k) == REP_PH2) { __syncthreads(); __VA_ARGS__; } if (BOTH(k)) SEAM(); }
#endif
#define WSP(T_, off) ((T_*)(ws + (off)))
#ifndef MOE_XCD_ORDER
#define MOE_XCD_ORDER 1
#endif
#if MOE_XCD_ORDER
#define MOE_CU(c) (((c).G % 8 == 0) ? ((c).bid % 8) * ((c).G / 8) + (c).bid / 8 : (c).bid)
#else
#define MOE_CU(c) ((c).bid)
#endif
#define GEMM_STATIC(EPI, A_, B_, N_, K_, ...) do { pg8::Gemm g{A_, B_, T, N_, K_}; pg8::StaticOrder S; S.init(T, N_, c.G, c.bid); EPI E{__VA_ARGS__}; pg8::gemm_phase<EPI, pg8::StaticOrder, GEMM_ALIGN, GEMM_SP2>(c.lds, g, S, E); } while (0)
#define GEMM_MOE(GATH, EPI, A_, B_, N_, K_, ...) do { pg8::Gemm g{A_, B_, MAXROWS, N_, K_}; const unsigned* cnt_ = WSP(unsigned, WS_CTL) + CW_CUR + L * 32; pg8::MoeOrder<GATH> S{(N_) / 256, c.G, MOE_CU(c), __builtin_amdgcn_readfirstlane(pg8::MoeOrder<GATH>::tiles(cnt_)), cnt_, (size_t)(N_) * (K_) * 2, WSP(int, WS_RM2), (LAS int*)(c.lds + LDSCTL_OFF + 5120)}; EPI E{__VA_ARGS__}; pg8::gemm_phase<EPI, pg8::MoeOrder<GATH>, GEMM_ALIGN, true>(c.lds, g, S, E); } while (0)
enum { P_PRO = 0, P_QKV, P_ATTA, P_ATTB, P_WO, P_MOE0, P_WIN = P_MOE0 + 4, P_CONV, P_CELL, P_HN, P_WOUT, P_MOE1, P_END = P_MOE1 + 4 };
static_assert(P_END == NPHASE, "phase count");
template <int L>
__device__ __forceinline__ void moe_block(const Ctx& c, const Args& args, unsigned char* ws, const int lo, const int hi, const XcdBarrier& bar, const int base) {
    (void)bar; (void)lo; (void)hi;
    PHASE(base + 0, ln_pass<0, 1, false>(c, WSP(bf16, WS_PRE), nullptr, nullptr, WSP(bf16, WS_XB), args.in[9] + L * D, args.in[10] + L * D, args.in[13], 16, 0, args.in[14], WSP(int, WS_RM2), WSP(float, WS_EGATE), WSP(unsigned, WS_CTL) + CW_CUR + L * 32, nullptr))
    PHASE(base + 1, GEMM_MOE(true, pg8::EpiSwiGLU, WSP(bf16, WS_XB), WSP(bf16, WS_WGU), GU_N, D, WSP(bf16, WS_H)))
#ifdef DOWN_NOSTORE_PROBE
    if (IN(base + 2)) { GEMM_MOE(false, pg8::EpiDownT<false>, WSP(bf16, WS_H), WSP(bf16, WS_WD), D, DE, WSP(unsigned char, WS_YB), (const LAS int*)(c.lds + LDSCTL_OFF + 5120)); __syncthreads(); }
#endif
    PHASE(base + 2, GEMM_MOE(false, pg8::EpiDown, WSP(bf16, WS_H), WSP(bf16, WS_WD), D, DE, WSP(unsigned char, WS_YB), (const LAS int*)(c.lds + LDSCTL_OFF + 5120)))
    if (L == 0) { PHASE(base + 3, ln_pass<1, 2, false>(c, nullptr, nullptr, WSP(bf16, WS_YB), WSP(bf16, WS_XB), args.in[11], args.in[12], args.in[3], ZLD, ZN, args.in[4], nullptr, WSP(float, WS_EGATE), nullptr, WSP(float, WS_GATES))) }
    else { PHASE(base + 3, ln_pass<1, 0, true>(c, nullptr, args.out, WSP(bf16, WS_YB), WSP(bf16, WS_XB), args.in[11] + D, args.in[12] + D, nullptr, 0, 0, nullptr, nullptr, WSP(float, WS_EGATE), nullptr, nullptr)) }
}
__global__ void __launch_bounds__(NTHR, 2) fwd(Args args) {
    extern __shared__ __attribute__((aligned(16))) unsigned char lds_raw[];
    Ctx c; c.lds = (LAS unsigned char*)lds_raw; c.tid = threadIdx.x; c.lane = c.tid & 63; c.wave = __builtin_amdgcn_readfirstlane(c.tid >> 6);
    c.G = gridDim.x; c.bid = blockIdx.x; c.gw = c.bid * NWAVES + c.wave; c.ngw = c.G * NWAVES; c.gtid = c.bid * NTHR + c.tid; c.ngt = c.G * NTHR;
    unsigned char* ws = args.ws;
    ((LAS unsigned*)(c.lds + LDSCTL_OFF))[c.tid] = 0u;
    __syncthreads();
#if MK_ONE_LAUNCH
    XcdBarrier bar = xcd_barrier_post((unsigned*)(ws + WS_CTL) + CW_BAR, (volatile LAS unsigned*)(c.lds + LDSCTL_OFF + LC_BAR));
#else
    XcdBarrier bar; bar.bar = nullptr; bar.x = 0; bar.st = nullptr;
#endif
    const int lo = args.ph_lo, hi = args.ph_hi; (void)lo; (void)hi;
#ifdef TS_PROBE
    SEAM(); TS_STAMP(0);
#endif
    PHASE(P_PRO, conv_job(c, args.in[1], QKV_N, D, QKV_N, WSP(bf16, WS_WQKV)); conv_job(c, args.in[2], D, OD, D, WSP(bf16, WS_WO)); conv_job(c, args.in[3], ZLD, D, ZN, WSP(bf16, WS_WIN)); conv_job(c, args.in[8], D, D, D, WSP(bf16, WS_WOUT));
        conv_moe(c, args.in[15], args.in[16], args.in[17], WSP(bf16, WS_WGU), WSP(bf16, WS_WD), c.gw, c.ngw);
        x_to_bf16(c, args.in[0], WSP(bf16, WS_XB)); rope_table(c, WSP(f32x2, WS_ROPE)))
    PHASE(P_QKV, GEMM_STATIC(pg8::EpiQKV, WSP(bf16, WS_XB), WSP(bf16, WS_WQKV), QKV_N, D, WSP(bf16, WS_QKV), QKV_N, WSP(const float, WS_ROPE)))
    PHASE(P_ATTA, att::attn_phase<false>(c, WSP(const bf16, WS_QKV), WSP(bf16, WS_XB), WSP(float, WS_GATES), nullptr))
    PHASE(P_ATTB, att::attn_phase<true>(c, WSP(const bf16, WS_QKV), WSP(bf16, WS_XB), WSP(float, WS_GATES), WSP(bf16, WS_O)))
    PHASE(P_WO, GEMM_STATIC(pg8::EpiRes<true>, WSP(bf16, WS_O), WSP(bf16, WS_WO), D, OD, args.in[0], WSP(bf16, WS_PRE), D, ALPHA))
    moe_block<0>(c, args, ws, lo, hi, bar, P_MOE0);
    PHASE(P_WIN, GEMM_STATIC(pg8::EpiStoreFp8, WSP(bf16, WS_XB), WSP(bf16, WS_WIN), ZN, D, WSP(unsigned char, WS_Z), ZN))
    PHASE(P_CONV, conv_pass(c, WSP(const unsigned char, WS_Z), args.in[5], args.in[6], WSP(bf16, WS_QKC)))
    PHASE(P_CELL,
#if defined(MLS_SKIP)
        mls::mlstm_phase<MLS_SKIP>(c, WSP(const bf16, WS_QKC), WSP(const unsigned char, WS_Z), WSP(const float, WS_GATES), WSP(bf16, WS_HC)); __syncthreads();
#endif
        mls::mlstm_phase<0>(c, WSP(const bf16, WS_QKC), WSP(const unsigned char, WS_Z), WSP(const float, WS_GATES), WSP(bf16, WS_HC));
#if 0
        mls::mlstm_phase<0>(c, WSP(const bf16, WS_QKC), WSP(const unsigned char, WS_Z), WSP(const float, WS_GATES), WSP(bf16, WS_HC));
#endif
        if (c.G > 128) { if (c.bid >= 128) conv_moe(c, args.in[15] + (size_t)NE * D * DE, args.in[16] + (size_t)NE * D * DE, args.in[17] + (size_t)NE * D * DE, WSP(bf16, WS_WGU), WSP(bf16, WS_WD), (c.bid - 128) * NWAVES + c.wave, (c.G - 128) * NWAVES); }
        else conv_moe(c, args.in[15] + (size_t)NE * D * DE, args.in[16] + (size_t)NE * D * DE, args.in[17] + (size_t)NE * D * DE, WSP(bf16, WS_WGU), WSP(bf16, WS_WD), c.gw, c.ngw);
        )
    PHASE(P_HN, headnorm_pass(c, WSP(const bf16, WS_HC), WSP(const unsigned char, WS_Z), args.in[7], WSP(bf16, WS_Y)))
    PHASE(P_WOUT, GEMM_STATIC(pg8::EpiRes<false>, WSP(bf16, WS_Y), WSP(bf16, WS_WOUT), D, D, WSP(bf16, WS_XB), WSP(bf16, WS_PRE), D, ALPHA))
    moe_block<1>(c, args, ws, lo, hi, bar, P_MOE1);
#ifdef TS_PROBE
    {
        SEAM();
        const unsigned long long* ts = (const unsigned long long*)(ws + WS_CTL + 65536);
        const unsigned long long t0 = __hip_atomic_load(ts + TS_PROBE, __ATOMIC_RELAXED, __HIP_MEMORY_SCOPE_AGENT), t1 = __hip_atomic_load(ts + TS_PROBE + 1, __ATOMIC_RELAXED, __HIP_MEMORY_SCOPE_AGENT), t2 = __hip_atomic_load(ts + TS_PROBE + 2, __ATOMIC_RELAXED, __HIP_MEMORY_SCOPE_AGENT);
        const float k1 = (float)(t1 - t0) * 0.001f;
        const float k2 = (TS_PROBE + 2 <= NPHASE) ? (float)(t2 - t1) * 10.0f : 0.f;
        for (size_t i = c.gtid; i < (size_t)T * D; i += c.ngt) args.out[i] = k1;
        SEAM();
        if (c.gtid == 0) args.out[0] = k2;
    }
#endif
}
#undef IN
#undef BOTH

extern "C" void kernel_launch(void* const* d_in, const int* in_sizes, int n_in, void* d_out, int out_size, void* d_ws, size_t ws_size, hipStream_t stream) {
    static int grid = 0;
    if (grid == 0) {
        if (n_in != 18 || in_sizes[0] != T * D || out_size != T * D || ws_size < WS_END) { fprintf(stderr, "kernel_launch: unexpected shapes (n_in %d, in0 %d, out %d, ws %zu)\n", n_in, n_in > 0 ? in_sizes[0] : -1, out_size, ws_size); grid = -1; return; }
        int dev = 0, cus = 0;
        if (hipGetDevice(&dev) != hipSuccess || hipDeviceGetAttribute(&cus, hipDeviceAttributeMultiprocessorCount, dev) != hipSuccess) { grid = -1; return; }
        if (hipFuncSetAttribute((const void*)fwd, hipFuncAttributeMaxDynamicSharedMemorySize, LDS_BYTES) != hipSuccess) { fprintf(stderr, "kernel_launch: hipFuncSetAttribute failed\n"); grid = -1; return; }
        int per_cu = 0;
        if (hipOccupancyMaxActiveBlocksPerMultiprocessor(&per_cu, (const void*)fwd, NTHR, LDS_BYTES) != hipSuccess || per_cu < 1) fprintf(stderr, "kernel_launch: occupancy query says %d\n", per_cu);
        (void)hipGetLastError();
        grid = cus > 256 ? 256 : cus;
    }
    if (grid < 0) return;
    (void)hipMemsetAsync((char*)d_ws + WS_CTL, 0, CTL_ZERO_BYTES, stream);
    Args a{};
    for (int i = 0; i < 18; ++i) a.in[i] = (const float*)d_in[i];
    a.out = (float*)d_out; a.ws = (unsigned char*)d_ws;
#if MK_ONE_LAUNCH
    a.ph_lo = 0; a.ph_hi = NPHASE;
    hipLaunchKernelGGL(fwd, dim3(grid), dim3(NTHR), LDS_BYTES, stream, a);
#else
    for (int p = 0; p < NPHASE; ++p) { a.ph_lo = p; a.ph_hi = p + 1; hipLaunchKernelGGL(fwd, dim3(grid), dim3(NTHR), LDS_BYTES, stream, a); }
#endif
}
```

```cpp
#include <hip/hip_runtime.h>
#include <cstdio>
#include <cstdint>
namespace pg8 {
#define PG8_LAS __attribute__((address_space(3)))
typedef unsigned short bf16_t;
typedef short bf16x8 __attribute__((ext_vector_type(8)));
typedef float f32x4 __attribute__((ext_vector_type(4)));
typedef unsigned u32x4 __attribute__((ext_vector_type(4)));
constexpr int BM = 256, BK = 64, HALF = 128, HTB = HALF * BK * 2  , STAGE_BYTES = 8 * HTB, NXCD = 8, WGM = 8;

__host__ __device__ __forceinline__ int lds_byte(int r, int c) { const int st = (r >> 4) * 2 + (c >> 5), rr = r & 15, cc = c & 31, ob = rr * 64 + cc * 2; return st * 1024 + (ob ^ (((ob >> 9) & 1) << 5)); }
__host__ __device__ __forceinline__ void stage_rc(int b, int& R, int& C) { const int st = b / 1024, sb = b % 1024, swz = sb ^ (((sb >> 9) & 1) << 5); R = (st >> 1) * 16 + swz / 64; C = (st & 1) * 32 + (swz % 64) / 2; }
__host__ __device__ __forceinline__ int perm32(int rho) { const int n = rho >> 4, i = rho & 15; return 8 * (i >> 2) + 4 * n + (i & 3); }

struct Unit { int pm, pn, ui; };
struct Gemm { const bf16_t* A; const bf16_t* Bt; int M, N, K; };

struct StaticOrder {
    int nM, nN, nwg, G, c;
    __host__ __device__ void init(int M, int N, int G_, int c_) { nM = M / BM; nN = N / BM; nwg = nM * nN; G = G_; c = c_; }
    __host__ __device__ bool next(int i, Unit& u) const {
        const long L = (long)i * G + c; if (L >= nwg) return false;
        int wgid = (int)L; { const int q = nwg / NXCD, r = nwg % NXCD, xcd = wgid % NXCD, off = wgid / NXCD; wgid = (xcd < r ? xcd * (q + 1) : r * (q + 1) + (xcd - r) * q) + off; }
        const int nig = WGM * nN, gid = wgid / nig, fm = gid * WGM, gsz = (nM - fm) < WGM ? (nM - fm) : WGM;
        u.pm = fm + ((wgid % nig) % gsz); u.pn = (wgid % nig) / gsz; u.ui = i; return true;
    }
    __device__ __forceinline__ const char* pa(const Gemm& g, const Unit& u) const { return (const char*)g.A + (size_t)u.pm * ((size_t)BM * g.K * 2); }
    __device__ __forceinline__ const char* pb(const Gemm& g, const Unit& u) const { return (const char*)g.Bt + (size_t)u.pn * ((size_t)BM * g.K * 2); }
    static constexpr bool GATHER = false;
    __device__ __forceinline__ void prep() const {}
    __device__ __forceinline__ void aoffs(int, int, int, unsigned (&)[2][2]) const {}
    __device__ __forceinline__ void a_ready(const Unit&) const {}
    __device__ __forceinline__ void done(const Unit&) const {}
};

__device__ __forceinline__ unsigned cvt_pk_bf16(float lo, float hi) { unsigned r; asm volatile("v_cvt_pk_bf16_f32 %0, %1, %2" : "=v"(r) : "v"(lo), "v"(hi)); return r; }
typedef float f32x2 __attribute__((ext_vector_type(2)));
template <class Epi, class Sched, bool ALIGN_EPI = false, bool SP2 = false>
__device__ __forceinline__ void gemm_phase(PG8_LAS unsigned char* lds, const Gemm g, const Sched& S, const Epi& E) {
    const int tid = threadIdx.x, wid = __builtin_amdgcn_readfirstlane(tid >> 6), lane = tid & 63, wr = wid >> 2, wc = wid & 3, fr = lane & 15, fq = lane >> 4;
    const int K = g.K, nt = K / BK;
    unsigned voffA[2], voffB[2];
#pragma unroll
    for (int i = 0; i < 2; ++i) { int R, C; stage_rc(tid * 16 + i * 8192, R, C); const int Rb = Epi::PERM ? ((R & ~31) + perm32(R & 31)) : R;
        voffA[i] = (unsigned)(R * K + C) * 2u; voffB[i] = (unsigned)(((int)Epi::WIDE == 2 ? ((R >> 5) * 64 + 16 * (perm32(R & 31) >> 3) + (perm32(R & 31) & 7)) : (int)Epi::WIDE == 1 ? ((R >> 5) * 64 + perm32(R & 31)) : Rb) * K + C) * 2u; }
    const size_t kstep = (size_t)(BK * 2);
    const size_t hstep = (size_t)HALF * K * 2;
    const size_t hstepB = (int)Epi::WIDE == 2 ? (size_t)8 * K * 2 : (int)Epi::WIDE == 1 ? (size_t)32 * K * 2 : hstep;
    const size_t tstep = 2 * hstep;
    const unsigned ldsw = (unsigned)wid * 1024u;
    const int aoff = lds_byte(wr * 64 + fr, fq * 8), boff = lds_byte(wc * 32 + fr, fq * 8);
#define PG8_SA(b, h) (((b) * 2 + (h)) * HTB)
#define PG8_SB(b, h) ((4 + (b) * 2 + (h)) * HTB)
#define PG8_STAGE(bufoff, gbase, voff) do { _Pragma("unroll") for (int _i = 0; _i < 2; ++_i) \
        __builtin_amdgcn_global_load_lds((const unsigned*)((const char*)(gbase) + (voff)[_i]), (PG8_LAS unsigned*)(lds + (bufoff) + ldsw + _i * 8192), 16, 0, 0); } while (0)
#define PG8_STAGE_A(bufoff, kptr, half, NXT) do { if constexpr (Sched::GATHER) { const unsigned vx_[2] = {(NXT) ? van[half][0] : va[half][0], (NXT) ? van[half][1] : va[half][1]}; PG8_STAGE(bufoff, kptr, vx_); } \
        else { PG8_STAGE(bufoff, (kptr) + ((half) ? hstep : 0), voffA); } } while (0)
#define PG8_LDA(dst, b, h) do { _Pragma("unroll") for (int m = 0; m < 4; ++m) _Pragma("unroll") for (int k = 0; k < 2; ++k) dst[m][k] = *(const PG8_LAS bf16x8*)(lds + PG8_SA(b, h) + aoff + m * 2048 + k * 1024); } while (0)
#define PG8_LDB(dst, b, h) do { _Pragma("unroll") for (int n = 0; n < 2; ++n) _Pragma("unroll") for (int k = 0; k < 2; ++k) dst[n][k] = *(const PG8_LAS bf16x8*)(lds + PG8_SB(b, h) + boff + n * 2048 + k * 1024); } while (0)
#define PG8_MMA(ai, bj, At, Bt) do { __builtin_amdgcn_s_setprio(1); _Pragma("unroll") for (int m = 0; m < 4; ++m) _Pragma("unroll") for (int n = 0; n < 2; ++n) _Pragma("unroll") for (int k = 0; k < 2; ++k) \
        acc[ai][bj][m][n] = __builtin_amdgcn_mfma_f32_16x16x32_bf16(Bt[n][k], At[m][k], acc[ai][bj][m][n], 0, 0, 0); __builtin_amdgcn_s_setprio(0); } while (0)
#define PG8_WAIT_V(n) asm volatile("s_waitcnt vmcnt(" #n ")" ::: "memory")
#define PG8_WAIT_L(n) asm volatile("s_waitcnt lgkmcnt(" #n ")" ::: "memory")
#define PG8_BAR __builtin_amdgcn_s_barrier()
#define PG8_SCHED __builtin_amdgcn_sched_barrier(0)
    Unit cur, nxt; int ui = 0;
    if (!S.next(0, cur)) return;
    S.prep();
    f32x4 acc[2][2][4][2];
#pragma unroll
    for (int a = 0; a < 2; ++a)
#pragma unroll
        for (int b = 0; b < 2; ++b)
#pragma unroll
            for (int m = 0; m < 4; ++m)
#pragma unroll
                for (int n = 0; n < 2; ++n) acc[a][b][m][n] = (f32x4){0.f, 0.f, 0.f, 0.f};
    bf16x8 At[4][2], B0[2][2], B1[2][2];
    const char* cA = S.pa(g, cur); const char* cB = S.pb(g, cur);
    unsigned va[2][2] = {{0u, 0u}, {0u, 0u}}, van[2][2] = {{0u, 0u}, {0u, 0u}};
    static_assert(SP2 || !Epi::WIDE, "WIDE epilogues: SP2 loop only");
    if constexpr (Sched::GATHER) { static_assert(SP2, "gathered A rows: SP2 loop only"); S.aoffs(0, K, tid, va); }
    S.a_ready(cur);
    if constexpr (SP2) {
        PG8_STAGE(PG8_SB(0, 0), cB, voffB); PG8_STAGE(PG8_SB(0, 1), cB + hstepB, voffB); PG8_STAGE_A(PG8_SA(0, 0), cA, 0, false); PG8_STAGE_A(PG8_SA(0, 1), cA, 1, false);
        if (wr == 1) PG8_BAR;
        PG8_WAIT_V(2); PG8_BAR;
        PG8_STAGE(PG8_SB(1, 0), cB + kstep, voffB); PG8_STAGE_A(PG8_SA(1, 0), cA + kstep, 0, false); PG8_STAGE(PG8_SB(1, 1), cB + hstepB + kstep, voffB);
        PG8_WAIT_V(6); PG8_BAR;
    } else {
        PG8_STAGE(PG8_SB(0, 0), cB, voffB); PG8_STAGE(PG8_SA(0, 0), cA, voffA); PG8_STAGE(PG8_SB(0, 1), cB + hstep, voffB); PG8_STAGE(PG8_SA(0, 1), cA + hstep, voffA);
        if (wr == 1) PG8_BAR;
        PG8_WAIT_V(4); PG8_BAR;
        PG8_STAGE(PG8_SB(1, 0), cB + kstep, voffB); PG8_STAGE(PG8_SA(1, 0), cA + kstep, voffA); PG8_STAGE(PG8_SB(1, 1), cB + hstep + kstep, voffB);
        PG8_WAIT_V(6); PG8_BAR;
    }
    for (;;) {
        const bool has_next = S.next(ui + 1, nxt);
        if constexpr (Sched::GATHER) { if (has_next) S.aoffs(ui + 1, K, tid, van); else { van[0][0] = va[0][0]; van[0][1] = va[0][1]; van[1][0] = va[1][0]; van[1][1] = va[1][1]; } }
        const char* nA = has_next ? S.pa(g, nxt) : cA; const char* nB = has_next ? S.pb(g, nxt) : cB;
        for (int t = 0; t < nt; t += 2) {
            const bool last = (t == nt - 2);
            const char* a1 = cA + (size_t)(t + 1) * kstep;
            const char* a2 = last ? nA : cA + (size_t)(t + 2) * kstep; const char* b2 = last ? nB : cB + (size_t)(t + 2) * kstep;
            const char* a3 = a2 + kstep; const char* b3 = b2 + kstep;
            if (last && has_next) S.a_ready(nxt);
            if constexpr (SP2) {
            PG8_LDB(B0, 0, 0); PG8_LDB(B1, 0, 1); PG8_SCHED; PG8_LDA(At, 0, 0); PG8_STAGE_A(PG8_SA(1, 1), a1, 1, false);
            PG8_WAIT_V(8); PG8_WAIT_L(0); PG8_BAR; PG8_MMA(0, 0, At, B0); PG8_MMA(0, 1, At, B1); PG8_BAR; PG8_SCHED;
            PG8_LDA(At, 0, 1); PG8_STAGE(PG8_SB(0, 0), b2, voffB); PG8_STAGE(PG8_SB(0, 1), b2 + hstepB, voffB); PG8_STAGE_A(PG8_SA(0, 0), a2, 0, last);
            PG8_WAIT_V(8); PG8_WAIT_L(0); PG8_BAR; PG8_MMA(1, 0, At, B0); PG8_MMA(1, 1, At, B1); PG8_BAR; PG8_SCHED;
            PG8_LDB(B0, 1, 0); PG8_LDB(B1, 1, 1); PG8_SCHED; PG8_LDA(At, 1, 0); PG8_STAGE_A(PG8_SA(0, 1), a2, 1, last);
            PG8_WAIT_V(8); PG8_WAIT_L(0); PG8_BAR; PG8_MMA(0, 0, At, B0); PG8_MMA(0, 1, At, B1); PG8_BAR; PG8_SCHED;
            PG8_LDA(At, 1, 1); PG8_STAGE(PG8_SB(1, 0), b3, voffB); PG8_STAGE(PG8_SB(1, 1), b3 + hstepB, voffB); PG8_STAGE_A(PG8_SA(1, 0), a3, 0, last);
            PG8_WAIT_V(8); PG8_WAIT_L(0); PG8_BAR; PG8_MMA(1, 0, At, B0); PG8_MMA(1, 1, At, B1); PG8_BAR; PG8_SCHED;
            } else {
            PG8_LDB(B0, 0, 0); PG8_SCHED; PG8_LDA(At, 0, 0); PG8_STAGE(PG8_SA(1, 1), a1 + hstep, voffA);
            PG8_WAIT_L(8); PG8_BAR; PG8_WAIT_L(0); PG8_MMA(0, 0, At, B0); PG8_BAR; PG8_SCHED;
            PG8_LDB(B1, 0, 1); PG8_STAGE(PG8_SB(0, 0), b2, voffB);
            PG8_BAR; PG8_WAIT_L(0); PG8_MMA(0, 1, At, B1); PG8_BAR;
            PG8_LDA(At, 0, 1); PG8_STAGE(PG8_SA(0, 0), a2, voffA);
            PG8_BAR; PG8_WAIT_L(0); PG8_MMA(1, 0, At, B0); PG8_BAR; PG8_SCHED;
            PG8_STAGE(PG8_SB(0, 1), b2 + hstep, voffB);
            PG8_WAIT_V(6); PG8_BAR; PG8_MMA(1, 1, At, B1); PG8_BAR;
            PG8_LDB(B0, 1, 0); PG8_SCHED; PG8_LDA(At, 1, 0); PG8_STAGE(PG8_SA(0, 1), a2 + hstep, voffA);
            PG8_WAIT_L(8); PG8_BAR; PG8_WAIT_L(0); PG8_MMA(0, 0, At, B0); PG8_BAR; PG8_SCHED;
            PG8_LDB(B1, 1, 1); PG8_STAGE(PG8_SB(1, 0), b3, voffB);
            PG8_BAR; PG8_WAIT_L(0); PG8_MMA(0, 1, At, B1); PG8_BAR;
            PG8_LDA(At, 1, 1); PG8_STAGE(PG8_SA(1, 0), a3, voffA);
            PG8_BAR; PG8_WAIT_L(0); PG8_MMA(1, 0, At, B0); PG8_BAR; PG8_SCHED;
            PG8_STAGE(PG8_SB(1, 1), b3 + hstep, voffB);
            PG8_WAIT_V(6); PG8_BAR; PG8_MMA(1, 1, At, B1); PG8_BAR;
            }
        }
        if constexpr (ALIGN_EPI) { if (wr == 0) PG8_BAR; }
        if constexpr (!Epi::AFTER_DRAIN) { E(acc, cur, wr, wc, fr, fq); S.done(cur); }
        if (!has_next) break;
#pragma unroll
        for (int a = 0; a < 2; ++a)
#pragma unroll
            for (int b = 0; b < 2; ++b)
#pragma unroll
                for (int m = 0; m < 4; ++m)
#pragma unroll
                    for (int n = 0; n < 2; ++n) acc[a][b][m][n] = (f32x4){0.f, 0.f, 0.f, 0.f};
        cur = nxt; cA = nA; cB = nB; ++ui;
        if constexpr (Sched::GATHER) { va[0][0] = van[0][0]; va[0][1] = van[0][1]; va[1][0] = van[1][0]; va[1][1] = van[1][1]; }
        if constexpr (ALIGN_EPI) { if (wr == 1) PG8_BAR; }
    }
    PG8_WAIT_V(0);
    if constexpr (!ALIGN_EPI) { if (wr == 0) PG8_BAR; }
    PG8_BAR;
    if constexpr (Epi::AFTER_DRAIN) { E.fused(acc, cur, wr, wc, fr, fq, lds, wid, lane); S.done(cur); }
#undef PG8_SA
#undef PG8_SB
#undef PG8_STAGE
#undef PG8_STAGE_A
#undef PG8_LDA
#undef PG8_LDB
#undef PG8_MMA
#undef PG8_WAIT_V
#undef PG8_WAIT_L
#undef PG8_BAR
#undef PG8_SCHED
}
}

#ifndef MK_ONE_LAUNCH
#define MK_ONE_LAUNCH 1
#endif
constexpr int NWAVES = 8, NTHR = 512;
constexpr int BATCH = 16, SEQ = 2048, T = BATCH * SEQ, D = 2048;
constexpr int QKV_N = 9216, NH = 8, HD = 128, OD = NH * HD;
constexpr int ZN = 6144, ZLD = 6160;
constexpr int NE = 16, DE = 768, GU_N = 2 * DE;
constexpr int MAXTILES = 272, MAXROWS = MAXTILES * 256;
constexpr float ALPHA = 1.41421356237309515f;
constexpr float LN_EPS = 1e-5f;
constexpr int NPHASE = 18;
constexpr int ECAP = 32768;

constexpr size_t MiB = 1u << 20, KiB = 1u << 10;
constexpr size_t WS_CTL = 0, CTL_ZERO_BYTES = 256 * KiB;
constexpr size_t WS_ROPE = 1 * MiB;
constexpr size_t WS_EID = 1 * MiB + 256 * KiB;
constexpr size_t WS_EGATE = 1 * MiB + 512 * KiB;
constexpr size_t WS_ROWMAP = 1 * MiB + 768 * KiB;
constexpr size_t WS_HIST = 2 * MiB + 256 * KiB;
constexpr size_t WS_TILEE = 2 * MiB + 320 * KiB;
constexpr size_t WS_GATES = 3 * MiB;
constexpr size_t WS_WQKV = 6 * MiB, WS_WO = 42 * MiB, WS_WIN = 46 * MiB, WS_WOUT = 70 * MiB, WS_WGU = 78 * MiB, WS_WD = 174 * MiB;
constexpr size_t WS_XB = 222 * MiB;
constexpr size_t WS_R = 350 * MiB;
constexpr size_t WS_QKV = WS_R, WS_O = WS_R + 576 * MiB;
constexpr size_t WS_PRE = WS_R, WS_YB = WS_R;
constexpr size_t WS_XG = WS_R + 256 * MiB, WS_H = WS_R + 528 * MiB;
constexpr size_t WS_Z = WS_R, WS_QKC = WS_R + 384 * MiB, WS_HC = WS_R + 512 * MiB, WS_Y = WS_QKC;
constexpr size_t WS_RM2 = 990 * MiB;
constexpr size_t WS_END = 992 * MiB;
static_assert(WS_ROWMAP + (size_t)MAXROWS * 4 <= WS_HIST && WS_H + (size_t)MAXROWS * DE * 2 <= WS_RM2 && WS_RM2 + (size_t)16 * ECAP * 4 <= WS_END && WS_XG + (size_t)MAXROWS * D * 2 <= WS_H, "ws map");
constexpr int CW_TMO = 0, CW_BAR = 4096, CW_CONVQ = 8192, CW_CUR = 12288;

constexpr int RING_BYTES = 131072, LDSCTL_OFF = RING_BYTES, LDS_BYTES = 147456;
constexpr int LC_HIST = 0, LC_BAR = 64;

#define GAS __attribute__((address_space(1)))
#define LAS __attribute__((address_space(3)))
typedef unsigned short bf16;
typedef unsigned u32x4 __attribute__((ext_vector_type(4)));
typedef unsigned u32x2 __attribute__((ext_vector_type(2)));
typedef float f32x4 __attribute__((ext_vector_type(4)));
typedef float f32x2 __attribute__((ext_vector_type(2)));
#define LDS_WAIT() asm volatile("s_waitcnt lgkmcnt(0)" ::: "memory")
__device__ __forceinline__ unsigned f2bf(float f) { unsigned u = __builtin_bit_cast(unsigned, f); return (u + 0x7fffu + ((u >> 16) & 1u)) >> 16; }
__device__ __forceinline__ unsigned pk2(float lo, float hi) { return pg8::cvt_pk_bf16(lo, hi); }
__device__ __forceinline__ float bflo(unsigned u) { return __builtin_bit_cast(float, u << 16); }
__device__ __forceinline__ float bfhi(unsigned u) { return __builtin_bit_cast(float, u & 0xffff0000u); }
__device__ __forceinline__ float bf1(bf16 b) { return __builtin_bit_cast(float, (unsigned)b << 16); }
template <int CTRL> __device__ __forceinline__ float dpp0(float x) { return __builtin_bit_cast(float, __builtin_amdgcn_update_dpp(0, __builtin_bit_cast(int, x), CTRL, 0xf, 0xf, true)); }
template <int CTRL> __device__ __forceinline__ float dppx(float x) { return __builtin_bit_cast(float, __builtin_amdgcn_mov_dpp(__builtin_bit_cast(int, x), CTRL, 0xf, 0xf, true)); }
template <int CTRL, int ROWMASK> __device__ __forceinline__ float dpps(float x) { return __builtin_bit_cast(float, __builtin_amdgcn_update_dpp(__builtin_bit_cast(int, x), __builtin_bit_cast(int, x), CTRL, ROWMASK, 0xf, false)); }
__device__ __forceinline__ float prefix_sum64(float v) {
    v += dpp0<0x111>(v); v += dpp0<0x112>(v); v += dpp0<0x114>(v); v += dpp0<0x118>(v);
    v += __builtin_bit_cast(float, __builtin_amdgcn_update_dpp(0, __builtin_bit_cast(int, v), 0x142, 0xa, 0xf, false));
    v += __builtin_bit_cast(float, __builtin_amdgcn_update_dpp(0, __builtin_bit_cast(int, v), 0x143, 0xc, 0xf, false));
    return v;
}
__device__ __forceinline__ float prefix_max64(float v) {
    v = fmaxf(v, dpps<0x111, 0xf>(v)); v = fmaxf(v, dpps<0x112, 0xf>(v)); v = fmaxf(v, dpps<0x114, 0xf>(v)); v = fmaxf(v, dpps<0x118, 0xf>(v));
    v = fmaxf(v, dpps<0x142, 0xa>(v)); v = fmaxf(v, dpps<0x143, 0xc>(v));
    return v;
}
__device__ __forceinline__ float lane_bcast(float v, int l) { return __builtin_bit_cast(float, __builtin_amdgcn_readlane(__builtin_bit_cast(int, v), l)); }
__device__ __forceinline__ float wave_sum(float v) { return lane_bcast(prefix_sum64(v), 63); }
__device__ __forceinline__ float row16_sum(float v) { v += dppx<0xB1>(v); v += dppx<0x4E>(v); v += dppx<0x141>(v); v += dppx<0x128>(v); return v; }
__device__ __forceinline__ float lane_xor1(float v) { return dppx<0xB1>(v); }
__device__ __forceinline__ float lane_xor32(float v) { auto r = __builtin_amdgcn_permlane32_swap(__builtin_bit_cast(unsigned, v), __builtin_bit_cast(unsigned, v), false, false);
    return __builtin_bit_cast(float, (threadIdx.x & 32) ? r[0] : r[1]); }

#define XB_TMO      128
#define XB_XCNT(j)  (256  + 64 * (j))
#define XB_XSUB(j)  (1280 + 64 * (j))
#define XB_XGEN(j)  (2304 + 64 * (j))
#define XB_TOP      3328
#define XB_TOPGEN   3392
#define XCD_BAR_WORDS 3456
#define XB_SPIN_CAP (1u << 18)
__device__ __forceinline__ unsigned xb_ld(unsigned* p)              { return __hip_atomic_load(p, __ATOMIC_RELAXED, __HIP_MEMORY_SCOPE_AGENT); }
__device__ __forceinline__ unsigned xb_add(unsigned* p, unsigned v) { return __hip_atomic_fetch_add(p, v, __ATOMIC_RELAXED, __HIP_MEMORY_SCOPE_AGENT); }
__device__ __forceinline__ unsigned xb_xcc_id() { return (unsigned)__builtin_amdgcn_s_getreg((3 << 11) | 20) & 0xFu; }
#define XB_SPIN(cond, bar) do { unsigned _sp = 0; while (cond) { __builtin_amdgcn_s_sleep(1); \
    if ((++_sp & 255u) == 0u) { if (xb_ld(&(bar)[XB_TMO])) break; if (_sp > XB_SPIN_CAP) { atomicAdd(&(bar)[XB_TMO], 1u); break; } } } } while (0)
struct XcdBarrier { unsigned* bar; unsigned x; volatile LAS unsigned* st; };
__device__ __forceinline__ XcdBarrier xcd_barrier_post(unsigned* bar, volatile LAS unsigned* st) {
    XcdBarrier b; b.bar = bar; b.x = xb_xcc_id(); b.st = st;
    if (threadIdx.x == 0) (void)xb_add(&bar[XB_XCNT(b.x)], 1u);
    return b;
}
__device__ __forceinline__ void xcd_barrier_complete(unsigned* bar, unsigned x, unsigned& nloc, unsigned& nx) {
    const unsigned G = gridDim.x * gridDim.y * gridDim.z;
    unsigned sum, cnt, mine, sp = 0u;
    for (;;) {
        sum = 0u; cnt = 0u; mine = 0u;
#pragma unroll
        for (unsigned j = 0; j < 16; ++j) { const unsigned c = xb_ld(&bar[XB_XCNT(j)]); sum += c; cnt += (c > 0u) ? 1u : 0u; mine = (j == x) ? c : mine; }
        if (sum == G) break;
        __builtin_amdgcn_s_sleep(1);
        if ((++sp & 255u) == 0u) { if (xb_ld(&bar[XB_TMO])) break; if (sp > XB_SPIN_CAP) { atomicAdd(&bar[XB_TMO], 1u); break; } }
    }
    nloc = mine > 0u ? mine : 1u; nx = cnt > 0u ? cnt : 1u;
}
__device__ __forceinline__ void xcd_barrier(const XcdBarrier& b) {
    asm volatile("s_waitcnt vmcnt(0)" ::: "memory");
    __syncthreads();
    if (threadIdx.x == 0) {
        unsigned* bar = b.bar;
        __builtin_amdgcn_s_waitcnt(0);
        unsigned nloc = b.st[0], nx = b.st[1];
        if (nloc == 0u) { xcd_barrier_complete(bar, b.x, nloc, nx); b.st[0] = nloc; b.st[1] = nx; }
        const unsigned old = xb_add(&bar[XB_XSUB(b.x)], 1u);
        const unsigned gen = old / nloc;
        if (old + 1u == (gen + 1u) * nloc) {
            __builtin_amdgcn_fence(__ATOMIC_RELEASE, "agent");
            asm volatile("s_waitcnt vmcnt(0)" ::: "memory");
            const unsigned og = xb_add(&bar[XB_TOP], 1u);
            const unsigned tg = og / nx;
            if (og + 1u == (tg + 1u) * nx) xb_add(&bar[XB_TOPGEN], 1u);
            else XB_SPIN(xb_ld(&bar[XB_TOPGEN]) == tg, bar);
            __builtin_amdgcn_fence(__ATOMIC_ACQUIRE, "agent");
            xb_add(&bar[XB_XGEN(b.x)], 1u);
            asm volatile("s_waitcnt vmcnt(0)" ::: "memory");
        } else {
            XB_SPIN(xb_ld(&bar[XB_XGEN(b.x)]) == gen, bar);
            __builtin_amdgcn_fence(__ATOMIC_ACQUIRE, "agent");
            asm volatile("s_waitcnt vmcnt(0)" ::: "memory");
        }
    }
    __syncthreads();
}

struct Ctx { LAS unsigned char* lds; int tid, lane, wave, G, bid, gw, ngw, gtid, ngt; };

struct TrDesc { const float* wp; bf16* dst; int ldw, K, row_mul; };
__device__ __forceinline__ void tr_mk(TrDesc& d, const float* W, int ldw, int K, bf16* WT, int row_off, int row_mul, int kb, int nb, int lane) {
    const int k0 = 64 * kb, n0 = 32 * nb; d.wp = W + (size_t)(k0 + (lane >> 5)) * ldw + n0 + (lane & 31); d.dst = WT + (size_t)(row_off + n0 * row_mul) * K + k0; d.ldw = ldw; d.K = K; d.row_mul = row_mul; }
__device__ __forceinline__ void tr_load(const TrDesc& d, float (&tv)[32]) {
#pragma unroll
    for (int i = 0; i < 32; ++i) tv[i] = d.wp[(size_t)(2 * i) * d.ldw]; }
__device__ __forceinline__ void tr_store(const TrDesc& d, const float (&tv)[32], LAS float* scr, int lane) {
#pragma unroll
    for (int i = 0; i < 32; ++i) scr[(2 * i + (lane >> 5)) * 33 + (lane & 31)] = tv[i];
    LDS_WAIT(); asm volatile("" ::: "memory");
    const int c = lane & 7;
#pragma unroll
    for (int j = 0; j < 4; ++j) { const int n = (lane >> 3) + 8 * j; const LAS float* s_ = scr + (8 * c) * 33 + n;
        u32x4 o; o.x = pk2(s_[0 * 33], s_[1 * 33]); o.y = pk2(s_[2 * 33], s_[3 * 33]); o.z = pk2(s_[4 * 33], s_[5 * 33]); o.w = pk2(s_[6 * 33], s_[7 * 33]);
        *(u32x4*)(d.dst + (size_t)(n * d.row_mul) * d.K + 8 * c) = o; }
    LDS_WAIT(); asm volatile("" ::: "memory");
}
#define TR_PIPELINE(first_, stride_, end_, MK_) do { LAS float* scr_ = (LAS float*)(c.lds + c.wave * 16384); TrDesc cur_, nxt_; float ta_[32], tb_[32]; int it_ = (first_); \
        if (it_ < (end_)) { MK_(cur_, it_); tr_load(cur_, ta_); } \
        for (; it_ < (end_); it_ += (stride_)) { const int itn_ = it_ + (stride_); const bool hn_ = itn_ < (end_); if (hn_) { MK_(nxt_, itn_); tr_load(nxt_, tb_); } \
            tr_store(cur_, ta_, scr_, c.lane); if (hn_) { cur_ = nxt_; _Pragma("unroll") for (int q_ = 0; q_ < 32; ++q_) ta_[q_] = tb_[q_]; } } } while (0)
__device__ __forceinline__ void conv_job(const Ctx& c, const float* W, int ldw, int K, int N, bf16* WT, int gw0, int ngw0) {
    const int nblk = N / 32, items = (K / 64) * nblk;
#define MK_JOB(d_, it2_) tr_mk(d_, W, ldw, K, WT, 0, 1, (it2_) / nblk, (it2_) % nblk, c.lane)
    TR_PIPELINE(gw0, ngw0, items, MK_JOB);
#undef MK_JOB
}
constexpr int CONV_MOE_ITEMS = 3 * NE * 768;
__device__ __forceinline__ void conv_moe_mk(TrDesc& d, int it, const float* Wg, const float* Wu, const float* Wd, bf16* WGU, bf16* WD, int lane) {
    constexpr int PER = 768; const int kind = it / (NE * PER), r = it % (NE * PER), e = r / PER, q = r % PER;
    if (kind < 2) tr_mk(d, (kind == 0 ? Wg : Wu) + (size_t)e * D * DE, DE, D, WGU + (size_t)e * GU_N * D, kind, 2, q / 24, q % 24, lane);
    else tr_mk(d, Wd + (size_t)e * DE * D, D, DE, WD + (size_t)e * D * DE, 0, 1, q / 64, q % 64, lane);
}
__device__ __forceinline__ void conv_moe(const Ctx& c, const float* Wg, const float* Wu, const float* Wd, bf16* WGU, bf16* WD, int gw0, int ngw0, int end = CONV_MOE_ITEMS, int start = 0) {
#define MK_MOE(d_, it2_) conv_moe_mk(d_, it2_, Wg, Wu, Wd, WGU, WD, c.lane)
    TR_PIPELINE(start + gw0, ngw0, end, MK_MOE);
#undef MK_MOE
}
__device__ __forceinline__ void x_to_bf16(const Ctx& c, const float* x, bf16* XB) {
    for (size_t i = c.gtid; i < (size_t)T * D / 8; i += c.ngt) { const f32x4 a = ((const f32x4*)x)[2 * i], b = ((const f32x4*)x)[2 * i + 1];
        u32x4 o; o.x = pk2(a.x, a.y); o.y = pk2(a.z, a.w); o.z = pk2(b.x, b.y); o.w = pk2(b.z, b.w); ((u32x4*)XB)[i] = o; }
}
__device__ __forceinline__ void rope_table(const Ctx& c, f32x2* tab) {
    for (int i = c.gtid; i < SEQ * 16; i += c.ngt) { const int pos = i >> 4, j = i & 15;
        const float inv = powf(500000.0f, -(float)j / 16.0f); const float ang = (float)pos * inv;
        tab[i] = (f32x2){cosf(ang), sinf(ang)}; }
}

__device__ __forceinline__ void rope_pass(const Ctx& c, bf16* QKV, const f32x2* tab) {
    for (int idx = c.gtid; idx < T * 48; idx += c.ngt) {
        const int h = idx & 7, s = (idx >> 3) & 1, g = (idx >> 4) % 3, tok = idx / 48, pos = tok & (SEQ - 1);
        u32x4* p = (u32x4*)(QKV + (size_t)tok * QKV_N + g * 3072 + s * 1024 + h * HD);
        u32x4 a0 = p[0], a1 = p[1], b0 = p[2], b1 = p[3];
        const f32x2* tb = tab + pos * 16;
        unsigned x1[8] = {a0.x, a0.y, a0.z, a0.w, a1.x, a1.y, a1.z, a1.w}, x2[8] = {b0.x, b0.y, b0.z, b0.w, b1.x, b1.y, b1.z, b1.w};
        unsigned o1[8], o2[8];
#pragma unroll
        for (int k = 0; k < 8; ++k) { const f32x2 cs0 = tb[2 * k], cs1 = tb[2 * k + 1];
            const float u0 = bflo(x1[k]), u1 = bfhi(x1[k]), v0 = bflo(x2[k]), v1 = bfhi(x2[k]);
            o1[k] = pk2(u0 * cs0.x - v0 * cs0.y, u1 * cs1.x - v1 * cs1.y);
            o2[k] = pk2(v0 * cs0.x + u0 * cs0.y, v1 * cs1.x + u1 * cs1.y); }
        p[0] = (u32x4){o1[0], o1[1], o1[2], o1[3]}; p[1] = (u32x4){o1[4], o1[5], o1[6], o1[7]};
        p[2] = (u32x4){o2[0], o2[1], o2[2], o2[3]}; p[3] = (u32x4){o2[4], o2[5], o2[6], o2[7]};
    }
}

__device__ __forceinline__ void attn_naive(const Ctx& c, const bf16* QKV, bf16* O) {
    const int sub = c.gtid & 3;
    for (int q = c.gtid >> 2; q < T * NH; q += c.ngt >> 2) {
        const int tok = q >> 3, h = q & 7, b = tok >> 11, t = tok & (SEQ - 1);
        float m = -1e30f, l = 0.f; float o[32];
#pragma unroll
        for (int i = 0; i < 32; ++i) o[i] = 0.f;
        for (int g = 0; g < 3; ++g) {
            const int dil = g == 0 ? 1 : (g == 1 ? 4 : 16);
            const u32x4* qp = (const u32x4*)(QKV + (size_t)tok * QKV_N + g * 3072 + h * HD + sub * 32);
            float qf[32];
#pragma unroll
            for (int i = 0; i < 4; ++i) { const u32x4 w = qp[i]; qf[8 * i + 0] = bflo(w.x); qf[8 * i + 1] = bfhi(w.x); qf[8 * i + 2] = bflo(w.y); qf[8 * i + 3] = bfhi(w.y);
                qf[8 * i + 4] = bflo(w.z); qf[8 * i + 5] = bfhi(w.z); qf[8 * i + 6] = bflo(w.w); qf[8 * i + 7] = bfhi(w.w); }
            for (int i = 0; i <= 128; ++i) {
                const int pos = t - dil * i; const bool valid = pos >= 0; const int pc = valid ? pos : t;
                const bf16* rowp = QKV + (size_t)(b * SEQ + pc) * QKV_N + g * 3072 + h * HD + sub * 32;
                const u32x4* kp = (const u32x4*)(rowp + 1024); const u32x4* vp = (const u32x4*)(rowp + 2048);
                float dot = 0.f;
#pragma unroll
                for (int j = 0; j < 4; ++j) { const u32x4 w = kp[j];
                    dot += qf[8 * j + 0] * bflo(w.x) + qf[8 * j + 1] * bfhi(w.x) + qf[8 * j + 2] * bflo(w.y) + qf[8 * j + 3] * bfhi(w.y)
                         + qf[8 * j + 4] * bflo(w.z) + qf[8 * j + 5] * bfhi(w.z) + qf[8 * j + 6] * bflo(w.w) + qf[8 * j + 7] * bfhi(w.w); }
                dot += __shfl_xor(dot, 1); dot += __shfl_xor(dot, 2);
                float s = dot * 0.08838834764831845f; if (!valid) s = -__builtin_inff();
                const float mn = fmaxf(m, s), al = __expf(m - mn), p = __expf(s - mn);
                l = l * al + p; m = mn;
#pragma unroll
                for (int j = 0; j < 4; ++j) { const u32x4 w = vp[j];
                    o[8 * j + 0] = o[8 * j + 0] * al + p * bflo(w.x); o[8 * j + 1] = o[8 * j + 1] * al + p * bfhi(w.x);
                    o[8 * j + 2] = o[8 * j + 2] * al + p * bflo(w.y); o[8 * j + 3] = o[8 * j + 3] * al + p * bfhi(w.y);
                    o[8 * j + 4] = o[8 * j + 4] * al + p * bflo(w.z); o[8 * j + 5] = o[8 * j + 5] * al + p * bfhi(w.z);
                    o[8 * j + 6] = o[8 * j + 6] * al + p * bflo(w.w); o[8 * j + 7] = o[8 * j + 7] * al + p * bfhi(w.w); }
            }
        }
        const float rl = 1.f / l;
        u32x4* op = (u32x4*)(O + (size_t)tok * OD + h * HD + sub * 32);
#pragma unroll
        for (int j = 0; j < 4; ++j) op[j] = (u32x4){pk2(o[8 * j] * rl, o[8 * j + 1] * rl), pk2(o[8 * j + 2] * rl, o[8 * j + 3] * rl), pk2(o[8 * j + 4] * rl, o[8 * j + 5] * rl), pk2(o[8 * j + 6] * rl, o[8 * j + 7] * rl)};
    }
}

template <int SRC, bool FINAL>
__device__ __forceinline__ void ln_row(const Ctx& c, int row, f32x4 (&v)[8], const bf16* PRE, float* OUT, const bf16* YB, bf16* XB, const float* lng, const float* lnb, const float* EG) {
    if (SRC == 0) { const u32x2* p = (const u32x2*)(PRE + (size_t)row * D) + c.lane;
#pragma unroll
        for (int j = 0; j < 8; ++j) { const u32x2 a = p[64 * j]; v[j] = (f32x4){bflo(a.x), bfhi(a.x), bflo(a.y), bfhi(a.y)}; } }
    else { const u32x2* p = (const u32x2*)(XB + (size_t)row * D) + c.lane; const unsigned* y0 = (const unsigned*)((const unsigned char*)YB + (size_t)(2 * row) * D) + c.lane; const unsigned* y1 = y0 + D / 4;
        const float g0 = EG[2 * row] * 0.0625f, g1 = EG[2 * row + 1] * 0.0625f;
#pragma unroll
        for (int j = 0; j < 8; ++j) { const u32x2 xf = p[64 * j]; const int a = (int)y0[64 * j], b = (int)y1[64 * j];
            v[j] = (f32x4){ALPHA * bflo(xf.x) + g0 * __builtin_amdgcn_cvt_f32_fp8(a, 0) + g1 * __builtin_amdgcn_cvt_f32_fp8(b, 0), ALPHA * bfhi(xf.x) + g0 * __builtin_amdgcn_cvt_f32_fp8(a, 1) + g1 * __builtin_amdgcn_cvt_f32_fp8(b, 1),
                           ALPHA * bflo(xf.y) + g0 * __builtin_amdgcn_cvt_f32_fp8(a, 2) + g1 * __builtin_amdgcn_cvt_f32_fp8(b, 2), ALPHA * bfhi(xf.y) + g0 * __builtin_amdgcn_cvt_f32_fp8(a, 3) + g1 * __builtin_amdgcn_cvt_f32_fp8(b, 3)}; } }
    float s = 0.f;
#pragma unroll
    for (int j = 0; j < 8; ++j) s += (v[j].x + v[j].y) + (v[j].z + v[j].w);
    const float mean = wave_sum(s) * (1.f / D); float s2 = 0.f;
#pragma unroll
    for (int j = 0; j < 8; ++j) { v[j] = v[j] - mean; s2 += (v[j].x * v[j].x + v[j].y * v[j].y) + (v[j].z * v[j].z + v[j].w * v[j].w); }
    const float rstd = 1.f / sqrtf(wave_sum(s2) * (1.f / D) + LN_EPS);
    f32x4* xo = (f32x4*)(OUT + (size_t)row * D) + c.lane; u32x2* bo = (u32x2*)(XB + (size_t)row * D) + c.lane;
#pragma unroll
    for (int j = 0; j < 8; ++j) { const f32x4 g = ((const f32x4*)lng)[64 * j + c.lane], b = ((const f32x4*)lnb)[64 * j + c.lane];
        v[j] = v[j] * rstd * g + b; if (FINAL) xo[64 * j] = v[j]; else bo[64 * j] = (u32x2){pk2(v[j].x, v[j].y), pk2(v[j].z, v[j].w)}; }
}
__device__ __forceinline__ float lane_xor16(float v) { auto r = __builtin_amdgcn_permlane16_swap(__builtin_bit_cast(unsigned, v), __builtin_bit_cast(unsigned, v), false, false);
    return __builtin_bit_cast(float, (threadIdx.x & 16) ? r[0] : r[1]); }
__device__ __forceinline__ float reduce16(float (&d)[16], int lane) {
    float a8[8], a4[4], a2[2];
    { const bool up = lane & 32;
#pragma unroll
      for (int e = 0; e < 8; ++e) { const float keep = up ? d[e + 8] : d[e], send = up ? d[e] : d[e + 8]; a8[e] = keep + lane_xor32(send); } }
    { const bool up = lane & 16;
#pragma unroll
      for (int e = 0; e < 4; ++e) { const float keep = up ? a8[e + 4] : a8[e], send = up ? a8[e] : a8[e + 4]; a4[e] = keep + lane_xor16(send); } }
    { const bool up = lane & 8;
#pragma unroll
      for (int e = 0; e < 2; ++e) { const float keep = up ? a4[e + 2] : a4[e], send = up ? a4[e] : a4[e + 2]; a2[e] = keep + dppx<0x128>(send); } }
    float a1; { const bool up = lane & 4; const float keep = up ? a2[1] : a2[0], send = up ? a2[0] : a2[1]; a1 = keep + dppx<0x141>(send); }
    a1 += dppx<0x4E>(a1); a1 += dppx<0xB1>(a1);
    return a1;
}
template <int SRC, int EXTRA, bool FINAL>
__device__ __forceinline__ void ln_pass(const Ctx& c, const bf16* PRE, float* OUT, const bf16* YB, bf16* XB, const float* lng, const float* lnb,
                                        const float* wsrc, int wld, int woff, const float* wbias, int* rowmap2, float* egate, unsigned* cursor, float* gates_out) {
    LAS char* wl = (LAS char*)c.lds;
    LAS int* lh = (LAS int*)(c.lds + LDSCTL_OFF + LC_HIST);
    LAS float* lg = (LAS float*)(c.lds + LDSCTL_OFF + 5120) + c.wave * 256;
    if (EXTRA) {
#pragma unroll 1
        for (int it = 0; it < 4; ++it) { float wv[16];
#pragma unroll
            for (int q = 0; q < 16; ++q) { const int idx = c.tid + NTHR * (16 * it + q); wv[q] = wsrc[(size_t)(idx >> 4) * wld + woff + (idx & 15)]; }
#pragma unroll
            for (int q = 0; q < 16; ++q) { const int idx = c.tid + NTHR * (16 * it + q), k = idx >> 4, e = idx & 15;
                const unsigned hb = f2bf(wv[q]); const float hf = __builtin_bit_cast(float, hb << 16); const unsigned lb = f2bf(wv[q] - hf);
                const int off = e * 4096 + ((((k >> 3) ^ e) & 255) << 4) + (k & 7) * 2;
                *(LAS unsigned short*)(wl + off) = (unsigned short)hb; *(LAS unsigned short*)(wl + 65536 + off) = (unsigned short)lb; } } }
    const int l15 = c.lane & 15, q4 = c.lane >> 4;
    for (int vb = c.bid; vb < 256; vb += c.G) {
        if (EXTRA == 1) { if (c.tid < 16) lh[c.tid] = 0; }
        __syncthreads();
        const int rowb = vb * 128 + c.wave * 16;
        int rt_e1 = 0, rt_e2 = 0, rt_r1 = 0, rt_r2 = 0;
        if (SRC == 0 && !FINAL) {
            f32x4 gv[8], bv[8];
#pragma unroll
            for (int j = 0; j < 8; ++j) { gv[j] = ((const f32x4*)lng)[64 * j + c.lane]; bv[j] = ((const f32x4*)lnb)[64 * j + c.lane]; }
            u32x2 ra[2][8], rn[2][8];
#pragma unroll
            for (int q = 0; q < 2; ++q) { const u32x2* p = (const u32x2*)(PRE + (size_t)(rowb + q) * D) + c.lane;
#pragma unroll
                for (int j = 0; j < 8; ++j) ra[q][j] = p[64 * j]; }
            for (int i = 0; i < 8; ++i) {
                if (i < 7) {
#pragma unroll
                    for (int q = 0; q < 2; ++q) { const u32x2* p = (const u32x2*)(PRE + (size_t)(rowb + 2 * i + 2 + q) * D) + c.lane;
#pragma unroll
                        for (int j = 0; j < 8; ++j) rn[q][j] = p[64 * j]; } }
#pragma unroll
                for (int q = 0; q < 2; ++q) { const int row = rowb + 2 * i + q; f32x4 v[8]; float s_ = 0.f;
#pragma unroll
                    for (int j = 0; j < 8; ++j) { const u32x2 a = ra[q][j]; v[j] = (f32x4){bflo(a.x), bfhi(a.x), bflo(a.y), bfhi(a.y)}; s_ += (v[j].x + v[j].y) + (v[j].z + v[j].w); }
                    const float mean = wave_sum(s_) * (1.f / D); float s2 = 0.f;
#pragma unroll
                    for (int j = 0; j < 8; ++j) { v[j] = v[j] - mean; s2 += (v[j].x * v[j].x + v[j].y * v[j].y) + (v[j].z * v[j].z + v[j].w * v[j].w); }
                    const float rstd = 1.f / sqrtf(wave_sum(s2) * (1.f / D) + LN_EPS);
                    u32x2* bo = (u32x2*)(XB + (size_t)row * D) + c.lane;
#pragma unroll
                    for (int j = 0; j < 8; ++j) { const f32x4 y = v[j] * rstd * gv[j] + bv[j]; bo[64 * j] = (u32x2){pk2(y.x, y.y), pk2(y.z, y.w)}; } }
#pragma unroll
                for (int q = 0; q < 2; ++q)
#pragma unroll
                    for (int j = 0; j < 8; ++j) ra[q][j] = rn[q][j];
            }
        } else if (SRC == 1) {
            f32x4 gv[8], bv[8];
#pragma unroll
            for (int j = 0; j < 8; ++j) { gv[j] = ((const f32x4*)lng)[64 * j + c.lane]; bv[j] = ((const f32x4*)lnb)[64 * j + c.lane]; }
            u32x2 rx[3][8]; unsigned ry0[3][8], ry1[3][8]; float rg0[3], rg1[3];
#define LN_LOAD1(slot_, row_) do { const u32x2* p_ = (const u32x2*)(XB + (size_t)(row_) * D) + c.lane; const unsigned* y0_ = (const unsigned*)((const unsigned char*)YB + (size_t)(2 * (row_)) * D) + c.lane; const unsigned* y1_ = y0_ + D / 4; \
                rg0[slot_] = egate[2 * (row_)] * 0.0625f; rg1[slot_] = egate[2 * (row_) + 1] * 0.0625f; \
                _Pragma("unroll") for (int j = 0; j < 8; ++j) { rx[slot_][j] = p_[64 * j]; ry0[slot_][j] = y0_[64 * j]; ry1[slot_][j] = y1_[64 * j]; } } while (0)
            LN_LOAD1(0, rowb); LN_LOAD1(1, rowb + 1); LN_LOAD1(2, rowb + 2);
            for (int i = 0; i < 16; ++i) { const int row = rowb + i; f32x4 v[8]; float s_ = 0.f; const float g0 = rg0[0], g1 = rg1[0];
#pragma unroll
                for (int j = 0; j < 8; ++j) { const u32x2 xf = rx[0][j]; const int a = (int)ry0[0][j], b = (int)ry1[0][j];
                    v[j] = (f32x4){ALPHA * bflo(xf.x) + g0 * __builtin_amdgcn_cvt_f32_fp8(a, 0) + g1 * __builtin_amdgcn_cvt_f32_fp8(b, 0), ALPHA * bfhi(xf.x) + g0 * __builtin_amdgcn_cvt_f32_fp8(a, 1) + g1 * __builtin_amdgcn_cvt_f32_fp8(b, 1),
                                   ALPHA * bflo(xf.y) + g0 * __builtin_amdgcn_cvt_f32_fp8(a, 2) + g1 * __builtin_amdgcn_cvt_f32_fp8(b, 2), ALPHA * bfhi(xf.y) + g0 * __builtin_amdgcn_cvt_f32_fp8(a, 3) + g1 * __builtin_amdgcn_cvt_f32_fp8(b, 3)};
                    s_ += (v[j].x + v[j].y) + (v[j].z + v[j].w); }
#pragma unroll
                for (int j = 0; j < 8; ++j) { rx[0][j] = rx[1][j]; ry0[0][j] = ry0[1][j]; ry1[0][j] = ry1[1][j]; rx[1][j] = rx[2][j]; ry0[1][j] = ry0[2][j]; ry1[1][j] = ry1[2][j]; }
                rg0[0] = rg0[1]; rg1[0] = rg1[1]; rg0[1] = rg0[2]; rg1[1] = rg1[2];
                if (i + 3 < 16) LN_LOAD1(2, rowb + i + 3);
                const float mean = wave_sum(s_) * (1.f / D); float s2 = 0.f;
#pragma unroll
                for (int j = 0; j < 8; ++j) { v[j] = v[j] - mean; s2 += (v[j].x * v[j].x + v[j].y * v[j].y) + (v[j].z * v[j].z + v[j].w * v[j].w); }
                const float rstd = 1.f / sqrtf(wave_sum(s2) * (1.f / D) + LN_EPS);
                f32x4* xo = (f32x4*)(OUT + (size_t)row * D) + c.lane; u32x2* bo = (u32x2*)(XB + (size_t)row * D) + c.lane;
#pragma unroll
                for (int j = 0; j < 8; ++j) { const f32x4 y = v[j] * rstd * gv[j] + bv[j]; if (FINAL) xo[64 * j] = y; else bo[64 * j] = (u32x2){pk2(y.x, y.y), pk2(y.z, y.w)}; } }
#undef LN_LOAD1
        } else
        for (int i = 0; i < 8; ++i) { f32x4 va[8], vc[8];
            ln_row<SRC, FINAL>(c, rowb + 2 * i, va, PRE, OUT, YB, XB, lng, lnb, egate);
            ln_row<SRC, FINAL>(c, rowb + 2 * i + 1, vc, PRE, OUT, YB, XB, lng, lnb, egate); }
        if (EXTRA) {
            asm volatile("s_waitcnt vmcnt(0)" ::: "memory");
            __builtin_amdgcn_fence(__ATOMIC_ACQUIRE, "agent");
            pg8::f32x4 acc = {0.f, 0.f, 0.f, 0.f};
            const bf16* arow = XB + (size_t)(rowb + l15) * D + 8 * q4; const LAS char* wrow = wl + l15 * 4096;
#pragma unroll 16
            for (int kk = 0; kk < 64; ++kk) { const pg8::bf16x8 a = *(const pg8::bf16x8*)(arow + 32 * kk);
                const int ch = (((4 * kk + q4) ^ l15) & 255) << 4;
                const pg8::bf16x8 bh = *(const LAS pg8::bf16x8*)(wrow + ch), bl = *(const LAS pg8::bf16x8*)(wrow + 65536 + ch);
                acc = __builtin_amdgcn_mfma_f32_16x16x32_bf16(a, bh, acc, 0, 0, 0); acc = __builtin_amdgcn_mfma_f32_16x16x32_bf16(a, bl, acc, 0, 0, 0); }
            const float bias = wbias[l15];
            if (EXTRA == 2) {
#pragma unroll
                for (int r = 0; r < 4; ++r) { float val = acc[r] + bias; if (l15 >= 8) val = fminf(val, 0.f) - log1pf(expf(-fabsf(val))); gates_out[(size_t)(rowb + 4 * q4 + r) * 16 + l15] = val; }
            } else {
#pragma unroll
                for (int r = 0; r < 4; ++r) lg[(4 * q4 + r) * 16 + l15] = acc[r] + bias;
                LDS_WAIT(); asm volatile("" ::: "memory");
                if (c.lane < 16) { const int row = rowb + c.lane; float dot[16];
#pragma unroll
                    for (int q = 0; q < 4; ++q) { const f32x4 t = *(const LAS f32x4*)(lg + 16 * c.lane + 4 * q); dot[4 * q] = t.x; dot[4 * q + 1] = t.y; dot[4 * q + 2] = t.z; dot[4 * q + 3] = t.w; }
                    float mx = dot[0];
#pragma unroll
                    for (int e = 1; e < 16; ++e) mx = fmaxf(mx, dot[e]);
                    float p[16];
#pragma unroll
                    for (int e = 0; e < 16; ++e) p[e] = __expf(dot[e] - mx);
                    float bestsc = -1.f, bp1 = 0.f, bp2 = 0.f; int be1 = 0, be2 = 0;
#pragma unroll
                    for (int g = 0; g < 4; ++g) { const float a0 = p[4 * g], a1 = p[4 * g + 1], a2 = p[4 * g + 2], a3 = p[4 * g + 3];
                        int i1 = 0; float p1 = a0; if (a1 > p1) { p1 = a1; i1 = 1; } if (a2 > p1) { p1 = a2; i1 = 2; } if (a3 > p1) { p1 = a3; i1 = 3; }
                        int i2 = 0; float p2 = -1.f;
                        if (i1 != 0 && a0 > p2) { p2 = a0; i2 = 0; } if (i1 != 1 && a1 > p2) { p2 = a1; i2 = 1; } if (i1 != 2 && a2 > p2) { p2 = a2; i2 = 2; } if (i1 != 3 && a3 > p2) { p2 = a3; i2 = 3; }
                        const float sc = p1 + p2; if (sc > bestsc) { bestsc = sc; be1 = 4 * g + i1; be2 = 4 * g + i2; bp1 = p1; bp2 = p2; } }
                    const float inv = 1.f / (bp1 + bp2); egate[2 * row] = bp1 * inv; egate[2 * row + 1] = bp2 * inv; rt_e1 = be1; rt_e2 = be2;
                    rt_r1 = __hip_atomic_fetch_add(lh + be1, 1, __ATOMIC_RELAXED, __HIP_MEMORY_SCOPE_WORKGROUP); rt_r2 = __hip_atomic_fetch_add(lh + be2, 1, __ATOMIC_RELAXED, __HIP_MEMORY_SCOPE_WORKGROUP); }
            }
        }
        __syncthreads();
        if (EXTRA == 1) {
            LAS int* lbase = (LAS int*)(c.lds + LDSCTL_OFF + 13312);
            if (c.tid < 16) lbase[c.tid] = (int)__hip_atomic_fetch_add(cursor + c.tid, (unsigned)lh[c.tid], __ATOMIC_RELAXED, __HIP_MEMORY_SCOPE_AGENT);
            __syncthreads();
            if (c.lane < 16) { const int row = rowb + c.lane; rowmap2[rt_e1 * ECAP + lbase[rt_e1] + rt_r1] = 2 * row; rowmap2[rt_e2 * ECAP + lbase[rt_e2] + rt_r2] = 2 * row + 1; }
        }
    }
}

__device__ __forceinline__ void gather_rows(const Ctx& c, const bf16* XB, const int* rowmap, const int* tile_e, bf16* XG) {
    const int nrows = tile_e[MAXTILES] * 256;
    for (int r = c.gw; r < nrows; r += c.ngw) { const int a = rowmap[r]; u32x4* dst = (u32x4*)(XG + (size_t)r * D) + c.lane;
        if (a >= 0) { const u32x4* src = (const u32x4*)(XB + (size_t)(a >> 1) * D) + c.lane;
#pragma unroll
            for (int j = 0; j < 4; ++j) dst[64 * j] = src[64 * j]; }
        else {
#pragma unroll
            for (int j = 0; j < 4; ++j) dst[64 * j] = (u32x4){0u, 0u, 0u, 0u}; } }
}

__device__ __forceinline__ void fp8x8_to_f32(u32x2 w, float (&o)[8]) { const int a = (int)w.x, b = (int)w.y;
    o[0] = __builtin_amdgcn_cvt_f32_fp8(a, 0) * 0.0625f; o[1] = __builtin_amdgcn_cvt_f32_fp8(a, 1) * 0.0625f; o[2] = __builtin_amdgcn_cvt_f32_fp8(a, 2) * 0.0625f; o[3] = __builtin_amdgcn_cvt_f32_fp8(a, 3) * 0.0625f;
    o[4] = __builtin_amdgcn_cvt_f32_fp8(b, 0) * 0.0625f; o[5] = __builtin_amdgcn_cvt_f32_fp8(b, 1) * 0.0625f; o[6] = __builtin_amdgcn_cvt_f32_fp8(b, 2) * 0.0625f; o[7] = __builtin_amdgcn_cvt_f32_fp8(b, 3) * 0.0625f; }

constexpr int CONV_ROWS = 16;
__device__ __forceinline__ void conv_pass(const Ctx& c, const unsigned char* Z, const float* cw, const float* cb, bf16* QKC) {
    constexpr int NITEMS = (T / CONV_ROWS) * 256;
    const int c0 = (c.gtid & 255) * 8;
    float w[4][8], bias[8];
#pragma unroll
    for (int j = 0; j < 4; ++j) { const f32x4 w0 = *(const f32x4*)(cw + j * 2048 + c0), w1 = *(const f32x4*)(cw + j * 2048 + c0 + 4); w[j][0] = w0.x; w[j][1] = w0.y; w[j][2] = w0.z; w[j][3] = w0.w; w[j][4] = w1.x; w[j][5] = w1.y; w[j][6] = w1.z; w[j][7] = w1.w; }
    { const f32x4 b0 = *(const f32x4*)(cb + c0), b1 = *(const f32x4*)(cb + c0 + 4); bias[0] = b0.x; bias[1] = b0.y; bias[2] = b0.z; bias[3] = b0.w; bias[4] = b1.x; bias[5] = b1.y; bias[6] = b1.z; bias[7] = b1.w; }
    const float sc = c0 >= 1024 ? 0.08838834764831845f : 1.f;
    u32x2 zr[CONV_ROWS + 3], zn[CONV_ROWS + 3];
#define CONV_LOAD(ZR, idx_) do { const int tok0_ = ((idx_) >> 8) * CONV_ROWS, t0_ = tok0_ & (SEQ - 1); _Pragma("unroll") for (int r = 0; r < CONV_ROWS + 3; ++r) { const int tt = t0_ - 3 + r; ZR[r] = tt >= 0 ? *(const u32x2*)(Z + (size_t)(tok0_ - 3 + r) * ZN + c0) : (u32x2){0u, 0u}; } } while (0)
    if (c.gtid < NITEMS) CONV_LOAD(zr, c.gtid);
    for (int idx = c.gtid; idx < NITEMS; idx += c.ngt) { const int tok0 = (idx >> 8) * CONV_ROWS;
        if (idx + c.ngt < NITEMS) CONV_LOAD(zn, idx + c.ngt);
#pragma unroll
        for (int r = 0; r < CONV_ROWS; ++r) { float acc[8];
#pragma unroll
            for (int k = 0; k < 8; ++k) acc[k] = bias[k];
#pragma unroll
            for (int j = 0; j < 4; ++j) { float zf[8]; fp8x8_to_f32(zr[r + j], zf);
#pragma unroll
                for (int k = 0; k < 8; ++k) acc[k] += zf[k] * w[j][k]; }
#pragma unroll
            for (int k = 0; k < 8; ++k) acc[k] = acc[k] / (1.f + __expf(-acc[k])) * sc;
            *(u32x4*)(QKC + (size_t)(tok0 + r) * 2048 + c0) = (u32x4){pk2(acc[0], acc[1]), pk2(acc[2], acc[3]), pk2(acc[4], acc[5]), pk2(acc[6], acc[7])}; }
#pragma unroll
        for (int r = 0; r < CONV_ROWS + 3; ++r) zr[r] = zn[r];
    }
#undef CONV_LOAD
}
__device__ __forceinline__ void mlstm_naive(const Ctx& c, const bf16* QKC, const bf16* Z, const float* GATES, bf16* HC) {
    LAS float* Qs = (LAS float*)c.lds; LAS float* Ks = Qs + 2048; LAS float* Vs = Ks + 2048; LAS float* LI = Vs + 2048; LAS float* LF = LI + 16; LAS float* DEN = LF + 16; LAS float* MEX = DEN + 16; LAS float* NUM = MEX + 16;
    const bool colthr = c.tid < 128, nthr = (c.wave == 2);
    for (int u = c.bid; u < 256; u += c.G) {
        const int b = u >> 4, h = (u >> 1) & 7, vh = u & 1;
        float C[128];
#pragma unroll
        for (int d = 0; d < 128; ++d) C[d] = 0.f;
        float m = -1e30f;
        for (int grp = 0; grp < 128; ++grp) {
            const int tok0 = b * SEQ + grp * 16;
#pragma unroll
            for (int k = 0; k < 12; ++k) { const int e = c.tid + NTHR * k, which = e >> 11, r = e & 2047, s = r >> 7, d = r & 127;
                const bf16* src = which == 0 ? QKC + (size_t)(tok0 + s) * 2048 + h * 128 + d : (which == 1 ? QKC + (size_t)(tok0 + s) * 2048 + 1024 + h * 128 + d : Z + (size_t)(tok0 + s) * ZN + 2048 + h * 256 + vh * 128 + d);
                Qs[e] = bf1(*src); }
            if (c.tid < 16) { LI[c.tid] = GATES[(size_t)(tok0 + c.tid) * 16 + h]; LF[c.tid] = GATES[(size_t)(tok0 + c.tid) * 16 + 8 + h]; }
            __syncthreads();
            if (colthr || nthr) {
                for (int s = 0; s < 16; ++s) {
                    const float lf = LF[s], li = LI[s], mn = fmaxf(lf + m, li), fd = __expf(lf + m - mn), iw = __expf(li - mn); m = mn;
                    const float vv = nthr ? 1.f : Vs[s * 128 + (c.tid & 127)]; const float kv = iw * vv; float acc = 0.f;
#pragma unroll
                    for (int d4 = 0; d4 < 32; ++d4) { const f32x4 k4 = *(const LAS f32x4*)(Ks + s * 128 + 4 * d4), q4 = *(const LAS f32x4*)(Qs + s * 128 + 4 * d4);
                        C[4 * d4 + 0] = fd * C[4 * d4 + 0] + kv * k4.x; acc += q4.x * C[4 * d4 + 0];
                        C[4 * d4 + 1] = fd * C[4 * d4 + 1] + kv * k4.y; acc += q4.y * C[4 * d4 + 1];
                        C[4 * d4 + 2] = fd * C[4 * d4 + 2] + kv * k4.z; acc += q4.z * C[4 * d4 + 2];
                        C[4 * d4 + 3] = fd * C[4 * d4 + 3] + kv * k4.w; acc += q4.w * C[4 * d4 + 3]; }
                    if (nthr) { if (c.lane == 0) { DEN[s] = acc; MEX[s] = __expf(-mn); } } else NUM[s * 128 + c.tid] = acc;
                }
            }
            __syncthreads();
            if (colthr) {
                for (int s = 0; s < 16; ++s) { const float hv = NUM[s * 128 + c.tid] / fmaxf(fabsf(DEN[s]), MEX[s]);
                    HC[(size_t)(tok0 + s) * 2048 + h * 256 + vh * 128 + c.tid] = (bf16)f2bf(hv); }
            }
        }
        __syncthreads();
    }
}
__device__ __forceinline__ void headnorm_pass(const Ctx& c, const bf16* HC, const unsigned char* Z, const float* ng, bf16* Y) {
    const int half = c.lane >> 5, l32 = c.lane & 31;
    f32x4 ga[4], gb[4];
#pragma unroll
    for (int p = 0; p < 4; ++p) { const float* gp = ng + (2 * p + half) * 256 + 8 * l32; ga[p] = *(const f32x4*)gp; gb[p] = *(const f32x4*)(gp + 4); }
    u32x4 hw[4], hn[4]; u32x2 ow[4], on[4];
#define HN_LOAD(HW, OW, tok_) do { _Pragma("unroll") for (int p = 0; p < 4; ++p) { HW[p] = *(const u32x4*)(HC + (size_t)(tok_) * 2048 + (2 * p + half) * 256 + 8 * l32); OW[p] = *(const u32x2*)(Z + (size_t)(tok_) * ZN + 4096 + (2 * p + half) * 256 + 8 * l32); } } while (0)
    if (c.gw < T) HN_LOAD(hw, ow, c.gw);
    for (int tok = c.gw; tok < T; tok += c.ngw) {
        if (tok + c.ngw < T) HN_LOAD(hn, on, tok + c.ngw);
#pragma unroll
        for (int p = 0; p < 4; ++p) {
            float x[8] = {bflo(hw[p].x), bfhi(hw[p].x), bflo(hw[p].y), bfhi(hw[p].y), bflo(hw[p].z), bfhi(hw[p].z), bflo(hw[p].w), bfhi(hw[p].w)};
            const float ps = prefix_sum64(((x[0] + x[1]) + (x[2] + x[3])) + ((x[4] + x[5]) + (x[6] + x[7]))); const float lo = lane_bcast(ps, 31), al = lane_bcast(ps, 63);
            const float mean = (half ? al - lo : lo) * (1.f / 256.f); float q = 0.f;
#pragma unroll
            for (int k = 0; k < 8; ++k) { x[k] -= mean; q += x[k] * x[k]; }
            const float pq = prefix_sum64(q); const float qlo = lane_bcast(pq, 31), qal = lane_bcast(pq, 63);
            const float rstd = 1.f / sqrtf((half ? qal - qlo : qlo) * (1.f / 256.f) + LN_EPS);
            float o[8]; fp8x8_to_f32(ow[p], o);
            const float gk[8] = {ga[p].x, ga[p].y, ga[p].z, ga[p].w, gb[p].x, gb[p].y, gb[p].z, gb[p].w}; float y[8];
#pragma unroll
            for (int k = 0; k < 8; ++k) y[k] = x[k] * rstd * gk[k] / (1.f + __expf(-o[k]));
            *(u32x4*)(Y + (size_t)tok * 2048 + (2 * p + half) * 256 + 8 * l32) = (u32x4){pk2(y[0], y[1]), pk2(y[2], y[3]), pk2(y[4], y[5]), pk2(y[6], y[7])}; }
#pragma unroll
        for (int p = 0; p < 4; ++p) { hw[p] = hn[p]; ow[p] = on[p]; }
    }
#undef HN_LOAD
}

namespace att {
typedef short bf16x8 __attribute__((ext_vector_type(8)));
typedef short s16x4 __attribute__((ext_vector_type(4)));
typedef float f32x16 __attribute__((ext_vector_type(16)));
constexpr float SCALE = 0.08838834764831845f, THR = 8.f;
constexpr int SHM = 16384;
#define KSWZ(row, colB) ((row) * 256 + ((colB) ^ (((row) & 7) << 4)))
#define SBAR() __builtin_amdgcn_sched_barrier(0)
__device__ __forceinline__ int v_st(int k, int c) { const int kk = (k & ~0xC) | ((k & 4) << 1) | ((k & 8) >> 1); return ((kk >> 3) * 4 + (c >> 5)) * 512 + ((kk & 7) * 32 + (c & 31)) * 2; }
__device__ __forceinline__ int v_rd_base(int lane) { return ((lane & 3) << 3) | (((lane >> 2) & 3) << 6) | (((lane >> 4) & 1) << 5) | (((lane >> 5) & 1) << 8); }
constexpr int v_rd_off(int d0, int ks, int half) { return d0 * 512 + ks * 4096 + half * 2048; }
__device__ __forceinline__ int crow(int r, int hi) { return (r & 3) + 8 * (r >> 2) + 4 * hi; }
__device__ __forceinline__ unsigned cvtpk(float lo, float hi) { unsigned r; asm volatile("v_cvt_pk_bf16_f32 %0, %1, %2" : "=v"(r) : "v"(lo), "v"(hi)); return r; }
__device__ __forceinline__ void mask_tile(f32x16& p0, f32x16& p1, int dq, unsigned W) {
    const float NEG = -__builtin_inff();
#pragma unroll
    for (int r = 0; r < 16; ++r) { const int cc = (r & 3) + 8 * (r >> 2);
        if ((unsigned)(dq - cc) >= W) p0[r] = NEG;
        if ((unsigned)(dq - cc - 32) >= W) p1[r] = NEG; }
}
__device__ __forceinline__ void partialSM(f32x16& p0, f32x16& p1, float& m_reg, float& mn, float& alpha) {
    float pmax = p0[0];
#pragma unroll
    for (int r = 1; r < 16; ++r) pmax = fmaxf(pmax, p0[r]);
#pragma unroll
    for (int r = 0; r < 16; ++r) pmax = fmaxf(pmax, p1[r]);
    { auto rr = __builtin_amdgcn_permlane32_swap(__float_as_uint(pmax), __float_as_uint(pmax), false, false);
      pmax = fmaxf(__uint_as_float(rr[0]), __uint_as_float(rr[1])); }
    constexpr float C2 = 1.4426950408889634f * SCALE;
    if (__builtin_expect(__all((pmax - m_reg) * SCALE <= THR), 1)) { mn = m_reg; alpha = 1.f; }
    else { mn = fmaxf(m_reg, pmax); alpha = __builtin_amdgcn_exp2f((m_reg - mn) * C2); m_reg = mn; }
    const float mnL = -mn * C2;
#pragma unroll
    for (int r = 0; r < 16; ++r) p0[r] = fmaf(p0[r], C2, mnL);
#pragma unroll
    for (int r = 0; r < 16; ++r) p1[r] = fmaf(p1[r], C2, mnL);
#pragma unroll
    for (int r = 0; r < 16; ++r) p0[r] = __builtin_amdgcn_exp2f(p0[r]);
}
__device__ __forceinline__ void finishSM(f32x16& p0, f32x16& p1, float alpha, float& l_reg, bf16x8& pa0, bf16x8& pa1, bf16x8& pa2, bf16x8& pa3) {
#pragma unroll
    for (int r = 0; r < 16; ++r) p1[r] = __builtin_amdgcn_exp2f(p1[r]);
    float ps = 0;
#pragma unroll
    for (int r = 0; r < 16; ++r) ps += p0[r];
#pragma unroll
    for (int r = 0; r < 16; ++r) ps += p1[r];
    { auto rr = __builtin_amdgcn_permlane32_swap(__float_as_uint(ps), __float_as_uint(ps), false, false);
      ps = __uint_as_float(rr[0]) + __uint_as_float(rr[1]); }
    l_reg = l_reg * alpha + ps;
#define PK4(P, B_, OUT) do { unsigned a0 = cvtpk(P[B_+0], P[B_+1]), a1 = cvtpk(P[B_+2], P[B_+3]);                          \
        unsigned b0 = cvtpk(P[B_+4], P[B_+5]), b1 = cvtpk(P[B_+6], P[B_+7]);                                             \
        auto r0 = __builtin_amdgcn_permlane32_swap(a0, b0, false, false); auto r1 = __builtin_amdgcn_permlane32_swap(a1, b1, false, false); \
        u32x4 w = {r0[0], r1[0], r0[1], r1[1]}; OUT = *reinterpret_cast<bf16x8*>(&w); } while (0)
    PK4(p0, 0, pa0); PK4(p0, 8, pa1); PK4(p1, 0, pa2); PK4(p1, 8, pa3);
#undef PK4
}
template <int KB>
__device__ __forceinline__ void qkt(f32x16& p0, f32x16& p1, const LAS char* K_lds, int r32, int hi, const bf16x8* qr) {
    p0 = f32x16{}; p1 = f32x16{};
    const LAS char* kb[4];
#pragma unroll
    for (int dd = 0; dd < 4; ++dd) kb[dd] = K_lds + KB * SHM + KSWZ(r32, (dd * 16 + hi * 8) * 2);
#pragma unroll
    for (int d0 = 0; d0 < 8; ++d0) { const LAS char* a = kb[d0 & 3] + (d0 >> 2) * 128;
        bf16x8 b0 = *reinterpret_cast<const LAS bf16x8*>(a);
        bf16x8 b1 = *reinterpret_cast<const LAS bf16x8*>(a + 32 * 256);
        p0 = __builtin_amdgcn_mfma_f32_32x32x16_bf16(b0, qr[d0], p0, 0, 0, 0);
        p1 = __builtin_amdgcn_mfma_f32_32x32x16_bf16(b1, qr[d0], p1, 0, 0, 0); }
}
template <int VB>
__device__ __forceinline__ void pv_tile(f32x16* o, int vb0, bf16x8 pa0, bf16x8 pa1, bf16x8 pa2, bf16x8 pa3) {
#define TRRD(dst, off) asm volatile("ds_read_b64_tr_b16 %0, %1 offset:%2" : "=&v"(dst) : "v"(vb0), "i"(off) : "memory")
#define PV_D0(d0) do { s16x4 l0, l1, l2, l3, h0, h1, h2, h3; constexpr int b_ = VB * SHM + v_rd_off(d0, 0, 0); \
        TRRD(l0, b_); TRRD(h0, b_ + 2048); TRRD(l1, b_ + 4096); TRRD(h1, b_ + 6144); TRRD(l2, b_ + 8192); TRRD(h2, b_ + 10240); TRRD(l3, b_ + 12288); TRRD(h3, b_ + 14336); \
        asm volatile("s_waitcnt lgkmcnt(0)" ::: "memory"); SBAR();   \
        o[d0] = __builtin_amdgcn_mfma_f32_32x32x16_bf16(pa0, (bf16x8){l0[0], l0[1], l0[2], l0[3], h0[0], h0[1], h0[2], h0[3]}, o[d0], 0, 0, 0);   \
        o[d0] = __builtin_amdgcn_mfma_f32_32x32x16_bf16(pa1, (bf16x8){l1[0], l1[1], l1[2], l1[3], h1[0], h1[1], h1[2], h1[3]}, o[d0], 0, 0, 0);   \
        o[d0] = __builtin_amdgcn_mfma_f32_32x32x16_bf16(pa2, (bf16x8){l2[0], l2[1], l2[2], l2[3], h2[0], h2[1], h2[2], h2[3]}, o[d0], 0, 0, 0);   \
        o[d0] = __builtin_amdgcn_mfma_f32_32x32x16_bf16(pa3, (bf16x8){l3[0], l3[1], l3[2], l3[3], h3[0], h3[1], h3[2], h3[3]}, o[d0], 0, 0, 0); } while (0)
    PV_D0(0); PV_D0(1); PV_D0(2); PV_D0(3);
#undef PV_D0
#undef TRRD
}
template <bool FINAL>
__device__ __forceinline__ void attn_phase(const Ctx& c, const bf16* QKV, bf16* OP, float* LSE, bf16* O) {
    const int half = c.wave >> 2, w4 = c.wave & 3, r32 = c.lane & 31, hi = c.lane >> 5, l = c.lane;
    LAS char* Vl = (LAS char*)c.lds + half * 65536; LAS char* Kl = Vl + 2 * SHM;
    LAS float* wl = (LAS float*)(c.lds + LDSCTL_OFF + 1024) + c.wave * 128; LAS float* al_l = wl + 96;
    const LAS float* wl4 = wl + 4 * hi;
    const int vb0 = (int)(unsigned)(uintptr_t)Vl + v_rd_base(c.lane);
    int krow[4], kcol[4], vrow[4], vcol[4];
#pragma unroll
    for (int j = 0; j < 4; ++j) { const int blk = 4 * w4 + j; krow[j] = 4 * blk + (l >> 4); kcol[j] = (((l & 15) ^ (krow[j] & 7)) * 16) + 2048;
        const int sub = 2 * blk + (l >> 5), kk = (sub >> 2) * 8 + ((l & 31) >> 2); vrow[j] = (kk & ~0xC) | ((kk & 4) << 1) | ((kk & 8) >> 1); vcol[j] = ((sub & 3) * 32 + (l & 3) * 8) * 2 + 4096; }
    constexpr int NUNITS = FINAL ? 1024 : 2048;
    for (int idx = c.bid; idx < NUNITS; idx += c.G) {
        const int hp = idx & 3, rj = (idx >> 2) & 15, b = (idx >> 6) & 15, g = FINAL ? 0 : 1 + (idx >> 10);
        const int h = 2 * hp + half, dil = 1 << (2 * g), nbm = (16 >> (2 * g)) - 1, jb = rj & nbm, r = rj >> (4 - 2 * g);
        const unsigned rs = (unsigned)dil * QKV_N * 2u;
        const char* base = (const char*)(QKV + ((size_t)b * SEQ + r) * QKV_N + g * 3072 + h * HD);
        const int q0 = 128 * jb + 32 * w4;
        bf16x8 qr[8];
#pragma unroll
        for (int d0 = 0; d0 < 8; ++d0) qr[d0] = *(const bf16x8*)(base + ((unsigned)(q0 + r32) * rs + (unsigned)(d0 * 32 + hi * 16)));
#define A_DMA(kb_, bf_) do { _Pragma("unroll") for (int j_ = 0; j_ < 4; ++j_) { \
            __builtin_amdgcn_global_load_lds((const unsigned*)(base + ((unsigned)((kb_) + krow[j_]) * rs + (unsigned)kcol[j_])), (LAS unsigned*)(Kl + (bf_) * SHM + (4 * w4 + j_) * 1024), 16, 0, 0); \
            __builtin_amdgcn_global_load_lds((const unsigned*)(base + ((unsigned)((kb_) + vrow[j_]) * rs + (unsigned)vcol[j_])), (LAS unsigned*)(Vl + (bf_) * SHM + (4 * w4 + j_) * 1024), 16, 0, 0); } } while (0)
        float m_reg = -1e30f, l_reg = 0.f; f32x16 o[4] = {};
        const int kt0 = jb == 0 ? 2 : 0, kb0 = 128 * (jb - 1);
        A_DMA(kb0 + 64 * kt0, 0);
        asm volatile("s_waitcnt vmcnt(0)" ::: "memory"); __syncthreads();
#define A_STEP(kt_, BUF) do { const int kb_ = kb0 + 64 * (kt_); \
            if ((kt_) < 3) A_DMA(kb_ + 64, (BUF) ^ 1);                                         \
            if (kb_ <= q0 + 31 && kb_ + 63 >= q0 - 128) { f32x16 p0, p1; float mn, alpha; bf16x8 pa0, pa1, pa2, pa3; \
                qkt<BUF>(p0, p1, Kl, r32, hi, qr); mask_tile(p0, p1, q0 + r32 - kb_ - 4 * hi, 129u); partialSM(p0, p1, m_reg, mn, alpha); \
                if (__any(alpha < 1.f)) { if (hi == 0) al_l[r32] = alpha; asm volatile("s_waitcnt lgkmcnt(0)" ::: "memory"); \
                    _Pragma("unroll") for (int d_ = 0; d_ < 4; ++d_) _Pragma("unroll") for (int r_ = 0; r_ < 16; ++r_) o[d_][r_] *= al_l[crow(r_, hi)]; } \
                finishSM(p0, p1, alpha, l_reg, pa0, pa1, pa2, pa3); SBAR(); pv_tile<BUF>(o, vb0, pa0, pa1, pa2, pa3); } \
            asm volatile("s_waitcnt vmcnt(0)" ::: "memory"); __syncthreads(); } while (0)
        for (int kt = kt0; kt < 4; kt += 2) { A_STEP(kt, 0); A_STEP(kt + 1, 1); }
#undef A_STEP
#undef A_DMA
        const float lse = m_reg * SCALE + __logf(l_reg);
        const unsigned tok0 = (unsigned)b * SEQ + r;
        if (hi == 0) { const unsigned tokq = tok0 + (unsigned)(q0 + r32) * dil; float w0 = 1.f / l_reg;
            if (FINAL) { const float l1 = LSE[tokq * 8u + h], l2 = LSE[((unsigned)T + tokq) * 8u + h]; const float M = fmaxf(lse, fmaxf(l1, l2));
                const float e0 = __expf(lse - M), e1 = __expf(l1 - M), e2 = __expf(l2 - M), inv = 1.f / (e0 + e1 + e2); w0 *= e0 * inv; wl[32 + r32] = e1 * inv; wl[64 + r32] = e2 * inv; }
            else LSE[((unsigned)(g - 1) * T + tokq) * 8u + h] = lse;
            wl[r32] = w0; }
        asm volatile("s_waitcnt lgkmcnt(0)" ::: "memory");
        LAS char* tile = Vl + (w4 < 2 ? SHM + w4 * 8192 : 3 * SHM + (w4 - 2) * 8192); LAS char* tile4 = tile + 4 * hi * 256 + r32 * 2;
#pragma unroll
        for (int r_ = 0; r_ < 16; ++r_) { const int orow = (r_ & 3) + 8 * (r_ >> 2); const float w0 = wl4[orow];
#pragma unroll
            for (int d0 = 0; d0 < 4; ++d0) { const float v = o[d0][r_] * w0; const float vn = lane_xor1(v);
                if ((r32 & 1) == 0) *(LAS unsigned*)(tile4 + orow * 256 + d0 * 64) = cvtpk(v, vn); } }
        asm volatile("s_waitcnt lgkmcnt(0)" ::: "memory");
#pragma unroll
        for (int i = 0; i < 8; ++i) { const int p = c.lane + 64 * i, row = p >> 4, ch = p & 15; const unsigned tok = tok0 + (unsigned)(q0 + row) * dil; const unsigned col8 = (unsigned)h * HD + ch * 8;
            const u32x4 x = *(const LAS u32x4*)(tile + row * 256 + ch * 16);
            if (FINAL) { const u32x4 pa = *(const u32x4*)(OP + (tok * (unsigned)OD + col8)), pb = *(const u32x4*)(OP + (((unsigned)T + tok) * (unsigned)OD + col8)); const float w1 = wl[32 + row], w2 = wl[64 + row];
                u32x4 y; y.x = cvtpk(bflo(x.x) + w1 * bflo(pa.x) + w2 * bflo(pb.x), bfhi(x.x) + w1 * bfhi(pa.x) + w2 * bfhi(pb.x)); y.y = cvtpk(bflo(x.y) + w1 * bflo(pa.y) + w2 * bflo(pb.y), bfhi(x.y) + w1 * bfhi(pa.y) + w2 * bfhi(pb.y));
                y.z = cvtpk(bflo(x.z) + w1 * bflo(pa.z) + w2 * bflo(pb.z), bfhi(x.z) + w1 * bfhi(pa.z) + w2 * bfhi(pb.z)); y.w = cvtpk(bflo(x.w) + w1 * bflo(pa.w) + w2 * bflo(pb.w), bfhi(x.w) + w1 * bfhi(pa.w) + w2 * bfhi(pb.w));
                *(u32x4*)(O + (tok * (unsigned)OD + col8)) = y; }
            else *(u32x4*)(OP + (((unsigned)(g - 1) * T + tok) * (unsigned)OD + col8)) = x; }
    }
}
#undef KSWZ
#undef SBAR
}

namespace mls {
using att::bf16x8; using att::s16x4; using att::f32x16; using att::v_st; using att::v_rd_base; using att::crow; using att::cvtpk;
constexpr int RSB = 272;
constexpr int L_QP = 0, L_KP = 17408, L_KTR = 34816, L_VTR = 51200, L_AM = 83968, L_RS = 93184, L_QN = 94208, L_WINT = 94464, L_MEXP = 94720, L_HDEN = 94976  , L_NV = 97024  , L_UV = 98048, L_AV = 98560  ;
constexpr int AMB = 144;
#define TRRD(dst, addr, off) asm volatile("ds_read_b64_tr_b16 %0, %1 offset:%2" : "=&v"(dst) : "v"(addr), "i"(off) : "memory")
template <int SKIP>
__device__ __forceinline__ void mlstm_phase(const Ctx& c, const bf16* QKC, const unsigned char* Z, const float* GATES, bf16* HC) {
    const int w = c.wave;
    LAS char* lds = (LAS char*)c.lds;
    LAS float* RS = (LAS float*)(lds + L_RS); LAS float* QN = (LAS float*)(lds + L_QN); LAS float* WINT = (LAS float*)(lds + L_WINT);     LAS float* HDEN = (LAS float*)(lds + L_HDEN);
    LAS float* UV = (LAS float*)(lds + L_UV); LAS float* AV = (LAS float*)(lds + L_AV);
    for (int unit = c.bid; unit < BATCH * 8; unit += c.G) {
        const int b = unit >> 3, h = unit & 7;
        f32x16 Ct[4] = {};
        float n0 = 0.f, n1 = 0.f, m_state = -1e30f;
        bf16x8 sq[2], sk[2]; u32x2 sv[4]; float g_li, g_lf;
#define M_LOAD(tok0_) do { \
            _Pragma("unroll") for (int i_ = 0; i_ < 2; ++i_) { const int p_ = tid_ + 512 * i_, row_ = p_ >> 4, c8_ = (p_ & 15) * 8; const bf16* s_ = QKC + (size_t)((tok0_) + row_) * 2048 + h * 128 + c8_; sq[i_] = *(const bf16x8*)s_; sk[i_] = *(const bf16x8*)(s_ + 1024); } \
            g_li = GATES[(size_t)((tok0_) + (tid_ & 63)) * 16 + h]; g_lf = GATES[(size_t)((tok0_) + (tid_ & 63)) * 16 + 8 + h]; } while (0)
#define M_LOADV(tok0_) do { \
            _Pragma("unroll") for (int i_ = 0; i_ < 4; ++i_) { const int p_ = tid_ + 512 * i_, row_ = p_ >> 5, c8_ = (p_ & 31) * 8; sv[i_] = *(const u32x2*)(Z + (size_t)((tok0_) + row_) * ZN + 2048 + h * 256 + c8_); } } while (0)
        int tid_ = c.tid; asm volatile("" : "+v"(tid_));
        M_LOAD(b * SEQ); M_LOADV(b * SEQ);
        if (w == 5) *(LAS f32x2*)(lds + L_NV + 512 + 8 * c.lane) = (f32x2){0.f, 0.f};
        for (int ch = 0; ch < 32; ++ch) {
            const int tok0 = b * SEQ + ch * 64;
            tid_ = c.tid; asm volatile("" : "+v"(tid_));
            const int l = tid_ & 63, hi = l >> 5, r32 = l & 31, q4 = l >> 4, l15 = l & 15;
            const int vbK = (int)(unsigned)(uintptr_t)(lds + L_KTR) + v_rd_base(l);
            const int vbV = (int)(unsigned)(uintptr_t)(lds + L_VTR) + (w >> 2) * 16384 + (w & 3) * 512 + v_rd_base(l);
            const LAS float* uv_b = UV + 16 * (w & 3) + 4 * q4; const LAS float* as_b = AV + 32 * (w >> 2) + l15;
            LAS char* am_w = lds + L_AM + (16 * (w & 3) + 4 * q4) * AMB + (32 * (w >> 2) + l15) * 2; LAS float* rs_w = RS + 128 * (w >> 2) + 16 * (w & 3) + 4 * q4;
            const LAS float* wint_b = WINT + 4 * hi; const LAS float* hden_b = HDEN + 64 * w + 4 * hi;
            const LAS char* q_b = lds + L_QP + r32 * RSB + 8 * hi; const LAS char* am_b = lds + L_AM + r32 * AMB + 16 * hi;
            const LAS char* sq_b = lds + L_QP + ((16 * (w & 3)) + l15) * RSB + 16 * q4; const LAS char* sk_b = lds + L_KP + l15 * RSB + 16 * q4;
            const int hc_lane = 4 * hi * 2048 + 32 * w + r32;
            const float bc = (SKIP & 64) ? g_lf : prefix_sum64(g_lf);
            const float a = g_li - bc, pm = (SKIP & 64) ? a : prefix_max64(a);
            const float u = fmaxf(m_state, pm), winter = __expf(m_state - u);
            const float blast = lane_bcast(bc, 63), u63 = lane_bcast(u, 63);
            const float wk = __expf(a - u63), decay = __expf(m_state - u63), mexp = __expf(-(bc + u));
            if (!(SKIP & 128)) {
#pragma unroll
            for (int i = 0; i < 2; ++i) { const int p = tid_ + 512 * i, row = p >> 4, c8 = (p & 15) * 8;
                *(LAS bf16x8*)(lds + L_QP + row * RSB + c8 * 2) = sq[i]; *(LAS bf16x8*)(lds + L_KP + row * RSB + c8 * 2) = sk[i];
                const float wr_ = __shfl(wk, row); const u32x4 kw = *reinterpret_cast<const u32x4*>(&sk[i]);
                u32x4 o; o.x = cvtpk(bflo(kw.x) * wr_, bfhi(kw.x) * wr_); o.y = cvtpk(bflo(kw.y) * wr_, bfhi(kw.y) * wr_); o.z = cvtpk(bflo(kw.z) * wr_, bfhi(kw.z) * wr_); o.w = cvtpk(bflo(kw.w) * wr_, bfhi(kw.w) * wr_);
                *(LAS u32x4*)(lds + L_KTR + v_st(row, c8)) = o; }
#pragma unroll
            for (int i = 0; i < 4; ++i) { const int p = tid_ + 512 * i, row = p >> 5, c8 = (p & 31) * 8;
                float vf_[8]; fp8x8_to_f32(sv[i], vf_); *(LAS u32x4*)(lds + L_VTR + (c8 >> 7) * 16384 + v_st(row, c8 & 127)) = (u32x4){cvtpk(vf_[0], vf_[1]), cvtpk(vf_[2], vf_[3]), cvtpk(vf_[4], vf_[5]), cvtpk(vf_[6], vf_[7])}; }
            }
            if (w == 0) { WINT[(ch & 1) * 64 + l] = winter; UV[(ch & 1) * 64 + l] = u; AV[(ch & 1) * 64 + l] = a; }
            if (!(SKIP & 32)) { if (ch + 1 < 32) { M_LOAD(tok0 + 64); M_LOADV(tok0 + 64); } }
            __syncthreads(); __builtin_amdgcn_sched_barrier(0);
            if (!(SKIP & 1)) {
                if (w == 4) { const LAS char* qrow = lds + L_QP + l * RSB; const LAS f32x4* nv = (const LAS f32x4*)(lds + L_NV + ((ch + 1) & 1) * 512);
                    float p0 = 0.f, p1 = 0.f;
#pragma unroll 2
                    for (int d8 = 0; d8 < 16; ++d8) { const u32x4 q = *(const LAS u32x4*)(qrow + 16 * d8); const f32x4 na = nv[2 * d8], nb = nv[2 * d8 + 1];
                        p0 += (bflo(q.x) * na.x + bfhi(q.x) * na.y) + (bflo(q.y) * na.z + bfhi(q.y) * na.w); p1 += (bflo(q.z) * nb.x + bfhi(q.z) * nb.y) + (bflo(q.w) * nb.z + bfhi(q.w) * nb.w); }
                    QN[l] = p0 + p1; }
                if (w == 5) { const LAS char* kb = lds + L_KTR + (l >> 4) * 512 + (l & 15) * 4;
                    float p0 = 0.f, p1 = 0.f;
#pragma unroll 2
                    for (int a_ = 0; a_ < 8; ++a_) {
                        const unsigned k0 = *(const LAS unsigned*)(kb + a_ * 2048 + 0), k1 = *(const LAS unsigned*)(kb + a_ * 2048 + 64), k2 = *(const LAS unsigned*)(kb + a_ * 2048 + 128), k3 = *(const LAS unsigned*)(kb + a_ * 2048 + 192);
                        const unsigned k4 = *(const LAS unsigned*)(kb + a_ * 2048 + 256), k5 = *(const LAS unsigned*)(kb + a_ * 2048 + 320), k6 = *(const LAS unsigned*)(kb + a_ * 2048 + 384), k7 = *(const LAS unsigned*)(kb + a_ * 2048 + 448);
                        p0 += ((bflo(k0) + bflo(k4)) + (bflo(k1) + bflo(k5))) + ((bflo(k2) + bflo(k6)) + (bflo(k3) + bflo(k7))); p1 += ((bfhi(k0) + bfhi(k4)) + (bfhi(k1) + bfhi(k5))) + ((bfhi(k2) + bfhi(k6)) + (bfhi(k3) + bfhi(k7))); }
                    n0 = n0 * decay + p0; n1 = n1 * decay + p1;
                    *(LAS f32x2*)(lds + L_NV + (ch & 1) * 512 + 8 * l) = (f32x2){n0, n1}; }
            }
            __builtin_amdgcn_sched_barrier(0);
            if (!(SKIP & 2)) { const int ti = w & 3, si0 = 2 * (w >> 2);
              const f32x4 ut4 = *(const LAS f32x4*)(uv_b + (ch & 1) * 64);
#pragma unroll
              for (int sj = 0; sj < 2; ++sj) { const int si = si0 + sj; float av[4] = {0.f, 0.f, 0.f, 0.f};
                if (si <= ti) { f32x4 acc = {0.f, 0.f, 0.f, 0.f};
#pragma unroll
                    for (int kk = 0; kk < 4; ++kk) { const bf16x8 af = *(const LAS bf16x8*)(sq_b + 64 * kk), bfr = *(const LAS bf16x8*)(sk_b + (16 * si) * RSB + 64 * kk);
                        acc = __builtin_amdgcn_mfma_f32_16x16x32_bf16(af, bfr, acc, 0, 0, 0); }
                    const float as_ = as_b[(ch & 1) * 64 + 16 * sj]; const int dts = 16 * (ti - si) + 4 * q4 - l15;
#pragma unroll
                    for (int r = 0; r < 4; ++r) av[r] = (dts + r >= 0) ? acc[r] * __expf(as_ - ut4[r]) : 0.f; }
#pragma unroll
                for (int r = 0; r < 4; ++r) { *(LAS unsigned short*)(am_w + r * AMB + sj * 32) = (unsigned short)f2bf(av[r]);
                    const float rs_ = row16_sum(av[r]);
                    if (l15 == 0) rs_w[sj * 64 + r] = rs_; } } }
            __builtin_amdgcn_sched_barrier(0);
            bf16x8 vf[4];
            { s16x4 l0, l1, l2, l3, h0, h1, h2, h3;
              TRRD(l0, vbV, 0); TRRD(h0, vbV, 2048); TRRD(l1, vbV, 4096); TRRD(h1, vbV, 6144); TRRD(l2, vbV, 8192); TRRD(h2, vbV, 10240); TRRD(l3, vbV, 12288); TRRD(h3, vbV, 14336);
              asm volatile("s_waitcnt lgkmcnt(0)" ::: "memory"); __builtin_amdgcn_sched_barrier(0);
              vf[0] = (bf16x8){l0[0], l0[1], l0[2], l0[3], h0[0], h0[1], h0[2], h0[3]}; vf[1] = (bf16x8){l1[0], l1[1], l1[2], l1[3], h1[0], h1[1], h1[2], h1[3]};
              vf[2] = (bf16x8){l2[0], l2[1], l2[2], l2[3], h2[0], h2[1], h2[2], h2[3]}; vf[3] = (bf16x8){l3[0], l3[1], l3[2], l3[3], h3[0], h3[1], h3[2], h3[3]}; }
            f32x16 ac[2] = {};
            if (!(SKIP & 4))
#pragma unroll
            for (int db = 0; db < 4; ++db)
#pragma unroll
                for (int s2 = 0; s2 < 2; ++s2) {
                    u32x4 cw; cw.x = cvtpk(Ct[db][8 * s2 + 0], Ct[db][8 * s2 + 1]); cw.y = cvtpk(Ct[db][8 * s2 + 2], Ct[db][8 * s2 + 3]); cw.z = cvtpk(Ct[db][8 * s2 + 4], Ct[db][8 * s2 + 5]); cw.w = cvtpk(Ct[db][8 * s2 + 6], Ct[db][8 * s2 + 7]);
#pragma unroll
                    for (int th = 0; th < 2; ++th) { const LAS char* qp = q_b + 32 * th * RSB + (32 * db + 16 * s2) * 2; const u32x2 x0 = *(const LAS u32x2*)qp, x1 = *(const LAS u32x2*)(qp + 16);
                        u32x4 o = {x0.x, x0.y, x1.x, x1.y}; ac[th] = __builtin_amdgcn_mfma_f32_32x32x16_bf16(*reinterpret_cast<bf16x8*>(&o), *reinterpret_cast<bf16x8*>(&cw), ac[th], 0, 0, 0); } }
            if (!(SKIP & 8))
#pragma unroll
            for (int db = 0; db < 4; ++db) { s16x4 l0, l1, l2, l3, h0, h1, h2, h3;
                TRRD(l0, vbK, db * 512 + 0); TRRD(h0, vbK, db * 512 + 2048); TRRD(l1, vbK, db * 512 + 4096); TRRD(h1, vbK, db * 512 + 6144); TRRD(l2, vbK, db * 512 + 8192); TRRD(h2, vbK, db * 512 + 10240); TRRD(l3, vbK, db * 512 + 12288); TRRD(h3, vbK, db * 512 + 14336);
#pragma unroll
                for (int r = 0; r < 16; ++r) Ct[db][r] *= decay;
                asm volatile("s_waitcnt lgkmcnt(0)" ::: "memory"); __builtin_amdgcn_sched_barrier(0);
                Ct[db] = __builtin_amdgcn_mfma_f32_32x32x16_bf16((bf16x8){l0[0], l0[1], l0[2], l0[3], h0[0], h0[1], h0[2], h0[3]}, vf[0], Ct[db], 0, 0, 0);
                Ct[db] = __builtin_amdgcn_mfma_f32_32x32x16_bf16((bf16x8){l1[0], l1[1], l1[2], l1[3], h1[0], h1[1], h1[2], h1[3]}, vf[1], Ct[db], 0, 0, 0);
                Ct[db] = __builtin_amdgcn_mfma_f32_32x32x16_bf16((bf16x8){l2[0], l2[1], l2[2], l2[3], h2[0], h2[1], h2[2], h2[3]}, vf[2], Ct[db], 0, 0, 0);
                Ct[db] = __builtin_amdgcn_mfma_f32_32x32x16_bf16((bf16x8){l3[0], l3[1], l3[2], l3[3], h3[0], h3[1], h3[2], h3[3]}, vf[3], Ct[db], 0, 0, 0); }
            m_state = blast + u63;
            __syncthreads(); __builtin_amdgcn_sched_barrier(0);
            if (!(SKIP & 16)) {
            { const float den = ((RS[l] + RS[64 + l]) + (RS[128 + l] + RS[192 + l])) + winter * QN[l]; HDEN[64 * w + l] = 1.f / fmaxf(fabsf(den), mexp); }
            const LAS float* wint_c = wint_b + (ch & 1) * 64;
#pragma unroll
            for (int th = 0; th < 2; ++th) { f32x16 ai = {};
#pragma unroll
                for (int ks = 0; ks < 4; ++ks) { if (th == 0 && ks >= 2) continue; const bf16x8 af = *(const LAS bf16x8*)(am_b + 32 * th * AMB + 32 * ks); ai = __builtin_amdgcn_mfma_f32_32x32x16_bf16(af, vf[ks], ai, 0, 0, 0); }
#pragma unroll
                for (int r = 0; r < 16; ++r) { const int tc = 32 * th + (r & 3) + 8 * (r >> 2); const float v = (ai[r] + wint_c[tc] * ac[th][r]) * hden_b[tc]; const float vn = lane_xor1(v);
                    bf16* rowp = HC + (size_t)(tok0 + tc) * 2048 + h * 256;
                    if ((r32 & 1) == 0) *(unsigned*)(rowp + hc_lane) = cvtpk(v, vn); } }
            }
        }
        __syncthreads();
    }
#undef M_LOAD
#undef M_LOADV
}
#undef TRRD
}

#ifndef GEMM_SP2
#define GEMM_SP2 true
#endif
#ifndef GEMM_ALIGN
#define GEMM_ALIGN true
#endif
#ifndef EPI_NT
#define EPI_NT 1
#endif
#if EPI_NT
#define EPI_ST(p, v) __builtin_nontemporal_store((v), (p))
#else
#define EPI_ST(p, v) (*(p) = (v))
#endif
namespace pg8 {
struct EpiStoreBf16 { static constexpr bool PERM = true, AFTER_DRAIN = false, WIDE = false; bf16_t* O; int ldc;
    __device__ __forceinline__ void operator()(const f32x4 (&acc)[2][2][4][2], const Unit& u, int wr, int wc, int fr, int fq) const {
        const int row0 = u.pm * BM + wr * 64 + fr, col0 = u.pn * BM + wc * 32 + 8 * fq;
#pragma unroll
        for (int ai = 0; ai < 2; ++ai)
#pragma unroll
            for (int m = 0; m < 4; ++m) { bf16_t* rowp = O + (size_t)(row0 + ai * HALF + m * 16) * ldc + col0;
#pragma unroll
                for (int bj = 0; bj < 2; ++bj) { const f32x4 v0 = acc[ai][bj][m][0], v1 = acc[ai][bj][m][1];
                    u32x4 w; w.x = cvt_pk_bf16(v0[0], v0[1]); w.y = cvt_pk_bf16(v0[2], v0[3]); w.z = cvt_pk_bf16(v1[0], v1[1]); w.w = cvt_pk_bf16(v1[2], v1[3]);
                    EPI_ST((u32x4*)(rowp + bj * HALF), w); } }
    }
};
struct EpiStoreFp8 { static constexpr bool PERM = true, AFTER_DRAIN = false; static constexpr int WIDE = 2; unsigned char* O; int ldc;
    __device__ __forceinline__ void operator()(const f32x4 (&acc)[2][2][4][2], const Unit& u, int wr, int wc, int fr, int fq) const {
        unsigned char* tb = O + (size_t)(u.pm * BM) * ldc + u.pn * BM; const unsigned lo = (unsigned)((wr * 64 + fr) * ldc + wc * 64 + 16 * fq);
#pragma unroll
        for (int ai = 0; ai < 2; ++ai)
#pragma unroll
            for (int m = 0; m < 4; ++m) { u32x4 w; unsigned pw[2][2];
#pragma unroll
                for (int bj = 0; bj < 2; ++bj) { const f32x4 v0 = acc[ai][bj][m][0] * 16.f, v1 = acc[ai][bj][m][1] * 16.f;
                    int t0 = __builtin_amdgcn_cvt_pk_fp8_f32(v0[0], v0[1], 0, false); t0 = __builtin_amdgcn_cvt_pk_fp8_f32(v0[2], v0[3], t0, true);
                    int t1 = __builtin_amdgcn_cvt_pk_fp8_f32(v1[0], v1[1], 0, false); t1 = __builtin_amdgcn_cvt_pk_fp8_f32(v1[2], v1[3], t1, true);
                    pw[bj][0] = (unsigned)t0; pw[bj][1] = (unsigned)t1; }
                w.x = pw[0][0]; w.y = pw[0][1]; w.z = pw[1][0]; w.w = pw[1][1];
                EPI_ST((u32x4*)(tb + (size_t)((ai * HALF + m * 16) * ldc) + lo), w); }
    }
};
struct EpiQKV { static constexpr bool PERM = true, AFTER_DRAIN = false, WIDE = false; bf16_t* O; int ldc; const float* tab;
    __device__ __forceinline__ void operator()(const f32x4 (&acc)[2][2][4][2], const Unit& u, int wr, int wc, int fr, int fq) const {
        const int row0 = u.pm * BM + wr * 64 + fr, col0 = u.pn * BM + wc * 32 + 8 * fq;
        const bool rot = ((u.pn >> 2) % 3) < 2 && wc == 0;
        const float* tb = tab + 16 * (fq & 1);
        f32x4 n0 = {1.f, 0.f, 1.f, 0.f}, n1 = n0, n2 = n0, n3 = n0;
        if (rot) { const f32x4* tp = (const f32x4*)(tb + (size_t)(row0 & 2047) * 32); n0 = tp[0]; n1 = tp[1]; n2 = tp[2]; n3 = tp[3]; }
#pragma unroll
        for (int ai = 0; ai < 2; ++ai)
#pragma unroll
            for (int m = 0; m < 4; ++m) { const int row = row0 + ai * HALF + m * 16; bf16_t* rowp = O + (size_t)row * ldc + col0;
                const f32x4 t0 = n0, t1 = n1, t2 = n2, t3 = n3;
                if (rot && (ai * 4 + m) < 7) { const int nrow = row0 + ((ai * 4 + m + 1) >> 2) * HALF + ((ai * 4 + m + 1) & 3) * 16; const f32x4* tp = (const f32x4*)(tb + (size_t)(nrow & 2047) * 32); n0 = tp[0]; n1 = tp[1]; n2 = tp[2]; n3 = tp[3]; }
                const f32x4 c0 = {t0[0], t0[2], t1[0], t1[2]}, c1 = {t2[0], t2[2], t3[0], t3[2]};
                f32x4 s0 = {t0[1], t0[3], t1[1], t1[3]}, s1 = {t2[1], t2[3], t3[1], t3[3]};
                if (fq < 2) { s0 = -s0; s1 = -s1; }
#pragma unroll
                for (int bj = 0; bj < 2; ++bj) { f32x4 v0 = acc[ai][bj][m][0], v1 = acc[ai][bj][m][1];
                    if (rot) { f32x4 p0, p1;
#pragma unroll
                        for (int k = 0; k < 4; ++k) { p0[k] = lane_xor32(v0[k]); p1[k] = lane_xor32(v1[k]); }
                        v0 = v0 * c0 + p0 * s0; v1 = v1 * c1 + p1 * s1; }
                    u32x4 w; w.x = cvt_pk_bf16(v0[0], v0[1]); w.y = cvt_pk_bf16(v0[2], v0[3]); w.z = cvt_pk_bf16(v1[0], v1[1]); w.w = cvt_pk_bf16(v1[2], v1[3]);
                    EPI_ST((u32x4*)(rowp + bj * HALF), w); } }
    }
};
template <bool RES_F32> struct EpiRes { static constexpr bool PERM = true, AFTER_DRAIN = false, WIDE = false; const void* res; bf16_t* out; int ldc; float alpha;
    __device__ __forceinline__ void operator()(const f32x4 (&acc)[2][2][4][2], const Unit& u, int wr, int wc, int fr, int fq) const {
        const int row0 = u.pm * BM + wr * 64 + fr, col0 = u.pn * BM + wc * 32 + 8 * fq;
#pragma unroll
        for (int ai = 0; ai < 2; ++ai)
#pragma unroll
            for (int m = 0; m < 4; ++m) { const size_t off = (size_t)(row0 + ai * HALF + m * 16) * ldc + col0;
#pragma unroll
                for (int bj = 0; bj < 2; ++bj) { f32x4 r0, r1;
                    if (RES_F32) { r0 = *(const f32x4*)((const float*)res + off + bj * HALF); r1 = *(const f32x4*)((const float*)res + off + bj * HALF + 4); }
                    else { const u32x4 rw = *(const u32x4*)((const bf16_t*)res + off + bj * HALF);
                        r0 = (f32x4){__builtin_bit_cast(float, rw.x << 16), __builtin_bit_cast(float, rw.x & 0xffff0000u), __builtin_bit_cast(float, rw.y << 16), __builtin_bit_cast(float, rw.y & 0xffff0000u)};
                        r1 = (f32x4){__builtin_bit_cast(float, rw.z << 16), __builtin_bit_cast(float, rw.z & 0xffff0000u), __builtin_bit_cast(float, rw.w << 16), __builtin_bit_cast(float, rw.w & 0xffff0000u)}; }
                    const f32x4 v0 = r0 * alpha + acc[ai][bj][m][0], v1 = r1 * alpha + acc[ai][bj][m][1];
                    u32x4 w; w.x = cvt_pk_bf16(v0[0], v0[1]); w.y = cvt_pk_bf16(v0[2], v0[3]); w.z = cvt_pk_bf16(v1[0], v1[1]); w.w = cvt_pk_bf16(v1[2], v1[3]);
                    EPI_ST((u32x4*)(out + off + bj * HALF), w); } }
    }
};
struct EpiSwiGLU { static constexpr bool PERM = true, AFTER_DRAIN = false, WIDE = false; bf16_t* H;
    __device__ __forceinline__ void operator()(const f32x4 (&acc)[2][2][4][2], const Unit& u, int wr, int wc, int fr, int fq) const {
        const int row0 = u.pm * BM + wr * 64 + fr, col0 = u.pn * 128 + wc * 16 + 4 * fq;
#pragma unroll
        for (int ai = 0; ai < 2; ++ai)
#pragma unroll
            for (int m = 0; m < 4; ++m) { bf16_t* rowp = H + (size_t)(row0 + ai * HALF + m * 16) * 768 + col0;
#pragma unroll
                for (int bj = 0; bj < 2; ++bj) { const f32x4 v0 = acc[ai][bj][m][0], v1 = acc[ai][bj][m][1];
                    const float h0 = v0[0] / (1.f + __expf(-v0[0])) * v0[1], h1 = v0[2] / (1.f + __expf(-v0[2])) * v0[3], h2 = v1[0] / (1.f + __expf(-v1[0])) * v1[1], h3 = v1[2] / (1.f + __expf(-v1[2])) * v1[3];
                    typedef unsigned u32x2v __attribute__((ext_vector_type(2))); u32x2v w; w.x = cvt_pk_bf16(h0, h1); w.y = cvt_pk_bf16(h2, h3);
                    EPI_ST((u32x2v*)(rowp + bj * 64), w); } }
    }
};
__device__ __forceinline__ unsigned ror8u(unsigned v) { return (unsigned)__builtin_amdgcn_mov_dpp((int)v, 0x128, 0xf, 0xf, true); }
template <bool STORE = true> struct EpiDownT { static constexpr bool PERM = true, AFTER_DRAIN = false, WIDE = true; unsigned char* YB8; const PG8_LAS int* atab;
    __device__ __forceinline__ void operator()(const f32x4 (&acc)[2][2][4][2], const Unit& u, int wr, int wc, int fr, int fq) const {
        typedef unsigned u32x2v __attribute__((ext_vector_type(2)));
        const bool up = fr >= 8; const unsigned ca = (unsigned)(u.pn * BM + wc * 64 + (up ? 32 : 0) + 8 * fq), cb = ca ^ 32u;
        const PG8_LAS int* at = atab + u.ui * 256 + wr * 64 + (fr & 7);
#pragma unroll
        for (int ai = 0; ai < 2; ++ai)
#pragma unroll
            for (int m = 0; m < 4; ++m) { u32x2v p[2];
#pragma unroll
                for (int bj = 0; bj < 2; ++bj) { const f32x4 v0 = acc[ai][bj][m][0] * 16.f, v1 = acc[ai][bj][m][1] * 16.f;
                    int t0 = __builtin_amdgcn_cvt_pk_fp8_f32(v0[0], v0[1], 0, false); t0 = __builtin_amdgcn_cvt_pk_fp8_f32(v0[2], v0[3], t0, true);
                    int t1 = __builtin_amdgcn_cvt_pk_fp8_f32(v1[0], v1[1], 0, false); t1 = __builtin_amdgcn_cvt_pk_fp8_f32(v1[2], v1[3], t1, true);
                    p[bj].x = (unsigned)t0; p[bj].y = (unsigned)t1; }
                const u32x2v x = {ror8u(p[1].x), ror8u(p[1].y)};
                const int aA = at[ai * HALF + m * 16], aB = at[ai * HALF + m * 16 + 8];
                const u32x2v dA = up ? x : p[0], dB = up ? p[0] : x;
                if (STORE) { if (aA >= 0) EPI_ST((u32x2v*)(YB8 + (size_t)aA * 2048 + ca), dA); if (aB >= 0) EPI_ST((u32x2v*)(YB8 + (size_t)aB * 2048 + cb), dB); }
                else asm volatile("" :: "v"(dA.x), "v"(dA.y), "v"(dB.x), "v"(dB.y)); }
    }
};
typedef EpiDownT<true> EpiDown;
template <bool GATHER_> struct MoeOrder { static constexpr bool GATHER = GATHER_; static constexpr int MAXU = 9;
    int nN, G, c, nt; const unsigned* cnt; size_t exp_bytes; const int* rowmap; PG8_LAS int* tok;
    static __device__ __forceinline__ int tiles(const unsigned* cnt) { int n = 0; for (int e = 0; e < 16; ++e) n += (int)(cnt[e] + 255u) >> 8; return n; }
    __device__ __forceinline__ bool next(int i, Unit& u) const { const long L = (long)i * G + c; if (L >= (long)nt * nN) return false; u.pm = (int)(L / nN); u.pn = (int)(L % nN); u.ui = i; return true; }
    __device__ __forceinline__ const char* pa(const Gemm& g, const Unit& u) const { return GATHER_ ? (const char*)g.A : (const char*)g.A + (size_t)u.pm * ((size_t)BM * g.K * 2); }
    __device__ __forceinline__ const char* pb(const Gemm& g, const Unit& u) const { const int e = __builtin_amdgcn_readfirstlane(tok[MAXU * 256 + u.pm]) & 15; return (const char*)g.Bt + (size_t)e * exp_bytes + (size_t)u.pn * ((size_t)BM * g.K * 2); }
    __device__ __forceinline__ void prep() const {
        if (threadIdx.x < 16) { const int e = threadIdx.x; int pm = 0; for (int q = 0; q < e; ++q) pm += (int)(cnt[q] + 255u) >> 8;
            const int ce = (int)cnt[e];
            for (int k = 0; k * 256 < ce; ++k) { const int rem = ce - k * 256; tok[MAXU * 256 + pm + k] = e | (k << 4) | ((rem > 256 ? 256 : rem) << 12); } }
        __syncthreads();
        for (int i = 0; i < MAXU; ++i) { Unit u; if (!next(i, u)) break; if (threadIdx.x < 256) { const int w = tok[MAXU * 256 + u.pm]; tok[i * 256 + threadIdx.x] = ((int)threadIdx.x < (w >> 12)) ? rowmap[(w & 15) * ECAP + ((w >> 4) & 255) * 256 + (int)threadIdx.x] : -1; } }
        asm volatile("s_waitcnt vmcnt(0) lgkmcnt(0)" ::: "memory"); __syncthreads();
    }
    __device__ __forceinline__ void aoffs(int ui, int K, int tid, unsigned (&out)[2][2]) const {
#pragma unroll
        for (int h = 0; h < 2; ++h)
#pragma unroll
            for (int i = 0; i < 2; ++i) { int R, C; stage_rc(tid * 16 + i * 8192, R, C); const int a = tok[ui * 256 + h * 128 + R]; out[h][i] = (unsigned)((a < 0 ? 0 : a) >> 1) * (unsigned)(K * 2) + (unsigned)(C * 2); }
    }
    __device__ __forceinline__ void a_ready(const Unit&) const {}
    __device__ __forceinline__ void done(const Unit&) const {}
};
}

struct Args { const float* in[18]; float* out; unsigned char* ws; int ph_lo, ph_hi; };
#ifdef ONLY_PH
#define IN(k) ((k) == ONLY_PH)
#else
#define IN(k) (lo <= (k) && (k) < hi)
#endif
#define BOTH(k) (IN(k) && IN((k) + 1))
#if MK_ONE_LAUNCH
#define SEAM() xcd_barrier(bar)
#else
#define SEAM() do {} while (0)
#endif
#ifndef REP_PH
#define REP_PH (-1)
#endif
#ifndef REP_PH2
#define REP_PH2 (-1)
#endif
#ifdef TS_PROBE
#define TS_STAMP(k) do { if (blockIdx.x == 0 && threadIdx.x == 0) __hip_atomic_store((unsigned long long*)(ws + WS_CTL + 65536) + (k), __builtin_amdgcn_s_memrealtime(), __ATOMIC_RELAXED, __HIP_MEMORY_SCOPE_AGENT); } while (0)
#define PHASE(k, ...) if (IN(k)) { __VA_ARGS__; SEAM(); TS_STAMP((k) + 1); }
#else
#define PHASE(k, ...) if (IN(k)) { __VA_ARGS__; if ((k) == REP_PH || (k) == REP_PH2) { __syncthreads(); __VA_ARGS__; } if (BOTH(k)) SEAM(); }
#endif
#define WSP(T_, off) ((T_*)(ws + (off)))
#ifndef MOE_XCD_ORDER
#define MOE_XCD_ORDER 1
#endif
#if MOE_XCD_ORDER
#define MOE_CU(c) (((c).G % 8 == 0) ? ((c).bid % 8) * ((c).G / 8) + (c).bid / 8 : (c).bid)
#else
#define MOE_CU(c) ((c).bid)
#endif
#define GEMM_STATIC(EPI, A_, B_, N_, K_, ...) do { pg8::Gemm g{A_, B_, T, N_, K_}; pg8::StaticOrder S; S.init(T, N_, c.G, c.bid); EPI E{__VA_ARGS__}; pg8::gemm_phase<EPI, pg8::StaticOrder, GEMM_ALIGN, GEMM_SP2>(c.lds, g, S, E); } while (0)
#define GEMM_MOE(GATH, EPI, A_, B_, N_, K_, ...) do { pg8::Gemm g{A_, B_, MAXROWS, N_, K_}; const unsigned* cnt_ = WSP(unsigned, WS_CTL) + CW_CUR + L * 32; pg8::MoeOrder<GATH> S{(N_) / 256, c.G, MOE_CU(c), __builtin_amdgcn_readfirstlane(pg8::MoeOrder<GATH>::tiles(cnt_)), cnt_, (size_t)(N_) * (K_) * 2, WSP(int, WS_RM2), (LAS int*)(c.lds + LDSCTL_OFF + 5120)}; EPI E{__VA_ARGS__}; pg8::gemm_phase<EPI, pg8::MoeOrder<GATH>, GEMM_ALIGN, true>(c.lds, g, S, E); } while (0)
enum { P_PRO = 0, P_QKV, P_ATTA, P_ATTB, P_WO, P_MOE0, P_WIN = P_MOE0 + 4, P_CONV, P_CELL, P_HN, P_WOUT, P_MOE1, P_END = P_MOE1 + 4 };
static_assert(P_END == NPHASE, "phase count");
constexpr int TAIL_E = 9;
__device__ __forceinline__ bool tail_share(const Ctx& c, int units, int& j, int& n) {
    const int R = (units + c.G - 1) / c.G, nlast = units - (R - 1) * c.G, cu = MOE_CU(c); n = c.G - nlast;
    if (n < 64) { j = c.bid; n = c.G; return true; }
    j = cu - nlast; return cu >= nlast; }
template <int L>
__device__ __forceinline__ void moe_block(const Ctx& c, const Args& args, unsigned char* ws, const int lo, const int hi, const XcdBarrier& bar, const int base) {
    (void)bar; (void)lo; (void)hi;
    PHASE(base + 0, ln_pass<0, 1, false>(c, WSP(bf16, WS_PRE), nullptr, nullptr, WSP(bf16, WS_XB), args.in[9] + L * D, args.in[10] + L * D, args.in[13], 16, 0, args.in[14], WSP(int, WS_RM2), WSP(float, WS_EGATE), WSP(unsigned, WS_CTL) + CW_CUR + L * 32, nullptr))
    PHASE(base + 1, GEMM_MOE(true, pg8::EpiSwiGLU, WSP(bf16, WS_XB), WSP(bf16, WS_WGU), GU_N, D, WSP(bf16, WS_H));
        if (L == 0) { int j_, n_; __syncthreads(); if (tail_share(c, pg8::MoeOrder<true>::tiles(WSP(unsigned, WS_CTL) + CW_CUR) * (GU_N / 256), j_, n_)) {
            conv_moe(c, args.in[15], args.in[16], args.in[17], WSP(bf16, WS_WGU), WSP(bf16, WS_WD), j_ * NWAVES + c.wave, n_ * NWAVES, 2 * NE * 768 + TAIL_E * 768, 2 * NE * 768);
            conv_job(c, args.in[8], D, D, D, WSP(bf16, WS_WOUT), j_ * NWAVES + c.wave, n_ * NWAVES); } })
#ifdef DOWN_NOSTORE_PROBE
    if (IN(base + 2)) { GEMM_MOE(false, pg8::EpiDownT<false>, WSP(bf16, WS_H), WSP(bf16, WS_WD), D, DE, WSP(unsigned char, WS_YB), (const LAS int*)(c.lds + LDSCTL_OFF + 5120)); __syncthreads(); }
#endif
    PHASE(base + 2, GEMM_MOE(false, pg8::EpiDown, WSP(bf16, WS_H), WSP(bf16, WS_WD), D, DE, WSP(unsigned char, WS_YB), (const LAS int*)(c.lds + LDSCTL_OFF + 5120));
        if (L == 0) { int j_, n_; __syncthreads(); if (tail_share(c, pg8::MoeOrder<true>::tiles(WSP(unsigned, WS_CTL) + CW_CUR) * (D / 256), j_, n_))
            conv_job(c, args.in[3], ZLD, D, ZN, WSP(bf16, WS_WIN), j_ * NWAVES + c.wave, n_ * NWAVES); })
    if (L == 0) { PHASE(base + 3, ln_pass<1, 2, false>(c, nullptr, nullptr, WSP(bf16, WS_YB), WSP(bf16, WS_XB), args.in[11], args.in[12], args.in[3], ZLD, ZN, args.in[4], nullptr, WSP(float, WS_EGATE), nullptr, WSP(float, WS_GATES))) }
    else { PHASE(base + 3, ln_pass<1, 0, true>(c, nullptr, args.out, WSP(bf16, WS_YB), WSP(bf16, WS_XB), args.in[11] + D, args.in[12] + D, nullptr, 0, 0, nullptr, nullptr, WSP(float, WS_EGATE), nullptr, nullptr)) }
}
__global__ void __launch_bounds__(NTHR, 2) fwd(Args args) {
    extern __shared__ __attribute__((aligned(16))) unsigned char lds_raw[];
    Ctx c; c.lds = (LAS unsigned char*)lds_raw; c.tid = threadIdx.x; c.lane = c.tid & 63; c.wave = __builtin_amdgcn_readfirstlane(c.tid >> 6);
    c.G = gridDim.x; c.bid = blockIdx.x; c.gw = c.bid * NWAVES + c.wave; c.ngw = c.G * NWAVES; c.gtid = c.bid * NTHR + c.tid; c.ngt = c.G * NTHR;
    unsigned char* ws = args.ws;
    ((LAS unsigned*)(c.lds + LDSCTL_OFF))[c.tid] = 0u;
    __syncthreads();
#if MK_ONE_LAUNCH
    XcdBarrier bar = xcd_barrier_post((unsigned*)(ws + WS_CTL) + CW_BAR, (volatile LAS unsigned*)(c.lds + LDSCTL_OFF + LC_BAR));
#else
    XcdBarrier bar; bar.bar = nullptr; bar.x = 0; bar.st = nullptr;
#endif
    const int lo = args.ph_lo, hi = args.ph_hi; (void)lo; (void)hi;
#ifdef TS_PROBE
    SEAM(); TS_STAMP(0);
#endif
    PHASE(P_PRO, conv_job(c, args.in[1], QKV_N, D, QKV_N, WSP(bf16, WS_WQKV), c.gw, c.ngw); conv_job(c, args.in[2], D, OD, D, WSP(bf16, WS_WO), c.gw, c.ngw);
        conv_moe(c, args.in[15], args.in[16], args.in[17], WSP(bf16, WS_WGU), WSP(bf16, WS_WD), c.gw, c.ngw, 2 * NE * 768);
        conv_moe(c, args.in[15], args.in[16], args.in[17], WSP(bf16, WS_WGU), WSP(bf16, WS_WD), c.gw, c.ngw, 3 * NE * 768, 2 * NE * 768 + TAIL_E * 768);
        x_to_bf16(c, args.in[0], WSP(bf16, WS_XB)); rope_table(c, WSP(f32x2, WS_ROPE)))
    PHASE(P_QKV, GEMM_STATIC(pg8::EpiQKV, WSP(bf16, WS_XB), WSP(bf16, WS_WQKV), QKV_N, D, WSP(bf16, WS_QKV), QKV_N, WSP(const float, WS_ROPE)))
    PHASE(P_ATTA, att::attn_phase<false>(c, WSP(const bf16, WS_QKV), WSP(bf16, WS_XB), WSP(float, WS_GATES), nullptr))
    PHASE(P_ATTB, att::attn_phase<true>(c, WSP(const bf16, WS_QKV), WSP(bf16, WS_XB), WSP(float, WS_GATES), WSP(bf16, WS_O)))
    PHASE(P_WO, GEMM_STATIC(pg8::EpiRes<true>, WSP(bf16, WS_O), WSP(bf16, WS_WO), D, OD, args.in[0], WSP(bf16, WS_PRE), D, ALPHA))
    moe_block<0>(c, args, ws, lo, hi, bar, P_MOE0);
    PHASE(P_WIN, GEMM_STATIC(pg8::EpiStoreFp8, WSP(bf16, WS_XB), WSP(bf16, WS_WIN), ZN, D, WSP(unsigned char, WS_Z), ZN))
    PHASE(P_CONV, conv_pass(c, WSP(const unsigned char, WS_Z), args.in[5], args.in[6], WSP(bf16, WS_QKC)))
    PHASE(P_CELL,
#if defined(MLS_SKIP)
        mls::mlstm_phase<MLS_SKIP>(c, WSP(const bf16, WS_QKC), WSP(const unsigned char, WS_Z), WSP(const float, WS_GATES), WSP(bf16, WS_HC)); __syncthreads();
#endif
        mls::mlstm_phase<0>(c, WSP(const bf16, WS_QKC), WSP(const unsigned char, WS_Z), WSP(const float, WS_GATES), WSP(bf16, WS_HC));
#if 0
        mls::mlstm_phase<0>(c, WSP(const bf16, WS_QKC), WSP(const unsigned char, WS_Z), WSP(const float, WS_GATES), WSP(bf16, WS_HC));
#endif
        if (c.G > 128) { if (c.bid >= 128) conv_moe(c, args.in[15] + (size_t)NE * D * DE, args.in[16] + (size_t)NE * D * DE, args.in[17] + (size_t)NE * D * DE, WSP(bf16, WS_WGU), WSP(bf16, WS_WD), (c.bid - 128) * NWAVES + c.wave, (c.G - 128) * NWAVES); }
        else conv_moe(c, args.in[15] + (size_t)NE * D * DE, args.in[16] + (size_t)NE * D * DE, args.in[17] + (size_t)NE * D * DE, WSP(bf16, WS_WGU), WSP(bf16, WS_WD), c.gw, c.ngw);
        )
    PHASE(P_HN, headnorm_pass(c, WSP(const bf16, WS_HC), WSP(const unsigned char, WS_Z), args.in[7], WSP(bf16, WS_Y)))
    PHASE(P_WOUT, GEMM_STATIC(pg8::EpiRes<false>, WSP(bf16, WS_Y), WSP(bf16, WS_WOUT), D, D, WSP(bf16, WS_XB), WSP(bf16, WS_PRE), D, ALPHA))
    moe_block<1>(c, args, ws, lo, hi, bar, P_MOE1);
#ifdef TS_PROBE
    {
        SEAM();
        const unsigned long long* ts = (const unsigned long long*)(ws + WS_CTL + 65536);
        const unsigned long long t0 = __hip_atomic_load(ts + TS_PROBE, __ATOMIC_RELAXED, __HIP_MEMORY_SCOPE_AGENT), t1 = __hip_atomic_load(ts + TS_PROBE + 1, __ATOMIC_RELAXED, __HIP_MEMORY_SCOPE_AGENT), t2 = __hip_atomic_load(ts + TS_PROBE + 2, __ATOMIC_RELAXED, __HIP_MEMORY_SCOPE_AGENT);
        const float k1 = (float)(t1 - t0) * 0.001f;
        const float k2 = (TS_PROBE + 2 <= NPHASE) ? (float)(t2 - t1) * 10.0f : 0.f;
        for (size_t i = c.gtid; i < (size_t)T * D; i += c.ngt) args.out[i] = k1;
        SEAM();
        if (c.gtid == 0) args.out[0] = k2;
    }
#endif
}
#undef IN
#undef BOTH

extern "C" void kernel_launch(void* const* d_in, const int* in_sizes, int n_in, void* d_out, int out_size, void* d_ws, size_t ws_size, hipStream_t stream) {
    static int grid = 0;
    if (grid == 0) {
        if (n_in != 18 || in_sizes[0] != T * D || out_size != T * D || ws_size < WS_END) { fprintf(stderr, "kernel_launch: unexpected shapes (n_in %d, in0 %d, out %d, ws %zu)\n", n_in, n_in > 0 ? in_sizes[0] : -1, out_size, ws_size); grid = -1; return; }
        int dev = 0, cus = 0;
        if (hipGetDevice(&dev) != hipSuccess || hipDeviceGetAttribute(&cus, hipDeviceAttributeMultiprocessorCount, dev) != hipSuccess) { grid = -1; return; }
        if (hipFuncSetAttribute((const void*)fwd, hipFuncAttributeMaxDynamicSharedMemorySize, LDS_BYTES) != hipSuccess) { fprintf(stderr, "kernel_launch: hipFuncSetAttribute failed\n"); grid = -1; return; }
        int per_cu = 0;
        if (hipOccupancyMaxActiveBlocksPerMultiprocessor(&per_cu, (const void*)fwd, NTHR, LDS_BYTES) != hipSuccess || per_cu < 1) fprintf(stderr, "kernel_launch: occupancy query says %d\n", per_cu);
        (void)hipGetLastError();
        grid = cus > 256 ? 256 : cus;
    }
    if (grid < 0) return;
    (void)hipMemsetAsync((char*)d_ws + WS_CTL, 0, CTL_ZERO_BYTES, stream);
    Args a{};
    for (int i = 0; i < 18; ++i) a.in[i] = (const float*)d_in[i];
    a.out = (float*)d_out; a.ws = (unsigned char*)d_ws;
#if MK_ONE_LAUNCH
    a.ph_lo = 0; a.ph_hi = NPHASE;
    hipLaunchKernelGGL(fwd, dim3(grid), dim3(NTHR), LDS_BYTES, stream, a);
#else
    for (int p = 0; p < NPHASE; ++p) { a.ph_lo = p; a.ph_hi = p + 1; hipLaunchKernelGGL(fwd, dim3(grid), dim3(NTHR), LDS_BYTES, stream, a); }
#endif
}
```

```cpp
#include <hip/hip_runtime.h>
#include <cstdio>
#include <cstdint>
namespace pg8 {
#define PG8_LAS __attribute__((address_space(3)))
typedef unsigned short bf16_t;
typedef short bf16x8 __attribute__((ext_vector_type(8)));
typedef float f32x4 __attribute__((ext_vector_type(4)));
typedef unsigned u32x4 __attribute__((ext_vector_type(4)));
constexpr int BM = 256, BK = 64, HALF = 128, HTB = HALF * BK * 2  , STAGE_BYTES = 8 * HTB, NXCD = 8, WGM = 8;

__host__ __device__ __forceinline__ int lds_byte(int r, int c) { const int st = (r >> 4) * 2 + (c >> 5), rr = r & 15, cc = c & 31, ob = rr * 64 + cc * 2; return st * 1024 + (ob ^ (((ob >> 9) & 1) << 5)); }
__host__ __device__ __forceinline__ void stage_rc(int b, int& R, int& C) { const int st = b / 1024, sb = b % 1024, swz = sb ^ (((sb >> 9) & 1) << 5); R = (st >> 1) * 16 + swz / 64; C = (st & 1) * 32 + (swz % 64) / 2; }
__host__ __device__ __forceinline__ int perm32(int rho) { const int n = rho >> 4, i = rho & 15; return 8 * (i >> 2) + 4 * n + (i & 3); }

struct Unit { int pm, pn, ui; };
struct Gemm { const bf16_t* A; const bf16_t* Bt; int M, N, K; };

struct StaticOrder {
    int nM, nN, nwg, G, c;
    __host__ __device__ void init(int M, int N, int G_, int c_) { nM = M / BM; nN = N / BM; nwg = nM * nN; G = G_; c = c_; }
    __host__ __device__ bool next(int i, Unit& u) const {
        const long L = (long)i * G + c; if (L >= nwg) return false;
        int wgid = (int)L; { const int q = nwg / NXCD, r = nwg % NXCD, xcd = wgid % NXCD, off = wgid / NXCD; wgid = (xcd < r ? xcd * (q + 1) : r * (q + 1) + (xcd - r) * q) + off; }
        const int nig = WGM * nN, gid = wgid / nig, fm = gid * WGM, gsz = (nM - fm) < WGM ? (nM - fm) : WGM;
        u.pm = fm + ((wgid % nig) % gsz); u.pn = (wgid % nig) / gsz; u.ui = i; return true;
    }
    __device__ __forceinline__ const char* pa(const Gemm& g, const Unit& u) const { return (const char*)g.A + (size_t)u.pm * ((size_t)BM * g.K * 2); }
    __device__ __forceinline__ const char* pb(const Gemm& g, const Unit& u) const { return (const char*)g.Bt + (size_t)u.pn * ((size_t)BM * g.K * 2); }
    static constexpr bool GATHER = false;
    __device__ __forceinline__ void prep() const {}
    __device__ __forceinline__ void aoffs(int, int, int, unsigned (&)[2][2]) const {}
    __device__ __forceinline__ void a_ready(const Unit&) const {}
    __device__ __forceinline__ void done(const Unit&) const {}
};

__device__ __forceinline__ unsigned cvt_pk_bf16(float lo, float hi) { unsigned r; asm volatile("v_cvt_pk_bf16_f32 %0, %1, %2" : "=v"(r) : "v"(lo), "v"(hi)); return r; }
typedef float f32x2 __attribute__((ext_vector_type(2)));
template <class Epi, class Sched, bool ALIGN_EPI = false, bool SP2 = false>
__device__ __forceinline__ void gemm_phase(PG8_LAS unsigned char* lds, const Gemm g, const Sched& S, const Epi& E) {
    const int tid = threadIdx.x, wid = __builtin_amdgcn_readfirstlane(tid >> 6), lane = tid & 63, wr = wid >> 2, wc = wid & 3, fr = lane & 15, fq = lane >> 4;
    const int K = g.K, nt = K / BK;
    unsigned voffA[2], voffB[2];
#pragma unroll
    for (int i = 0; i < 2; ++i) { int R, C; stage_rc(tid * 16 + i * 8192, R, C); const int Rb = Epi::PERM ? ((R & ~31) + perm32(R & 31)) : R;
        voffA[i] = (unsigned)(R * K + C) * 2u; voffB[i] = (unsigned)(((int)Epi::WIDE == 2 ? ((R >> 5) * 64 + 16 * (perm32(R & 31) >> 3) + (perm32(R & 31) & 7)) : (int)Epi::WIDE == 1 ? ((R >> 5) * 64 + perm32(R & 31)) : Rb) * K + C) * 2u; }
    const size_t kstep = (size_t)(BK * 2);
    const size_t hstep = (size_t)HALF * K * 2;
    const size_t hstepB = (int)Epi::WIDE == 2 ? (size_t)8 * K * 2 : (int)Epi::WIDE == 1 ? (size_t)32 * K * 2 : hstep;
    const size_t tstep = 2 * hstep;
    const unsigned ldsw = (unsigned)wid * 1024u;
    const int aoff = lds_byte(wr * 64 + fr, fq * 8), boff = lds_byte(wc * 32 + fr, fq * 8);
#define PG8_SA(b, h) (((b) * 2 + (h)) * HTB)
#define PG8_SB(b, h) ((4 + (b) * 2 + (h)) * HTB)
#define PG8_STAGE(bufoff, gbase, voff) do { _Pragma("unroll") for (int _i = 0; _i < 2; ++_i) \
        __builtin_amdgcn_global_load_lds((const unsigned*)((const char*)(gbase) + (voff)[_i]), (PG8_LAS unsigned*)(lds + (bufoff) + ldsw + _i * 8192), 16, 0, 0); } while (0)
#define PG8_STAGE_A(bufoff, kptr, half, NXT) do { if constexpr (Sched::GATHER) { const unsigned vx_[2] = {(NXT) ? van[half][0] : va[half][0], (NXT) ? van[half][1] : va[half][1]}; PG8_STAGE(bufoff, kptr, vx_); } \
        else { PG8_STAGE(bufoff, (kptr) + ((half) ? hstep : 0), voffA); } } while (0)
#define PG8_LDA(dst, b, h) do { _Pragma("unroll") for (int m = 0; m < 4; ++m) _Pragma("unroll") for (int k = 0; k < 2; ++k) dst[m][k] = *(const PG8_LAS bf16x8*)(lds + PG8_SA(b, h) + aoff + m * 2048 + k * 1024); } while (0)
#define PG8_LDB(dst, b, h) do { _Pragma("unroll") for (int n = 0; n < 2; ++n) _Pragma("unroll") for (int k = 0; k < 2; ++k) dst[n][k] = *(const PG8_LAS bf16x8*)(lds + PG8_SB(b, h) + boff + n * 2048 + k * 1024); } while (0)
#define PG8_MMA(ai, bj, At, Bt) do { __builtin_amdgcn_s_setprio(1); _Pragma("unroll") for (int m = 0; m < 4; ++m) _Pragma("unroll") for (int n = 0; n < 2; ++n) _Pragma("unroll") for (int k = 0; k < 2; ++k) \
        acc[ai][bj][m][n] = __builtin_amdgcn_mfma_f32_16x16x32_bf16(Bt[n][k], At[m][k], acc[ai][bj][m][n], 0, 0, 0); __builtin_amdgcn_s_setprio(0); } while (0)
#define PG8_WAIT_V(n) asm volatile("s_waitcnt vmcnt(" #n ")" ::: "memory")
#define PG8_WAIT_L(n) asm volatile("s_waitcnt lgkmcnt(" #n ")" ::: "memory")
#define PG8_BAR __builtin_amdgcn_s_barrier()
#define PG8_SCHED __builtin_amdgcn_sched_barrier(0)
    Unit cur, nxt; int ui = 0;
    if (!S.next(0, cur)) return;
    S.prep();
    f32x4 acc[2][2][4][2];
#pragma unroll
    for (int a = 0; a < 2; ++a)
#pragma unroll
        for (int b = 0; b < 2; ++b)
#pragma unroll
            for (int m = 0; m < 4; ++m)
#pragma unroll
                for (int n = 0; n < 2; ++n) acc[a][b][m][n] = (f32x4){0.f, 0.f, 0.f, 0.f};
    bf16x8 At[4][2], B0[2][2], B1[2][2];
    const char* cA = S.pa(g, cur); const char* cB = S.pb(g, cur);
    unsigned va[2][2] = {{0u, 0u}, {0u, 0u}}, van[2][2] = {{0u, 0u}, {0u, 0u}};
    static_assert(SP2 || !Epi::WIDE, "WIDE epilogues: SP2 loop only");
    if constexpr (Sched::GATHER) { static_assert(SP2, "gathered A rows: SP2 loop only"); S.aoffs(0, K, tid, va); }
    S.a_ready(cur);
    if constexpr (SP2) {
        PG8_STAGE(PG8_SB(0, 0), cB, voffB); PG8_STAGE(PG8_SB(0, 1), cB + hstepB, voffB); PG8_STAGE_A(PG8_SA(0, 0), cA, 0, false); PG8_STAGE_A(PG8_SA(0, 1), cA, 1, false);
        if (wr == 1) PG8_BAR;
        PG8_WAIT_V(2); PG8_BAR;
        PG8_STAGE(PG8_SB(1, 0), cB + kstep, voffB); PG8_STAGE_A(PG8_SA(1, 0), cA + kstep, 0, false); PG8_STAGE(PG8_SB(1, 1), cB + hstepB + kstep, voffB);
        PG8_WAIT_V(6); PG8_BAR;
    } else {
        PG8_STAGE(PG8_SB(0, 0), cB, voffB); PG8_STAGE(PG8_SA(0, 0), cA, voffA); PG8_STAGE(PG8_SB(0, 1), cB + hstep, voffB); PG8_STAGE(PG8_SA(0, 1), cA + hstep, voffA);
        if (wr == 1) PG8_BAR;
        PG8_WAIT_V(4); PG8_BAR;
        PG8_STAGE(PG8_SB(1, 0), cB + kstep, voffB); PG8_STAGE(PG8_SA(1, 0), cA + kstep, voffA); PG8_STAGE(PG8_SB(1, 1), cB + hstep + kstep, voffB);
        PG8_WAIT_V(6); PG8_BAR;
    }
    for (;;) {
        const bool has_next = S.next(ui + 1, nxt);
        if constexpr (Sched::GATHER) { if (has_next) S.aoffs(ui + 1, K, tid, van); else { van[0][0] = va[0][0]; van[0][1] = va[0][1]; van[1][0] = va[1][0]; van[1][1] = va[1][1]; } }
        const char* nA = has_next ? S.pa(g, nxt) : cA; const char* nB = has_next ? S.pb(g, nxt) : cB;
        for (int t = 0; t < nt; t += 2) {
            const bool last = (t == nt - 2);
            const char* a1 = cA + (size_t)(t + 1) * kstep;
            const char* a2 = last ? nA : cA + (size_t)(t + 2) * kstep; const char* b2 = last ? nB : cB + (size_t)(t + 2) * kstep;
            const char* a3 = a2 + kstep; const char* b3 = b2 + kstep;
            if (last && has_next) S.a_ready(nxt);
            if constexpr (SP2) {
            PG8_LDB(B0, 0, 0); PG8_LDB(B1, 0, 1); PG8_SCHED; PG8_LDA(At, 0, 0); PG8_STAGE_A(PG8_SA(1, 1), a1, 1, false);
            PG8_WAIT_V(8); PG8_WAIT_L(0); PG8_BAR; PG8_MMA(0, 0, At, B0); PG8_MMA(0, 1, At, B1); PG8_BAR; PG8_SCHED;
            PG8_LDA(At, 0, 1); PG8_STAGE(PG8_SB(0, 0), b2, voffB); PG8_STAGE(PG8_SB(0, 1), b2 + hstepB, voffB); PG8_STAGE_A(PG8_SA(0, 0), a2, 0, last);
            PG8_WAIT_V(8); PG8_WAIT_L(0); PG8_BAR; PG8_MMA(1, 0, At, B0); PG8_MMA(1, 1, At, B1); PG8_BAR; PG8_SCHED;
            PG8_LDB(B0, 1, 0); PG8_LDB(B1, 1, 1); PG8_SCHED; PG8_LDA(At, 1, 0); PG8_STAGE_A(PG8_SA(0, 1), a2, 1, last);
            PG8_WAIT_V(8); PG8_WAIT_L(0); PG8_BAR; PG8_MMA(0, 0, At, B0); PG8_MMA(0, 1, At, B1); PG8_BAR; PG8_SCHED;
            PG8_LDA(At, 1, 1); PG8_STAGE(PG8_SB(1, 0), b3, voffB); PG8_STAGE(PG8_SB(1, 1), b3 + hstepB, voffB); PG8_STAGE_A(PG8_SA(1, 0), a3, 0, last);
            PG8_WAIT_V(8); PG8_WAIT_L(0); PG8_BAR; PG8_MMA(1, 0, At, B0); PG8_MMA(1, 1, At, B1); PG8_BAR; PG8_SCHED;
            } else {
            PG8_LDB(B0, 0, 0); PG8_SCHED; PG8_LDA(At, 0, 0); PG8_STAGE(PG8_SA(1, 1), a1 + hstep, voffA);
            PG8_WAIT_L(8); PG8_BAR; PG8_WAIT_L(0); PG8_MMA(0, 0, At, B0); PG8_BAR; PG8_SCHED;
            PG8_LDB(B1, 0, 1); PG8_STAGE(PG8_SB(0, 0), b2, voffB);
            PG8_BAR; PG8_WAIT_L(0); PG8_MMA(0, 1, At, B1); PG8_BAR;
            PG8_LDA(At, 0, 1); PG8_STAGE(PG8_SA(0, 0), a2, voffA);
            PG8_BAR; PG8_WAIT_L(0); PG8_MMA(1, 0, At, B0); PG8_BAR; PG8_SCHED;
            PG8_STAGE(PG8_SB(0, 1), b2 + hstep, voffB);
            PG8_WAIT_V(6); PG8_BAR; PG8_MMA(1, 1, At, B1); PG8_BAR;
            PG8_LDB(B0, 1, 0); PG8_SCHED; PG8_LDA(At, 1, 0); PG8_STAGE(PG8_SA(0, 1), a2 + hstep, voffA);
            PG8_WAIT_L(8); PG8_BAR; PG8_WAIT_L(0); PG8_MMA(0, 0, At, B0); PG8_BAR; PG8_SCHED;
            PG8_LDB(B1, 1, 1); PG8_STAGE(PG8_SB(1, 0), b3, voffB);
            PG8_BAR; PG8_WAIT_L(0); PG8_MMA(0, 1, At, B1); PG8_BAR;
            PG8_LDA(At, 1, 1); PG8_STAGE(PG8_SA(1, 0), a3, voffA);
            PG8_BAR; PG8_WAIT_L(0); PG8_MMA(1, 0, At, B0); PG8_BAR; PG8_SCHED;
            PG8_STAGE(PG8_SB(1, 1), b3 + hstep, voffB);
            PG8_WAIT_V(6); PG8_BAR; PG8_MMA(1, 1, At, B1); PG8_BAR;
            }
        }
        if constexpr (ALIGN_EPI) { if (wr == 0) PG8_BAR; }
        if constexpr (!Epi::AFTER_DRAIN) { E(acc, cur, wr, wc, fr, fq); S.done(cur); }
        if (!has_next) break;
#pragma unroll
        for (int a = 0; a < 2; ++a)
#pragma unroll
            for (int b = 0; b < 2; ++b)
#pragma unroll
                for (int m = 0; m < 4; ++m)
#pragma unroll
                    for (int n = 0; n < 2; ++n) acc[a][b][m][n] = (f32x4){0.f, 0.f, 0.f, 0.f};
        cur = nxt; cA = nA; cB = nB; ++ui;
        if constexpr (Sched::GATHER) { va[0][0] = van[0][0]; va[0][1] = van[0][1]; va[1][0] = van[1][0]; va[1][1] = van[1][1]; }
        if constexpr (ALIGN_EPI) { if (wr == 1) PG8_BAR; }
    }
    PG8_WAIT_V(0);
    if constexpr (!ALIGN_EPI) { if (wr == 0) PG8_BAR; }
    PG8_BAR;
    if constexpr (Epi::AFTER_DRAIN) { E.fused(acc, cur, wr, wc, fr, fq, lds, wid, lane); S.done(cur); }
#undef PG8_SA
#undef PG8_SB
#undef PG8_STAGE
#undef PG8_STAGE_A
#undef PG8_LDA
#undef PG8_LDB
#undef PG8_MMA
#undef PG8_WAIT_V
#undef PG8_WAIT_L
#undef PG8_BAR
#undef PG8_SCHED
}
}

#ifndef MK_ONE_LAUNCH
#define MK_ONE_LAUNCH 1
#endif
constexpr int NWAVES = 8, NTHR = 512;
constexpr int BATCH = 16, SEQ = 2048, T = BATCH * SEQ, D = 2048;
constexpr int QKV_N = 9216, NH = 8, HD = 128, OD = NH * HD;
constexpr int ZN = 6144, ZLD = 6160;
constexpr int NE = 16, DE = 768, GU_N = 2 * DE;
constexpr int MAXTILES = 272, MAXROWS = MAXTILES * 256;
constexpr float ALPHA = 1.41421356237309515f;
constexpr float LN_EPS = 1e-5f;
constexpr int NPHASE = 18;
constexpr int ECAP = 32768;

constexpr size_t MiB = 1u << 20, KiB = 1u << 10;
constexpr size_t WS_CTL = 0, CTL_ZERO_BYTES = 256 * KiB;
constexpr size_t WS_ROPE = 1 * MiB;
constexpr size_t WS_EID = 1 * MiB + 256 * KiB;
constexpr size_t WS_EGATE = 1 * MiB + 512 * KiB;
constexpr size_t WS_ROWMAP = 1 * MiB + 768 * KiB;
constexpr size_t WS_HIST = 2 * MiB + 256 * KiB;
constexpr size_t WS_TILEE = 2 * MiB + 320 * KiB;
constexpr size_t WS_GATES = 3 * MiB;
constexpr size_t WS_WQKV = 6 * MiB, WS_WO = 42 * MiB, WS_WIN = 46 * MiB, WS_WOUT = 70 * MiB, WS_WGU = 78 * MiB, WS_WD = 174 * MiB;
constexpr size_t WS_XB = 222 * MiB;
constexpr size_t WS_R = 350 * MiB;
constexpr size_t WS_QKV = WS_R, WS_O = WS_R + 576 * MiB;
constexpr size_t WS_PRE = WS_R, WS_YB = WS_R;
constexpr size_t WS_XG = WS_R + 256 * MiB, WS_H = WS_R + 528 * MiB;
constexpr size_t WS_Z = WS_R, WS_QKC = WS_R + 384 * MiB, WS_HC = WS_R + 512 * MiB, WS_Y = WS_QKC;
constexpr size_t WS_RM2 = 990 * MiB;
constexpr size_t WS_END = 992 * MiB;
static_assert(WS_ROWMAP + (size_t)MAXROWS * 4 <= WS_HIST && WS_H + (size_t)MAXROWS * DE * 2 <= WS_RM2 && WS_RM2 + (size_t)16 * ECAP * 4 <= WS_END && WS_XG + (size_t)MAXROWS * D * 2 <= WS_H, "ws map");
constexpr int CW_TMO = 0, CW_BAR = 4096, CW_CONVQ = 8192, CW_CUR = 12288;

constexpr int RING_BYTES = 131072, LDSCTL_OFF = RING_BYTES, LDS_BYTES = 147456;
constexpr int LC_HIST = 0, LC_BAR = 64;

#define GAS __attribute__((address_space(1)))
#define LAS __attribute__((address_space(3)))
typedef unsigned short bf16;
typedef unsigned u32x4 __attribute__((ext_vector_type(4)));
typedef unsigned u32x2 __attribute__((ext_vector_type(2)));
typedef float f32x4 __attribute__((ext_vector_type(4)));
typedef float f32x2 __attribute__((ext_vector_type(2)));
#define LDS_WAIT() asm volatile("s_waitcnt lgkmcnt(0)" ::: "memory")
__device__ __forceinline__ unsigned f2bf(float f) { unsigned u = __builtin_bit_cast(unsigned, f); return (u + 0x7fffu + ((u >> 16) & 1u)) >> 16; }
__device__ __forceinline__ unsigned pk2(float lo, float hi) { return pg8::cvt_pk_bf16(lo, hi); }
__device__ __forceinline__ float bflo(unsigned u) { return __builtin_bit_cast(float, u << 16); }
__device__ __forceinline__ float bfhi(unsigned u) { return __builtin_bit_cast(float, u & 0xffff0000u); }
__device__ __forceinline__ float bf1(bf16 b) { return __builtin_bit_cast(float, (unsigned)b << 16); }
template <int CTRL> __device__ __forceinline__ float dpp0(float x) { return __builtin_bit_cast(float, __builtin_amdgcn_update_dpp(0, __builtin_bit_cast(int, x), CTRL, 0xf, 0xf, true)); }
template <int CTRL> __device__ __forceinline__ float dppx(float x) { return __builtin_bit_cast(float, __builtin_amdgcn_mov_dpp(__builtin_bit_cast(int, x), CTRL, 0xf, 0xf, true)); }
template <int CTRL, int ROWMASK> __device__ __forceinline__ float dpps(float x) { return __builtin_bit_cast(float, __builtin_amdgcn_update_dpp(__builtin_bit_cast(int, x), __builtin_bit_cast(int, x), CTRL, ROWMASK, 0xf, false)); }
__device__ __forceinline__ float prefix_sum64(float v) {
    v += dpp0<0x111>(v); v += dpp0<0x112>(v); v += dpp0<0x114>(v); v += dpp0<0x118>(v);
    v += __builtin_bit_cast(float, __builtin_amdgcn_update_dpp(0, __builtin_bit_cast(int, v), 0x142, 0xa, 0xf, false));
    v += __builtin_bit_cast(float, __builtin_amdgcn_update_dpp(0, __builtin_bit_cast(int, v), 0x143, 0xc, 0xf, false));
    return v;
}
__device__ __forceinline__ float prefix_max64(float v) {
    v = fmaxf(v, dpps<0x111, 0xf>(v)); v = fmaxf(v, dpps<0x112, 0xf>(v)); v = fmaxf(v, dpps<0x114, 0xf>(v)); v = fmaxf(v, dpps<0x118, 0xf>(v));
    v = fmaxf(v, dpps<0x142, 0xa>(v)); v = fmaxf(v, dpps<0x143, 0xc>(v));
    return v;
}
__device__ __forceinline__ float lane_bcast(float v, int l) { return __builtin_bit_cast(float, __builtin_amdgcn_readlane(__builtin_bit_cast(int, v), l)); }
__device__ __forceinline__ float wave_sum(float v) { return lane_bcast(prefix_sum64(v), 63); }
__device__ __forceinline__ float row16_sum(float v) { v += dppx<0xB1>(v); v += dppx<0x4E>(v); v += dppx<0x141>(v); v += dppx<0x128>(v); return v; }
__device__ __forceinline__ float lane_xor1(float v) { return dppx<0xB1>(v); }
__device__ __forceinline__ float lane_xor32(float v) { auto r = __builtin_amdgcn_permlane32_swap(__builtin_bit_cast(unsigned, v), __builtin_bit_cast(unsigned, v), false, false);
    return __builtin_bit_cast(float, (threadIdx.x & 32) ? r[0] : r[1]); }

#define XB_TMO      128
#define XB_XCNT(j)  (256  + 64 * (j))
#define XB_XSUB(j)  (1280 + 64 * (j))
#define XB_XGEN(j)  (2304 + 64 * (j))
#define XB_TOP      3328
#define XB_TOPGEN   3392
#define XCD_BAR_WORDS 3456
#define XB_SPIN_CAP (1u << 18)
__device__ __forceinline__ unsigned xb_ld(unsigned* p)              { return __hip_atomic_load(p, __ATOMIC_RELAXED, __HIP_MEMORY_SCOPE_AGENT); }
__device__ __forceinline__ unsigned xb_add(unsigned* p, unsigned v) { return __hip_atomic_fetch_add(p, v, __ATOMIC_RELAXED, __HIP_MEMORY_SCOPE_AGENT); }
__device__ __forceinline__ unsigned xb_xcc_id() { return (unsigned)__builtin_amdgcn_s_getreg((3 << 11) | 20) & 0xFu; }
#define XB_SPIN(cond, bar) do { unsigned _sp = 0; while (cond) { __builtin_amdgcn_s_sleep(1); \
    if ((++_sp & 255u) == 0u) { if (xb_ld(&(bar)[XB_TMO])) break; if (_sp > XB_SPIN_CAP) { atomicAdd(&(bar)[XB_TMO], 1u); break; } } } } while (0)
struct XcdBarrier { unsigned* bar; unsigned x; volatile LAS unsigned* st; };
__device__ __forceinline__ XcdBarrier xcd_barrier_post(unsigned* bar, volatile LAS unsigned* st) {
    XcdBarrier b; b.bar = bar; b.x = xb_xcc_id(); b.st = st;
    if (threadIdx.x == 0) (void)xb_add(&bar[XB_XCNT(b.x)], 1u);
    return b;
}
__device__ __forceinline__ void xcd_barrier_complete(unsigned* bar, unsigned x, unsigned& nloc, unsigned& nx) {
    const unsigned G = gridDim.x * gridDim.y * gridDim.z;
    unsigned sum, cnt, mine, sp = 0u;
    for (;;) {
        sum = 0u; cnt = 0u; mine = 0u;
#pragma unroll
        for (unsigned j = 0; j < 16; ++j) { const unsigned c = xb_ld(&bar[XB_XCNT(j)]); sum += c; cnt += (c > 0u) ? 1u : 0u; mine = (j == x) ? c : mine; }
        if (sum == G) break;
        __builtin_amdgcn_s_sleep(1);
        if ((++sp & 255u) == 0u) { if (xb_ld(&bar[XB_TMO])) break; if (sp > XB_SPIN_CAP) { atomicAdd(&bar[XB_TMO], 1u); break; } }
    }
    nloc = mine > 0u ? mine : 1u; nx = cnt > 0u ? cnt : 1u;
}
__device__ __forceinline__ void xcd_barrier(const XcdBarrier& b) {
    asm volatile("s_waitcnt vmcnt(0)" ::: "memory");
    __syncthreads();
    if (threadIdx.x == 0) {
        unsigned* bar = b.bar;
        __builtin_amdgcn_s_waitcnt(0);
        unsigned nloc = b.st[0], nx = b.st[1];
        if (nloc == 0u) { xcd_barrier_complete(bar, b.x, nloc, nx); b.st[0] = nloc; b.st[1] = nx; }
        const unsigned old = xb_add(&bar[XB_XSUB(b.x)], 1u);
        const unsigned gen = old / nloc;
        if (old + 1u == (gen + 1u) * nloc) {
            __builtin_amdgcn_fence(__ATOMIC_RELEASE, "agent");
            asm volatile("s_waitcnt vmcnt(0)" ::: "memory");
            const unsigned og = xb_add(&bar[XB_TOP], 1u);
            const unsigned tg = og / nx;
            if (og + 1u == (tg + 1u) * nx) xb_add(&bar[XB_TOPGEN], 1u);
            else XB_SPIN(xb_ld(&bar[XB_TOPGEN]) == tg, bar);
            __builtin_amdgcn_fence(__ATOMIC_ACQUIRE, "agent");
            xb_add(&bar[XB_XGEN(b.x)], 1u);
            asm volatile("s_waitcnt vmcnt(0)" ::: "memory");
        } else {
            XB_SPIN(xb_ld(&bar[XB_XGEN(b.x)]) == gen, bar);
            __builtin_amdgcn_fence(__ATOMIC_ACQUIRE, "agent");
            asm volatile("s_waitcnt vmcnt(0)" ::: "memory");
        }
    }
    __syncthreads();
}

struct Ctx { LAS unsigned char* lds; int tid, lane, wave, G, bid, gw, ngw, gtid, ngt; };

struct TrDesc { const float* wp; bf16* dst; int ldw, K, row_mul, n0; };
__device__ __forceinline__ void tr_mk(TrDesc& d, const float* W, int ldw, int K, bf16* WT, int row_off, int row_mul, int kb, int nb, int lane) {
    const int k0 = 64 * kb, n0 = 32 * nb; d.wp = W + (size_t)(k0 + (lane >> 5)) * ldw + n0 + (lane & 31); d.dst = WT + (size_t)(row_off + n0 * row_mul) * K + k0; d.ldw = ldw; d.K = K; d.row_mul = row_mul; d.n0 = n0; }
__device__ __forceinline__ void tr_load(const TrDesc& d, float (&tv)[32]) {
#pragma unroll
    for (int i = 0; i < 32; ++i) tv[i] = d.wp[(size_t)(2 * i) * d.ldw]; }
__device__ __forceinline__ int qk_perm(int n) {
    if ((n % 3072) >= 2048) return n;
    const int d = n & 127; int g, e; if (d < 16) { g = d; e = 0; } else if (d < 32) { g = d - 16; e = 1; } else { const int t = d - 32; g = t / 6; e = t - 6 * g + 2; }
    return (n & ~127) + (g >> 2) * 32 + (g & 3) * 8 + e; }
template <bool PQ>
__device__ __forceinline__ void tr_store(const TrDesc& d, const float (&tv)[32], LAS float* scr, int lane) {
#pragma unroll
    for (int i = 0; i < 32; ++i) scr[(2 * i + (lane >> 5)) * 33 + (lane & 31)] = tv[i];
    LDS_WAIT(); asm volatile("" ::: "memory");
    const int c = lane & 7;
#pragma unroll
    for (int j = 0; j < 4; ++j) { const int n = (lane >> 3) + 8 * j; const LAS float* s_ = scr + (8 * c) * 33 + n;
        u32x4 o; o.x = pk2(s_[0 * 33], s_[1 * 33]); o.y = pk2(s_[2 * 33], s_[3 * 33]); o.z = pk2(s_[4 * 33], s_[5 * 33]); o.w = pk2(s_[6 * 33], s_[7 * 33]);
        if (PQ) *(u32x4*)(d.dst + (ptrdiff_t)(qk_perm(d.n0 + n) - d.n0) * d.K + 8 * c) = o;
        else *(u32x4*)(d.dst + (size_t)(n * d.row_mul) * d.K + 8 * c) = o; }
    LDS_WAIT(); asm volatile("" ::: "memory");
}
#define TR_PIPELINE(first_, stride_, end_, MK_) TR_PIPELINE_X(first_, stride_, end_, MK_, false)
#define TR_PIPELINE_X(first_, stride_, end_, MK_, PQ_) do { LAS float* scr_ = (LAS float*)(c.lds + c.wave * 16384); TrDesc cur_, nxt_; float ta_[32], tb_[32]; int it_ = (first_); \
        if (it_ < (end_)) { MK_(cur_, it_); tr_load(cur_, ta_); } \
        for (; it_ < (end_); it_ += (stride_)) { const int itn_ = it_ + (stride_); const bool hn_ = itn_ < (end_); if (hn_) { MK_(nxt_, itn_); tr_load(nxt_, tb_); } \
            tr_store<PQ_>(cur_, ta_, scr_, c.lane); if (hn_) { cur_ = nxt_; _Pragma("unroll") for (int q_ = 0; q_ < 32; ++q_) ta_[q_] = tb_[q_]; } } } while (0)
template <bool PQ = false>
__device__ __forceinline__ void conv_job(const Ctx& c, const float* W, int ldw, int K, int N, bf16* WT, int gw0, int ngw0) {
    const int nblk = N / 32, items = (K / 64) * nblk;
#define MK_JOB(d_, it2_) tr_mk(d_, W, ldw, K, WT, 0, 1, (it2_) / nblk, (it2_) % nblk, c.lane)
    TR_PIPELINE_X(gw0, ngw0, items, MK_JOB, PQ);
#undef MK_JOB
}
constexpr int CONV_MOE_ITEMS = 3 * NE * 768;
__device__ __forceinline__ void conv_moe_mk(TrDesc& d, int it, const float* Wg, const float* Wu, const float* Wd, bf16* WGU, bf16* WD, int lane) {
    constexpr int PER = 768; const int kind = it / (NE * PER), r = it % (NE * PER), e = r / PER, q = r % PER;
    if (kind < 2) tr_mk(d, (kind == 0 ? Wg : Wu) + (size_t)e * D * DE, DE, D, WGU + (size_t)e * GU_N * D, kind, 2, q / 24, q % 24, lane);
    else tr_mk(d, Wd + (size_t)e * DE * D, D, DE, WD + (size_t)e * D * DE, 0, 1, q / 64, q % 64, lane);
}
__device__ __forceinline__ void conv_moe(const Ctx& c, const float* Wg, const float* Wu, const float* Wd, bf16* WGU, bf16* WD, int gw0, int ngw0, int end = CONV_MOE_ITEMS, int start = 0) {
#define MK_MOE(d_, it2_) conv_moe_mk(d_, it2_, Wg, Wu, Wd, WGU, WD, c.lane)
    TR_PIPELINE(start + gw0, ngw0, end, MK_MOE);
#undef MK_MOE
}
__device__ __forceinline__ void x_to_bf16(const Ctx& c, const float* x, bf16* XB) {
    for (size_t i = c.gtid; i < (size_t)T * D / 8; i += c.ngt) { const f32x4 a = ((const f32x4*)x)[2 * i], b = ((const f32x4*)x)[2 * i + 1];
        u32x4 o; o.x = pk2(a.x, a.y); o.y = pk2(a.z, a.w); o.z = pk2(b.x, b.y); o.w = pk2(b.z, b.w); ((u32x4*)XB)[i] = o; }
}
__device__ __forceinline__ void rope_table(const Ctx& c, f32x2* tab) {
    for (int i = c.gtid; i < SEQ * 16; i += c.ngt) { const int pos = i >> 4, j = i & 15;
        const float inv = powf(500000.0f, -(float)j / 16.0f); const float ang = (float)pos * inv;
        tab[i] = (f32x2){cosf(ang), sinf(ang)}; }
}

__device__ __forceinline__ void rope_pass(const Ctx& c, bf16* QKV, const f32x2* tab) {
    for (int idx = c.gtid; idx < T * 48; idx += c.ngt) {
        const int h = idx & 7, s = (idx >> 3) & 1, g = (idx >> 4) % 3, tok = idx / 48, pos = tok & (SEQ - 1);
        u32x4* p = (u32x4*)(QKV + (size_t)tok * QKV_N + g * 3072 + s * 1024 + h * HD);
        u32x4 a0 = p[0], a1 = p[1], b0 = p[2], b1 = p[3];
        const f32x2* tb = tab + pos * 16;
        unsigned x1[8] = {a0.x, a0.y, a0.z, a0.w, a1.x, a1.y, a1.z, a1.w}, x2[8] = {b0.x, b0.y, b0.z, b0.w, b1.x, b1.y, b1.z, b1.w};
        unsigned o1[8], o2[8];
#pragma unroll
        for (int k = 0; k < 8; ++k) { const f32x2 cs0 = tb[2 * k], cs1 = tb[2 * k + 1];
            const float u0 = bflo(x1[k]), u1 = bfhi(x1[k]), v0 = bflo(x2[k]), v1 = bfhi(x2[k]);
            o1[k] = pk2(u0 * cs0.x - v0 * cs0.y, u1 * cs1.x - v1 * cs1.y);
            o2[k] = pk2(v0 * cs0.x + u0 * cs0.y, v1 * cs1.x + u1 * cs1.y); }
        p[0] = (u32x4){o1[0], o1[1], o1[2], o1[3]}; p[1] = (u32x4){o1[4], o1[5], o1[6], o1[7]};
        p[2] = (u32x4){o2[0], o2[1], o2[2], o2[3]}; p[3] = (u32x4){o2[4], o2[5], o2[6], o2[7]};
    }
}

__device__ __forceinline__ void attn_naive(const Ctx& c, const bf16* QKV, bf16* O) {
    const int sub = c.gtid & 3;
    for (int q = c.gtid >> 2; q < T * NH; q += c.ngt >> 2) {
        const int tok = q >> 3, h = q & 7, b = tok >> 11, t = tok & (SEQ - 1);
        float m = -1e30f, l = 0.f; float o[32];
#pragma unroll
        for (int i = 0; i < 32; ++i) o[i] = 0.f;
        for (int g = 0; g < 3; ++g) {
            const int dil = g == 0 ? 1 : (g == 1 ? 4 : 16);
            const u32x4* qp = (const u32x4*)(QKV + (size_t)tok * QKV_N + g * 3072 + h * HD + sub * 32);
            float qf[32];
#pragma unroll
            for (int i = 0; i < 4; ++i) { const u32x4 w = qp[i]; qf[8 * i + 0] = bflo(w.x); qf[8 * i + 1] = bfhi(w.x); qf[8 * i + 2] = bflo(w.y); qf[8 * i + 3] = bfhi(w.y);
                qf[8 * i + 4] = bflo(w.z); qf[8 * i + 5] = bfhi(w.z); qf[8 * i + 6] = bflo(w.w); qf[8 * i + 7] = bfhi(w.w); }
            for (int i = 0; i <= 128; ++i) {
                const int pos = t - dil * i; const bool valid = pos >= 0; const int pc = valid ? pos : t;
                const bf16* rowp = QKV + (size_t)(b * SEQ + pc) * QKV_N + g * 3072 + h * HD + sub * 32;
                const u32x4* kp = (const u32x4*)(rowp + 1024); const u32x4* vp = (const u32x4*)(rowp + 2048);
                float dot = 0.f;
#pragma unroll
                for (int j = 0; j < 4; ++j) { const u32x4 w = kp[j];
                    dot += qf[8 * j + 0] * bflo(w.x) + qf[8 * j + 1] * bfhi(w.x) + qf[8 * j + 2] * bflo(w.y) + qf[8 * j + 3] * bfhi(w.y)
                         + qf[8 * j + 4] * bflo(w.z) + qf[8 * j + 5] * bfhi(w.z) + qf[8 * j + 6] * bflo(w.w) + qf[8 * j + 7] * bfhi(w.w); }
                dot += __shfl_xor(dot, 1); dot += __shfl_xor(dot, 2);
                float s = dot * 0.08838834764831845f; if (!valid) s = -__builtin_inff();
                const float mn = fmaxf(m, s), al = __expf(m - mn), p = __expf(s - mn);
                l = l * al + p; m = mn;
#pragma unroll
                for (int j = 0; j < 4; ++j) { const u32x4 w = vp[j];
                    o[8 * j + 0] = o[8 * j + 0] * al + p * bflo(w.x); o[8 * j + 1] = o[8 * j + 1] * al + p * bfhi(w.x);
                    o[8 * j + 2] = o[8 * j + 2] * al + p * bflo(w.y); o[8 * j + 3] = o[8 * j + 3] * al + p * bfhi(w.y);
                    o[8 * j + 4] = o[8 * j + 4] * al + p * bflo(w.z); o[8 * j + 5] = o[8 * j + 5] * al + p * bfhi(w.z);
                    o[8 * j + 6] = o[8 * j + 6] * al + p * bflo(w.w); o[8 * j + 7] = o[8 * j + 7] * al + p * bfhi(w.w); }
            }
        }
        const float rl = 1.f / l;
        u32x4* op = (u32x4*)(O + (size_t)tok * OD + h * HD + sub * 32);
#pragma unroll
        for (int j = 0; j < 4; ++j) op[j] = (u32x4){pk2(o[8 * j] * rl, o[8 * j + 1] * rl), pk2(o[8 * j + 2] * rl, o[8 * j + 3] * rl), pk2(o[8 * j + 4] * rl, o[8 * j + 5] * rl), pk2(o[8 * j + 6] * rl, o[8 * j + 7] * rl)};
    }
}

template <int SRC, bool FINAL>
__device__ __forceinline__ void ln_row(const Ctx& c, int row, f32x4 (&v)[8], const bf16* PRE, float* OUT, const bf16* YB, bf16* XB, const float* lng, const float* lnb, const float* EG) {
    if (SRC == 0) { const u32x2* p = (const u32x2*)(PRE + (size_t)row * D) + c.lane;
#pragma unroll
        for (int j = 0; j < 8; ++j) { const u32x2 a = p[64 * j]; v[j] = (f32x4){bflo(a.x), bfhi(a.x), bflo(a.y), bfhi(a.y)}; } }
    else { const u32x2* p = (const u32x2*)(XB + (size_t)row * D) + c.lane; const unsigned* y0 = (const unsigned*)((const unsigned char*)YB + (size_t)(2 * row) * D) + c.lane; const unsigned* y1 = y0 + D / 4;
        const float g0 = EG[2 * row] * 0.0625f, g1 = EG[2 * row + 1] * 0.0625f;
#pragma unroll
        for (int j = 0; j < 8; ++j) { const u32x2 xf = p[64 * j]; const int a = (int)y0[64 * j], b = (int)y1[64 * j];
            v[j] = (f32x4){ALPHA * bflo(xf.x) + g0 * __builtin_amdgcn_cvt_f32_fp8(a, 0) + g1 * __builtin_amdgcn_cvt_f32_fp8(b, 0), ALPHA * bfhi(xf.x) + g0 * __builtin_amdgcn_cvt_f32_fp8(a, 1) + g1 * __builtin_amdgcn_cvt_f32_fp8(b, 1),
                           ALPHA * bflo(xf.y) + g0 * __builtin_amdgcn_cvt_f32_fp8(a, 2) + g1 * __builtin_amdgcn_cvt_f32_fp8(b, 2), ALPHA * bfhi(xf.y) + g0 * __builtin_amdgcn_cvt_f32_fp8(a, 3) + g1 * __builtin_amdgcn_cvt_f32_fp8(b, 3)}; } }
    float s = 0.f;
#pragma unroll
    for (int j = 0; j < 8; ++j) s += (v[j].x + v[j].y) + (v[j].z + v[j].w);
    const float mean = wave_sum(s) * (1.f / D); float s2 = 0.f;
#pragma unroll
    for (int j = 0; j < 8; ++j) { v[j] = v[j] - mean; s2 += (v[j].x * v[j].x + v[j].y * v[j].y) + (v[j].z * v[j].z + v[j].w * v[j].w); }
    const float rstd = 1.f / sqrtf(wave_sum(s2) * (1.f / D) + LN_EPS);
    f32x4* xo = (f32x4*)(OUT + (size_t)row * D) + c.lane; u32x2* bo = (u32x2*)(XB + (size_t)row * D) + c.lane;
#pragma unroll
    for (int j = 0; j < 8; ++j) { const f32x4 g = ((const f32x4*)lng)[64 * j + c.lane], b = ((const f32x4*)lnb)[64 * j + c.lane];
        v[j] = v[j] * rstd * g + b; if (FINAL) xo[64 * j] = v[j]; else bo[64 * j] = (u32x2){pk2(v[j].x, v[j].y), pk2(v[j].z, v[j].w)}; }
}
__device__ __forceinline__ float lane_xor16(float v) { auto r = __builtin_amdgcn_permlane16_swap(__builtin_bit_cast(unsigned, v), __builtin_bit_cast(unsigned, v), false, false);
    return __builtin_bit_cast(float, (threadIdx.x & 16) ? r[0] : r[1]); }
__device__ __forceinline__ float reduce16(float (&d)[16], int lane) {
    float a8[8], a4[4], a2[2];
    { const bool up = lane & 32;
#pragma unroll
      for (int e = 0; e < 8; ++e) { const float keep = up ? d[e + 8] : d[e], send = up ? d[e] : d[e + 8]; a8[e] = keep + lane_xor32(send); } }
    { const bool up = lane & 16;
#pragma unroll
      for (int e = 0; e < 4; ++e) { const float keep = up ? a8[e + 4] : a8[e], send = up ? a8[e] : a8[e + 4]; a4[e] = keep + lane_xor16(send); } }
    { const bool up = lane & 8;
#pragma unroll
      for (int e = 0; e < 2; ++e) { const float keep = up ? a4[e + 2] : a4[e], send = up ? a4[e] : a4[e + 2]; a2[e] = keep + dppx<0x128>(send); } }
    float a1; { const bool up = lane & 4; const float keep = up ? a2[1] : a2[0], send = up ? a2[0] : a2[1]; a1 = keep + dppx<0x141>(send); }
    a1 += dppx<0x4E>(a1); a1 += dppx<0xB1>(a1);
    return a1;
}
template <int SRC, int EXTRA, bool FINAL>
__device__ __forceinline__ void ln_pass(const Ctx& c, const bf16* PRE, float* OUT, const bf16* YB, bf16* XB, const float* lng, const float* lnb,
                                        const float* wsrc, int wld, int woff, const float* wbias, int* rowmap2, float* egate, unsigned* cursor, float* gates_out) {
    LAS char* wl = (LAS char*)c.lds;
    LAS int* lh = (LAS int*)(c.lds + LDSCTL_OFF + LC_HIST);
    LAS float* lg = (LAS float*)(c.lds + LDSCTL_OFF + 5120) + c.wave * 256;
    if (EXTRA) {
#pragma unroll 1
        for (int it = 0; it < 4; ++it) { float wv[16];
#pragma unroll
            for (int q = 0; q < 16; ++q) { const int idx = c.tid + NTHR * (16 * it + q); wv[q] = wsrc[(size_t)(idx >> 4) * wld + woff + (idx & 15)]; }
#pragma unroll
            for (int q = 0; q < 16; ++q) { const int idx = c.tid + NTHR * (16 * it + q), k = idx >> 4, e = idx & 15;
                const unsigned hb = f2bf(wv[q]); const float hf = __builtin_bit_cast(float, hb << 16); const unsigned lb = f2bf(wv[q] - hf);
                const int off = e * 4096 + ((((k >> 3) ^ e) & 255) << 4) + (k & 7) * 2;
                *(LAS unsigned short*)(wl + off) = (unsigned short)hb; *(LAS unsigned short*)(wl + 65536 + off) = (unsigned short)lb; } } }
    const int l15 = c.lane & 15, q4 = c.lane >> 4;
    for (int vb = c.bid; vb < 256; vb += c.G) {
        if (EXTRA == 1) { if (c.tid < 16) lh[c.tid] = 0; }
        __syncthreads();
        const int rowb = vb * 128 + c.wave * 16;
        int rt_e1 = 0, rt_e2 = 0, rt_r1 = 0, rt_r2 = 0;
        if (SRC == 0 && !FINAL) {
            f32x4 gv[8], bv[8];
#pragma unroll
            for (int j = 0; j < 8; ++j) { gv[j] = ((const f32x4*)lng)[64 * j + c.lane]; bv[j] = ((const f32x4*)lnb)[64 * j + c.lane]; }
            u32x2 ra[2][8], rn[2][8];
#pragma unroll
            for (int q = 0; q < 2; ++q) { const u32x2* p = (const u32x2*)(PRE + (size_t)(rowb + q) * D) + c.lane;
#pragma unroll
                for (int j = 0; j < 8; ++j) ra[q][j] = p[64 * j]; }
            for (int i = 0; i < 8; ++i) {
                if (i < 7) {
#pragma unroll
                    for (int q = 0; q < 2; ++q) { const u32x2* p = (const u32x2*)(PRE + (size_t)(rowb + 2 * i + 2 + q) * D) + c.lane;
#pragma unroll
                        for (int j = 0; j < 8; ++j) rn[q][j] = p[64 * j]; } }
#pragma unroll
                for (int q = 0; q < 2; ++q) { const int row = rowb + 2 * i + q; f32x4 v[8]; float s_ = 0.f;
#pragma unroll
                    for (int j = 0; j < 8; ++j) { const u32x2 a = ra[q][j]; v[j] = (f32x4){bflo(a.x), bfhi(a.x), bflo(a.y), bfhi(a.y)}; s_ += (v[j].x + v[j].y) + (v[j].z + v[j].w); }
                    const float mean = wave_sum(s_) * (1.f / D); float s2 = 0.f;
#pragma unroll
                    for (int j = 0; j < 8; ++j) { v[j] = v[j] - mean; s2 += (v[j].x * v[j].x + v[j].y * v[j].y) + (v[j].z * v[j].z + v[j].w * v[j].w); }
                    const float rstd = 1.f / sqrtf(wave_sum(s2) * (1.f / D) + LN_EPS);
                    u32x2* bo = (u32x2*)(XB + (size_t)row * D) + c.lane;
#pragma unroll
                    for (int j = 0; j < 8; ++j) { const f32x4 y = v[j] * rstd * gv[j] + bv[j]; bo[64 * j] = (u32x2){pk2(y.x, y.y), pk2(y.z, y.w)}; } }
#pragma unroll
                for (int q = 0; q < 2; ++q)
#pragma unroll
                    for (int j = 0; j < 8; ++j) ra[q][j] = rn[q][j];
            }
        } else if (SRC == 1) {
            f32x4 gv[8], bv[8];
#pragma unroll
            for (int j = 0; j < 8; ++j) { gv[j] = ((const f32x4*)lng)[64 * j + c.lane]; bv[j] = ((const f32x4*)lnb)[64 * j + c.lane]; }
            u32x2 rx[3][8]; unsigned ry0[3][8], ry1[3][8]; float rg0[3], rg1[3];
#define LN_LOAD1(slot_, row_) do { const u32x2* p_ = (const u32x2*)(XB + (size_t)(row_) * D) + c.lane; const unsigned* y0_ = (const unsigned*)((const unsigned char*)YB + (size_t)(2 * (row_)) * D) + c.lane; const unsigned* y1_ = y0_ + D / 4; \
                rg0[slot_] = egate[2 * (row_)] * 0.0625f; rg1[slot_] = egate[2 * (row_) + 1] * 0.0625f; \
                _Pragma("unroll") for (int j = 0; j < 8; ++j) { rx[slot_][j] = p_[64 * j]; ry0[slot_][j] = y0_[64 * j]; ry1[slot_][j] = y1_[64 * j]; } } while (0)
            LN_LOAD1(0, rowb); LN_LOAD1(1, rowb + 1); LN_LOAD1(2, rowb + 2);
            for (int i = 0; i < 16; ++i) { const int row = rowb + i; f32x4 v[8]; float s_ = 0.f; const float g0 = rg0[0], g1 = rg1[0];
#pragma unroll
                for (int j = 0; j < 8; ++j) { const u32x2 xf = rx[0][j]; const int a = (int)ry0[0][j], b = (int)ry1[0][j];
                    v[j] = (f32x4){ALPHA * bflo(xf.x) + g0 * __builtin_amdgcn_cvt_f32_fp8(a, 0) + g1 * __builtin_amdgcn_cvt_f32_fp8(b, 0), ALPHA * bfhi(xf.x) + g0 * __builtin_amdgcn_cvt_f32_fp8(a, 1) + g1 * __builtin_amdgcn_cvt_f32_fp8(b, 1),
                                   ALPHA * bflo(xf.y) + g0 * __builtin_amdgcn_cvt_f32_fp8(a, 2) + g1 * __builtin_amdgcn_cvt_f32_fp8(b, 2), ALPHA * bfhi(xf.y) + g0 * __builtin_amdgcn_cvt_f32_fp8(a, 3) + g1 * __builtin_amdgcn_cvt_f32_fp8(b, 3)};
                    s_ += (v[j].x + v[j].y) + (v[j].z + v[j].w); }
#pragma unroll
                for (int j = 0; j < 8; ++j) { rx[0][j] = rx[1][j]; ry0[0][j] = ry0[1][j]; ry1[0][j] = ry1[1][j]; rx[1][j] = rx[2][j]; ry0[1][j] = ry0[2][j]; ry1[1][j] = ry1[2][j]; }
                rg0[0] = rg0[1]; rg1[0] = rg1[1]; rg0[1] = rg0[2]; rg1[1] = rg1[2];
                if (i + 3 < 16) LN_LOAD1(2, rowb + i + 3);
                const float mean = wave_sum(s_) * (1.f / D); float s2 = 0.f;
#pragma unroll
                for (int j = 0; j < 8; ++j) { v[j] = v[j] - mean; s2 += (v[j].x * v[j].x + v[j].y * v[j].y) + (v[j].z * v[j].z + v[j].w * v[j].w); }
                const float rstd = 1.f / sqrtf(wave_sum(s2) * (1.f / D) + LN_EPS);
                f32x4* xo = (f32x4*)(OUT + (size_t)row * D) + c.lane; u32x2* bo = (u32x2*)(XB + (size_t)row * D) + c.lane;
#pragma unroll
                for (int j = 0; j < 8; ++j) { const f32x4 y = v[j] * rstd * gv[j] + bv[j]; if (FINAL) xo[64 * j] = y; else bo[64 * j] = (u32x2){pk2(y.x, y.y), pk2(y.z, y.w)}; } }
#undef LN_LOAD1
        } else
        for (int i = 0; i < 8; ++i) { f32x4 va[8], vc[8];
            ln_row<SRC, FINAL>(c, rowb + 2 * i, va, PRE, OUT, YB, XB, lng, lnb, egate);
            ln_row<SRC, FINAL>(c, rowb + 2 * i + 1, vc, PRE, OUT, YB, XB, lng, lnb, egate); }
        if (EXTRA) {
            asm volatile("s_waitcnt vmcnt(0)" ::: "memory");
            __builtin_amdgcn_fence(__ATOMIC_ACQUIRE, "agent");
            pg8::f32x4 acc = {0.f, 0.f, 0.f, 0.f};
            const bf16* arow = XB + (size_t)(rowb + l15) * D + 8 * q4; const LAS char* wrow = wl + l15 * 4096;
#pragma unroll 16
            for (int kk = 0; kk < 64; ++kk) { const pg8::bf16x8 a = *(const pg8::bf16x8*)(arow + 32 * kk);
                const int ch = (((4 * kk + q4) ^ l15) & 255) << 4;
                const pg8::bf16x8 bh = *(const LAS pg8::bf16x8*)(wrow + ch), bl = *(const LAS pg8::bf16x8*)(wrow + 65536 + ch);
                acc = __builtin_amdgcn_mfma_f32_16x16x32_bf16(a, bh, acc, 0, 0, 0); acc = __builtin_amdgcn_mfma_f32_16x16x32_bf16(a, bl, acc, 0, 0, 0); }
            const float bias = wbias[l15];
            if (EXTRA == 2) {
#pragma unroll
                for (int r = 0; r < 4; ++r) { float val = acc[r] + bias; if (l15 >= 8) val = fminf(val, 0.f) - log1pf(expf(-fabsf(val))); gates_out[(size_t)(rowb + 4 * q4 + r) * 16 + l15] = val; }
            } else {
#pragma unroll
                for (int r = 0; r < 4; ++r) lg[(4 * q4 + r) * 16 + l15] = acc[r] + bias;
                LDS_WAIT(); asm volatile("" ::: "memory");
                if (c.lane < 16) { const int row = rowb + c.lane; float dot[16];
#pragma unroll
                    for (int q = 0; q < 4; ++q) { const f32x4 t = *(const LAS f32x4*)(lg + 16 * c.lane + 4 * q); dot[4 * q] = t.x; dot[4 * q + 1] = t.y; dot[4 * q + 2] = t.z; dot[4 * q + 3] = t.w; }
                    float mx = dot[0];
#pragma unroll
                    for (int e = 1; e < 16; ++e) mx = fmaxf(mx, dot[e]);
                    float p[16];
#pragma unroll
                    for (int e = 0; e < 16; ++e) p[e] = __expf(dot[e] - mx);
                    float bestsc = -1.f, bp1 = 0.f, bp2 = 0.f; int be1 = 0, be2 = 0;
#pragma unroll
                    for (int g = 0; g < 4; ++g) { const float a0 = p[4 * g], a1 = p[4 * g + 1], a2 = p[4 * g + 2], a3 = p[4 * g + 3];
                        int i1 = 0; float p1 = a0; if (a1 > p1) { p1 = a1; i1 = 1; } if (a2 > p1) { p1 = a2; i1 = 2; } if (a3 > p1) { p1 = a3; i1 = 3; }
                        int i2 = 0; float p2 = -1.f;
                        if (i1 != 0 && a0 > p2) { p2 = a0; i2 = 0; } if (i1 != 1 && a1 > p2) { p2 = a1; i2 = 1; } if (i1 != 2 && a2 > p2) { p2 = a2; i2 = 2; } if (i1 != 3 && a3 > p2) { p2 = a3; i2 = 3; }
                        const float sc = p1 + p2; if (sc > bestsc) { bestsc = sc; be1 = 4 * g + i1; be2 = 4 * g + i2; bp1 = p1; bp2 = p2; } }
                    const float inv = 1.f / (bp1 + bp2); egate[2 * row] = bp1 * inv; egate[2 * row + 1] = bp2 * inv; rt_e1 = be1; rt_e2 = be2;
                    rt_r1 = __hip_atomic_fetch_add(lh + be1, 1, __ATOMIC_RELAXED, __HIP_MEMORY_SCOPE_WORKGROUP); rt_r2 = __hip_atomic_fetch_add(lh + be2, 1, __ATOMIC_RELAXED, __HIP_MEMORY_SCOPE_WORKGROUP); }
            }
        }
        __syncthreads();
        if (EXTRA == 1) {
            LAS int* lbase = (LAS int*)(c.lds + LDSCTL_OFF + 13312);
            if (c.tid < 16) lbase[c.tid] = (int)__hip_atomic_fetch_add(cursor + c.tid, (unsigned)lh[c.tid], __ATOMIC_RELAXED, __HIP_MEMORY_SCOPE_AGENT);
            __syncthreads();
            if (c.lane < 16) { const int row = rowb + c.lane; rowmap2[rt_e1 * ECAP + lbase[rt_e1] + rt_r1] = 2 * row; rowmap2[rt_e2 * ECAP + lbase[rt_e2] + rt_r2] = 2 * row + 1; }
        }
    }
}

__device__ __forceinline__ void gather_rows(const Ctx& c, const bf16* XB, const int* rowmap, const int* tile_e, bf16* XG) {
    const int nrows = tile_e[MAXTILES] * 256;
    for (int r = c.gw; r < nrows; r += c.ngw) { const int a = rowmap[r]; u32x4* dst = (u32x4*)(XG + (size_t)r * D) + c.lane;
        if (a >= 0) { const u32x4* src = (const u32x4*)(XB + (size_t)(a >> 1) * D) + c.lane;
#pragma unroll
            for (int j = 0; j < 4; ++j) dst[64 * j] = src[64 * j]; }
        else {
#pragma unroll
            for (int j = 0; j < 4; ++j) dst[64 * j] = (u32x4){0u, 0u, 0u, 0u}; } }
}

__device__ __forceinline__ void fp8x8_to_f32(u32x2 w, float (&o)[8]) { const int a = (int)w.x, b = (int)w.y;
    o[0] = __builtin_amdgcn_cvt_f32_fp8(a, 0) * 0.0625f; o[1] = __builtin_amdgcn_cvt_f32_fp8(a, 1) * 0.0625f; o[2] = __builtin_amdgcn_cvt_f32_fp8(a, 2) * 0.0625f; o[3] = __builtin_amdgcn_cvt_f32_fp8(a, 3) * 0.0625f;
    o[4] = __builtin_amdgcn_cvt_f32_fp8(b, 0) * 0.0625f; o[5] = __builtin_amdgcn_cvt_f32_fp8(b, 1) * 0.0625f; o[6] = __builtin_amdgcn_cvt_f32_fp8(b, 2) * 0.0625f; o[7] = __builtin_amdgcn_cvt_f32_fp8(b, 3) * 0.0625f; }

constexpr int CONV_ROWS = 16;
__device__ __forceinline__ void conv_pass(const Ctx& c, const unsigned char* Z, const float* cw, const float* cb, bf16* QKC) {
    constexpr int NITEMS = (T / CONV_ROWS) * 256;
    const int c0 = (c.gtid & 255) * 8;
    float w[4][8], bias[8];
#pragma unroll
    for (int j = 0; j < 4; ++j) { const f32x4 w0 = *(const f32x4*)(cw + j * 2048 + c0), w1 = *(const f32x4*)(cw + j * 2048 + c0 + 4); w[j][0] = w0.x; w[j][1] = w0.y; w[j][2] = w0.z; w[j][3] = w0.w; w[j][4] = w1.x; w[j][5] = w1.y; w[j][6] = w1.z; w[j][7] = w1.w; }
    { const f32x4 b0 = *(const f32x4*)(cb + c0), b1 = *(const f32x4*)(cb + c0 + 4); bias[0] = b0.x; bias[1] = b0.y; bias[2] = b0.z; bias[3] = b0.w; bias[4] = b1.x; bias[5] = b1.y; bias[6] = b1.z; bias[7] = b1.w; }
    const float sc = c0 >= 1024 ? 0.08838834764831845f : 1.f;
    u32x2 zr[CONV_ROWS + 3], zn[CONV_ROWS + 3];
#define CONV_LOAD(ZR, idx_) do { const int tok0_ = ((idx_) >> 8) * CONV_ROWS, t0_ = tok0_ & (SEQ - 1); _Pragma("unroll") for (int r = 0; r < CONV_ROWS + 3; ++r) { const int tt = t0_ - 3 + r; ZR[r] = tt >= 0 ? *(const u32x2*)(Z + (size_t)(tok0_ - 3 + r) * ZN + c0) : (u32x2){0u, 0u}; } } while (0)
    if (c.gtid < NITEMS) CONV_LOAD(zr, c.gtid);
    for (int idx = c.gtid; idx < NITEMS; idx += c.ngt) { const int tok0 = (idx >> 8) * CONV_ROWS;
        if (idx + c.ngt < NITEMS) CONV_LOAD(zn, idx + c.ngt);
#pragma unroll
        for (int r = 0; r < CONV_ROWS; ++r) { float acc[8];
#pragma unroll
            for (int k = 0; k < 8; ++k) acc[k] = bias[k];
#pragma unroll
            for (int j = 0; j < 4; ++j) { float zf[8]; fp8x8_to_f32(zr[r + j], zf);
#pragma unroll
                for (int k = 0; k < 8; ++k) acc[k] += zf[k] * w[j][k]; }
#pragma unroll
            for (int k = 0; k < 8; ++k) acc[k] = acc[k] / (1.f + __expf(-acc[k])) * sc;
            *(u32x4*)(QKC + (size_t)(tok0 + r) * 2048 + c0) = (u32x4){pk2(acc[0], acc[1]), pk2(acc[2], acc[3]), pk2(acc[4], acc[5]), pk2(acc[6], acc[7])}; }
#pragma unroll
        for (int r = 0; r < CONV_ROWS + 3; ++r) zr[r] = zn[r];
    }
#undef CONV_LOAD
}
__device__ __forceinline__ void mlstm_naive(const Ctx& c, const bf16* QKC, const bf16* Z, const float* GATES, bf16* HC) {
    LAS float* Qs = (LAS float*)c.lds; LAS float* Ks = Qs + 2048; LAS float* Vs = Ks + 2048; LAS float* LI = Vs + 2048; LAS float* LF = LI + 16; LAS float* DEN = LF + 16; LAS float* MEX = DEN + 16; LAS float* NUM = MEX + 16;
    const bool colthr = c.tid < 128, nthr = (c.wave == 2);
    for (int u = c.bid; u < 256; u += c.G) {
        const int b = u >> 4, h = (u >> 1) & 7, vh = u & 1;
        float C[128];
#pragma unroll
        for (int d = 0; d < 128; ++d) C[d] = 0.f;
        float m = -1e30f;
        for (int grp = 0; grp < 128; ++grp) {
            const int tok0 = b * SEQ + grp * 16;
#pragma unroll
            for (int k = 0; k < 12; ++k) { const int e = c.tid + NTHR * k, which = e >> 11, r = e & 2047, s = r >> 7, d = r & 127;
                const bf16* src = which == 0 ? QKC + (size_t)(tok0 + s) * 2048 + h * 128 + d : (which == 1 ? QKC + (size_t)(tok0 + s) * 2048 + 1024 + h * 128 + d : Z + (size_t)(tok0 + s) * ZN + 2048 + h * 256 + vh * 128 + d);
                Qs[e] = bf1(*src); }
            if (c.tid < 16) { LI[c.tid] = GATES[(size_t)(tok0 + c.tid) * 16 + h]; LF[c.tid] = GATES[(size_t)(tok0 + c.tid) * 16 + 8 + h]; }
            __syncthreads();
            if (colthr || nthr) {
                for (int s = 0; s < 16; ++s) {
                    const float lf = LF[s], li = LI[s], mn = fmaxf(lf + m, li), fd = __expf(lf + m - mn), iw = __expf(li - mn); m = mn;
                    const float vv = nthr ? 1.f : Vs[s * 128 + (c.tid & 127)]; const float kv = iw * vv; float acc = 0.f;
#pragma unroll
                    for (int d4 = 0; d4 < 32; ++d4) { const f32x4 k4 = *(const LAS f32x4*)(Ks + s * 128 + 4 * d4), q4 = *(const LAS f32x4*)(Qs + s * 128 + 4 * d4);
                        C[4 * d4 + 0] = fd * C[4 * d4 + 0] + kv * k4.x; acc += q4.x * C[4 * d4 + 0];
                        C[4 * d4 + 1] = fd * C[4 * d4 + 1] + kv * k4.y; acc += q4.y * C[4 * d4 + 1];
                        C[4 * d4 + 2] = fd * C[4 * d4 + 2] + kv * k4.z; acc += q4.z * C[4 * d4 + 2];
                        C[4 * d4 + 3] = fd * C[4 * d4 + 3] + kv * k4.w; acc += q4.w * C[4 * d4 + 3]; }
                    if (nthr) { if (c.lane == 0) { DEN[s] = acc; MEX[s] = __expf(-mn); } } else NUM[s * 128 + c.tid] = acc;
                }
            }
            __syncthreads();
            if (colthr) {
                for (int s = 0; s < 16; ++s) { const float hv = NUM[s * 128 + c.tid] / fmaxf(fabsf(DEN[s]), MEX[s]);
                    HC[(size_t)(tok0 + s) * 2048 + h * 256 + vh * 128 + c.tid] = (bf16)f2bf(hv); }
            }
        }
        __syncthreads();
    }
}
__device__ __forceinline__ void headnorm_pass(const Ctx& c, const bf16* HC, const unsigned char* Z, const float* ng, bf16* Y) {
    const int half = c.lane >> 5, l32 = c.lane & 31;
    f32x4 ga[4], gb[4];
#pragma unroll
    for (int p = 0; p < 4; ++p) { const float* gp = ng + (2 * p + half) * 256 + 8 * l32; ga[p] = *(const f32x4*)gp; gb[p] = *(const f32x4*)(gp + 4); }
    u32x4 hw[4], hn[4]; u32x2 ow[4], on[4];
#define HN_LOAD(HW, OW, tok_) do { _Pragma("unroll") for (int p = 0; p < 4; ++p) { HW[p] = *(const u32x4*)(HC + (size_t)(tok_) * 2048 + (2 * p + half) * 256 + 8 * l32); OW[p] = *(const u32x2*)(Z + (size_t)(tok_) * ZN + 4096 + (2 * p + half) * 256 + 8 * l32); } } while (0)
    if (c.gw < T) HN_LOAD(hw, ow, c.gw);
    for (int tok = c.gw; tok < T; tok += c.ngw) {
        if (tok + c.ngw < T) HN_LOAD(hn, on, tok + c.ngw);
#pragma unroll
        for (int p = 0; p < 4; ++p) {
            float x[8] = {bflo(hw[p].x), bfhi(hw[p].x), bflo(hw[p].y), bfhi(hw[p].y), bflo(hw[p].z), bfhi(hw[p].z), bflo(hw[p].w), bfhi(hw[p].w)};
            const float ps = prefix_sum64(((x[0] + x[1]) + (x[2] + x[3])) + ((x[4] + x[5]) + (x[6] + x[7]))); const float lo = lane_bcast(ps, 31), al = lane_bcast(ps, 63);
            const float mean = (half ? al - lo : lo) * (1.f / 256.f); float q = 0.f;
#pragma unroll
            for (int k = 0; k < 8; ++k) { x[k] -= mean; q += x[k] * x[k]; }
            const float pq = prefix_sum64(q); const float qlo = lane_bcast(pq, 31), qal = lane_bcast(pq, 63);
            const float rstd = 1.f / sqrtf((half ? qal - qlo : qlo) * (1.f / 256.f) + LN_EPS);
            float o[8]; fp8x8_to_f32(ow[p], o);
            const float gk[8] = {ga[p].x, ga[p].y, ga[p].z, ga[p].w, gb[p].x, gb[p].y, gb[p].z, gb[p].w}; float y[8];
#pragma unroll
            for (int k = 0; k < 8; ++k) y[k] = x[k] * rstd * gk[k] / (1.f + __expf(-o[k]));
            *(u32x4*)(Y + (size_t)tok * 2048 + (2 * p + half) * 256 + 8 * l32) = (u32x4){pk2(y[0], y[1]), pk2(y[2], y[3]), pk2(y[4], y[5]), pk2(y[6], y[7])}; }
#pragma unroll
        for (int p = 0; p < 4; ++p) { hw[p] = hn[p]; ow[p] = on[p]; }
    }
#undef HN_LOAD
}

namespace att {
typedef short bf16x8 __attribute__((ext_vector_type(8)));
typedef short s16x4 __attribute__((ext_vector_type(4)));
typedef float f32x16 __attribute__((ext_vector_type(16)));
constexpr float SCALE = 0.08838834764831845f, THR = 8.f;
constexpr int SHM = 16384;
#define KSWZ(row, colB) ((row) * 256 + ((colB) ^ (((row) & 7) << 4)))
#define SBAR() __builtin_amdgcn_sched_barrier(0)
__device__ __forceinline__ int v_st(int k, int c) { const int kk = (k & ~0xC) | ((k & 4) << 1) | ((k & 8) >> 1); return ((kk >> 3) * 4 + (c >> 5)) * 512 + ((kk & 7) * 32 + (c & 31)) * 2; }
__device__ __forceinline__ int v_rd_base(int lane) { return ((lane & 3) << 3) | (((lane >> 2) & 3) << 6) | (((lane >> 4) & 1) << 5) | (((lane >> 5) & 1) << 8); }
constexpr int v_rd_off(int d0, int ks, int half) { return d0 * 512 + ks * 4096 + half * 2048; }
__device__ __forceinline__ int crow(int r, int hi) { return (r & 3) + 8 * (r >> 2) + 4 * hi; }
__device__ __forceinline__ unsigned cvtpk(float lo, float hi) { unsigned r; asm volatile("v_cvt_pk_bf16_f32 %0, %1, %2" : "=v"(r) : "v"(lo), "v"(hi)); return r; }
__device__ __forceinline__ void mask_tile(f32x16& p0, f32x16& p1, int dq, unsigned W) {
    const float NEG = -__builtin_inff();
#pragma unroll
    for (int r = 0; r < 16; ++r) { const int cc = (r & 3) + 8 * (r >> 2);
        if ((unsigned)(dq - cc) >= W) p0[r] = NEG;
        if ((unsigned)(dq - cc - 32) >= W) p1[r] = NEG; }
}
__device__ __forceinline__ void partialSM(f32x16& p0, f32x16& p1, float& m_reg, float& mn, float& alpha) {
    float pmax = p0[0];
#pragma unroll
    for (int r = 1; r < 16; ++r) pmax = fmaxf(pmax, p0[r]);
#pragma unroll
    for (int r = 0; r < 16; ++r) pmax = fmaxf(pmax, p1[r]);
    { auto rr = __builtin_amdgcn_permlane32_swap(__float_as_uint(pmax), __float_as_uint(pmax), false, false);
      pmax = fmaxf(__uint_as_float(rr[0]), __uint_as_float(rr[1])); }
    constexpr float C2 = 1.4426950408889634f * SCALE;
    if (__builtin_expect(__all((pmax - m_reg) * SCALE <= THR), 1)) { mn = m_reg; alpha = 1.f; }
    else { mn = fmaxf(m_reg, pmax); alpha = __builtin_amdgcn_exp2f((m_reg - mn) * C2); m_reg = mn; }
    const float mnL = -mn * C2;
#pragma unroll
    for (int r = 0; r < 16; ++r) p0[r] = fmaf(p0[r], C2, mnL);
#pragma unroll
    for (int r = 0; r < 16; ++r) p1[r] = fmaf(p1[r], C2, mnL);
#pragma unroll
    for (int r = 0; r < 16; ++r) p0[r] = __builtin_amdgcn_exp2f(p0[r]);
}
__device__ __forceinline__ void finishSM(f32x16& p0, f32x16& p1, float alpha, float& l_reg, bf16x8& pa0, bf16x8& pa1, bf16x8& pa2, bf16x8& pa3) {
#pragma unroll
    for (int r = 0; r < 16; ++r) p1[r] = __builtin_amdgcn_exp2f(p1[r]);
    float ps = 0;
#pragma unroll
    for (int r = 0; r < 16; ++r) ps += p0[r];
#pragma unroll
    for (int r = 0; r < 16; ++r) ps += p1[r];
    { auto rr = __builtin_amdgcn_permlane32_swap(__float_as_uint(ps), __float_as_uint(ps), false, false);
      ps = __uint_as_float(rr[0]) + __uint_as_float(rr[1]); }
    l_reg = l_reg * alpha + ps;
#define PK4(P, B_, OUT) do { unsigned a0 = cvtpk(P[B_+0], P[B_+1]), a1 = cvtpk(P[B_+2], P[B_+3]);                          \
        unsigned b0 = cvtpk(P[B_+4], P[B_+5]), b1 = cvtpk(P[B_+6], P[B_+7]);                                             \
        auto r0 = __builtin_amdgcn_permlane32_swap(a0, b0, false, false); auto r1 = __builtin_amdgcn_permlane32_swap(a1, b1, false, false); \
        u32x4 w = {r0[0], r1[0], r0[1], r1[1]}; OUT = *reinterpret_cast<bf16x8*>(&w); } while (0)
    PK4(p0, 0, pa0); PK4(p0, 8, pa1); PK4(p1, 0, pa2); PK4(p1, 8, pa3);
#undef PK4
}
template <int KB>
__device__ __forceinline__ void qkt(f32x16& p0, f32x16& p1, const LAS char* K_lds, int r32, int hi, const bf16x8* qr) {
    p0 = f32x16{}; p1 = f32x16{};
    const LAS char* kb[4];
#pragma unroll
    for (int dd = 0; dd < 4; ++dd) kb[dd] = K_lds + KB * SHM + KSWZ(r32, (dd * 16 + hi * 8) * 2);
#pragma unroll
    for (int d0 = 0; d0 < 8; ++d0) { const LAS char* a = kb[d0 & 3] + (d0 >> 2) * 128;
        bf16x8 b0 = *reinterpret_cast<const LAS bf16x8*>(a);
        bf16x8 b1 = *reinterpret_cast<const LAS bf16x8*>(a + 32 * 256);
        p0 = __builtin_amdgcn_mfma_f32_32x32x16_bf16(b0, qr[d0], p0, 0, 0, 0);
        p1 = __builtin_amdgcn_mfma_f32_32x32x16_bf16(b1, qr[d0], p1, 0, 0, 0); }
}
template <int VB>
__device__ __forceinline__ void pv_tile(f32x16* o, int vb0, bf16x8 pa0, bf16x8 pa1, bf16x8 pa2, bf16x8 pa3) {
#define TRRD(dst, off) asm volatile("ds_read_b64_tr_b16 %0, %1 offset:%2" : "=&v"(dst) : "v"(vb0), "i"(off) : "memory")
#define PV_D0(d0) do { s16x4 l0, l1, l2, l3, h0, h1, h2, h3; constexpr int b_ = VB * SHM + v_rd_off(d0, 0, 0); \
        TRRD(l0, b_); TRRD(h0, b_ + 2048); TRRD(l1, b_ + 4096); TRRD(h1, b_ + 6144); TRRD(l2, b_ + 8192); TRRD(h2, b_ + 10240); TRRD(l3, b_ + 12288); TRRD(h3, b_ + 14336); \
        asm volatile("s_waitcnt lgkmcnt(0)" ::: "memory"); SBAR();   \
        o[d0] = __builtin_amdgcn_mfma_f32_32x32x16_bf16(pa0, (bf16x8){l0[0], l0[1], l0[2], l0[3], h0[0], h0[1], h0[2], h0[3]}, o[d0], 0, 0, 0);   \
        o[d0] = __builtin_amdgcn_mfma_f32_32x32x16_bf16(pa1, (bf16x8){l1[0], l1[1], l1[2], l1[3], h1[0], h1[1], h1[2], h1[3]}, o[d0], 0, 0, 0);   \
        o[d0] = __builtin_amdgcn_mfma_f32_32x32x16_bf16(pa2, (bf16x8){l2[0], l2[1], l2[2], l2[3], h2[0], h2[1], h2[2], h2[3]}, o[d0], 0, 0, 0);   \
        o[d0] = __builtin_amdgcn_mfma_f32_32x32x16_bf16(pa3, (bf16x8){l3[0], l3[1], l3[2], l3[3], h3[0], h3[1], h3[2], h3[3]}, o[d0], 0, 0, 0); } while (0)
    PV_D0(0); PV_D0(1); PV_D0(2); PV_D0(3);
#undef PV_D0
#undef TRRD
}
template <bool FINAL>
__device__ __forceinline__ void attn_phase(const Ctx& c, const bf16* QKV, bf16* OP, float* LSE, bf16* O) {
    const int half = c.wave >> 2, w4 = c.wave & 3, r32 = c.lane & 31, hi = c.lane >> 5, l = c.lane;
    LAS char* Vl = (LAS char*)c.lds + half * 65536; LAS char* Kl = Vl + 2 * SHM;
    LAS float* wl = (LAS float*)(c.lds + LDSCTL_OFF + 1024) + c.wave * 128; LAS float* al_l = wl + 96;
    const LAS float* wl4 = wl + 4 * hi;
    const int vb0 = (int)(unsigned)(uintptr_t)Vl + v_rd_base(c.lane);
    int krow[4], kcol[4], vrow[4], vcol[4];
#pragma unroll
    for (int j = 0; j < 4; ++j) { const int blk = 4 * w4 + j; krow[j] = 4 * blk + (l >> 4); kcol[j] = (((l & 15) ^ (krow[j] & 7)) * 16) + 2048;
        const int sub = 2 * blk + (l >> 5), kk = (sub >> 2) * 8 + ((l & 31) >> 2); vrow[j] = (kk & ~0xC) | ((kk & 4) << 1) | ((kk & 8) >> 1); vcol[j] = ((sub & 3) * 32 + (l & 3) * 8) * 2 + 4096; }
    constexpr int NUNITS = FINAL ? 1024 : 2048;
    for (int idx = c.bid; idx < NUNITS; idx += c.G) {
        const int hp = idx & 3, rj = (idx >> 2) & 15, b = (idx >> 6) & 15, g = FINAL ? 0 : 1 + (idx >> 10);
        const int h = 2 * hp + half, dil = 1 << (2 * g), nbm = (16 >> (2 * g)) - 1, jb = rj & nbm, r = rj >> (4 - 2 * g);
        const unsigned rs = (unsigned)dil * QKV_N * 2u;
        const char* base = (const char*)(QKV + ((size_t)b * SEQ + r) * QKV_N + g * 3072 + h * HD);
        const int q0 = 128 * jb + 32 * w4;
        bf16x8 qr[8];
#pragma unroll
        for (int d0 = 0; d0 < 8; ++d0) qr[d0] = *(const bf16x8*)(base + ((unsigned)(q0 + r32) * rs + (unsigned)(d0 * 32 + hi * 16)));
#define A_DMA(kb_, bf_) do { _Pragma("unroll") for (int j_ = 0; j_ < 4; ++j_) { \
            __builtin_amdgcn_global_load_lds((const unsigned*)(base + ((unsigned)((kb_) + krow[j_]) * rs + (unsigned)kcol[j_])), (LAS unsigned*)(Kl + (bf_) * SHM + (4 * w4 + j_) * 1024), 16, 0, 0); \
            __builtin_amdgcn_global_load_lds((const unsigned*)(base + ((unsigned)((kb_) + vrow[j_]) * rs + (unsigned)vcol[j_])), (LAS unsigned*)(Vl + (bf_) * SHM + (4 * w4 + j_) * 1024), 16, 0, 0); } } while (0)
        float m_reg = -1e30f, l_reg = 0.f; f32x16 o[4] = {};
        const int kt0 = jb == 0 ? 2 : 0, kb0 = 128 * (jb - 1);
        A_DMA(kb0 + 64 * kt0, 0);
        asm volatile("s_waitcnt vmcnt(0)" ::: "memory"); __syncthreads();
#define A_STEP(kt_, BUF) do { const int kb_ = kb0 + 64 * (kt_); \
            if ((kt_) < 3) A_DMA(kb_ + 64, (BUF) ^ 1);                                         \
            if (kb_ <= q0 + 31 && kb_ + 63 >= q0 - 128) { f32x16 p0, p1; float mn, alpha; bf16x8 pa0, pa1, pa2, pa3; \
                qkt<BUF>(p0, p1, Kl, r32, hi, qr); mask_tile(p0, p1, q0 + r32 - kb_ - 4 * hi, 129u); partialSM(p0, p1, m_reg, mn, alpha); \
                if (__any(alpha < 1.f)) { if (hi == 0) al_l[r32] = alpha; asm volatile("s_waitcnt lgkmcnt(0)" ::: "memory"); \
                    _Pragma("unroll") for (int d_ = 0; d_ < 4; ++d_) _Pragma("unroll") for (int r_ = 0; r_ < 16; ++r_) o[d_][r_] *= al_l[crow(r_, hi)]; } \
                finishSM(p0, p1, alpha, l_reg, pa0, pa1, pa2, pa3); SBAR(); pv_tile<BUF>(o, vb0, pa0, pa1, pa2, pa3); } \
            asm volatile("s_waitcnt vmcnt(0)" ::: "memory"); __syncthreads(); } while (0)
        for (int kt = kt0; kt < 4; kt += 2) { A_STEP(kt, 0); A_STEP(kt + 1, 1); }
#undef A_STEP
#undef A_DMA
        const float lse = m_reg * SCALE + __logf(l_reg);
        const unsigned tok0 = (unsigned)b * SEQ + r;
        if (hi == 0) { const unsigned tokq = tok0 + (unsigned)(q0 + r32) * dil; float w0 = 1.f / l_reg;
            if (FINAL) { const float l1 = LSE[tokq * 8u + h], l2 = LSE[((unsigned)T + tokq) * 8u + h]; const float M = fmaxf(lse, fmaxf(l1, l2));
                const float e0 = __expf(lse - M), e1 = __expf(l1 - M), e2 = __expf(l2 - M), inv = 1.f / (e0 + e1 + e2); w0 *= e0 * inv; wl[32 + r32] = e1 * inv; wl[64 + r32] = e2 * inv; }
            else LSE[((unsigned)(g - 1) * T + tokq) * 8u + h] = lse;
            wl[r32] = w0; }
        asm volatile("s_waitcnt lgkmcnt(0)" ::: "memory");
        LAS char* tile = Vl + (w4 < 2 ? SHM + w4 * 8192 : 3 * SHM + (w4 - 2) * 8192); LAS char* tile4 = tile + 4 * hi * 256 + r32 * 2;
#pragma unroll
        for (int r_ = 0; r_ < 16; ++r_) { const int orow = (r_ & 3) + 8 * (r_ >> 2); const float w0 = wl4[orow];
#pragma unroll
            for (int d0 = 0; d0 < 4; ++d0) { const float v = o[d0][r_] * w0; const float vn = lane_xor1(v);
                if ((r32 & 1) == 0) *(LAS unsigned*)(tile4 + orow * 256 + d0 * 64) = cvtpk(v, vn); } }
        asm volatile("s_waitcnt lgkmcnt(0)" ::: "memory");
#pragma unroll
        for (int i = 0; i < 8; ++i) { const int p = c.lane + 64 * i, row = p >> 4, ch = p & 15; const unsigned tok = tok0 + (unsigned)(q0 + row) * dil; const unsigned col8 = (unsigned)h * HD + ch * 8;
            const u32x4 x = *(const LAS u32x4*)(tile + row * 256 + ch * 16);
            if (FINAL) { const u32x4 pa = *(const u32x4*)(OP + (tok * (unsigned)OD + col8)), pb = *(const u32x4*)(OP + (((unsigned)T + tok) * (unsigned)OD + col8)); const float w1 = wl[32 + row], w2 = wl[64 + row];
                u32x4 y; y.x = cvtpk(bflo(x.x) + w1 * bflo(pa.x) + w2 * bflo(pb.x), bfhi(x.x) + w1 * bfhi(pa.x) + w2 * bfhi(pb.x)); y.y = cvtpk(bflo(x.y) + w1 * bflo(pa.y) + w2 * bflo(pb.y), bfhi(x.y) + w1 * bfhi(pa.y) + w2 * bfhi(pb.y));
                y.z = cvtpk(bflo(x.z) + w1 * bflo(pa.z) + w2 * bflo(pb.z), bfhi(x.z) + w1 * bfhi(pa.z) + w2 * bfhi(pb.z)); y.w = cvtpk(bflo(x.w) + w1 * bflo(pa.w) + w2 * bflo(pb.w), bfhi(x.w) + w1 * bfhi(pa.w) + w2 * bfhi(pb.w));
                *(u32x4*)(O + (tok * (unsigned)OD + col8)) = y; }
            else *(u32x4*)(OP + (((unsigned)(g - 1) * T + tok) * (unsigned)OD + col8)) = x; }
    }
}
#undef KSWZ
#undef SBAR
}

namespace mls {
using att::bf16x8; using att::s16x4; using att::f32x16; using att::v_st; using att::v_rd_base; using att::crow; using att::cvtpk;
constexpr int RSB = 272;
constexpr int L_QP = 0, L_KP = 17408, L_KTR = 34816, L_VTR = 51200, L_AM = 83968, L_RS = 93184, L_QN = 94208, L_WINT = 94464, L_MEXP = 94720, L_HDEN = 94976  , L_NV = 97024  , L_UV = 98048, L_AV = 98560  ;
constexpr int AMB = 144;
#define TRRD(dst, addr, off) asm volatile("ds_read_b64_tr_b16 %0, %1 offset:%2" : "=&v"(dst) : "v"(addr), "i"(off) : "memory")
template <int SKIP>
__device__ __forceinline__ void mlstm_phase(const Ctx& c, const bf16* QKC, const unsigned char* Z, const float* GATES, bf16* HC) {
    const int w = c.wave;
    LAS char* lds = (LAS char*)c.lds;
    LAS float* RS = (LAS float*)(lds + L_RS); LAS float* QN = (LAS float*)(lds + L_QN); LAS float* WINT = (LAS float*)(lds + L_WINT);     LAS float* HDEN = (LAS float*)(lds + L_HDEN);
    LAS float* UV = (LAS float*)(lds + L_UV); LAS float* AV = (LAS float*)(lds + L_AV);
    for (int unit = c.bid; unit < BATCH * 8; unit += c.G) {
        const int b = unit >> 3, h = unit & 7;
        f32x16 Ct[4] = {};
        float n0 = 0.f, n1 = 0.f, m_state = -1e30f;
        bf16x8 sq[2], sk[2]; u32x2 sv[4]; float g_li, g_lf;
#define M_LOAD(tok0_) do { \
            _Pragma("unroll") for (int i_ = 0; i_ < 2; ++i_) { const int p_ = tid_ + 512 * i_, row_ = p_ >> 4, c8_ = (p_ & 15) * 8; const bf16* s_ = QKC + (size_t)((tok0_) + row_) * 2048 + h * 128 + c8_; sq[i_] = *(const bf16x8*)s_; sk[i_] = *(const bf16x8*)(s_ + 1024); } \
            g_li = GATES[(size_t)((tok0_) + (tid_ & 63)) * 16 + h]; g_lf = GATES[(size_t)((tok0_) + (tid_ & 63)) * 16 + 8 + h]; } while (0)
#define M_LOADV(tok0_) do { \
            _Pragma("unroll") for (int i_ = 0; i_ < 4; ++i_) { const int p_ = tid_ + 512 * i_, row_ = p_ >> 5, c8_ = (p_ & 31) * 8; sv[i_] = *(const u32x2*)(Z + (size_t)((tok0_) + row_) * ZN + 2048 + h * 256 + c8_); } } while (0)
        int tid_ = c.tid; asm volatile("" : "+v"(tid_));
        M_LOAD(b * SEQ); M_LOADV(b * SEQ);
        if (w == 5) *(LAS f32x2*)(lds + L_NV + 512 + 8 * c.lane) = (f32x2){0.f, 0.f};
        for (int ch = 0; ch < 32; ++ch) {
            const int tok0 = b * SEQ + ch * 64;
            tid_ = c.tid; asm volatile("" : "+v"(tid_));
            const int l = tid_ & 63, hi = l >> 5, r32 = l & 31, q4 = l >> 4, l15 = l & 15;
            const int vbK = (int)(unsigned)(uintptr_t)(lds + L_KTR) + v_rd_base(l);
            const int vbV = (int)(unsigned)(uintptr_t)(lds + L_VTR) + (w >> 2) * 16384 + (w & 3) * 512 + v_rd_base(l);
            const LAS float* uv_b = UV + 16 * (w & 3) + 4 * q4; const LAS float* as_b = AV + 32 * (w >> 2) + l15;
            LAS char* am_w = lds + L_AM + (16 * (w & 3) + 4 * q4) * AMB + (32 * (w >> 2) + l15) * 2; LAS float* rs_w = RS + 128 * (w >> 2) + 16 * (w & 3) + 4 * q4;
            const LAS float* wint_b = WINT + 4 * hi; const LAS float* hden_b = HDEN + 64 * w + 4 * hi;
            const LAS char* q_b = lds + L_QP + r32 * RSB + 8 * hi; const LAS char* am_b = lds + L_AM + r32 * AMB + 16 * hi;
            const LAS char* sq_b = lds + L_QP + ((16 * (w & 3)) + l15) * RSB + 16 * q4; const LAS char* sk_b = lds + L_KP + l15 * RSB + 16 * q4;
            const int hc_lane = 4 * hi * 2048 + 32 * w + r32;
            const float bc = (SKIP & 64) ? g_lf : prefix_sum64(g_lf);
            const float a = g_li - bc, pm = (SKIP & 64) ? a : prefix_max64(a);
            const float u = fmaxf(m_state, pm), winter = __expf(m_state - u);
            const float blast = lane_bcast(bc, 63), u63 = lane_bcast(u, 63);
            const float wk = __expf(a - u63), decay = __expf(m_state - u63), mexp = __expf(-(bc + u));
            if (!(SKIP & 128)) {
#pragma unroll
            for (int i = 0; i < 2; ++i) { const int p = tid_ + 512 * i, row = p >> 4, c8 = (p & 15) * 8;
                *(LAS bf16x8*)(lds + L_QP + row * RSB + c8 * 2) = sq[i]; *(LAS bf16x8*)(lds + L_KP + row * RSB + c8 * 2) = sk[i];
                const float wr_ = __shfl(wk, row); const u32x4 kw = *reinterpret_cast<const u32x4*>(&sk[i]);
                u32x4 o; o.x = cvtpk(bflo(kw.x) * wr_, bfhi(kw.x) * wr_); o.y = cvtpk(bflo(kw.y) * wr_, bfhi(kw.y) * wr_); o.z = cvtpk(bflo(kw.z) * wr_, bfhi(kw.z) * wr_); o.w = cvtpk(bflo(kw.w) * wr_, bfhi(kw.w) * wr_);
                *(LAS u32x4*)(lds + L_KTR + v_st(row, c8)) = o; }
#pragma unroll
            for (int i = 0; i < 4; ++i) { const int p = tid_ + 512 * i, row = p >> 5, c8 = (p & 31) * 8;
                float vf_[8]; fp8x8_to_f32(sv[i], vf_); *(LAS u32x4*)(lds + L_VTR + (c8 >> 7) * 16384 + v_st(row, c8 & 127)) = (u32x4){cvtpk(vf_[0], vf_[1]), cvtpk(vf_[2], vf_[3]), cvtpk(vf_[4], vf_[5]), cvtpk(vf_[6], vf_[7])}; }
            }
            if (w == 0) { WINT[(ch & 1) * 64 + l] = winter; UV[(ch & 1) * 64 + l] = u; AV[(ch & 1) * 64 + l] = a; }
            if (!(SKIP & 32)) { if (ch + 1 < 32) { M_LOAD(tok0 + 64); M_LOADV(tok0 + 64); } }
            __syncthreads(); __builtin_amdgcn_sched_barrier(0);
            if (!(SKIP & 1)) {
                if (w == 4) { const LAS char* qrow = lds + L_QP + l * RSB; const LAS f32x4* nv = (const LAS f32x4*)(lds + L_NV + ((ch + 1) & 1) * 512);
                    float p0 = 0.f, p1 = 0.f;
#pragma unroll 2
                    for (int d8 = 0; d8 < 16; ++d8) { const u32x4 q = *(const LAS u32x4*)(qrow + 16 * d8); const f32x4 na = nv[2 * d8], nb = nv[2 * d8 + 1];
                        p0 += (bflo(q.x) * na.x + bfhi(q.x) * na.y) + (bflo(q.y) * na.z + bfhi(q.y) * na.w); p1 += (bflo(q.z) * nb.x + bfhi(q.z) * nb.y) + (bflo(q.w) * nb.z + bfhi(q.w) * nb.w); }
                    QN[l] = p0 + p1; }
                if (w == 5) { const LAS char* kb = lds + L_KTR + (l >> 4) * 512 + (l & 15) * 4;
                    float p0 = 0.f, p1 = 0.f;
#pragma unroll 2
                    for (int a_ = 0; a_ < 8; ++a_) {
                        const unsigned k0 = *(const LAS unsigned*)(kb + a_ * 2048 + 0), k1 = *(const LAS unsigned*)(kb + a_ * 2048 + 64), k2 = *(const LAS unsigned*)(kb + a_ * 2048 + 128), k3 = *(const LAS unsigned*)(kb + a_ * 2048 + 192);
                        const unsigned k4 = *(const LAS unsigned*)(kb + a_ * 2048 + 256), k5 = *(const LAS unsigned*)(kb + a_ * 2048 + 320), k6 = *(const LAS unsigned*)(kb + a_ * 2048 + 384), k7 = *(const LAS unsigned*)(kb + a_ * 2048 + 448);
                        p0 += ((bflo(k0) + bflo(k4)) + (bflo(k1) + bflo(k5))) + ((bflo(k2) + bflo(k6)) + (bflo(k3) + bflo(k7))); p1 += ((bfhi(k0) + bfhi(k4)) + (bfhi(k1) + bfhi(k5))) + ((bfhi(k2) + bfhi(k6)) + (bfhi(k3) + bfhi(k7))); }
                    n0 = n0 * decay + p0; n1 = n1 * decay + p1;
                    *(LAS f32x2*)(lds + L_NV + (ch & 1) * 512 + 8 * l) = (f32x2){n0, n1}; }
            }
            __builtin_amdgcn_sched_barrier(0);
            if (!(SKIP & 2)) { const int ti = w & 3, si0 = 2 * (w >> 2);
              const f32x4 ut4 = *(const LAS f32x4*)(uv_b + (ch & 1) * 64);
#pragma unroll
              for (int sj = 0; sj < 2; ++sj) { const int si = si0 + sj; float av[4] = {0.f, 0.f, 0.f, 0.f};
                if (si <= ti) { f32x4 acc = {0.f, 0.f, 0.f, 0.f};
#pragma unroll
                    for (int kk = 0; kk < 4; ++kk) { const bf16x8 af = *(const LAS bf16x8*)(sq_b + 64 * kk), bfr = *(const LAS bf16x8*)(sk_b + (16 * si) * RSB + 64 * kk);
                        acc = __builtin_amdgcn_mfma_f32_16x16x32_bf16(af, bfr, acc, 0, 0, 0); }
                    const float as_ = as_b[(ch & 1) * 64 + 16 * sj]; const int dts = 16 * (ti - si) + 4 * q4 - l15;
#pragma unroll
                    for (int r = 0; r < 4; ++r) av[r] = (dts + r >= 0) ? acc[r] * __expf(as_ - ut4[r]) : 0.f; }
#pragma unroll
                for (int r = 0; r < 4; ++r) { *(LAS unsigned short*)(am_w + r * AMB + sj * 32) = (unsigned short)f2bf(av[r]);
                    const float rs_ = row16_sum(av[r]);
                    if (l15 == 0) rs_w[sj * 64 + r] = rs_; } } }
            __builtin_amdgcn_sched_barrier(0);
            bf16x8 vf[4];
            { s16x4 l0, l1, l2, l3, h0, h1, h2, h3;
              TRRD(l0, vbV, 0); TRRD(h0, vbV, 2048); TRRD(l1, vbV, 4096); TRRD(h1, vbV, 6144); TRRD(l2, vbV, 8192); TRRD(h2, vbV, 10240); TRRD(l3, vbV, 12288); TRRD(h3, vbV, 14336);
              asm volatile("s_waitcnt lgkmcnt(0)" ::: "memory"); __builtin_amdgcn_sched_barrier(0);
              vf[0] = (bf16x8){l0[0], l0[1], l0[2], l0[3], h0[0], h0[1], h0[2], h0[3]}; vf[1] = (bf16x8){l1[0], l1[1], l1[2], l1[3], h1[0], h1[1], h1[2], h1[3]};
              vf[2] = (bf16x8){l2[0], l2[1], l2[2], l2[3], h2[0], h2[1], h2[2], h2[3]}; vf[3] = (bf16x8){l3[0], l3[1], l3[2], l3[3], h3[0], h3[1], h3[2], h3[3]}; }
            f32x16 ac[2] = {};
            if (!(SKIP & 4))
#pragma unroll
            for (int db = 0; db < 4; ++db)
#pragma unroll
                for (int s2 = 0; s2 < 2; ++s2) {
                    u32x4 cw; cw.x = cvtpk(Ct[db][8 * s2 + 0], Ct[db][8 * s2 + 1]); cw.y = cvtpk(Ct[db][8 * s2 + 2], Ct[db][8 * s2 + 3]); cw.z = cvtpk(Ct[db][8 * s2 + 4], Ct[db][8 * s2 + 5]); cw.w = cvtpk(Ct[db][8 * s2 + 6], Ct[db][8 * s2 + 7]);
#pragma unroll
                    for (int th = 0; th < 2; ++th) { const LAS char* qp = q_b + 32 * th * RSB + (32 * db + 16 * s2) * 2; const u32x2 x0 = *(const LAS u32x2*)qp, x1 = *(const LAS u32x2*)(qp + 16);
                        u32x4 o = {x0.x, x0.y, x1.x, x1.y}; ac[th] = __builtin_amdgcn_mfma_f32_32x32x16_bf16(*reinterpret_cast<bf16x8*>(&o), *reinterpret_cast<bf16x8*>(&cw), ac[th], 0, 0, 0); } }
            if (!(SKIP & 8))
#pragma unroll
            for (int db = 0; db < 4; ++db) { s16x4 l0, l1, l2, l3, h0, h1, h2, h3;
                TRRD(l0, vbK, db * 512 + 0); TRRD(h0, vbK, db * 512 + 2048); TRRD(l1, vbK, db * 512 + 4096); TRRD(h1, vbK, db * 512 + 6144); TRRD(l2, vbK, db * 512 + 8192); TRRD(h2, vbK, db * 512 + 10240); TRRD(l3, vbK, db * 512 + 12288); TRRD(h3, vbK, db * 512 + 14336);
#pragma unroll
                for (int r = 0; r < 16; ++r) Ct[db][r] *= decay;
                asm volatile("s_waitcnt lgkmcnt(0)" ::: "memory"); __builtin_amdgcn_sched_barrier(0);
                Ct[db] = __builtin_amdgcn_mfma_f32_32x32x16_bf16((bf16x8){l0[0], l0[1], l0[2], l0[3], h0[0], h0[1], h0[2], h0[3]}, vf[0], Ct[db], 0, 0, 0);
                Ct[db] = __builtin_amdgcn_mfma_f32_32x32x16_bf16((bf16x8){l1[0], l1[1], l1[2], l1[3], h1[0], h1[1], h1[2], h1[3]}, vf[1], Ct[db], 0, 0, 0);
                Ct[db] = __builtin_amdgcn_mfma_f32_32x32x16_bf16((bf16x8){l2[0], l2[1], l2[2], l2[3], h2[0], h2[1], h2[2], h2[3]}, vf[2], Ct[db], 0, 0, 0);
                Ct[db] = __builtin_amdgcn_mfma_f32_32x32x16_bf16((bf16x8){l3[0], l3[1], l3[2], l3[3], h3[0], h3[1], h3[2], h3[3]}, vf[3], Ct[db], 0, 0, 0); }
            m_state = blast + u63;
            __syncthreads(); __builtin_amdgcn_sched_barrier(0);
            if (!(SKIP & 16)) {
            { const float den = ((RS[l] + RS[64 + l]) + (RS[128 + l] + RS[192 + l])) + winter * QN[l]; HDEN[64 * w + l] = 1.f / fmaxf(fabsf(den), mexp); }
            const LAS float* wint_c = wint_b + (ch & 1) * 64;
#pragma unroll
            for (int th = 0; th < 2; ++th) { f32x16 ai = {};
#pragma unroll
                for (int ks = 0; ks < 4; ++ks) { if (th == 0 && ks >= 2) continue; const bf16x8 af = *(const LAS bf16x8*)(am_b + 32 * th * AMB + 32 * ks); ai = __builtin_amdgcn_mfma_f32_32x32x16_bf16(af, vf[ks], ai, 0, 0, 0); }
#pragma unroll
                for (int r = 0; r < 16; ++r) { const int tc = 32 * th + (r & 3) + 8 * (r >> 2); const float v = (ai[r] + wint_c[tc] * ac[th][r]) * hden_b[tc]; const float vn = lane_xor1(v);
                    bf16* rowp = HC + (size_t)(tok0 + tc) * 2048 + h * 256;
                    if ((r32 & 1) == 0) *(unsigned*)(rowp + hc_lane) = cvtpk(v, vn); } }
            }
        }
        __syncthreads();
    }
#undef M_LOAD
#undef M_LOADV
}
#undef TRRD
}

#ifndef GEMM_SP2
#define GEMM_SP2 true
#endif
#ifndef GEMM_ALIGN
#define GEMM_ALIGN true
#endif
#ifndef EPI_NT
#define EPI_NT 1
#endif
#if EPI_NT
#define EPI_ST(p, v) __builtin_nontemporal_store((v), (p))
#else
#define EPI_ST(p, v) (*(p) = (v))
#endif
namespace pg8 {
struct EpiStoreBf16 { static constexpr bool PERM = true, AFTER_DRAIN = false, WIDE = false; bf16_t* O; int ldc;
    __device__ __forceinline__ void operator()(const f32x4 (&acc)[2][2][4][2], const Unit& u, int wr, int wc, int fr, int fq) const {
        const int row0 = u.pm * BM + wr * 64 + fr, col0 = u.pn * BM + wc * 32 + 8 * fq;
#pragma unroll
        for (int ai = 0; ai < 2; ++ai)
#pragma unroll
            for (int m = 0; m < 4; ++m) { bf16_t* rowp = O + (size_t)(row0 + ai * HALF + m * 16) * ldc + col0;
#pragma unroll
                for (int bj = 0; bj < 2; ++bj) { const f32x4 v0 = acc[ai][bj][m][0], v1 = acc[ai][bj][m][1];
                    u32x4 w; w.x = cvt_pk_bf16(v0[0], v0[1]); w.y = cvt_pk_bf16(v0[2], v0[3]); w.z = cvt_pk_bf16(v1[0], v1[1]); w.w = cvt_pk_bf16(v1[2], v1[3]);
                    EPI_ST((u32x4*)(rowp + bj * HALF), w); } }
    }
};
struct EpiStoreFp8 { static constexpr bool PERM = true, AFTER_DRAIN = false; static constexpr int WIDE = 2; unsigned char* O; int ldc;
    __device__ __forceinline__ void operator()(const f32x4 (&acc)[2][2][4][2], const Unit& u, int wr, int wc, int fr, int fq) const {
        unsigned char* tb = O + (size_t)(u.pm * BM) * ldc + u.pn * BM; const unsigned lo = (unsigned)((wr * 64 + fr) * ldc + wc * 64 + 16 * fq);
#pragma unroll
        for (int ai = 0; ai < 2; ++ai)
#pragma unroll
            for (int m = 0; m < 4; ++m) { u32x4 w; unsigned pw[2][2];
#pragma unroll
                for (int bj = 0; bj < 2; ++bj) { const f32x4 v0 = acc[ai][bj][m][0] * 16.f, v1 = acc[ai][bj][m][1] * 16.f;
                    int t0 = __builtin_amdgcn_cvt_pk_fp8_f32(v0[0], v0[1], 0, false); t0 = __builtin_amdgcn_cvt_pk_fp8_f32(v0[2], v0[3], t0, true);
                    int t1 = __builtin_amdgcn_cvt_pk_fp8_f32(v1[0], v1[1], 0, false); t1 = __builtin_amdgcn_cvt_pk_fp8_f32(v1[2], v1[3], t1, true);
                    pw[bj][0] = (unsigned)t0; pw[bj][1] = (unsigned)t1; }
                w.x = pw[0][0]; w.y = pw[0][1]; w.z = pw[1][0]; w.w = pw[1][1];
                EPI_ST((u32x4*)(tb + (size_t)((ai * HALF + m * 16) * ldc) + lo), w); }
    }
};
struct EpiQKV { static constexpr bool PERM = true, AFTER_DRAIN = false, WIDE = false; bf16_t* O; int ldc;
    __device__ __forceinline__ void operator()(const f32x4 (&acc)[2][2][4][2], const Unit& u, int wr, int wc, int fr, int fq) const {
        const int row0 = u.pm * BM + wr * 64 + fr, col0 = u.pn * BM + wc * 32 + 8 * fq;
        const bool rot = ((u.pn >> 2) % 3) < 2;
        const float frev = __builtin_amdgcn_exp2f(-(float)(4 * wc + fq) * (18.931568569324174f / 16.f)) * 0.15915494309189535f;
        const float r16 = __builtin_amdgcn_fractf(16.f * frev), c16 = __builtin_amdgcn_cosf(r16), s16 = __builtin_amdgcn_sinf(r16);
#pragma unroll
        for (int ai = 0; ai < 2; ++ai) {
            const float r0 = __builtin_amdgcn_fractf((float)((row0 + ai * HALF) & 2047) * frev); float cs = __builtin_amdgcn_cosf(r0), sn = __builtin_amdgcn_sinf(r0);
#pragma unroll
            for (int m = 0; m < 4; ++m) { const int row = row0 + ai * HALF + m * 16; bf16_t* rowp = O + (size_t)row * ldc + col0;
#pragma unroll
                for (int bj = 0; bj < 2; ++bj) { f32x4 v0 = acc[ai][bj][m][0]; const f32x4 v1 = acc[ai][bj][m][1];
                    if (rot) { const float a = v0[0], b = v0[1]; v0[0] = a * cs - b * sn; v0[1] = b * cs + a * sn; }
                    u32x4 w; w.x = cvt_pk_bf16(v0[0], v0[1]); w.y = cvt_pk_bf16(v0[2], v0[3]); w.z = cvt_pk_bf16(v1[0], v1[1]); w.w = cvt_pk_bf16(v1[2], v1[3]);
                    EPI_ST((u32x4*)(rowp + bj * HALF), w); }
                const float cn = cs * c16 - sn * s16; sn = sn * c16 + cs * s16; cs = cn; } }
    }
};
template <bool RES_F32> struct EpiRes { static constexpr bool PERM = true, AFTER_DRAIN = false, WIDE = false; const void* res; bf16_t* out; int ldc; float alpha;
    __device__ __forceinline__ void operator()(const f32x4 (&acc)[2][2][4][2], const Unit& u, int wr, int wc, int fr, int fq) const {
        const int row0 = u.pm * BM + wr * 64 + fr, col0 = u.pn * BM + wc * 32 + 8 * fq;
#pragma unroll
        for (int ai = 0; ai < 2; ++ai)
#pragma unroll
            for (int m = 0; m < 4; ++m) { const size_t off = (size_t)(row0 + ai * HALF + m * 16) * ldc + col0;
#pragma unroll
                for (int bj = 0; bj < 2; ++bj) { f32x4 r0, r1;
                    if (RES_F32) { r0 = *(const f32x4*)((const float*)res + off + bj * HALF); r1 = *(const f32x4*)((const float*)res + off + bj * HALF + 4); }
                    else { const u32x4 rw = *(const u32x4*)((const bf16_t*)res + off + bj * HALF);
                        r0 = (f32x4){__builtin_bit_cast(float, rw.x << 16), __builtin_bit_cast(float, rw.x & 0xffff0000u), __builtin_bit_cast(float, rw.y << 16), __builtin_bit_cast(float, rw.y & 0xffff0000u)};
                        r1 = (f32x4){__builtin_bit_cast(float, rw.z << 16), __builtin_bit_cast(float, rw.z & 0xffff0000u), __builtin_bit_cast(float, rw.w << 16), __builtin_bit_cast(float, rw.w & 0xffff0000u)}; }
                    const f32x4 v0 = r0 * alpha + acc[ai][bj][m][0], v1 = r1 * alpha + acc[ai][bj][m][1];
                    u32x4 w; w.x = cvt_pk_bf16(v0[0], v0[1]); w.y = cvt_pk_bf16(v0[2], v0[3]); w.z = cvt_pk_bf16(v1[0], v1[1]); w.w = cvt_pk_bf16(v1[2], v1[3]);
                    EPI_ST((u32x4*)(out + off + bj * HALF), w); } }
    }
};
struct EpiSwiGLU { static constexpr bool PERM = true, AFTER_DRAIN = false, WIDE = false; bf16_t* H;
    __device__ __forceinline__ void operator()(const f32x4 (&acc)[2][2][4][2], const Unit& u, int wr, int wc, int fr, int fq) const {
        const int row0 = u.pm * BM + wr * 64 + fr, col0 = u.pn * 128 + wc * 16 + 4 * fq;
#pragma unroll
        for (int ai = 0; ai < 2; ++ai)
#pragma unroll
            for (int m = 0; m < 4; ++m) { bf16_t* rowp = H + (size_t)(row0 + ai * HALF + m * 16) * 768 + col0;
#pragma unroll
                for (int bj = 0; bj < 2; ++bj) { const f32x4 v0 = acc[ai][bj][m][0], v1 = acc[ai][bj][m][1];
                    const float h0 = v0[0] / (1.f + __expf(-v0[0])) * v0[1], h1 = v0[2] / (1.f + __expf(-v0[2])) * v0[3], h2 = v1[0] / (1.f + __expf(-v1[0])) * v1[1], h3 = v1[2] / (1.f + __expf(-v1[2])) * v1[3];
                    typedef unsigned u32x2v __attribute__((ext_vector_type(2))); u32x2v w; w.x = cvt_pk_bf16(h0, h1); w.y = cvt_pk_bf16(h2, h3);
                    EPI_ST((u32x2v*)(rowp + bj * 64), w); } }
    }
};
__device__ __forceinline__ unsigned ror8u(unsigned v) { return (unsigned)__builtin_amdgcn_mov_dpp((int)v, 0x128, 0xf, 0xf, true); }
template <bool STORE = true> struct EpiDownT { static constexpr bool PERM = true, AFTER_DRAIN = false, WIDE = true; unsigned char* YB8; const PG8_LAS int* atab;
    __device__ __forceinline__ void operator()(const f32x4 (&acc)[2][2][4][2], const Unit& u, int wr, int wc, int fr, int fq) const {
        typedef unsigned u32x2v __attribute__((ext_vector_type(2)));
        const bool up = fr >= 8; const unsigned ca = (unsigned)(u.pn * BM + wc * 64 + (up ? 32 : 0) + 8 * fq), cb = ca ^ 32u;
        const PG8_LAS int* at = atab + u.ui * 256 + wr * 64 + (fr & 7);
#pragma unroll
        for (int ai = 0; ai < 2; ++ai)
#pragma unroll
            for (int m = 0; m < 4; ++m) { u32x2v p[2];
#pragma unroll
                for (int bj = 0; bj < 2; ++bj) { const f32x4 v0 = acc[ai][bj][m][0] * 16.f, v1 = acc[ai][bj][m][1] * 16.f;
                    int t0 = __builtin_amdgcn_cvt_pk_fp8_f32(v0[0], v0[1], 0, false); t0 = __builtin_amdgcn_cvt_pk_fp8_f32(v0[2], v0[3], t0, true);
                    int t1 = __builtin_amdgcn_cvt_pk_fp8_f32(v1[0], v1[1], 0, false); t1 = __builtin_amdgcn_cvt_pk_fp8_f32(v1[2], v1[3], t1, true);
                    p[bj].x = (unsigned)t0; p[bj].y = (unsigned)t1; }
                const u32x2v x = {ror8u(p[1].x), ror8u(p[1].y)};
                const int aA = at[ai * HALF + m * 16], aB = at[ai * HALF + m * 16 + 8];
                const u32x2v dA = up ? x : p[0], dB = up ? p[0] : x;
                if (STORE) { if (aA >= 0) EPI_ST((u32x2v*)(YB8 + (size_t)aA * 2048 + ca), dA); if (aB >= 0) EPI_ST((u32x2v*)(YB8 + (size_t)aB * 2048 + cb), dB); }
                else asm volatile("" :: "v"(dA.x), "v"(dA.y), "v"(dB.x), "v"(dB.y)); }
    }
};
typedef EpiDownT<true> EpiDown;
template <bool GATHER_> struct MoeOrder { static constexpr bool GATHER = GATHER_; static constexpr int MAXU = 9;
    int nN, G, c, nt; const unsigned* cnt; size_t exp_bytes; const int* rowmap; PG8_LAS int* tok;
    static __device__ __forceinline__ int tiles(const unsigned* cnt) { int n = 0; for (int e = 0; e < 16; ++e) n += (int)(cnt[e] + 255u) >> 8; return n; }
    __device__ __forceinline__ bool next(int i, Unit& u) const { const long L = (long)i * G + c; if (L >= (long)nt * nN) return false; u.pm = (int)(L / nN); u.pn = (int)(L % nN); u.ui = i; return true; }
    __device__ __forceinline__ const char* pa(const Gemm& g, const Unit& u) const { return GATHER_ ? (const char*)g.A : (const char*)g.A + (size_t)u.pm * ((size_t)BM * g.K * 2); }
    __device__ __forceinline__ const char* pb(const Gemm& g, const Unit& u) const { const int e = __builtin_amdgcn_readfirstlane(tok[MAXU * 256 + u.pm]) & 15; return (const char*)g.Bt + (size_t)e * exp_bytes + (size_t)u.pn * ((size_t)BM * g.K * 2); }
    __device__ __forceinline__ void prep() const {
        if (threadIdx.x < 16) { const int e = threadIdx.x; int pm = 0; for (int q = 0; q < e; ++q) pm += (int)(cnt[q] + 255u) >> 8;
            const int ce = (int)cnt[e];
            for (int k = 0; k * 256 < ce; ++k) { const int rem = ce - k * 256; tok[MAXU * 256 + pm + k] = e | (k << 4) | ((rem > 256 ? 256 : rem) << 12); } }
        __syncthreads();
        for (int i = 0; i < MAXU; ++i) { Unit u; if (!next(i, u)) break; if (threadIdx.x < 256) { const int w = tok[MAXU * 256 + u.pm]; tok[i * 256 + threadIdx.x] = ((int)threadIdx.x < (w >> 12)) ? rowmap[(w & 15) * ECAP + ((w >> 4) & 255) * 256 + (int)threadIdx.x] : -1; } }
        asm volatile("s_waitcnt vmcnt(0) lgkmcnt(0)" ::: "memory"); __syncthreads();
    }
    __device__ __forceinline__ void aoffs(int ui, int K, int tid, unsigned (&out)[2][2]) const {
#pragma unroll
        for (int h = 0; h < 2; ++h)
#pragma unroll
            for (int i = 0; i < 2; ++i) { int R, C; stage_rc(tid * 16 + i * 8192, R, C); const int a = tok[ui * 256 + h * 128 + R]; out[h][i] = (unsigned)((a < 0 ? 0 : a) >> 1) * (unsigned)(K * 2) + (unsigned)(C * 2); }
    }
    __device__ __forceinline__ void a_ready(const Unit&) const {}
    __device__ __forceinline__ void done(const Unit&) const {}
};
}

struct Args { const float* in[18]; float* out; unsigned char* ws; int ph_lo, ph_hi; };
#ifdef ONLY_PH
#define IN(k) ((k) == ONLY_PH)
#else
#define IN(k) (lo <= (k) && (k) < hi)
#endif
#define BOTH(k) (IN(k) && IN((k) + 1))
#if MK_ONE_LAUNCH
#define SEAM() xcd_barrier(bar)
#else
#define SEAM() do {} while (0)
#endif
#ifndef REP_PH
#define REP_PH (-1)
#endif
#ifndef REP_PH2
#define REP_PH2 (-1)
#endif
#ifdef TS_PROBE
#define TS_STAMP(k) do { if (blockIdx.x == 0 && threadIdx.x == 0) __hip_atomic_store((unsigned long long*)(ws + WS_CTL + 65536) + (k), __builtin_amdgcn_s_memrealtime(), __ATOMIC_RELAXED, __HIP_MEMORY_SCOPE_AGENT); } while (0)
#define PHASE(k, ...) if (IN(k)) { __VA_ARGS__; SEAM(); TS_STAMP((k) + 1); }
#else
#define PHASE(k, ...) if (IN(k)) { __VA_ARGS__; if ((k) == REP_PH || (k) == REP_PH2) { __syncthreads(); __VA_ARGS__; } if (BOTH(k)) SEAM(); }
#endif
#define WSP(T_, off) ((T_*)(ws + (off)))
#ifndef MOE_XCD_ORDER
#define MOE_XCD_ORDER 1
#endif
#if MOE_XCD_ORDER
#define MOE_CU(c) (((c).G % 8 == 0) ? ((c).bid % 8) * ((c).G / 8) + (c).bid / 8 : (c).bid)
#else
#define MOE_CU(c) ((c).bid)
#endif
#define GEMM_STATIC(EPI, A_, B_, N_, K_, ...) do { pg8::Gemm g{A_, B_, T, N_, K_}; pg8::StaticOrder S; S.init(T, N_, c.G, c.bid); EPI E{__VA_ARGS__}; pg8::gemm_phase<EPI, pg8::StaticOrder, GEMM_ALIGN, GEMM_SP2>(c.lds, g, S, E); } while (0)
#define GEMM_MOE(GATH, EPI, A_, B_, N_, K_, ...) do { pg8::Gemm g{A_, B_, MAXROWS, N_, K_}; const unsigned* cnt_ = WSP(unsigned, WS_CTL) + CW_CUR + L * 32; pg8::MoeOrder<GATH> S{(N_) / 256, c.G, MOE_CU(c), __builtin_amdgcn_readfirstlane(pg8::MoeOrder<GATH>::tiles(cnt_)), cnt_, (size_t)(N_) * (K_) * 2, WSP(int, WS_RM2), (LAS int*)(c.lds + LDSCTL_OFF + 5120)}; EPI E{__VA_ARGS__}; pg8::gemm_phase<EPI, pg8::MoeOrder<GATH>, GEMM_ALIGN, true>(c.lds, g, S, E); } while (0)
enum { P_PRO = 0, P_QKV, P_ATTA, P_ATTB, P_WO, P_MOE0, P_WIN = P_MOE0 + 4, P_CONV, P_CELL, P_HN, P_WOUT, P_MOE1, P_END = P_MOE1 + 4 };
static_assert(P_END == NPHASE, "phase count");
constexpr int TAIL_E = 9;
__device__ __forceinline__ bool tail_share(const Ctx& c, int units, int& j, int& n) {
    const int R = (units + c.G - 1) / c.G, nlast = units - (R - 1) * c.G, cu = MOE_CU(c); n = c.G - nlast;
    if (n < 64) { j = c.bid; n = c.G; return true; }
    j = cu - nlast; return cu >= nlast; }
template <int L>
__device__ __forceinline__ void moe_block(const Ctx& c, const Args& args, unsigned char* ws, const int lo, const int hi, const XcdBarrier& bar, const int base) {
    (void)bar; (void)lo; (void)hi;
    PHASE(base + 0, ln_pass<0, 1, false>(c, WSP(bf16, WS_PRE), nullptr, nullptr, WSP(bf16, WS_XB), args.in[9] + L * D, args.in[10] + L * D, args.in[13], 16, 0, args.in[14], WSP(int, WS_RM2), WSP(float, WS_EGATE), WSP(unsigned, WS_CTL) + CW_CUR + L * 32, nullptr))
    PHASE(base + 1, GEMM_MOE(true, pg8::EpiSwiGLU, WSP(bf16, WS_XB), WSP(bf16, WS_WGU), GU_N, D, WSP(bf16, WS_H));
        if (L == 0) { int j_, n_; __syncthreads(); if (tail_share(c, pg8::MoeOrder<true>::tiles(WSP(unsigned, WS_CTL) + CW_CUR) * (GU_N / 256), j_, n_)) {
            conv_moe(c, args.in[15], args.in[16], args.in[17], WSP(bf16, WS_WGU), WSP(bf16, WS_WD), j_ * NWAVES + c.wave, n_ * NWAVES, 2 * NE * 768 + TAIL_E * 768, 2 * NE * 768);
            conv_job(c, args.in[8], D, D, D, WSP(bf16, WS_WOUT), j_ * NWAVES + c.wave, n_ * NWAVES); } })
#ifdef DOWN_NOSTORE_PROBE
    if (IN(base + 2)) { GEMM_MOE(false, pg8::EpiDownT<false>, WSP(bf16, WS_H), WSP(bf16, WS_WD), D, DE, WSP(unsigned char, WS_YB), (const LAS int*)(c.lds + LDSCTL_OFF + 5120)); __syncthreads(); }
#endif
    PHASE(base + 2, GEMM_MOE(false, pg8::EpiDown, WSP(bf16, WS_H), WSP(bf16, WS_WD), D, DE, WSP(unsigned char, WS_YB), (const LAS int*)(c.lds + LDSCTL_OFF + 5120));
        if (L == 0) { int j_, n_; __syncthreads(); if (tail_share(c, pg8::MoeOrder<true>::tiles(WSP(unsigned, WS_CTL) + CW_CUR) * (D / 256), j_, n_))
            conv_job(c, args.in[3], ZLD, D, ZN, WSP(bf16, WS_WIN), j_ * NWAVES + c.wave, n_ * NWAVES); })
    if (L == 0) { PHASE(base + 3, ln_pass<1, 2, false>(c, nullptr, nullptr, WSP(bf16, WS_YB), WSP(bf16, WS_XB), args.in[11], args.in[12], args.in[3], ZLD, ZN, args.in[4], nullptr, WSP(float, WS_EGATE), nullptr, WSP(float, WS_GATES))) }
    else { PHASE(base + 3, ln_pass<1, 0, true>(c, nullptr, args.out, WSP(bf16, WS_YB), WSP(bf16, WS_XB), args.in[11] + D, args.in[12] + D, nullptr, 0, 0, nullptr, nullptr, WSP(float, WS_EGATE), nullptr, nullptr)) }
}
__global__ void __launch_bounds__(NTHR, 2) fwd(Args args) {
    extern __shared__ __attribute__((aligned(16))) unsigned char lds_raw[];
    Ctx c; c.lds = (LAS unsigned char*)lds_raw; c.tid = threadIdx.x; c.lane = c.tid & 63; c.wave = __builtin_amdgcn_readfirstlane(c.tid >> 6);
    c.G = gridDim.x; c.bid = blockIdx.x; c.gw = c.bid * NWAVES + c.wave; c.ngw = c.G * NWAVES; c.gtid = c.bid * NTHR + c.tid; c.ngt = c.G * NTHR;
    unsigned char* ws = args.ws;
    ((LAS unsigned*)(c.lds + LDSCTL_OFF))[c.tid] = 0u;
    __syncthreads();
#if MK_ONE_LAUNCH
    XcdBarrier bar = xcd_barrier_post((unsigned*)(ws + WS_CTL) + CW_BAR, (volatile LAS unsigned*)(c.lds + LDSCTL_OFF + LC_BAR));
#else
    XcdBarrier bar; bar.bar = nullptr; bar.x = 0; bar.st = nullptr;
#endif
    const int lo = args.ph_lo, hi = args.ph_hi; (void)lo; (void)hi;
#ifdef TS_PROBE
    SEAM(); TS_STAMP(0);
#endif
    PHASE(P_PRO, conv_job<true>(c, args.in[1], QKV_N, D, QKV_N, WSP(bf16, WS_WQKV), c.gw, c.ngw); conv_job(c, args.in[2], D, OD, D, WSP(bf16, WS_WO), c.gw, c.ngw);
        conv_moe(c, args.in[15], args.in[16], args.in[17], WSP(bf16, WS_WGU), WSP(bf16, WS_WD), c.gw, c.ngw, 2 * NE * 768);
        conv_moe(c, args.in[15], args.in[16], args.in[17], WSP(bf16, WS_WGU), WSP(bf16, WS_WD), c.gw, c.ngw, 3 * NE * 768, 2 * NE * 768 + TAIL_E * 768);
        x_to_bf16(c, args.in[0], WSP(bf16, WS_XB)))
    PHASE(P_QKV, GEMM_STATIC(pg8::EpiQKV, WSP(bf16, WS_XB), WSP(bf16, WS_WQKV), QKV_N, D, WSP(bf16, WS_QKV), QKV_N))
    PHASE(P_ATTA, att::attn_phase<false>(c, WSP(const bf16, WS_QKV), WSP(bf16, WS_XB), WSP(float, WS_GATES), nullptr))
    PHASE(P_ATTB, att::attn_phase<true>(c, WSP(const bf16, WS_QKV), WSP(bf16, WS_XB), WSP(float, WS_GATES), WSP(bf16, WS_O)))
    PHASE(P_WO, GEMM_STATIC(pg8::EpiRes<true>, WSP(bf16, WS_O), WSP(bf16, WS_WO), D, OD, args.in[0], WSP(bf16, WS_PRE), D, ALPHA))
    moe_block<0>(c, args, ws, lo, hi, bar, P_MOE0);
    PHASE(P_WIN, GEMM_STATIC(pg8::EpiStoreFp8, WSP(bf16, WS_XB), WSP(bf16, WS_WIN), ZN, D, WSP(unsigned char, WS_Z), ZN))
    PHASE(P_CONV, conv_pass(c, WSP(const unsigned char, WS_Z), args.in[5], args.in[6], WSP(bf16, WS_QKC)))
    PHASE(P_CELL,
#if defined(MLS_SKIP)
        mls::mlstm_phase<MLS_SKIP>(c, WSP(const bf16, WS_QKC), WSP(const unsigned char, WS_Z), WSP(const float, WS_GATES), WSP(bf16, WS_HC)); __syncthreads();
#endif
        mls::mlstm_phase<0>(c, WSP(const bf16, WS_QKC), WSP(const unsigned char, WS_Z), WSP(const float, WS_GATES), WSP(bf16, WS_HC));
#if 0
        mls::mlstm_phase<0>(c, WSP(const bf16, WS_QKC), WSP(const unsigned char, WS_Z), WSP(const float, WS_GATES), WSP(bf16, WS_HC));
#endif
        if (c.G > 128) { if (c.bid >= 128) conv_moe(c, args.in[15] + (size_t)NE * D * DE, args.in[16] + (size_t)NE * D * DE, args.in[17] + (size_t)NE * D * DE, WSP(bf16, WS_WGU), WSP(bf16, WS_WD), (c.bid - 128) * NWAVES + c.wave, (c.G - 128) * NWAVES); }
        else conv_moe(c, args.in[15] + (size_t)NE * D * DE, args.in[16] + (size_t)NE * D * DE, args.in[17] + (size_t)NE * D * DE, WSP(bf16, WS_WGU), WSP(bf16, WS_WD), c.gw, c.ngw);
        )
    PHASE(P_HN, headnorm_pass(c, WSP(const bf16, WS_HC), WSP(const unsigned char, WS_Z), args.in[7], WSP(bf16, WS_Y)))
    PHASE(P_WOUT, GEMM_STATIC(pg8::EpiRes<false>, WSP(bf16, WS_Y), WSP(bf16, WS_WOUT), D, D, WSP(bf16, WS_XB), WSP(bf16, WS_PRE), D, ALPHA))
    moe_block<1>(c, args, ws, lo, hi, bar, P_MOE1);
#ifdef TS_PROBE
    {
        SEAM();
        const unsigned long long* ts = (const unsigned long long*)(ws + WS_CTL + 65536);
        const unsigned long long t0 = __hip_atomic_load(ts + TS_PROBE, __ATOMIC_RELAXED, __HIP_MEMORY_SCOPE_AGENT), t1 = __hip_atomic_load(ts + TS_PROBE + 1, __ATOMIC_RELAXED, __HIP_MEMORY_SCOPE_AGENT), t2 = __hip_atomic_load(ts + TS_PROBE + 2, __ATOMIC_RELAXED, __HIP_MEMORY_SCOPE_AGENT);
        const float k1 = (float)(t1 - t0) * 0.001f;
        const float k2 = (TS_PROBE + 2 <= NPHASE) ? (float)(t2 - t1) * 10.0f : 0.f;
        for (size_t i = c.gtid; i < (size_t)T * D; i += c.ngt) args.out[i] = k1;
        SEAM();
        if (c.gtid == 0) args.out[0] = k2;
    }
#endif
}
#undef IN
#undef BOTH

extern "C" void kernel_launch(void* const* d_in, const int* in_sizes, int n_in, void* d_out, int out_size, void* d_ws, size_t ws_size, hipStream_t stream) {
    static int grid = 0;
    if (grid == 0) {
        if (n_in != 18 || in_sizes[0] != T * D || out_size != T * D || ws_size < WS_END) { fprintf(stderr, "kernel_launch: unexpected shapes (n_in %d, in0 %d, out %d, ws %zu)\n", n_in, n_in > 0 ? in_sizes[0] : -1, out_size, ws_size); grid = -1; return; }
        int dev = 0, cus = 0;
        if (hipGetDevice(&dev) != hipSuccess || hipDeviceGetAttribute(&cus, hipDeviceAttributeMultiprocessorCount, dev) != hipSuccess) { grid = -1; return; }
        if (hipFuncSetAttribute((const void*)fwd, hipFuncAttributeMaxDynamicSharedMemorySize, LDS_BYTES) != hipSuccess) { fprintf(stderr, "kernel_launch: hipFuncSetAttribute failed\n"); grid = -1; return; }
        int per_cu = 0;
        if (hipOccupancyMaxActiveBlocksPerMultiprocessor(&per_cu, (const void*)fwd, NTHR, LDS_BYTES) != hipSuccess || per_cu < 1) fprintf(stderr, "kernel_launch: occupancy query says %d\n", per_cu);
        (void)hipGetLastError();
        grid = cus > 256 ? 256 : cus;
    }
    if (grid < 0) return;
    (void)hipMemsetAsync((char*)d_ws + WS_CTL, 0, CTL_ZERO_BYTES, stream);
    Args a{};
    for (int i = 0; i < 18; ++i) a.in[i] = (const float*)d_in[i];
    a.out = (float*)d_out; a.ws = (unsigned char*)d_ws;
#if MK_ONE_LAUNCH
    a.ph_lo = 0; a.ph_hi = NPHASE;
    hipLaunchKernelGGL(fwd, dim3(grid), dim3(NTHR), LDS_BYTES, stream, a);
#else
    for (int p = 0; p < NPHASE; ++p) { a.ph_lo = p; a.ph_hi = p + 1; hipLaunchKernelGGL(fwd, dim3(grid), dim3(NTHR), LDS_BYTES, stream, a); }
#endif
}
```

```cpp
#include <hip/hip_runtime.h>
#include <cstdio>
#include <cstdint>
namespace pg8 {
#define PG8_LAS __attribute__((address_space(3)))
typedef unsigned short bf16_t;
typedef short bf16x8 __attribute__((ext_vector_type(8)));
typedef float f32x4 __attribute__((ext_vector_type(4)));
typedef unsigned u32x4 __attribute__((ext_vector_type(4)));
constexpr int BM = 256, BK = 64, HALF = 128, HTB = HALF * BK * 2  , STAGE_BYTES = 8 * HTB, NXCD = 8, WGM = 8;

__host__ __device__ __forceinline__ int lds_byte(int r, int c) { const int st = (r >> 4) * 2 + (c >> 5), rr = r & 15, cc = c & 31, ob = rr * 64 + cc * 2; return st * 1024 + (ob ^ (((ob >> 9) & 1) << 5)); }
__host__ __device__ __forceinline__ void stage_rc(int b, int& R, int& C) { const int st = b / 1024, sb = b % 1024, swz = sb ^ (((sb >> 9) & 1) << 5); R = (st >> 1) * 16 + swz / 64; C = (st & 1) * 32 + (swz % 64) / 2; }
__host__ __device__ __forceinline__ int perm32(int rho) { const int n = rho >> 4, i = rho & 15; return 8 * (i >> 2) + 4 * n + (i & 3); }

struct Unit { int pm, pn, ui; };
struct Gemm { const bf16_t* A; const bf16_t* Bt; int M, N, K; };

struct StaticOrder {
    int nM, nN, nwg, G, c;
    __host__ __device__ void init(int M, int N, int G_, int c_) { nM = M / BM; nN = N / BM; nwg = nM * nN; G = G_; c = c_; }
    __host__ __device__ bool next(int i, Unit& u) const {
        const long L = (long)i * G + c; if (L >= nwg) return false;
        int wgid = (int)L; { const int q = nwg / NXCD, r = nwg % NXCD, xcd = wgid % NXCD, off = wgid / NXCD; wgid = (xcd < r ? xcd * (q + 1) : r * (q + 1) + (xcd - r) * q) + off; }
        const int nig = WGM * nN, gid = wgid / nig, fm = gid * WGM, gsz = (nM - fm) < WGM ? (nM - fm) : WGM;
        u.pm = fm + ((wgid % nig) % gsz); u.pn = (wgid % nig) / gsz; u.ui = i; return true;
    }
    __device__ __forceinline__ const char* pa(const Gemm& g, const Unit& u) const { return (const char*)g.A + (size_t)u.pm * ((size_t)BM * g.K * 2); }
    __device__ __forceinline__ const char* pb(const Gemm& g, const Unit& u) const { return (const char*)g.Bt + (size_t)u.pn * ((size_t)BM * g.K * 2); }
    static constexpr bool GATHER = false;
    __device__ __forceinline__ void prep() const {}
    __device__ __forceinline__ void aoffs(int, int, int, unsigned (&)[2][2]) const {}
    __device__ __forceinline__ void a_ready(const Unit&) const {}
    __device__ __forceinline__ void done(const Unit&) const {}
};

__device__ __forceinline__ unsigned cvt_pk_bf16(float lo, float hi) { unsigned r; asm volatile("v_cvt_pk_bf16_f32 %0, %1, %2" : "=v"(r) : "v"(lo), "v"(hi)); return r; }
typedef float f32x2 __attribute__((ext_vector_type(2)));
template <class Epi, class Sched, bool ALIGN_EPI = false, bool SP2 = false>
__device__ __forceinline__ void gemm_phase(PG8_LAS unsigned char* lds, const Gemm g, const Sched& S, const Epi& E) {
    const int tid = threadIdx.x, wid = __builtin_amdgcn_readfirstlane(tid >> 6), lane = tid & 63, wr = wid >> 2, wc = wid & 3, fr = lane & 15, fq = lane >> 4;
    const int K = g.K, nt = K / BK;
    unsigned voffA[2], voffB[2];
#pragma unroll
    for (int i = 0; i < 2; ++i) { int R, C; stage_rc(tid * 16 + i * 8192, R, C); const int Rb = Epi::PERM ? ((R & ~31) + perm32(R & 31)) : R;
        voffA[i] = (unsigned)(R * K + C) * 2u; voffB[i] = (unsigned)(((int)Epi::WIDE == 2 ? ((R >> 5) * 64 + 16 * (perm32(R & 31) >> 3) + (perm32(R & 31) & 7)) : (int)Epi::WIDE == 1 ? ((R >> 5) * 64 + perm32(R & 31)) : Rb) * K + C) * 2u; }
    const size_t kstep = (size_t)(BK * 2);
    const size_t hstep = (size_t)HALF * K * 2;
    const size_t hstepB = (int)Epi::WIDE == 2 ? (size_t)8 * K * 2 : (int)Epi::WIDE == 1 ? (size_t)32 * K * 2 : hstep;
    const size_t tstep = 2 * hstep;
    const unsigned ldsw = (unsigned)wid * 1024u;
    const int aoff = lds_byte(wr * 64 + fr, fq * 8), boff = lds_byte(wc * 32 + fr, fq * 8);
#define PG8_SA(b, h) (((b) * 2 + (h)) * HTB)
#define PG8_SB(b, h) ((4 + (b) * 2 + (h)) * HTB)
#define PG8_STAGE(bufoff, gbase, voff) do { _Pragma("unroll") for (int _i = 0; _i < 2; ++_i) \
        __builtin_amdgcn_global_load_lds((const unsigned*)((const char*)(gbase) + (voff)[_i]), (PG8_LAS unsigned*)(lds + (bufoff) + ldsw + _i * 8192), 16, 0, 0); } while (0)
#define PG8_STAGE_A(bufoff, kptr, half, NXT) do { if constexpr (Sched::GATHER) { const unsigned vx_[2] = {(NXT) ? van[half][0] : va[half][0], (NXT) ? van[half][1] : va[half][1]}; PG8_STAGE(bufoff, kptr, vx_); } \
        else { PG8_STAGE(bufoff, (kptr) + ((half) ? hstep : 0), voffA); } } while (0)
#define PG8_LDA(dst, b, h) do { _Pragma("unroll") for (int m = 0; m < 4; ++m) _Pragma("unroll") for (int k = 0; k < 2; ++k) dst[m][k] = *(const PG8_LAS bf16x8*)(lds + PG8_SA(b, h) + aoff + m * 2048 + k * 1024); } while (0)
#define PG8_LDB(dst, b, h) do { _Pragma("unroll") for (int n = 0; n < 2; ++n) _Pragma("unroll") for (int k = 0; k < 2; ++k) dst[n][k] = *(const PG8_LAS bf16x8*)(lds + PG8_SB(b, h) + boff + n * 2048 + k * 1024); } while (0)
#define PG8_MMA(ai, bj, At, Bt) do { __builtin_amdgcn_s_setprio(1); _Pragma("unroll") for (int m = 0; m < 4; ++m) _Pragma("unroll") for (int n = 0; n < 2; ++n) _Pragma("unroll") for (int k = 0; k < 2; ++k) \
        acc[ai][bj][m][n] = __builtin_amdgcn_mfma_f32_16x16x32_bf16(Bt[n][k], At[m][k], acc[ai][bj][m][n], 0, 0, 0); __builtin_amdgcn_s_setprio(0); } while (0)
#define PG8_WAIT_V(n) asm volatile("s_waitcnt vmcnt(" #n ")" ::: "memory")
#define PG8_WAIT_L(n) asm volatile("s_waitcnt lgkmcnt(" #n ")" ::: "memory")
#define PG8_BAR __builtin_amdgcn_s_barrier()
#define PG8_SCHED __builtin_amdgcn_sched_barrier(0)
    Unit cur, nxt; int ui = 0;
    if (!S.next(0, cur)) return;
    S.prep();
    f32x4 acc[2][2][4][2];
#pragma unroll
    for (int a = 0; a < 2; ++a)
#pragma unroll
        for (int b = 0; b < 2; ++b)
#pragma unroll
            for (int m = 0; m < 4; ++m)
#pragma unroll
                for (int n = 0; n < 2; ++n) acc[a][b][m][n] = (f32x4){0.f, 0.f, 0.f, 0.f};
    bf16x8 At[4][2], B0[2][2], B1[2][2];
    const char* cA = S.pa(g, cur); const char* cB = S.pb(g, cur);
    unsigned va[2][2] = {{0u, 0u}, {0u, 0u}}, van[2][2] = {{0u, 0u}, {0u, 0u}};
    static_assert(SP2 || !Epi::WIDE, "WIDE epilogues: SP2 loop only");
    if constexpr (Sched::GATHER) { static_assert(SP2, "gathered A rows: SP2 loop only"); S.aoffs(0, K, tid, va); }
    S.a_ready(cur);
    if constexpr (SP2) {
        PG8_STAGE(PG8_SB(0, 0), cB, voffB); PG8_STAGE(PG8_SB(0, 1), cB + hstepB, voffB); PG8_STAGE_A(PG8_SA(0, 0), cA, 0, false); PG8_STAGE_A(PG8_SA(0, 1), cA, 1, false);
        if (wr == 1) PG8_BAR;
        PG8_WAIT_V(2); PG8_BAR;
        PG8_STAGE(PG8_SB(1, 0), cB + kstep, voffB); PG8_STAGE_A(PG8_SA(1, 0), cA + kstep, 0, false); PG8_STAGE(PG8_SB(1, 1), cB + hstepB + kstep, voffB);
        PG8_WAIT_V(6); PG8_BAR;
    } else {
        PG8_STAGE(PG8_SB(0, 0), cB, voffB); PG8_STAGE(PG8_SA(0, 0), cA, voffA); PG8_STAGE(PG8_SB(0, 1), cB + hstep, voffB); PG8_STAGE(PG8_SA(0, 1), cA + hstep, voffA);
        if (wr == 1) PG8_BAR;
        PG8_WAIT_V(4); PG8_BAR;
        PG8_STAGE(PG8_SB(1, 0), cB + kstep, voffB); PG8_STAGE(PG8_SA(1, 0), cA + kstep, voffA); PG8_STAGE(PG8_SB(1, 1), cB + hstep + kstep, voffB);
        PG8_WAIT_V(6); PG8_BAR;
    }
    for (;;) {
        const bool has_next = S.next(ui + 1, nxt);
        if constexpr (Sched::GATHER) { if (has_next) S.aoffs(ui + 1, K, tid, van); else { van[0][0] = va[0][0]; van[0][1] = va[0][1]; van[1][0] = va[1][0]; van[1][1] = va[1][1]; } }
        const char* nA = has_next ? S.pa(g, nxt) : cA; const char* nB = has_next ? S.pb(g, nxt) : cB;
        for (int t = 0; t < nt; t += 2) {
            const bool last = (t == nt - 2);
            const char* a1 = cA + (size_t)(t + 1) * kstep;
            const char* a2 = last ? nA : cA + (size_t)(t + 2) * kstep; const char* b2 = last ? nB : cB + (size_t)(t + 2) * kstep;
            const char* a3 = a2 + kstep; const char* b3 = b2 + kstep;
            if (last && has_next) S.a_ready(nxt);
            if constexpr (SP2) {
            PG8_LDB(B0, 0, 0); PG8_LDB(B1, 0, 1); PG8_SCHED; PG8_LDA(At, 0, 0); PG8_STAGE_A(PG8_SA(1, 1), a1, 1, false);
            PG8_WAIT_V(8); PG8_WAIT_L(0); PG8_BAR; PG8_MMA(0, 0, At, B0); PG8_MMA(0, 1, At, B1); PG8_BAR; PG8_SCHED;
            PG8_LDA(At, 0, 1); PG8_STAGE(PG8_SB(0, 0), b2, voffB); PG8_STAGE(PG8_SB(0, 1), b2 + hstepB, voffB); PG8_STAGE_A(PG8_SA(0, 0), a2, 0, last);
            PG8_WAIT_V(8); PG8_WAIT_L(0); PG8_BAR; PG8_MMA(1, 0, At, B0); PG8_MMA(1, 1, At, B1); PG8_BAR; PG8_SCHED;
            PG8_LDB(B0, 1, 0); PG8_LDB(B1, 1, 1); PG8_SCHED; PG8_LDA(At, 1, 0); PG8_STAGE_A(PG8_SA(0, 1), a2, 1, last);
            PG8_WAIT_V(8); PG8_WAIT_L(0); PG8_BAR; PG8_MMA(0, 0, At, B0); PG8_MMA(0, 1, At, B1); PG8_BAR; PG8_SCHED;
            PG8_LDA(At, 1, 1); PG8_STAGE(PG8_SB(1, 0), b3, voffB); PG8_STAGE(PG8_SB(1, 1), b3 + hstepB, voffB); PG8_STAGE_A(PG8_SA(1, 0), a3, 0, last);
            PG8_WAIT_V(8); PG8_WAIT_L(0); PG8_BAR; PG8_MMA(1, 0, At, B0); PG8_MMA(1, 1, At, B1); PG8_BAR; PG8_SCHED;
            } else {
            PG8_LDB(B0, 0, 0); PG8_SCHED; PG8_LDA(At, 0, 0); PG8_STAGE(PG8_SA(1, 1), a1 + hstep, voffA);
            PG8_WAIT_L(8); PG8_BAR; PG8_WAIT_L(0); PG8_MMA(0, 0, At, B0); PG8_BAR; PG8_SCHED;
            PG8_LDB(B1, 0, 1); PG8_STAGE(PG8_SB(0, 0), b2, voffB);
            PG8_BAR; PG8_WAIT_L(0); PG8_MMA(0, 1, At, B1); PG8_BAR;
            PG8_LDA(At, 0, 1); PG8_STAGE(PG8_SA(0, 0), a2, voffA);
            PG8_BAR; PG8_WAIT_L(0); PG8_MMA(1, 0, At, B0); PG8_BAR; PG8_SCHED;
            PG8_STAGE(PG8_SB(0, 1), b2 + hstep, voffB);
            PG8_WAIT_V(6); PG8_BAR; PG8_MMA(1, 1, At, B1); PG8_BAR;
            PG8_LDB(B0, 1, 0); PG8_SCHED; PG8_LDA(At, 1, 0); PG8_STAGE(PG8_SA(0, 1), a2 + hstep, voffA);
            PG8_WAIT_L(8); PG8_BAR; PG8_WAIT_L(0); PG8_MMA(0, 0, At, B0); PG8_BAR; PG8_SCHED;
            PG8_LDB(B1, 1, 1); PG8_STAGE(PG8_SB(1, 0), b3, voffB);
            PG8_BAR; PG8_WAIT_L(0); PG8_MMA(0, 1, At, B1); PG8_BAR;
            PG8_LDA(At, 1, 1); PG8_STAGE(PG8_SA(1, 0), a3, voffA);
            PG8_BAR; PG8_WAIT_L(0); PG8_MMA(1, 0, At, B0); PG8_BAR; PG8_SCHED;
            PG8_STAGE(PG8_SB(1, 1), b3 + hstep, voffB);
            PG8_WAIT_V(6); PG8_BAR; PG8_MMA(1, 1, At, B1); PG8_BAR;
            }
        }
        if constexpr (ALIGN_EPI) { if (wr == 0) PG8_BAR; }
        if constexpr (!Epi::AFTER_DRAIN) { E(acc, cur, wr, wc, fr, fq); S.done(cur); }
        if (!has_next) break;
#pragma unroll
        for (int a = 0; a < 2; ++a)
#pragma unroll
            for (int b = 0; b < 2; ++b)
#pragma unroll
                for (int m = 0; m < 4; ++m)
#pragma unroll
                    for (int n = 0; n < 2; ++n) acc[a][b][m][n] = (f32x4){0.f, 0.f, 0.f, 0.f};
        cur = nxt; cA = nA; cB = nB; ++ui;
        if constexpr (Sched::GATHER) { va[0][0] = van[0][0]; va[0][1] = van[0][1]; va[1][0] = van[1][0]; va[1][1] = van[1][1]; }
        if constexpr (ALIGN_EPI) { if (wr == 1) PG8_BAR; }
    }
    PG8_WAIT_V(0);
    if constexpr (!ALIGN_EPI) { if (wr == 0) PG8_BAR; }
    PG8_BAR;
    if constexpr (Epi::AFTER_DRAIN) { E.fused(acc, cur, wr, wc, fr, fq, lds, wid, lane); S.done(cur); }
#undef PG8_SA
#undef PG8_SB
#undef PG8_STAGE
#undef PG8_STAGE_A
#undef PG8_LDA
#undef PG8_LDB
#undef PG8_MMA
#undef PG8_WAIT_V
#undef PG8_WAIT_L
#undef PG8_BAR
#undef PG8_SCHED
}
}

#ifndef MK_ONE_LAUNCH
#define MK_ONE_LAUNCH 1
#endif
constexpr int NWAVES = 8, NTHR = 512;
constexpr int BATCH = 16, SEQ = 2048, T = BATCH * SEQ, D = 2048;
constexpr int QKV_N = 9216, NH = 8, HD = 128, OD = NH * HD;
constexpr int ZN = 6144, ZLD = 6160;
constexpr int NE = 16, DE = 768, GU_N = 2 * DE;
constexpr int MAXTILES = 272, MAXROWS = MAXTILES * 256;
constexpr float ALPHA = 1.41421356237309515f;
constexpr float LN_EPS = 1e-5f;
constexpr int NPHASE = 18;
constexpr int ECAP = 32768;

constexpr size_t MiB = 1u << 20, KiB = 1u << 10;
constexpr size_t WS_CTL = 0, CTL_ZERO_BYTES = 256 * KiB;
constexpr size_t WS_ROPE = 1 * MiB;
constexpr size_t WS_EID = 1 * MiB + 256 * KiB;
constexpr size_t WS_EGATE = 1 * MiB + 512 * KiB;
constexpr size_t WS_ROWMAP = 1 * MiB + 768 * KiB;
constexpr size_t WS_HIST = 2 * MiB + 256 * KiB;
constexpr size_t WS_TILEE = 2 * MiB + 320 * KiB;
constexpr size_t WS_GATES = 3 * MiB;
constexpr size_t WS_WQKV = 6 * MiB, WS_WO = 42 * MiB, WS_WIN = 46 * MiB, WS_WOUT = 70 * MiB, WS_WGU = 78 * MiB, WS_WD = 174 * MiB;
constexpr size_t WS_XB = 222 * MiB;
constexpr size_t WS_R = 350 * MiB;
constexpr size_t WS_QKV = WS_R, WS_O = WS_R + 576 * MiB;
constexpr size_t WS_PRE = WS_R, WS_YB = WS_R;
constexpr size_t WS_XG = WS_R + 256 * MiB, WS_H = WS_R + 528 * MiB;
constexpr size_t WS_Z = WS_R, WS_QKC = WS_R + 384 * MiB, WS_HC = WS_R + 512 * MiB, WS_Y = WS_QKC;
constexpr size_t WS_RM2 = 990 * MiB;
constexpr size_t WS_END = 992 * MiB;
static_assert(WS_ROWMAP + (size_t)MAXROWS * 4 <= WS_HIST && WS_H + (size_t)MAXROWS * DE * 2 <= WS_RM2 && WS_RM2 + (size_t)16 * ECAP * 4 <= WS_END && WS_XG + (size_t)MAXROWS * D * 2 <= WS_H, "ws map");
constexpr int CW_TMO = 0, CW_BAR = 4096, CW_CONVQ = 8192, CW_CUR = 12288;

constexpr int RING_BYTES = 131072, LDSCTL_OFF = RING_BYTES, LDS_BYTES = 147456;
constexpr int LC_HIST = 0, LC_BAR = 64;

#define GAS __attribute__((address_space(1)))
#define LAS __attribute__((address_space(3)))
typedef unsigned short bf16;
typedef unsigned u32x4 __attribute__((ext_vector_type(4)));
typedef unsigned u32x2 __attribute__((ext_vector_type(2)));
typedef float f32x4 __attribute__((ext_vector_type(4)));
typedef float f32x2 __attribute__((ext_vector_type(2)));
#define LDS_WAIT() asm volatile("s_waitcnt lgkmcnt(0)" ::: "memory")
__device__ __forceinline__ unsigned f2bf(float f) { unsigned u = __builtin_bit_cast(unsigned, f); return (u + 0x7fffu + ((u >> 16) & 1u)) >> 16; }
__device__ __forceinline__ unsigned pk2(float lo, float hi) { return pg8::cvt_pk_bf16(lo, hi); }
__device__ __forceinline__ float bflo(unsigned u) { return __builtin_bit_cast(float, u << 16); }
__device__ __forceinline__ float bfhi(unsigned u) { return __builtin_bit_cast(float, u & 0xffff0000u); }
__device__ __forceinline__ float bf1(bf16 b) { return __builtin_bit_cast(float, (unsigned)b << 16); }
template <int CTRL> __device__ __forceinline__ float dpp0(float x) { return __builtin_bit_cast(float, __builtin_amdgcn_update_dpp(0, __builtin_bit_cast(int, x), CTRL, 0xf, 0xf, true)); }
template <int CTRL> __device__ __forceinline__ float dppx(float x) { return __builtin_bit_cast(float, __builtin_amdgcn_mov_dpp(__builtin_bit_cast(int, x), CTRL, 0xf, 0xf, true)); }
template <int CTRL, int ROWMASK> __device__ __forceinline__ float dpps(float x) { return __builtin_bit_cast(float, __builtin_amdgcn_update_dpp(__builtin_bit_cast(int, x), __builtin_bit_cast(int, x), CTRL, ROWMASK, 0xf, false)); }
__device__ __forceinline__ float prefix_sum64(float v) {
    v += dpp0<0x111>(v); v += dpp0<0x112>(v); v += dpp0<0x114>(v); v += dpp0<0x118>(v);
    v += __builtin_bit_cast(float, __builtin_amdgcn_update_dpp(0, __builtin_bit_cast(int, v), 0x142, 0xa, 0xf, false));
    v += __builtin_bit_cast(float, __builtin_amdgcn_update_dpp(0, __builtin_bit_cast(int, v), 0x143, 0xc, 0xf, false));
    return v;
}
__device__ __forceinline__ float prefix_max64(float v) {
    v = fmaxf(v, dpps<0x111, 0xf>(v)); v = fmaxf(v, dpps<0x112, 0xf>(v)); v = fmaxf(v, dpps<0x114, 0xf>(v)); v = fmaxf(v, dpps<0x118, 0xf>(v));
    v = fmaxf(v, dpps<0x142, 0xa>(v)); v = fmaxf(v, dpps<0x143, 0xc>(v));
    return v;
}
__device__ __forceinline__ float lane_bcast(float v, int l) { return __builtin_bit_cast(float, __builtin_amdgcn_readlane(__builtin_bit_cast(int, v), l)); }
__device__ __forceinline__ float wave_sum(float v) { return lane_bcast(prefix_sum64(v), 63); }
__device__ __forceinline__ float row16_sum(float v) { v += dppx<0xB1>(v); v += dppx<0x4E>(v); v += dppx<0x141>(v); v += dppx<0x128>(v); return v; }
__device__ __forceinline__ float lane_xor1(float v) { return dppx<0xB1>(v); }
__device__ __forceinline__ float lane_xor32(float v) { auto r = __builtin_amdgcn_permlane32_swap(__builtin_bit_cast(unsigned, v), __builtin_bit_cast(unsigned, v), false, false);
    return __builtin_bit_cast(float, (threadIdx.x & 32) ? r[0] : r[1]); }

#define XB_TMO      128
#define XB_XCNT(j)  (256  + 64 * (j))
#define XB_XSUB(j)  (1280 + 64 * (j))
#define XB_XGEN(j)  (2304 + 64 * (j))
#define XB_TOP      3328
#define XB_TOPGEN   3392
#define XCD_BAR_WORDS 3456
#define XB_SPIN_CAP (1u << 18)
__device__ __forceinline__ unsigned xb_ld(unsigned* p)              { return __hip_atomic_load(p, __ATOMIC_RELAXED, __HIP_MEMORY_SCOPE_AGENT); }
__device__ __forceinline__ unsigned xb_add(unsigned* p, unsigned v) { return __hip_atomic_fetch_add(p, v, __ATOMIC_RELAXED, __HIP_MEMORY_SCOPE_AGENT); }
__device__ __forceinline__ unsigned xb_xcc_id() { return (unsigned)__builtin_amdgcn_s_getreg((3 << 11) | 20) & 0xFu; }
#define XB_SPIN(cond, bar) do { unsigned _sp = 0; while (cond) { __builtin_amdgcn_s_sleep(1); \
    if ((++_sp & 255u) == 0u) { if (xb_ld(&(bar)[XB_TMO])) break; if (_sp > XB_SPIN_CAP) { atomicAdd(&(bar)[XB_TMO], 1u); break; } } } } while (0)
struct XcdBarrier { unsigned* bar; unsigned x; volatile LAS unsigned* st; };
__device__ __forceinline__ XcdBarrier xcd_barrier_post(unsigned* bar, volatile LAS unsigned* st) {
    XcdBarrier b; b.bar = bar; b.x = xb_xcc_id(); b.st = st;
    if (threadIdx.x == 0) (void)xb_add(&bar[XB_XCNT(b.x)], 1u);
    return b;
}
__device__ __forceinline__ void xcd_barrier_complete(unsigned* bar, unsigned x, unsigned& nloc, unsigned& nx) {
    const unsigned G = gridDim.x * gridDim.y * gridDim.z;
    unsigned sum, cnt, mine, sp = 0u;
    for (;;) {
        sum = 0u; cnt = 0u; mine = 0u;
#pragma unroll
        for (unsigned j = 0; j < 16; ++j) { const unsigned c = xb_ld(&bar[XB_XCNT(j)]); sum += c; cnt += (c > 0u) ? 1u : 0u; mine = (j == x) ? c : mine; }
        if (sum == G) break;
        __builtin_amdgcn_s_sleep(1);
        if ((++sp & 255u) == 0u) { if (xb_ld(&bar[XB_TMO])) break; if (sp > XB_SPIN_CAP) { atomicAdd(&bar[XB_TMO], 1u); break; } }
    }
    nloc = mine > 0u ? mine : 1u; nx = cnt > 0u ? cnt : 1u;
}
__device__ __forceinline__ void xcd_barrier(const XcdBarrier& b) {
    asm volatile("s_waitcnt vmcnt(0)" ::: "memory");
    __syncthreads();
    if (threadIdx.x == 0) {
        unsigned* bar = b.bar;
        __builtin_amdgcn_s_waitcnt(0);
        unsigned nloc = b.st[0], nx = b.st[1];
        if (nloc == 0u) { xcd_barrier_complete(bar, b.x, nloc, nx); b.st[0] = nloc; b.st[1] = nx; }
        const unsigned old = xb_add(&bar[XB_XSUB(b.x)], 1u);
        const unsigned gen = old / nloc;
        if (old + 1u == (gen + 1u) * nloc) {
            __builtin_amdgcn_fence(__ATOMIC_RELEASE, "agent");
            asm volatile("s_waitcnt vmcnt(0)" ::: "memory");
            const unsigned og = xb_add(&bar[XB_TOP], 1u);
            const unsigned tg = og / nx;
            if (og + 1u == (tg + 1u) * nx) xb_add(&bar[XB_TOPGEN], 1u);
            else XB_SPIN(xb_ld(&bar[XB_TOPGEN]) == tg, bar);
            __builtin_amdgcn_fence(__ATOMIC_ACQUIRE, "agent");
            xb_add(&bar[XB_XGEN(b.x)], 1u);
            asm volatile("s_waitcnt vmcnt(0)" ::: "memory");
        } else {
            XB_SPIN(xb_ld(&bar[XB_XGEN(b.x)]) == gen, bar);
            __builtin_amdgcn_fence(__ATOMIC_ACQUIRE, "agent");
            asm volatile("s_waitcnt vmcnt(0)" ::: "memory");
        }
    }
    __syncthreads();
}

struct Ctx { LAS unsigned char* lds; int tid, lane, wave, G, bid, gw, ngw, gtid, ngt; };

struct TrDesc { const float* wp; bf16* dst; int ldw, K, row_mul, n0; };
__device__ __forceinline__ void tr_mk(TrDesc& d, const float* W, int ldw, int K, bf16* WT, int row_off, int row_mul, int kb, int nb, int lane) {
    const int k0 = 64 * kb, n0 = 32 * nb; d.wp = W + (size_t)(k0 + (lane >> 5)) * ldw + n0 + (lane & 31); d.dst = WT + (size_t)(row_off + n0 * row_mul) * K + k0; d.ldw = ldw; d.K = K; d.row_mul = row_mul; d.n0 = n0; }
__device__ __forceinline__ void tr_load(const TrDesc& d, float (&tv)[32]) {
#pragma unroll
    for (int i = 0; i < 32; ++i) tv[i] = d.wp[(size_t)(2 * i) * d.ldw]; }
__device__ __forceinline__ int qk_perm(int n) {
    if ((n % 3072) >= 2048) return n;
    const int d = n & 127; int g, e; if (d < 16) { g = d; e = 0; } else if (d < 32) { g = d - 16; e = 1; } else { const int t = d - 32; g = t / 6; e = t - 6 * g + 2; }
    return (n & ~127) + (g >> 2) * 32 + (g & 3) * 8 + e; }
template <bool PQ>
__device__ __forceinline__ void tr_store(const TrDesc& d, const float (&tv)[32], LAS float* scr, int lane) {
#pragma unroll
    for (int i = 0; i < 32; ++i) scr[(2 * i + (lane >> 5)) * 33 + (lane & 31)] = tv[i];
    LDS_WAIT(); asm volatile("" ::: "memory");
    const int c = lane & 7;
#pragma unroll
    for (int j = 0; j < 4; ++j) { const int n = (lane >> 3) + 8 * j; const LAS float* s_ = scr + (8 * c) * 33 + n;
        u32x4 o; o.x = pk2(s_[0 * 33], s_[1 * 33]); o.y = pk2(s_[2 * 33], s_[3 * 33]); o.z = pk2(s_[4 * 33], s_[5 * 33]); o.w = pk2(s_[6 * 33], s_[7 * 33]);
        if (PQ) *(u32x4*)(d.dst + (ptrdiff_t)(qk_perm(d.n0 + n) - d.n0) * d.K + 8 * c) = o;
        else *(u32x4*)(d.dst + (size_t)(n * d.row_mul) * d.K + 8 * c) = o; }
    LDS_WAIT(); asm volatile("" ::: "memory");
}
#define TR_PIPELINE(first_, stride_, end_, MK_) TR_PIPELINE_X(first_, stride_, end_, MK_, false)
#define TR_PIPELINE_X(first_, stride_, end_, MK_, PQ_) do { LAS float* scr_ = (LAS float*)(c.lds + c.wave * 16384); TrDesc cur_, nxt_; float ta_[32], tb_[32]; int it_ = (first_); \
        if (it_ < (end_)) { MK_(cur_, it_); tr_load(cur_, ta_); } \
        for (; it_ < (end_); it_ += (stride_)) { const int itn_ = it_ + (stride_); const bool hn_ = itn_ < (end_); if (hn_) { MK_(nxt_, itn_); tr_load(nxt_, tb_); } \
            tr_store<PQ_>(cur_, ta_, scr_, c.lane); if (hn_) { cur_ = nxt_; _Pragma("unroll") for (int q_ = 0; q_ < 32; ++q_) ta_[q_] = tb_[q_]; } } } while (0)
template <bool PQ = false>
__device__ __forceinline__ void conv_job(const Ctx& c, const float* W, int ldw, int K, int N, bf16* WT, int gw0, int ngw0) {
    const int nblk = N / 32, items = (K / 64) * nblk;
#define MK_JOB(d_, it2_) tr_mk(d_, W, ldw, K, WT, 0, 1, (it2_) / nblk, (it2_) % nblk, c.lane)
    TR_PIPELINE_X(gw0, ngw0, items, MK_JOB, PQ);
#undef MK_JOB
}
constexpr int CONV_MOE_ITEMS = 3 * NE * 768;
__device__ __forceinline__ void conv_moe_mk(TrDesc& d, int it, const float* Wg, const float* Wu, const float* Wd, bf16* WGU, bf16* WD, int lane) {
    constexpr int PER = 768; const int kind = it / (NE * PER), r = it % (NE * PER), e = r / PER, q = r % PER;
    if (kind < 2) tr_mk(d, (kind == 0 ? Wg : Wu) + (size_t)e * D * DE, DE, D, WGU + (size_t)e * GU_N * D, kind, 2, q / 24, q % 24, lane);
    else tr_mk(d, Wd + (size_t)e * DE * D, D, DE, WD + (size_t)e * D * DE, 0, 1, q / 64, q % 64, lane);
}
__device__ __forceinline__ void conv_moe(const Ctx& c, const float* Wg, const float* Wu, const float* Wd, bf16* WGU, bf16* WD, int gw0, int ngw0, int end = CONV_MOE_ITEMS, int start = 0) {
#define MK_MOE(d_, it2_) conv_moe_mk(d_, it2_, Wg, Wu, Wd, WGU, WD, c.lane)
    TR_PIPELINE(start + gw0, ngw0, end, MK_MOE);
#undef MK_MOE
}
__device__ __forceinline__ void x_to_bf16(const Ctx& c, const float* x, bf16* XB) {
    for (size_t i = c.gtid; i < (size_t)T * D / 8; i += c.ngt) { const f32x4 a = ((const f32x4*)x)[2 * i], b = ((const f32x4*)x)[2 * i + 1];
        u32x4 o; o.x = pk2(a.x, a.y); o.y = pk2(a.z, a.w); o.z = pk2(b.x, b.y); o.w = pk2(b.z, b.w); ((u32x4*)XB)[i] = o; }
}
__device__ __forceinline__ void rope_table(const Ctx& c, f32x2* tab) {
    for (int i = c.gtid; i < SEQ * 16; i += c.ngt) { const int pos = i >> 4, j = i & 15;
        const float inv = powf(500000.0f, -(float)j / 16.0f); const float ang = (float)pos * inv;
        tab[i] = (f32x2){cosf(ang), sinf(ang)}; }
}

__device__ __forceinline__ void rope_pass(const Ctx& c, bf16* QKV, const f32x2* tab) {
    for (int idx = c.gtid; idx < T * 48; idx += c.ngt) {
        const int h = idx & 7, s = (idx >> 3) & 1, g = (idx >> 4) % 3, tok = idx / 48, pos = tok & (SEQ - 1);
        u32x4* p = (u32x4*)(QKV + (size_t)tok * QKV_N + g * 3072 + s * 1024 + h * HD);
        u32x4 a0 = p[0], a1 = p[1], b0 = p[2], b1 = p[3];
        const f32x2* tb = tab + pos * 16;
        unsigned x1[8] = {a0.x, a0.y, a0.z, a0.w, a1.x, a1.y, a1.z, a1.w}, x2[8] = {b0.x, b0.y, b0.z, b0.w, b1.x, b1.y, b1.z, b1.w};
        unsigned o1[8], o2[8];
#pragma unroll
        for (int k = 0; k < 8; ++k) { const f32x2 cs0 = tb[2 * k], cs1 = tb[2 * k + 1];
            const float u0 = bflo(x1[k]), u1 = bfhi(x1[k]), v0 = bflo(x2[k]), v1 = bfhi(x2[k]);
            o1[k] = pk2(u0 * cs0.x - v0 * cs0.y, u1 * cs1.x - v1 * cs1.y);
            o2[k] = pk2(v0 * cs0.x + u0 * cs0.y, v1 * cs1.x + u1 * cs1.y); }
        p[0] = (u32x4){o1[0], o1[1], o1[2], o1[3]}; p[1] = (u32x4){o1[4], o1[5], o1[6], o1[7]};
        p[2] = (u32x4){o2[0], o2[1], o2[2], o2[3]}; p[3] = (u32x4){o2[4], o2[5], o2[6], o2[7]};
    }
}

__device__ __forceinline__ void attn_naive(const Ctx& c, const bf16* QKV, bf16* O) {
    const int sub = c.gtid & 3;
    for (int q = c.gtid >> 2; q < T * NH; q += c.ngt >> 2) {
        const int tok = q >> 3, h = q & 7, b = tok >> 11, t = tok & (SEQ - 1);
        float m = -1e30f, l = 0.f; float o[32];
#pragma unroll
        for (int i = 0; i < 32; ++i) o[i] = 0.f;
        for (int g = 0; g < 3; ++g) {
            const int dil = g == 0 ? 1 : (g == 1 ? 4 : 16);
            const u32x4* qp = (const u32x4*)(QKV + (size_t)tok * QKV_N + g * 3072 + h * HD + sub * 32);
            float qf[32];
#pragma unroll
            for (int i = 0; i < 4; ++i) { const u32x4 w = qp[i]; qf[8 * i + 0] = bflo(w.x); qf[8 * i + 1] = bfhi(w.x); qf[8 * i + 2] = bflo(w.y); qf[8 * i + 3] = bfhi(w.y);
                qf[8 * i + 4] = bflo(w.z); qf[8 * i + 5] = bfhi(w.z); qf[8 * i + 6] = bflo(w.w); qf[8 * i + 7] = bfhi(w.w); }
            for (int i = 0; i <= 128; ++i) {
                const int pos = t - dil * i; const bool valid = pos >= 0; const int pc = valid ? pos : t;
                const bf16* rowp = QKV + (size_t)(b * SEQ + pc) * QKV_N + g * 3072 + h * HD + sub * 32;
                const u32x4* kp = (const u32x4*)(rowp + 1024); const u32x4* vp = (const u32x4*)(rowp + 2048);
                float dot = 0.f;
#pragma unroll
                for (int j = 0; j < 4; ++j) { const u32x4 w = kp[j];
                    dot += qf[8 * j + 0] * bflo(w.x) + qf[8 * j + 1] * bfhi(w.x) + qf[8 * j + 2] * bflo(w.y) + qf[8 * j + 3] * bfhi(w.y)
                         + qf[8 * j + 4] * bflo(w.z) + qf[8 * j + 5] * bfhi(w.z) + qf[8 * j + 6] * bflo(w.w) + qf[8 * j + 7] * bfhi(w.w); }
                dot += __shfl_xor(dot, 1); dot += __shfl_xor(dot, 2);
                float s = dot * 0.08838834764831845f; if (!valid) s = -__builtin_inff();
                const float mn = fmaxf(m, s), al = __expf(m - mn), p = __expf(s - mn);
                l = l * al + p; m = mn;
#pragma unroll
                for (int j = 0; j < 4; ++j) { const u32x4 w = vp[j];
                    o[8 * j + 0] = o[8 * j + 0] * al + p * bflo(w.x); o[8 * j + 1] = o[8 * j + 1] * al + p * bfhi(w.x);
                    o[8 * j + 2] = o[8 * j + 2] * al + p * bflo(w.y); o[8 * j + 3] = o[8 * j + 3] * al + p * bfhi(w.y);
                    o[8 * j + 4] = o[8 * j + 4] * al + p * bflo(w.z); o[8 * j + 5] = o[8 * j + 5] * al + p * bfhi(w.z);
                    o[8 * j + 6] = o[8 * j + 6] * al + p * bflo(w.w); o[8 * j + 7] = o[8 * j + 7] * al + p * bfhi(w.w); }
            }
        }
        const float rl = 1.f / l;
        u32x4* op = (u32x4*)(O + (size_t)tok * OD + h * HD + sub * 32);
#pragma unroll
        for (int j = 0; j < 4; ++j) op[j] = (u32x4){pk2(o[8 * j] * rl, o[8 * j + 1] * rl), pk2(o[8 * j + 2] * rl, o[8 * j + 3] * rl), pk2(o[8 * j + 4] * rl, o[8 * j + 5] * rl), pk2(o[8 * j + 6] * rl, o[8 * j + 7] * rl)};
    }
}

template <int SRC, bool FINAL>
__device__ __forceinline__ void ln_row(const Ctx& c, int row, f32x4 (&v)[8], const bf16* PRE, float* OUT, const bf16* YB, bf16* XB, const float* lng, const float* lnb, const float* EG) {
    if (SRC == 0) { const u32x2* p = (const u32x2*)(PRE + (size_t)row * D) + c.lane;
#pragma unroll
        for (int j = 0; j < 8; ++j) { const u32x2 a = p[64 * j]; v[j] = (f32x4){bflo(a.x), bfhi(a.x), bflo(a.y), bfhi(a.y)}; } }
    else { const u32x2* p = (const u32x2*)(XB + (size_t)row * D) + c.lane; const unsigned* y0 = (const unsigned*)((const unsigned char*)YB + (size_t)(2 * row) * D) + c.lane; const unsigned* y1 = y0 + D / 4;
        const float g0 = EG[2 * row] * 0.0625f, g1 = EG[2 * row + 1] * 0.0625f;
#pragma unroll
        for (int j = 0; j < 8; ++j) { const u32x2 xf = p[64 * j]; const int a = (int)y0[64 * j], b = (int)y1[64 * j];
            v[j] = (f32x4){ALPHA * bflo(xf.x) + g0 * __builtin_amdgcn_cvt_f32_fp8(a, 0) + g1 * __builtin_amdgcn_cvt_f32_fp8(b, 0), ALPHA * bfhi(xf.x) + g0 * __builtin_amdgcn_cvt_f32_fp8(a, 1) + g1 * __builtin_amdgcn_cvt_f32_fp8(b, 1),
                           ALPHA * bflo(xf.y) + g0 * __builtin_amdgcn_cvt_f32_fp8(a, 2) + g1 * __builtin_amdgcn_cvt_f32_fp8(b, 2), ALPHA * bfhi(xf.y) + g0 * __builtin_amdgcn_cvt_f32_fp8(a, 3) + g1 * __builtin_amdgcn_cvt_f32_fp8(b, 3)}; } }
    float s = 0.f;
#pragma unroll
    for (int j = 0; j < 8; ++j) s += (v[j].x + v[j].y) + (v[j].z + v[j].w);
    const float mean = wave_sum(s) * (1.f / D); float s2 = 0.f;
#pragma unroll
    for (int j = 0; j < 8; ++j) { v[j] = v[j] - mean; s2 += (v[j].x * v[j].x + v[j].y * v[j].y) + (v[j].z * v[j].z + v[j].w * v[j].w); }
    const float rstd = 1.f / sqrtf(wave_sum(s2) * (1.f / D) + LN_EPS);
    f32x4* xo = (f32x4*)(OUT + (size_t)row * D) + c.lane; u32x2* bo = (u32x2*)(XB + (size_t)row * D) + c.lane;
#pragma unroll
    for (int j = 0; j < 8; ++j) { const f32x4 g = ((const f32x4*)lng)[64 * j + c.lane], b = ((const f32x4*)lnb)[64 * j + c.lane];
        v[j] = v[j] * rstd * g + b; if (FINAL) xo[64 * j] = v[j]; else bo[64 * j] = (u32x2){pk2(v[j].x, v[j].y), pk2(v[j].z, v[j].w)}; }
}
__device__ __forceinline__ float lane_xor16(float v) { auto r = __builtin_amdgcn_permlane16_swap(__builtin_bit_cast(unsigned, v), __builtin_bit_cast(unsigned, v), false, false);
    return __builtin_bit_cast(float, (threadIdx.x & 16) ? r[0] : r[1]); }
__device__ __forceinline__ float reduce16(float (&d)[16], int lane) {
    float a8[8], a4[4], a2[2];
    { const bool up = lane & 32;
#pragma unroll
      for (int e = 0; e < 8; ++e) { const float keep = up ? d[e + 8] : d[e], send = up ? d[e] : d[e + 8]; a8[e] = keep + lane_xor32(send); } }
    { const bool up = lane & 16;
#pragma unroll
      for (int e = 0; e < 4; ++e) { const float keep = up ? a8[e + 4] : a8[e], send = up ? a8[e] : a8[e + 4]; a4[e] = keep + lane_xor16(send); } }
    { const bool up = lane & 8;
#pragma unroll
      for (int e = 0; e < 2; ++e) { const float keep = up ? a4[e + 2] : a4[e], send = up ? a4[e] : a4[e + 2]; a2[e] = keep + dppx<0x128>(send); } }
    float a1; { const bool up = lane & 4; const float keep = up ? a2[1] : a2[0], send = up ? a2[0] : a2[1]; a1 = keep + dppx<0x141>(send); }
    a1 += dppx<0x4E>(a1); a1 += dppx<0xB1>(a1);
    return a1;
}
template <int SRC, int EXTRA, bool FINAL>
__device__ __forceinline__ void ln_pass(const Ctx& c, const bf16* PRE, float* OUT, const bf16* YB, bf16* XB, const float* lng, const float* lnb,
                                        const float* wsrc, int wld, int woff, const float* wbias, int* rowmap2, float* egate, unsigned* cursor, float* gates_out) {
    LAS char* wl = (LAS char*)c.lds;
    LAS int* lh = (LAS int*)(c.lds + LDSCTL_OFF + LC_HIST);
    LAS float* lg = (LAS float*)(c.lds + LDSCTL_OFF + 5120) + c.wave * 256;
    if (EXTRA) {
#pragma unroll 1
        for (int it = 0; it < 4; ++it) { float wv[16];
#pragma unroll
            for (int q = 0; q < 16; ++q) { const int idx = c.tid + NTHR * (16 * it + q); wv[q] = wsrc[(size_t)(idx >> 4) * wld + woff + (idx & 15)]; }
#pragma unroll
            for (int q = 0; q < 16; ++q) { const int idx = c.tid + NTHR * (16 * it + q), k = idx >> 4, e = idx & 15;
                const unsigned hb = f2bf(wv[q]); const float hf = __builtin_bit_cast(float, hb << 16); const unsigned lb = f2bf(wv[q] - hf);
                const int off = e * 4096 + ((((k >> 3) ^ e) & 255) << 4) + (k & 7) * 2;
                *(LAS unsigned short*)(wl + off) = (unsigned short)hb; *(LAS unsigned short*)(wl + 65536 + off) = (unsigned short)lb; } } }
    const int l15 = c.lane & 15, q4 = c.lane >> 4;
    for (int vb = c.bid; vb < 256; vb += c.G) {
        if (EXTRA == 1) { if (c.tid < 16) lh[c.tid] = 0; }
        __syncthreads();
        const int rowb = vb * 128 + c.wave * 16;
        int rt_e1 = 0, rt_e2 = 0, rt_r1 = 0, rt_r2 = 0;
        if (SRC == 0 && !FINAL) {
            f32x4 gv[8], bv[8];
#pragma unroll
            for (int j = 0; j < 8; ++j) { gv[j] = ((const f32x4*)lng)[64 * j + c.lane]; bv[j] = ((const f32x4*)lnb)[64 * j + c.lane]; }
            u32x2 ra[2][8], rn[2][8];
#pragma unroll
            for (int q = 0; q < 2; ++q) { const u32x2* p = (const u32x2*)(PRE + (size_t)(rowb + q) * D) + c.lane;
#pragma unroll
                for (int j = 0; j < 8; ++j) ra[q][j] = p[64 * j]; }
            for (int i = 0; i < 8; ++i) {
                if (i < 7) {
#pragma unroll
                    for (int q = 0; q < 2; ++q) { const u32x2* p = (const u32x2*)(PRE + (size_t)(rowb + 2 * i + 2 + q) * D) + c.lane;
#pragma unroll
                        for (int j = 0; j < 8; ++j) rn[q][j] = p[64 * j]; } }
#pragma unroll
                for (int q = 0; q < 2; ++q) { const int row = rowb + 2 * i + q; f32x4 v[8]; float s_ = 0.f;
#pragma unroll
                    for (int j = 0; j < 8; ++j) { const u32x2 a = ra[q][j]; v[j] = (f32x4){bflo(a.x), bfhi(a.x), bflo(a.y), bfhi(a.y)}; s_ += (v[j].x + v[j].y) + (v[j].z + v[j].w); }
                    const float mean = wave_sum(s_) * (1.f / D); float s2 = 0.f;
#pragma unroll
                    for (int j = 0; j < 8; ++j) { v[j] = v[j] - mean; s2 += (v[j].x * v[j].x + v[j].y * v[j].y) + (v[j].z * v[j].z + v[j].w * v[j].w); }
                    const float rstd = 1.f / sqrtf(wave_sum(s2) * (1.f / D) + LN_EPS);
                    u32x2* bo = (u32x2*)(XB + (size_t)row * D) + c.lane;
#pragma unroll
                    for (int j = 0; j < 8; ++j) { const f32x4 y = v[j] * rstd * gv[j] + bv[j]; bo[64 * j] = (u32x2){pk2(y.x, y.y), pk2(y.z, y.w)}; } }
#pragma unroll
                for (int q = 0; q < 2; ++q)
#pragma unroll
                    for (int j = 0; j < 8; ++j) ra[q][j] = rn[q][j];
            }
        } else if (SRC == 1) {
            f32x4 gv[8], bv[8];
#pragma unroll
            for (int j = 0; j < 8; ++j) { gv[j] = ((const f32x4*)lng)[64 * j + c.lane]; bv[j] = ((const f32x4*)lnb)[64 * j + c.lane]; }
            u32x2 rx[3][8]; unsigned ry0[3][8], ry1[3][8]; float rg0[3], rg1[3];
#define LN_LOAD1(slot_, row_) do { const u32x2* p_ = (const u32x2*)(XB + (size_t)(row_) * D) + c.lane; const unsigned* y0_ = (const unsigned*)((const unsigned char*)YB + (size_t)(2 * (row_)) * D) + c.lane; const unsigned* y1_ = y0_ + D / 4; \
                rg0[slot_] = egate[2 * (row_)] * 0.0625f; rg1[slot_] = egate[2 * (row_) + 1] * 0.0625f; \
                _Pragma("unroll") for (int j = 0; j < 8; ++j) { rx[slot_][j] = p_[64 * j]; ry0[slot_][j] = y0_[64 * j]; ry1[slot_][j] = y1_[64 * j]; } } while (0)
            LN_LOAD1(0, rowb); LN_LOAD1(1, rowb + 1); LN_LOAD1(2, rowb + 2);
            for (int i = 0; i < 16; ++i) { const int row = rowb + i; f32x4 v[8]; float s_ = 0.f; const float g0 = rg0[0], g1 = rg1[0];
#pragma unroll
                for (int j = 0; j < 8; ++j) { const u32x2 xf = rx[0][j]; const int a = (int)ry0[0][j], b = (int)ry1[0][j];
                    v[j] = (f32x4){ALPHA * bflo(xf.x) + g0 * __builtin_amdgcn_cvt_f32_fp8(a, 0) + g1 * __builtin_amdgcn_cvt_f32_fp8(b, 0), ALPHA * bfhi(xf.x) + g0 * __builtin_amdgcn_cvt_f32_fp8(a, 1) + g1 * __builtin_amdgcn_cvt_f32_fp8(b, 1),
                                   ALPHA * bflo(xf.y) + g0 * __builtin_amdgcn_cvt_f32_fp8(a, 2) + g1 * __builtin_amdgcn_cvt_f32_fp8(b, 2), ALPHA * bfhi(xf.y) + g0 * __builtin_amdgcn_cvt_f32_fp8(a, 3) + g1 * __builtin_amdgcn_cvt_f32_fp8(b, 3)};
                    s_ += (v[j].x + v[j].y) + (v[j].z + v[j].w); }
#pragma unroll
                for (int j = 0; j < 8; ++j) { rx[0][j] = rx[1][j]; ry0[0][j] = ry0[1][j]; ry1[0][j] = ry1[1][j]; rx[1][j] = rx[2][j]; ry0[1][j] = ry0[2][j]; ry1[1][j] = ry1[2][j]; }
                rg0[0] = rg0[1]; rg1[0] = rg1[1]; rg0[1] = rg0[2]; rg1[1] = rg1[2];
                if (i + 3 < 16) LN_LOAD1(2, rowb + i + 3);
                const float mean = wave_sum(s_) * (1.f / D); float s2 = 0.f;
#pragma unroll
                for (int j = 0; j < 8; ++j) { v[j] = v[j] - mean; s2 += (v[j].x * v[j].x + v[j].y * v[j].y) + (v[j].z * v[j].z + v[j].w * v[j].w); }
                const float rstd = 1.f / sqrtf(wave_sum(s2) * (1.f / D) + LN_EPS);
                f32x4* xo = (f32x4*)(OUT + (size_t)row * D) + c.lane; u32x2* bo = (u32x2*)(XB + (size_t)row * D) + c.lane;
#pragma unroll
                for (int j = 0; j < 8; ++j) { const f32x4 y = v[j] * rstd * gv[j] + bv[j]; if (FINAL) xo[64 * j] = y; else bo[64 * j] = (u32x2){pk2(y.x, y.y), pk2(y.z, y.w)}; } }
#undef LN_LOAD1
        } else
        for (int i = 0; i < 8; ++i) { f32x4 va[8], vc[8];
            ln_row<SRC, FINAL>(c, rowb + 2 * i, va, PRE, OUT, YB, XB, lng, lnb, egate);
            ln_row<SRC, FINAL>(c, rowb + 2 * i + 1, vc, PRE, OUT, YB, XB, lng, lnb, egate); }
        if (EXTRA) {
            asm volatile("s_waitcnt vmcnt(0)" ::: "memory");
            __builtin_amdgcn_fence(__ATOMIC_ACQUIRE, "agent");
            pg8::f32x4 acc = {0.f, 0.f, 0.f, 0.f};
            const bf16* arow = XB + (size_t)(rowb + l15) * D + 8 * q4; const LAS char* wrow = wl + l15 * 4096;
#pragma unroll 16
            for (int kk = 0; kk < 64; ++kk) { const pg8::bf16x8 a = *(const pg8::bf16x8*)(arow + 32 * kk);
                const int ch = (((4 * kk + q4) ^ l15) & 255) << 4;
                const pg8::bf16x8 bh = *(const LAS pg8::bf16x8*)(wrow + ch), bl = *(const LAS pg8::bf16x8*)(wrow + 65536 + ch);
                acc = __builtin_amdgcn_mfma_f32_16x16x32_bf16(a, bh, acc, 0, 0, 0); acc = __builtin_amdgcn_mfma_f32_16x16x32_bf16(a, bl, acc, 0, 0, 0); }
            const float bias = wbias[l15];
            if (EXTRA == 2) {
#pragma unroll
                for (int r = 0; r < 4; ++r) { float val = acc[r] + bias; if (l15 >= 8) val = fminf(val, 0.f) - log1pf(expf(-fabsf(val))); gates_out[(size_t)(rowb + 4 * q4 + r) * 16 + l15] = val; }
            } else {
#pragma unroll
                for (int r = 0; r < 4; ++r) lg[(4 * q4 + r) * 16 + l15] = acc[r] + bias;
                LDS_WAIT(); asm volatile("" ::: "memory");
                if (c.lane < 16) { const int row = rowb + c.lane; float dot[16];
#pragma unroll
                    for (int q = 0; q < 4; ++q) { const f32x4 t = *(const LAS f32x4*)(lg + 16 * c.lane + 4 * q); dot[4 * q] = t.x; dot[4 * q + 1] = t.y; dot[4 * q + 2] = t.z; dot[4 * q + 3] = t.w; }
                    float mx = dot[0];
#pragma unroll
                    for (int e = 1; e < 16; ++e) mx = fmaxf(mx, dot[e]);
                    float p[16];
#pragma unroll
                    for (int e = 0; e < 16; ++e) p[e] = __expf(dot[e] - mx);
                    float bestsc = -1.f, bp1 = 0.f, bp2 = 0.f; int be1 = 0, be2 = 0;
#pragma unroll
                    for (int g = 0; g < 4; ++g) { const float a0 = p[4 * g], a1 = p[4 * g + 1], a2 = p[4 * g + 2], a3 = p[4 * g + 3];
                        int i1 = 0; float p1 = a0; if (a1 > p1) { p1 = a1; i1 = 1; } if (a2 > p1) { p1 = a2; i1 = 2; } if (a3 > p1) { p1 = a3; i1 = 3; }
                        int i2 = 0; float p2 = -1.f;
                        if (i1 != 0 && a0 > p2) { p2 = a0; i2 = 0; } if (i1 != 1 && a1 > p2) { p2 = a1; i2 = 1; } if (i1 != 2 && a2 > p2) { p2 = a2; i2 = 2; } if (i1 != 3 && a3 > p2) { p2 = a3; i2 = 3; }
                        const float sc = p1 + p2; if (sc > bestsc) { bestsc = sc; be1 = 4 * g + i1; be2 = 4 * g + i2; bp1 = p1; bp2 = p2; } }
                    const float inv = 1.f / (bp1 + bp2); egate[2 * row] = bp1 * inv; egate[2 * row + 1] = bp2 * inv; rt_e1 = be1; rt_e2 = be2;
                    rt_r1 = __hip_atomic_fetch_add(lh + be1, 1, __ATOMIC_RELAXED, __HIP_MEMORY_SCOPE_WORKGROUP); rt_r2 = __hip_atomic_fetch_add(lh + be2, 1, __ATOMIC_RELAXED, __HIP_MEMORY_SCOPE_WORKGROUP); }
            }
        }
        __syncthreads();
        if (EXTRA == 1) {
            LAS int* lbase = (LAS int*)(c.lds + LDSCTL_OFF + 13312);
            if (c.tid < 16) lbase[c.tid] = (int)__hip_atomic_fetch_add(cursor + c.tid, (unsigned)lh[c.tid], __ATOMIC_RELAXED, __HIP_MEMORY_SCOPE_AGENT);
            __syncthreads();
            if (c.lane < 16) { const int row = rowb + c.lane; rowmap2[rt_e1 * ECAP + lbase[rt_e1] + rt_r1] = 2 * row; rowmap2[rt_e2 * ECAP + lbase[rt_e2] + rt_r2] = 2 * row + 1; }
        }
    }
}

__device__ __forceinline__ void gather_rows(const Ctx& c, const bf16* XB, const int* rowmap, const int* tile_e, bf16* XG) {
    const int nrows = tile_e[MAXTILES] * 256;
    for (int r = c.gw; r < nrows; r += c.ngw) { const int a = rowmap[r]; u32x4* dst = (u32x4*)(XG + (size_t)r * D) + c.lane;
        if (a >= 0) { const u32x4* src = (const u32x4*)(XB + (size_t)(a >> 1) * D) + c.lane;
#pragma unroll
            for (int j = 0; j < 4; ++j) dst[64 * j] = src[64 * j]; }
        else {
#pragma unroll
            for (int j = 0; j < 4; ++j) dst[64 * j] = (u32x4){0u, 0u, 0u, 0u}; } }
}

__device__ __forceinline__ void fp8x8_to_f32(u32x2 w, float (&o)[8]) { const int a = (int)w.x, b = (int)w.y;
    o[0] = __builtin_amdgcn_cvt_f32_fp8(a, 0) * 0.0625f; o[1] = __builtin_amdgcn_cvt_f32_fp8(a, 1) * 0.0625f; o[2] = __builtin_amdgcn_cvt_f32_fp8(a, 2) * 0.0625f; o[3] = __builtin_amdgcn_cvt_f32_fp8(a, 3) * 0.0625f;
    o[4] = __builtin_amdgcn_cvt_f32_fp8(b, 0) * 0.0625f; o[5] = __builtin_amdgcn_cvt_f32_fp8(b, 1) * 0.0625f; o[6] = __builtin_amdgcn_cvt_f32_fp8(b, 2) * 0.0625f; o[7] = __builtin_amdgcn_cvt_f32_fp8(b, 3) * 0.0625f; }

constexpr int CONV_ROWS = 16;
__device__ __forceinline__ void conv_pass(const Ctx& c, const unsigned char* Z, const float* cw, const float* cb, bf16* QKC) {
    constexpr int NITEMS = (T / CONV_ROWS) * 256;
    const int c0 = (c.gtid & 255) * 8;
    float w[4][8], bias[8];
#pragma unroll
    for (int j = 0; j < 4; ++j) { const f32x4 w0 = *(const f32x4*)(cw + j * 2048 + c0), w1 = *(const f32x4*)(cw + j * 2048 + c0 + 4); w[j][0] = w0.x; w[j][1] = w0.y; w[j][2] = w0.z; w[j][3] = w0.w; w[j][4] = w1.x; w[j][5] = w1.y; w[j][6] = w1.z; w[j][7] = w1.w; }
    { const f32x4 b0 = *(const f32x4*)(cb + c0), b1 = *(const f32x4*)(cb + c0 + 4); bias[0] = b0.x; bias[1] = b0.y; bias[2] = b0.z; bias[3] = b0.w; bias[4] = b1.x; bias[5] = b1.y; bias[6] = b1.z; bias[7] = b1.w; }
    const float sc = c0 >= 1024 ? 0.08838834764831845f : 1.f;
    u32x2 zr[CONV_ROWS + 3], zn[CONV_ROWS + 3];
#define CONV_LOAD(ZR, idx_) do { const int tok0_ = ((idx_) >> 8) * CONV_ROWS, t0_ = tok0_ & (SEQ - 1); _Pragma("unroll") for (int r = 0; r < CONV_ROWS + 3; ++r) { const int tt = t0_ - 3 + r; ZR[r] = tt >= 0 ? *(const u32x2*)(Z + (size_t)(tok0_ - 3 + r) * ZN + c0) : (u32x2){0u, 0u}; } } while (0)
    if (c.gtid < NITEMS) CONV_LOAD(zr, c.gtid);
    for (int idx = c.gtid; idx < NITEMS; idx += c.ngt) { const int tok0 = (idx >> 8) * CONV_ROWS;
        if (idx + c.ngt < NITEMS) CONV_LOAD(zn, idx + c.ngt);
#pragma unroll
        for (int r = 0; r < CONV_ROWS; ++r) { float acc[8];
#pragma unroll
            for (int k = 0; k < 8; ++k) acc[k] = bias[k];
#pragma unroll
            for (int j = 0; j < 4; ++j) { float zf[8]; fp8x8_to_f32(zr[r + j], zf);
#pragma unroll
                for (int k = 0; k < 8; ++k) acc[k] += zf[k] * w[j][k]; }
#pragma unroll
            for (int k = 0; k < 8; ++k) acc[k] = acc[k] / (1.f + __expf(-acc[k])) * sc;
            *(u32x4*)(QKC + (size_t)(tok0 + r) * 2048 + c0) = (u32x4){pk2(acc[0], acc[1]), pk2(acc[2], acc[3]), pk2(acc[4], acc[5]), pk2(acc[6], acc[7])}; }
#pragma unroll
        for (int r = 0; r < CONV_ROWS + 3; ++r) zr[r] = zn[r];
    }
#undef CONV_LOAD
}
__device__ __forceinline__ void mlstm_naive(const Ctx& c, const bf16* QKC, const bf16* Z, const float* GATES, bf16* HC) {
    LAS float* Qs = (LAS float*)c.lds; LAS float* Ks = Qs + 2048; LAS float* Vs = Ks + 2048; LAS float* LI = Vs + 2048; LAS float* LF = LI + 16; LAS float* DEN = LF + 16; LAS float* MEX = DEN + 16; LAS float* NUM = MEX + 16;
    const bool colthr = c.tid < 128, nthr = (c.wave == 2);
    for (int u = c.bid; u < 256; u += c.G) {
        const int b = u >> 4, h = (u >> 1) & 7, vh = u & 1;
        float C[128];
#pragma unroll
        for (int d = 0; d < 128; ++d) C[d] = 0.f;
        float m = -1e30f;
        for (int grp = 0; grp < 128; ++grp) {
            const int tok0 = b * SEQ + grp * 16;
#pragma unroll
            for (int k = 0; k < 12; ++k) { const int e = c.tid + NTHR * k, which = e >> 11, r = e & 2047, s = r >> 7, d = r & 127;
                const bf16* src = which == 0 ? QKC + (size_t)(tok0 + s) * 2048 + h * 128 + d : (which == 1 ? QKC + (size_t)(tok0 + s) * 2048 + 1024 + h * 128 + d : Z + (size_t)(tok0 + s) * ZN + 2048 + h * 256 + vh * 128 + d);
                Qs[e] = bf1(*src); }
            if (c.tid < 16) { LI[c.tid] = GATES[(size_t)(tok0 + c.tid) * 16 + h]; LF[c.tid] = GATES[(size_t)(tok0 + c.tid) * 16 + 8 + h]; }
            __syncthreads();
            if (colthr || nthr) {
                for (int s = 0; s < 16; ++s) {
                    const float lf = LF[s], li = LI[s], mn = fmaxf(lf + m, li), fd = __expf(lf + m - mn), iw = __expf(li - mn); m = mn;
                    const float vv = nthr ? 1.f : Vs[s * 128 + (c.tid & 127)]; const float kv = iw * vv; float acc = 0.f;
#pragma unroll
                    for (int d4 = 0; d4 < 32; ++d4) { const f32x4 k4 = *(const LAS f32x4*)(Ks + s * 128 + 4 * d4), q4 = *(const LAS f32x4*)(Qs + s * 128 + 4 * d4);
                        C[4 * d4 + 0] = fd * C[4 * d4 + 0] + kv * k4.x; acc += q4.x * C[4 * d4 + 0];
                        C[4 * d4 + 1] = fd * C[4 * d4 + 1] + kv * k4.y; acc += q4.y * C[4 * d4 + 1];
                        C[4 * d4 + 2] = fd * C[4 * d4 + 2] + kv * k4.z; acc += q4.z * C[4 * d4 + 2];
                        C[4 * d4 + 3] = fd * C[4 * d4 + 3] + kv * k4.w; acc += q4.w * C[4 * d4 + 3]; }
                    if (nthr) { if (c.lane == 0) { DEN[s] = acc; MEX[s] = __expf(-mn); } } else NUM[s * 128 + c.tid] = acc;
                }
            }
            __syncthreads();
            if (colthr) {
                for (int s = 0; s < 16; ++s) { const float hv = NUM[s * 128 + c.tid] / fmaxf(fabsf(DEN[s]), MEX[s]);
                    HC[(size_t)(tok0 + s) * 2048 + h * 256 + vh * 128 + c.tid] = (bf16)f2bf(hv); }
            }
        }
        __syncthreads();
    }
}
__device__ __forceinline__ void headnorm_pass(const Ctx& c, const bf16* HC, const unsigned char* Z, const float* ng, bf16* Y) {
    const int half = c.lane >> 5, l32 = c.lane & 31;
    f32x4 ga[4], gb[4];
#pragma unroll
    for (int p = 0; p < 4; ++p) { const float* gp = ng + (2 * p + half) * 256 + 8 * l32; ga[p] = *(const f32x4*)gp; gb[p] = *(const f32x4*)(gp + 4); }
    u32x4 hw[4], hn[4]; u32x2 ow[4], on[4];
#define HN_LOAD(HW, OW, tok_) do { _Pragma("unroll") for (int p = 0; p < 4; ++p) { HW[p] = *(const u32x4*)(HC + (size_t)(tok_) * 2048 + (2 * p + half) * 256 + 8 * l32); OW[p] = *(const u32x2*)(Z + (size_t)(tok_) * ZN + 4096 + (2 * p + half) * 256 + 8 * l32); } } while (0)
    if (c.gw < T) HN_LOAD(hw, ow, c.gw);
    for (int tok = c.gw; tok < T; tok += c.ngw) {
        if (tok + c.ngw < T) HN_LOAD(hn, on, tok + c.ngw);
#pragma unroll
        for (int p = 0; p < 4; ++p) {
            float x[8] = {bflo(hw[p].x), bfhi(hw[p].x), bflo(hw[p].y), bfhi(hw[p].y), bflo(hw[p].z), bfhi(hw[p].z), bflo(hw[p].w), bfhi(hw[p].w)};
            const float ps = prefix_sum64(((x[0] + x[1]) + (x[2] + x[3])) + ((x[4] + x[5]) + (x[6] + x[7]))); const float lo = lane_bcast(ps, 31), al = lane_bcast(ps, 63);
            const float mean = (half ? al - lo : lo) * (1.f / 256.f); float q = 0.f;
#pragma unroll
            for (int k = 0; k < 8; ++k) { x[k] -= mean; q += x[k] * x[k]; }
            const float pq = prefix_sum64(q); const float qlo = lane_bcast(pq, 31), qal = lane_bcast(pq, 63);
            const float rstd = 1.f / sqrtf((half ? qal - qlo : qlo) * (1.f / 256.f) + LN_EPS);
            float o[8]; fp8x8_to_f32(ow[p], o);
            const float gk[8] = {ga[p].x, ga[p].y, ga[p].z, ga[p].w, gb[p].x, gb[p].y, gb[p].z, gb[p].w}; float y[8];
#pragma unroll
            for (int k = 0; k < 8; ++k) y[k] = x[k] * rstd * gk[k] / (1.f + __expf(-o[k]));
            *(u32x4*)(Y + (size_t)tok * 2048 + (2 * p + half) * 256 + 8 * l32) = (u32x4){pk2(y[0], y[1]), pk2(y[2], y[3]), pk2(y[4], y[5]), pk2(y[6], y[7])}; }
#pragma unroll
        for (int p = 0; p < 4; ++p) { hw[p] = hn[p]; ow[p] = on[p]; }
    }
#undef HN_LOAD
}

namespace att {
typedef short bf16x8 __attribute__((ext_vector_type(8)));
typedef short s16x4 __attribute__((ext_vector_type(4)));
typedef float f32x16 __attribute__((ext_vector_type(16)));
constexpr float SCALE = 0.08838834764831845f, THR = 8.f;
constexpr int SHM = 16384;
#define KSWZ(row, colB) ((row) * 256 + ((colB) ^ (((row) & 7) << 4)))
#define SBAR() __builtin_amdgcn_sched_barrier(0)
__device__ __forceinline__ int v_st(int k, int c) { const int kk = (k & ~0xC) | ((k & 4) << 1) | ((k & 8) >> 1); return ((kk >> 3) * 4 + (c >> 5)) * 512 + ((kk & 7) * 32 + (c & 31)) * 2; }
__device__ __forceinline__ int v_rd_base(int lane) { return ((lane & 3) << 3) | (((lane >> 2) & 3) << 6) | (((lane >> 4) & 1) << 5) | (((lane >> 5) & 1) << 8); }
constexpr int v_rd_off(int d0, int ks, int half) { return d0 * 512 + ks * 4096 + half * 2048; }
__device__ __forceinline__ int crow(int r, int hi) { return (r & 3) + 8 * (r >> 2) + 4 * hi; }
__device__ __forceinline__ unsigned cvtpk(float lo, float hi) { unsigned r; asm volatile("v_cvt_pk_bf16_f32 %0, %1, %2" : "=v"(r) : "v"(lo), "v"(hi)); return r; }
__device__ __forceinline__ void mask_tile(f32x16& p0, f32x16& p1, int dq, unsigned W) {
    const float NEG = -__builtin_inff();
#pragma unroll
    for (int r = 0; r < 16; ++r) { const int cc = (r & 3) + 8 * (r >> 2);
        if ((unsigned)(dq - cc) >= W) p0[r] = NEG;
        if ((unsigned)(dq - cc - 32) >= W) p1[r] = NEG; }
}
__device__ __forceinline__ void partialSM(f32x16& p0, f32x16& p1, float& m_reg, float& mn, float& alpha) {
    float pmax = p0[0];
#pragma unroll
    for (int r = 1; r < 16; ++r) pmax = fmaxf(pmax, p0[r]);
#pragma unroll
    for (int r = 0; r < 16; ++r) pmax = fmaxf(pmax, p1[r]);
    { auto rr = __builtin_amdgcn_permlane32_swap(__float_as_uint(pmax), __float_as_uint(pmax), false, false);
      pmax = fmaxf(__uint_as_float(rr[0]), __uint_as_float(rr[1])); }
    constexpr float C2 = 1.4426950408889634f * SCALE;
    if (__builtin_expect(__all((pmax - m_reg) * SCALE <= THR), 1)) { mn = m_reg; alpha = 1.f; }
    else { mn = fmaxf(m_reg, pmax); alpha = __builtin_amdgcn_exp2f((m_reg - mn) * C2); m_reg = mn; }
    const float mnL = -mn * C2;
#pragma unroll
    for (int r = 0; r < 16; ++r) p0[r] = fmaf(p0[r], C2, mnL);
#pragma unroll
    for (int r = 0; r < 16; ++r) p1[r] = fmaf(p1[r], C2, mnL);
#pragma unroll
    for (int r = 0; r < 16; ++r) p0[r] = __builtin_amdgcn_exp2f(p0[r]);
}
__device__ __forceinline__ void finishSM(f32x16& p0, f32x16& p1, float alpha, float& l_reg, bf16x8& pa0, bf16x8& pa1, bf16x8& pa2, bf16x8& pa3) {
#pragma unroll
    for (int r = 0; r < 16; ++r) p1[r] = __builtin_amdgcn_exp2f(p1[r]);
    float ps = 0;
#pragma unroll
    for (int r = 0; r < 16; ++r) ps += p0[r];
#pragma unroll
    for (int r = 0; r < 16; ++r) ps += p1[r];
    { auto rr = __builtin_amdgcn_permlane32_swap(__float_as_uint(ps), __float_as_uint(ps), false, false);
      ps = __uint_as_float(rr[0]) + __uint_as_float(rr[1]); }
    l_reg = l_reg * alpha + ps;
#define PK4(P, B_, OUT) do { unsigned a0 = cvtpk(P[B_+0], P[B_+1]), a1 = cvtpk(P[B_+2], P[B_+3]);                          \
        unsigned b0 = cvtpk(P[B_+4], P[B_+5]), b1 = cvtpk(P[B_+6], P[B_+7]);                                             \
        auto r0 = __builtin_amdgcn_permlane32_swap(a0, b0, false, false); auto r1 = __builtin_amdgcn_permlane32_swap(a1, b1, false, false); \
        u32x4 w = {r0[0], r1[0], r0[1], r1[1]}; OUT = *reinterpret_cast<bf16x8*>(&w); } while (0)
    PK4(p0, 0, pa0); PK4(p0, 8, pa1); PK4(p1, 0, pa2); PK4(p1, 8, pa3);
#undef PK4
}
template <int KB>
__device__ __forceinline__ void qkt(f32x16& p0, f32x16& p1, const LAS char* K_lds, int r32, int hi, const bf16x8* qr) {
    p0 = f32x16{}; p1 = f32x16{};
    const LAS char* kb[4];
#pragma unroll
    for (int dd = 0; dd < 4; ++dd) kb[dd] = K_lds + KB * SHM + KSWZ(r32, (dd * 16 + hi * 8) * 2);
#pragma unroll
    for (int d0 = 0; d0 < 8; ++d0) { const LAS char* a = kb[d0 & 3] + (d0 >> 2) * 128;
        bf16x8 b0 = *reinterpret_cast<const LAS bf16x8*>(a);
        bf16x8 b1 = *reinterpret_cast<const LAS bf16x8*>(a + 32 * 256);
        p0 = __builtin_amdgcn_mfma_f32_32x32x16_bf16(b0, qr[d0], p0, 0, 0, 0);
        p1 = __builtin_amdgcn_mfma_f32_32x32x16_bf16(b1, qr[d0], p1, 0, 0, 0); }
}
template <int VB>
__device__ __forceinline__ void pv_tile(f32x16* o, int vb0, bf16x8 pa0, bf16x8 pa1, bf16x8 pa2, bf16x8 pa3) {
#define TRRD(dst, off) asm volatile("ds_read_b64_tr_b16 %0, %1 offset:%2" : "=&v"(dst) : "v"(vb0), "i"(off) : "memory")
#define PV_D0(d0) do { s16x4 l0, l1, l2, l3, h0, h1, h2, h3; constexpr int b_ = VB * SHM + v_rd_off(d0, 0, 0); \
        TRRD(l0, b_); TRRD(h0, b_ + 2048); TRRD(l1, b_ + 4096); TRRD(h1, b_ + 6144); TRRD(l2, b_ + 8192); TRRD(h2, b_ + 10240); TRRD(l3, b_ + 12288); TRRD(h3, b_ + 14336); \
        asm volatile("s_waitcnt lgkmcnt(0)" ::: "memory"); SBAR();   \
        o[d0] = __builtin_amdgcn_mfma_f32_32x32x16_bf16(pa0, (bf16x8){l0[0], l0[1], l0[2], l0[3], h0[0], h0[1], h0[2], h0[3]}, o[d0], 0, 0, 0);   \
        o[d0] = __builtin_amdgcn_mfma_f32_32x32x16_bf16(pa1, (bf16x8){l1[0], l1[1], l1[2], l1[3], h1[0], h1[1], h1[2], h1[3]}, o[d0], 0, 0, 0);   \
        o[d0] = __builtin_amdgcn_mfma_f32_32x32x16_bf16(pa2, (bf16x8){l2[0], l2[1], l2[2], l2[3], h2[0], h2[1], h2[2], h2[3]}, o[d0], 0, 0, 0);   \
        o[d0] = __builtin_amdgcn_mfma_f32_32x32x16_bf16(pa3, (bf16x8){l3[0], l3[1], l3[2], l3[3], h3[0], h3[1], h3[2], h3[3]}, o[d0], 0, 0, 0); } while (0)
    PV_D0(0); PV_D0(1); PV_D0(2); PV_D0(3);
#undef PV_D0
#undef TRRD
}
template <bool FINAL>
__device__ __forceinline__ void attn_phase(const Ctx& c, const bf16* QKV, bf16* OP, float* LSE, bf16* O) {
    const int half = c.wave >> 2, w4 = c.wave & 3, r32 = c.lane & 31, hi = c.lane >> 5, l = c.lane;
    LAS char* Vl = (LAS char*)c.lds + half * 65536; LAS char* Kl = Vl + 2 * SHM;
    LAS float* wl = (LAS float*)(c.lds + LDSCTL_OFF + 1024) + c.wave * 128; LAS float* al_l = wl + 96;
    const LAS float* wl4 = wl + 4 * hi;
    const int vb0 = (int)(unsigned)(uintptr_t)Vl + v_rd_base(c.lane);
    int krow[4], kcol[4], vrow[4], vcol[4];
#pragma unroll
    for (int j = 0; j < 4; ++j) { const int blk = 4 * w4 + j; krow[j] = 4 * blk + (l >> 4); kcol[j] = (((l & 15) ^ (krow[j] & 7)) * 16) + 2048;
        const int sub = 2 * blk + (l >> 5), kk = (sub >> 2) * 8 + ((l & 31) >> 2); vrow[j] = (kk & ~0xC) | ((kk & 4) << 1) | ((kk & 8) >> 1); vcol[j] = ((sub & 3) * 32 + (l & 3) * 8) * 2 + 4096; }
    constexpr int NUNITS = FINAL ? 1024 : 2048;
    for (int idx = c.bid; idx < NUNITS; idx += c.G) {
        const int hp = idx & 3, rj = (idx >> 2) & 15, b = (idx >> 6) & 15, g = FINAL ? 0 : 1 + (idx >> 10);
        const int h = 2 * hp + half, dil = 1 << (2 * g), nbm = (16 >> (2 * g)) - 1, jb = (g == 1 ? rj + (b >> 2) : rj) & nbm, r = rj >> (4 - 2 * g);
        const unsigned rs = (unsigned)dil * QKV_N * 2u;
        const char* base = (const char*)(QKV + ((size_t)b * SEQ + r) * QKV_N + g * 3072 + h * HD);
        const int q0 = 128 * jb + 32 * w4;
        bf16x8 qr[8];
#pragma unroll
        for (int d0 = 0; d0 < 8; ++d0) qr[d0] = *(const bf16x8*)(base + ((unsigned)(q0 + r32) * rs + (unsigned)(d0 * 32 + hi * 16)));
#define A_DMA(kb_, bf_) do { _Pragma("unroll") for (int j_ = 0; j_ < 4; ++j_) { \
            __builtin_amdgcn_global_load_lds((const unsigned*)(base + ((unsigned)((kb_) + krow[j_]) * rs + (unsigned)kcol[j_])), (LAS unsigned*)(Kl + (bf_) * SHM + (4 * w4 + j_) * 1024), 16, 0, 0); \
            __builtin_amdgcn_global_load_lds((const unsigned*)(base + ((unsigned)((kb_) + vrow[j_]) * rs + (unsigned)vcol[j_])), (LAS unsigned*)(Vl + (bf_) * SHM + (4 * w4 + j_) * 1024), 16, 0, 0); } } while (0)
        float m_reg = -1e30f, l_reg = 0.f; f32x16 o[4] = {};
        const int kt0 = jb == 0 ? 2 : 0, kb0 = 128 * (jb - 1);
        A_DMA(kb0 + 64 * kt0, 0);
        asm volatile("s_waitcnt vmcnt(0)" ::: "memory"); __syncthreads();
#define A_STEP(kt_, BUF) do { const int kb_ = kb0 + 64 * (kt_); \
            if ((kt_) < 3) A_DMA(kb_ + 64, (BUF) ^ 1);                                         \
            if (kb_ <= q0 + 31 && kb_ + 63 >= q0 - 128) { f32x16 p0, p1; float mn, alpha; bf16x8 pa0, pa1, pa2, pa3; \
                qkt<BUF>(p0, p1, Kl, r32, hi, qr); mask_tile(p0, p1, q0 + r32 - kb_ - 4 * hi, 129u); partialSM(p0, p1, m_reg, mn, alpha); \
                if (__any(alpha < 1.f)) { if (hi == 0) al_l[r32] = alpha; asm volatile("s_waitcnt lgkmcnt(0)" ::: "memory"); \
                    _Pragma("unroll") for (int d_ = 0; d_ < 4; ++d_) _Pragma("unroll") for (int r_ = 0; r_ < 16; ++r_) o[d_][r_] *= al_l[crow(r_, hi)]; } \
                finishSM(p0, p1, alpha, l_reg, pa0, pa1, pa2, pa3); SBAR(); pv_tile<BUF>(o, vb0, pa0, pa1, pa2, pa3); } \
            asm volatile("s_waitcnt vmcnt(0)" ::: "memory"); __syncthreads(); } while (0)
        for (int kt = kt0; kt < 4; kt += 2) { A_STEP(kt, 0); A_STEP(kt + 1, 1); }
#undef A_STEP
#undef A_DMA
        const float lse = m_reg * SCALE + __logf(l_reg);
        const unsigned tok0 = (unsigned)b * SEQ + r;
        if (hi == 0) { const unsigned tokq = tok0 + (unsigned)(q0 + r32) * dil; float w0 = 1.f / l_reg;
            if (FINAL) { const float l1 = LSE[tokq * 8u + h], l2 = LSE[((unsigned)T + tokq) * 8u + h]; const float M = fmaxf(lse, fmaxf(l1, l2));
                const float e0 = __expf(lse - M), e1 = __expf(l1 - M), e2 = __expf(l2 - M), inv = 1.f / (e0 + e1 + e2); w0 *= e0 * inv; wl[32 + r32] = e1 * inv; wl[64 + r32] = e2 * inv; }
            else LSE[((unsigned)(g - 1) * T + tokq) * 8u + h] = lse;
            wl[r32] = w0; }
        asm volatile("s_waitcnt lgkmcnt(0)" ::: "memory");
        LAS char* tile = Vl + (w4 < 2 ? SHM + w4 * 8192 : 3 * SHM + (w4 - 2) * 8192); LAS char* tile4 = tile + 4 * hi * 256 + r32 * 2;
#pragma unroll
        for (int r_ = 0; r_ < 16; ++r_) { const int orow = (r_ & 3) + 8 * (r_ >> 2); const float w0 = wl4[orow];
#pragma unroll
            for (int d0 = 0; d0 < 4; ++d0) { const float v = o[d0][r_] * w0; const float vn = lane_xor1(v);
                if ((r32 & 1) == 0) *(LAS unsigned*)(tile4 + orow * 256 + d0 * 64) = cvtpk(v, vn); } }
        asm volatile("s_waitcnt lgkmcnt(0)" ::: "memory");
#pragma unroll
        for (int i = 0; i < 8; ++i) { const int p = c.lane + 64 * i, row = p >> 4, ch = p & 15; const unsigned tok = tok0 + (unsigned)(q0 + row) * dil; const unsigned col8 = (unsigned)h * HD + ch * 8;
            const u32x4 x = *(const LAS u32x4*)(tile + row * 256 + ch * 16);
            if (FINAL) { const u32x4 pa = *(const u32x4*)(OP + (tok * (unsigned)OD + col8)), pb = *(const u32x4*)(OP + (((unsigned)T + tok) * (unsigned)OD + col8)); const float w1 = wl[32 + row], w2 = wl[64 + row];
                u32x4 y; y.x = cvtpk(bflo(x.x) + w1 * bflo(pa.x) + w2 * bflo(pb.x), bfhi(x.x) + w1 * bfhi(pa.x) + w2 * bfhi(pb.x)); y.y = cvtpk(bflo(x.y) + w1 * bflo(pa.y) + w2 * bflo(pb.y), bfhi(x.y) + w1 * bfhi(pa.y) + w2 * bfhi(pb.y));
                y.z = cvtpk(bflo(x.z) + w1 * bflo(pa.z) + w2 * bflo(pb.z), bfhi(x.z) + w1 * bfhi(pa.z) + w2 * bfhi(pb.z)); y.w = cvtpk(bflo(x.w) + w1 * bflo(pa.w) + w2 * bflo(pb.w), bfhi(x.w) + w1 * bfhi(pa.w) + w2 * bfhi(pb.w));
                *(u32x4*)(O + (tok * (unsigned)OD + col8)) = y; }
            else *(u32x4*)(OP + (((unsigned)(g - 1) * T + tok) * (unsigned)OD + col8)) = x; }
    }
}
#undef KSWZ
#undef SBAR
}

namespace mls {
using att::bf16x8; using att::s16x4; using att::f32x16; using att::v_st; using att::v_rd_base; using att::crow; using att::cvtpk;
constexpr int RSB = 272;
constexpr int L_QP = 0, L_KP = 17408, L_KTR = 34816, L_VTR = 51200, L_AM = 83968, L_RS = 93184, L_QN = 94208, L_WINT = 94464, L_MEXP = 94720, L_HDEN = 94976  , L_NV = 97024  , L_UV = 98048, L_AV = 98560  ;
constexpr int AMB = 144;
#define TRRD(dst, addr, off) asm volatile("ds_read_b64_tr_b16 %0, %1 offset:%2" : "=&v"(dst) : "v"(addr), "i"(off) : "memory")
template <int SKIP>
__device__ __forceinline__ void mlstm_phase(const Ctx& c, const bf16* QKC, const unsigned char* Z, const float* GATES, bf16* HC) {
    const int w = c.wave;
    LAS char* lds = (LAS char*)c.lds;
    LAS float* RS = (LAS float*)(lds + L_RS); LAS float* QN = (LAS float*)(lds + L_QN); LAS float* WINT = (LAS float*)(lds + L_WINT);     LAS float* HDEN = (LAS float*)(lds + L_HDEN);
    LAS float* UV = (LAS float*)(lds + L_UV); LAS float* AV = (LAS float*)(lds + L_AV);
    for (int unit = c.bid; unit < BATCH * 8; unit += c.G) {
        const int b = unit >> 3, h = unit & 7;
        f32x16 Ct[4] = {};
        float n0 = 0.f, n1 = 0.f, m_state = -1e30f;
        bf16x8 sq[2], sk[2]; u32x2 sv[4]; float g_li, g_lf;
#define M_LOAD(tok0_) do { \
            _Pragma("unroll") for (int i_ = 0; i_ < 2; ++i_) { const int p_ = tid_ + 512 * i_, row_ = p_ >> 4, c8_ = (p_ & 15) * 8; const bf16* s_ = QKC + (size_t)((tok0_) + row_) * 2048 + h * 128 + c8_; sq[i_] = *(const bf16x8*)s_; sk[i_] = *(const bf16x8*)(s_ + 1024); } \
            g_li = GATES[(size_t)((tok0_) + (tid_ & 63)) * 16 + h]; g_lf = GATES[(size_t)((tok0_) + (tid_ & 63)) * 16 + 8 + h]; } while (0)
#define M_LOADV(tok0_) do { \
            _Pragma("unroll") for (int i_ = 0; i_ < 4; ++i_) { const int p_ = tid_ + 512 * i_, row_ = p_ >> 5, c8_ = (p_ & 31) * 8; sv[i_] = *(const u32x2*)(Z + (size_t)((tok0_) + row_) * ZN + 2048 + h * 256 + c8_); } } while (0)
        int tid_ = c.tid; asm volatile("" : "+v"(tid_));
        M_LOAD(b * SEQ); M_LOADV(b * SEQ);
        if (w == 5) *(LAS f32x2*)(lds + L_NV + 512 + 8 * c.lane) = (f32x2){0.f, 0.f};
        for (int ch = 0; ch < 32; ++ch) {
            const int tok0 = b * SEQ + ch * 64;
            tid_ = c.tid; asm volatile("" : "+v"(tid_));
            const int l = tid_ & 63, hi = l >> 5, r32 = l & 31, q4 = l >> 4, l15 = l & 15;
            const int vbK = (int)(unsigned)(uintptr_t)(lds + L_KTR) + v_rd_base(l);
            const int vbV = (int)(unsigned)(uintptr_t)(lds + L_VTR) + (w >> 2) * 16384 + (w & 3) * 512 + v_rd_base(l);
            const LAS float* uv_b = UV + 16 * (w & 3) + 4 * q4; const LAS float* as_b = AV + 32 * (w >> 2) + l15;
            LAS char* am_w = lds + L_AM + (16 * (w & 3) + 4 * q4) * AMB + (32 * (w >> 2) + l15) * 2; LAS float* rs_w = RS + 128 * (w >> 2) + 16 * (w & 3) + 4 * q4;
            const LAS float* wint_b = WINT + 4 * hi; const LAS float* hden_b = HDEN + 64 * w + 4 * hi;
            const LAS char* q_b = lds + L_QP + r32 * RSB + 8 * hi; const LAS char* am_b = lds + L_AM + r32 * AMB + 16 * hi;
            const LAS char* sq_b = lds + L_QP + ((16 * (w & 3)) + l15) * RSB + 16 * q4; const LAS char* sk_b = lds + L_KP + l15 * RSB + 16 * q4;
            const int hc_lane = 4 * hi * 2048 + 32 * w + r32;
            const float bc = (SKIP & 64) ? g_lf : prefix_sum64(g_lf);
            const float a = g_li - bc, pm = (SKIP & 64) ? a : prefix_max64(a);
            const float u = fmaxf(m_state, pm), winter = __expf(m_state - u);
            const float blast = lane_bcast(bc, 63), u63 = lane_bcast(u, 63);
            const float wk = __expf(a - u63), decay = __expf(m_state - u63), mexp = __expf(-(bc + u));
            if (!(SKIP & 128)) {
#pragma unroll
            for (int i = 0; i < 2; ++i) { const int p = tid_ + 512 * i, row = p >> 4, c8 = (p & 15) * 8;
                *(LAS bf16x8*)(lds + L_QP + row * RSB + c8 * 2) = sq[i]; *(LAS bf16x8*)(lds + L_KP + row * RSB + c8 * 2) = sk[i];
                const float wr_ = __shfl(wk, row); const u32x4 kw = *reinterpret_cast<const u32x4*>(&sk[i]);
                u32x4 o; o.x = cvtpk(bflo(kw.x) * wr_, bfhi(kw.x) * wr_); o.y = cvtpk(bflo(kw.y) * wr_, bfhi(kw.y) * wr_); o.z = cvtpk(bflo(kw.z) * wr_, bfhi(kw.z) * wr_); o.w = cvtpk(bflo(kw.w) * wr_, bfhi(kw.w) * wr_);
                *(LAS u32x4*)(lds + L_KTR + v_st(row, c8)) = o; }
#pragma unroll
            for (int i = 0; i < 4; ++i) { const int p = tid_ + 512 * i, row = p >> 5, c8 = (p & 31) * 8;
                float vf_[8]; fp8x8_to_f32(sv[i], vf_); *(LAS u32x4*)(lds + L_VTR + (c8 >> 7) * 16384 + v_st(row, c8 & 127)) = (u32x4){cvtpk(vf_[0], vf_[1]), cvtpk(vf_[2], vf_[3]), cvtpk(vf_[4], vf_[5]), cvtpk(vf_[6], vf_[7])}; }
            }
            if (w == 0) { WINT[(ch & 1) * 64 + l] = winter; UV[(ch & 1) * 64 + l] = u; AV[(ch & 1) * 64 + l] = a; }
            if (!(SKIP & 32)) { if (ch + 1 < 32) { M_LOAD(tok0 + 64); M_LOADV(tok0 + 64); } }
            __syncthreads(); __builtin_amdgcn_sched_barrier(0);
            if (!(SKIP & 1)) {
                if (w == 4) { const LAS char* qrow = lds + L_QP + l * RSB; const LAS f32x4* nv = (const LAS f32x4*)(lds + L_NV + ((ch + 1) & 1) * 512);
                    float p0 = 0.f, p1 = 0.f;
#pragma unroll 2
                    for (int d8 = 0; d8 < 16; ++d8) { const u32x4 q = *(const LAS u32x4*)(qrow + 16 * d8); const f32x4 na = nv[2 * d8], nb = nv[2 * d8 + 1];
                        p0 += (bflo(q.x) * na.x + bfhi(q.x) * na.y) + (bflo(q.y) * na.z + bfhi(q.y) * na.w); p1 += (bflo(q.z) * nb.x + bfhi(q.z) * nb.y) + (bflo(q.w) * nb.z + bfhi(q.w) * nb.w); }
                    QN[l] = p0 + p1; }
                if (w == 5) { const LAS char* kb = lds + L_KTR + (l >> 4) * 512 + (l & 15) * 4;
                    float p0 = 0.f, p1 = 0.f;
#pragma unroll 2
                    for (int a_ = 0; a_ < 8; ++a_) {
                        const unsigned k0 = *(const LAS unsigned*)(kb + a_ * 2048 + 0), k1 = *(const LAS unsigned*)(kb + a_ * 2048 + 64), k2 = *(const LAS unsigned*)(kb + a_ * 2048 + 128), k3 = *(const LAS unsigned*)(kb + a_ * 2048 + 192);
                        const unsigned k4 = *(const LAS unsigned*)(kb + a_ * 2048 + 256), k5 = *(const LAS unsigned*)(kb + a_ * 2048 + 320), k6 = *(const LAS unsigned*)(kb + a_ * 2048 + 384), k7 = *(const LAS unsigned*)(kb + a_ * 2048 + 448);
                        p0 += ((bflo(k0) + bflo(k4)) + (bflo(k1) + bflo(k5))) + ((bflo(k2) + bflo(k6)) + (bflo(k3) + bflo(k7))); p1 += ((bfhi(k0) + bfhi(k4)) + (bfhi(k1) + bfhi(k5))) + ((bfhi(k2) + bfhi(k6)) + (bfhi(k3) + bfhi(k7))); }
                    n0 = n0 * decay + p0; n1 = n1 * decay + p1;
                    *(LAS f32x2*)(lds + L_NV + (ch & 1) * 512 + 8 * l) = (f32x2){n0, n1}; }
            }
            __builtin_amdgcn_sched_barrier(0);
            if (!(SKIP & 2)) { const int ti = w & 3, si0 = 2 * (w >> 2);
              const f32x4 ut4 = *(const LAS f32x4*)(uv_b + (ch & 1) * 64);
#pragma unroll
              for (int sj = 0; sj < 2; ++sj) { const int si = si0 + sj; float av[4] = {0.f, 0.f, 0.f, 0.f};
                if (si <= ti) { f32x4 acc = {0.f, 0.f, 0.f, 0.f};
#pragma unroll
                    for (int kk = 0; kk < 4; ++kk) { const bf16x8 af = *(const LAS bf16x8*)(sq_b + 64 * kk), bfr = *(const LAS bf16x8*)(sk_b + (16 * si) * RSB + 64 * kk);
                        acc = __builtin_amdgcn_mfma_f32_16x16x32_bf16(af, bfr, acc, 0, 0, 0); }
                    const float as_ = as_b[(ch & 1) * 64 + 16 * sj]; const int dts = 16 * (ti - si) + 4 * q4 - l15;
#pragma unroll
                    for (int r = 0; r < 4; ++r) av[r] = (dts + r >= 0) ? acc[r] * __expf(as_ - ut4[r]) : 0.f; }
#pragma unroll
                for (int r = 0; r < 4; ++r) { *(LAS unsigned short*)(am_w + r * AMB + sj * 32) = (unsigned short)f2bf(av[r]);
                    const float rs_ = row16_sum(av[r]);
                    if (l15 == 0) rs_w[sj * 64 + r] = rs_; } } }
            __builtin_amdgcn_sched_barrier(0);
            bf16x8 vf[4];
            { s16x4 l0, l1, l2, l3, h0, h1, h2, h3;
              TRRD(l0, vbV, 0); TRRD(h0, vbV, 2048); TRRD(l1, vbV, 4096); TRRD(h1, vbV, 6144); TRRD(l2, vbV, 8192); TRRD(h2, vbV, 10240); TRRD(l3, vbV, 12288); TRRD(h3, vbV, 14336);
              asm volatile("s_waitcnt lgkmcnt(0)" ::: "memory"); __builtin_amdgcn_sched_barrier(0);
              vf[0] = (bf16x8){l0[0], l0[1], l0[2], l0[3], h0[0], h0[1], h0[2], h0[3]}; vf[1] = (bf16x8){l1[0], l1[1], l1[2], l1[3], h1[0], h1[1], h1[2], h1[3]};
              vf[2] = (bf16x8){l2[0], l2[1], l2[2], l2[3], h2[0], h2[1], h2[2], h2[3]}; vf[3] = (bf16x8){l3[0], l3[1], l3[2], l3[3], h3[0], h3[1], h3[2], h3[3]}; }
            f32x16 ac[2] = {};
            if (!(SKIP & 4))
#pragma unroll
            for (int db = 0; db < 4; ++db)
#pragma unroll
                for (int s2 = 0; s2 < 2; ++s2) {
                    u32x4 cw; cw.x = cvtpk(Ct[db][8 * s2 + 0], Ct[db][8 * s2 + 1]); cw.y = cvtpk(Ct[db][8 * s2 + 2], Ct[db][8 * s2 + 3]); cw.z = cvtpk(Ct[db][8 * s2 + 4], Ct[db][8 * s2 + 5]); cw.w = cvtpk(Ct[db][8 * s2 + 6], Ct[db][8 * s2 + 7]);
#pragma unroll
                    for (int th = 0; th < 2; ++th) { const LAS char* qp = q_b + 32 * th * RSB + (32 * db + 16 * s2) * 2; const u32x2 x0 = *(const LAS u32x2*)qp, x1 = *(const LAS u32x2*)(qp + 16);
                        u32x4 o = {x0.x, x0.y, x1.x, x1.y}; ac[th] = __builtin_amdgcn_mfma_f32_32x32x16_bf16(*reinterpret_cast<bf16x8*>(&o), *reinterpret_cast<bf16x8*>(&cw), ac[th], 0, 0, 0); } }
            if (!(SKIP & 8))
#pragma unroll
            for (int db = 0; db < 4; ++db) { s16x4 l0, l1, l2, l3, h0, h1, h2, h3;
                TRRD(l0, vbK, db * 512 + 0); TRRD(h0, vbK, db * 512 + 2048); TRRD(l1, vbK, db * 512 + 4096); TRRD(h1, vbK, db * 512 + 6144); TRRD(l2, vbK, db * 512 + 8192); TRRD(h2, vbK, db * 512 + 10240); TRRD(l3, vbK, db * 512 + 12288); TRRD(h3, vbK, db * 512 + 14336);
#pragma unroll
                for (int r = 0; r < 16; ++r) Ct[db][r] *= decay;
                asm volatile("s_waitcnt lgkmcnt(0)" ::: "memory"); __builtin_amdgcn_sched_barrier(0);
                Ct[db] = __builtin_amdgcn_mfma_f32_32x32x16_bf16((bf16x8){l0[0], l0[1], l0[2], l0[3], h0[0], h0[1], h0[2], h0[3]}, vf[0], Ct[db], 0, 0, 0);
                Ct[db] = __builtin_amdgcn_mfma_f32_32x32x16_bf16((bf16x8){l1[0], l1[1], l1[2], l1[3], h1[0], h1[1], h1[2], h1[3]}, vf[1], Ct[db], 0, 0, 0);
                Ct[db] = __builtin_amdgcn_mfma_f32_32x32x16_bf16((bf16x8){l2[0], l2[1], l2[2], l2[3], h2[0], h2[1], h2[2], h2[3]}, vf[2], Ct[db], 0, 0, 0);
                Ct[db] = __builtin_amdgcn_mfma_f32_32x32x16_bf16((bf16x8){l3[0], l3[1], l3[2], l3[3], h3[0], h3[1], h3[2], h3[3]}, vf[3], Ct[db], 0, 0, 0); }
            m_state = blast + u63;
            __syncthreads(); __builtin_amdgcn_sched_barrier(0);
            if (!(SKIP & 16)) {
            { const float den = ((RS[l] + RS[64 + l]) + (RS[128 + l] + RS[192 + l])) + winter * QN[l]; HDEN[64 * w + l] = 1.f / fmaxf(fabsf(den), mexp); }
            const LAS float* wint_c = wint_b + (ch & 1) * 64;
#pragma unroll
            for (int th = 0; th < 2; ++th) { f32x16 ai = {};
#pragma unroll
                for (int ks = 0; ks < 4; ++ks) { if (th == 0 && ks >= 2) continue; const bf16x8 af = *(const LAS bf16x8*)(am_b + 32 * th * AMB + 32 * ks); ai = __builtin_amdgcn_mfma_f32_32x32x16_bf16(af, vf[ks], ai, 0, 0, 0); }
#pragma unroll
                for (int r = 0; r < 16; ++r) { const int tc = 32 * th + (r & 3) + 8 * (r >> 2); const float v = (ai[r] + wint_c[tc] * ac[th][r]) * hden_b[tc]; const float vn = lane_xor1(v);
                    bf16* rowp = HC + (size_t)(tok0 + tc) * 2048 + h * 256;
                    if ((r32 & 1) == 0) *(unsigned*)(rowp + hc_lane) = cvtpk(v, vn); } }
            }
        }
        __syncthreads();
    }
#undef M_LOAD
#undef M_LOADV
}
#undef TRRD
}

#ifndef GEMM_SP2
#define GEMM_SP2 true
#endif
#ifndef GEMM_ALIGN
#define GEMM_ALIGN true
#endif
#ifndef EPI_NT
#define EPI_NT 1
#endif
#if EPI_NT
#define EPI_ST(p, v) __builtin_nontemporal_store((v), (p))
#else
#define EPI_ST(p, v) (*(p) = (v))
#endif
namespace pg8 {
struct EpiStoreBf16 { static constexpr bool PERM = true, AFTER_DRAIN = false, WIDE = false; bf16_t* O; int ldc;
    __device__ __forceinline__ void operator()(const f32x4 (&acc)[2][2][4][2], const Unit& u, int wr, int wc, int fr, int fq) const {
        const int row0 = u.pm * BM + wr * 64 + fr, col0 = u.pn * BM + wc * 32 + 8 * fq;
#pragma unroll
        for (int ai = 0; ai < 2; ++ai)
#pragma unroll
            for (int m = 0; m < 4; ++m) { bf16_t* rowp = O + (size_t)(row0 + ai * HALF + m * 16) * ldc + col0;
#pragma unroll
                for (int bj = 0; bj < 2; ++bj) { const f32x4 v0 = acc[ai][bj][m][0], v1 = acc[ai][bj][m][1];
                    u32x4 w; w.x = cvt_pk_bf16(v0[0], v0[1]); w.y = cvt_pk_bf16(v0[2], v0[3]); w.z = cvt_pk_bf16(v1[0], v1[1]); w.w = cvt_pk_bf16(v1[2], v1[3]);
                    EPI_ST((u32x4*)(rowp + bj * HALF), w); } }
    }
};
struct EpiStoreFp8 { static constexpr bool PERM = true, AFTER_DRAIN = false; static constexpr int WIDE = 2; unsigned char* O; int ldc;
    __device__ __forceinline__ void operator()(const f32x4 (&acc)[2][2][4][2], const Unit& u, int wr, int wc, int fr, int fq) const {
        unsigned char* tb = O + (size_t)(u.pm * BM) * ldc + u.pn * BM; const unsigned lo = (unsigned)((wr * 64 + fr) * ldc + wc * 64 + 16 * fq);
#pragma unroll
        for (int ai = 0; ai < 2; ++ai)
#pragma unroll
            for (int m = 0; m < 4; ++m) { u32x4 w; unsigned pw[2][2];
#pragma unroll
                for (int bj = 0; bj < 2; ++bj) { const f32x4 v0 = acc[ai][bj][m][0] * 16.f, v1 = acc[ai][bj][m][1] * 16.f;
                    int t0 = __builtin_amdgcn_cvt_pk_fp8_f32(v0[0], v0[1], 0, false); t0 = __builtin_amdgcn_cvt_pk_fp8_f32(v0[2], v0[3], t0, true);
                    int t1 = __builtin_amdgcn_cvt_pk_fp8_f32(v1[0], v1[1], 0, false); t1 = __builtin_amdgcn_cvt_pk_fp8_f32(v1[2], v1[3], t1, true);
                    pw[bj][0] = (unsigned)t0; pw[bj][1] = (unsigned)t1; }
                w.x = pw[0][0]; w.y = pw[0][1]; w.z = pw[1][0]; w.w = pw[1][1];
                EPI_ST((u32x4*)(tb + (size_t)((ai * HALF + m * 16) * ldc) + lo), w); }
    }
};
struct EpiQKV { static constexpr bool PERM = true, AFTER_DRAIN = false, WIDE = false; bf16_t* O; int ldc;
    __device__ __forceinline__ void operator()(const f32x4 (&acc)[2][2][4][2], const Unit& u, int wr, int wc, int fr, int fq) const {
        const int row0 = u.pm * BM + wr * 64 + fr, col0 = u.pn * BM + wc * 32 + 8 * fq;
        const bool rot = ((u.pn >> 2) % 3) < 2;
        const float frev = __builtin_amdgcn_exp2f(-(float)(4 * wc + fq) * (18.931568569324174f / 16.f)) * 0.15915494309189535f;
        const float r16 = __builtin_amdgcn_fractf(16.f * frev), c16 = __builtin_amdgcn_cosf(r16), s16 = __builtin_amdgcn_sinf(r16);
#pragma unroll
        for (int ai = 0; ai < 2; ++ai) {
            const float r0 = __builtin_amdgcn_fractf((float)((row0 + ai * HALF) & 2047) * frev); float cs = __builtin_amdgcn_cosf(r0), sn = __builtin_amdgcn_sinf(r0);
#pragma unroll
            for (int m = 0; m < 4; ++m) { const int row = row0 + ai * HALF + m * 16; bf16_t* rowp = O + (size_t)row * ldc + col0;
#pragma unroll
                for (int bj = 0; bj < 2; ++bj) { f32x4 v0 = acc[ai][bj][m][0]; const f32x4 v1 = acc[ai][bj][m][1];
                    if (rot) { const float a = v0[0], b = v0[1]; v0[0] = a * cs - b * sn; v0[1] = b * cs + a * sn; }
                    u32x4 w; w.x = cvt_pk_bf16(v0[0], v0[1]); w.y = cvt_pk_bf16(v0[2], v0[3]); w.z = cvt_pk_bf16(v1[0], v1[1]); w.w = cvt_pk_bf16(v1[2], v1[3]);
                    EPI_ST((u32x4*)(rowp + bj * HALF), w); }
                const float cn = cs * c16 - sn * s16; sn = sn * c16 + cs * s16; cs = cn; } }
    }
};
template <bool RES_F32> struct EpiRes { static constexpr bool PERM = true, AFTER_DRAIN = false, WIDE = false; const void* res; bf16_t* out; int ldc; float alpha;
    __device__ __forceinline__ void operator()(const f32x4 (&acc)[2][2][4][2], const Unit& u, int wr, int wc, int fr, int fq) const {
        const int row0 = u.pm * BM + wr * 64 + fr, col0 = u.pn * BM + wc * 32 + 8 * fq;
#pragma unroll
        for (int ai = 0; ai < 2; ++ai)
#pragma unroll
            for (int m = 0; m < 4; ++m) { const size_t off = (size_t)(row0 + ai * HALF + m * 16) * ldc + col0;
#pragma unroll
                for (int bj = 0; bj < 2; ++bj) { f32x4 r0, r1;
                    if (RES_F32) { r0 = *(const f32x4*)((const float*)res + off + bj * HALF); r1 = *(const f32x4*)((const float*)res + off + bj * HALF + 4); }
                    else { const u32x4 rw = *(const u32x4*)((const bf16_t*)res + off + bj * HALF);
                        r0 = (f32x4){__builtin_bit_cast(float, rw.x << 16), __builtin_bit_cast(float, rw.x & 0xffff0000u), __builtin_bit_cast(float, rw.y << 16), __builtin_bit_cast(float, rw.y & 0xffff0000u)};
                        r1 = (f32x4){__builtin_bit_cast(float, rw.z << 16), __builtin_bit_cast(float, rw.z & 0xffff0000u), __builtin_bit_cast(float, rw.w << 16), __builtin_bit_cast(float, rw.w & 0xffff0000u)}; }
                    const f32x4 v0 = r0 * alpha + acc[ai][bj][m][0], v1 = r1 * alpha + acc[ai][bj][m][1];
                    u32x4 w; w.x = cvt_pk_bf16(v0[0], v0[1]); w.y = cvt_pk_bf16(v0[2], v0[3]); w.z = cvt_pk_bf16(v1[0], v1[1]); w.w = cvt_pk_bf16(v1[2], v1[3]);
                    EPI_ST((u32x4*)(out + off + bj * HALF), w); } }
    }
};
struct EpiSwiGLU { static constexpr bool PERM = true, AFTER_DRAIN = false, WIDE = false; bf16_t* H;
    __device__ __forceinline__ void operator()(const f32x4 (&acc)[2][2][4][2], const Unit& u, int wr, int wc, int fr, int fq) const {
        const int row0 = u.pm * BM + wr * 64 + fr, col0 = u.pn * 128 + wc * 16 + 4 * fq;
#pragma unroll
        for (int ai = 0; ai < 2; ++ai)
#pragma unroll
            for (int m = 0; m < 4; ++m) { bf16_t* rowp = H + (size_t)(row0 + ai * HALF + m * 16) * 768 + col0;
#pragma unroll
                for (int bj = 0; bj < 2; ++bj) { const f32x4 v0 = acc[ai][bj][m][0], v1 = acc[ai][bj][m][1];
                    const float h0 = v0[0] / (1.f + __expf(-v0[0])) * v0[1], h1 = v0[2] / (1.f + __expf(-v0[2])) * v0[3], h2 = v1[0] / (1.f + __expf(-v1[0])) * v1[1], h3 = v1[2] / (1.f + __expf(-v1[2])) * v1[3];
                    typedef unsigned u32x2v __attribute__((ext_vector_type(2))); u32x2v w; w.x = cvt_pk_bf16(h0, h1); w.y = cvt_pk_bf16(h2, h3);
                    EPI_ST((u32x2v*)(rowp + bj * 64), w); } }
    }
};
__device__ __forceinline__ unsigned ror8u(unsigned v) { return (unsigned)__builtin_amdgcn_mov_dpp((int)v, 0x128, 0xf, 0xf, true); }
template <bool STORE = true> struct EpiDownT { static constexpr bool PERM = true, AFTER_DRAIN = false, WIDE = true; unsigned char* YB8; const PG8_LAS int* atab;
    __device__ __forceinline__ void operator()(const f32x4 (&acc)[2][2][4][2], const Unit& u, int wr, int wc, int fr, int fq) const {
        typedef unsigned u32x2v __attribute__((ext_vector_type(2)));
        const bool up = fr >= 8; const unsigned ca = (unsigned)(u.pn * BM + wc * 64 + (up ? 32 : 0) + 8 * fq), cb = ca ^ 32u;
        const PG8_LAS int* at = atab + u.ui * 256 + wr * 64 + (fr & 7);
#pragma unroll
        for (int ai = 0; ai < 2; ++ai)
#pragma unroll
            for (int m = 0; m < 4; ++m) { u32x2v p[2];
#pragma unroll
                for (int bj = 0; bj < 2; ++bj) { const f32x4 v0 = acc[ai][bj][m][0] * 16.f, v1 = acc[ai][bj][m][1] * 16.f;
                    int t0 = __builtin_amdgcn_cvt_pk_fp8_f32(v0[0], v0[1], 0, false); t0 = __builtin_amdgcn_cvt_pk_fp8_f32(v0[2], v0[3], t0, true);
                    int t1 = __builtin_amdgcn_cvt_pk_fp8_f32(v1[0], v1[1], 0, false); t1 = __builtin_amdgcn_cvt_pk_fp8_f32(v1[2], v1[3], t1, true);
                    p[bj].x = (unsigned)t0; p[bj].y = (unsigned)t1; }
                const u32x2v x = {ror8u(p[1].x), ror8u(p[1].y)};
                const int aA = at[ai * HALF + m * 16], aB = at[ai * HALF + m * 16 + 8];
                const u32x2v dA = up ? x : p[0], dB = up ? p[0] : x;
                if (STORE) { if (aA >= 0) EPI_ST((u32x2v*)(YB8 + (size_t)aA * 2048 + ca), dA); if (aB >= 0) EPI_ST((u32x2v*)(YB8 + (size_t)aB * 2048 + cb), dB); }
                else asm volatile("" :: "v"(dA.x), "v"(dA.y), "v"(dB.x), "v"(dB.y)); }
    }
};
typedef EpiDownT<true> EpiDown;
template <bool GATHER_> struct MoeOrder { static constexpr bool GATHER = GATHER_; static constexpr int MAXU = 9;
    int nN, G, c, nt; const unsigned* cnt; size_t exp_bytes; const int* rowmap; PG8_LAS int* tok;
    static __device__ __forceinline__ int tiles(const unsigned* cnt) { int n = 0; for (int e = 0; e < 16; ++e) n += (int)(cnt[e] + 255u) >> 8; return n; }
    __device__ __forceinline__ bool next(int i, Unit& u) const { const long L = (long)i * G + c; if (L >= (long)nt * nN) return false; u.pm = (int)(L / nN); u.pn = (int)(L % nN); u.ui = i; return true; }
    __device__ __forceinline__ const char* pa(const Gemm& g, const Unit& u) const { return GATHER_ ? (const char*)g.A : (const char*)g.A + (size_t)u.pm * ((size_t)BM * g.K * 2); }
    __device__ __forceinline__ const char* pb(const Gemm& g, const Unit& u) const { const int e = __builtin_amdgcn_readfirstlane(tok[MAXU * 256 + u.pm]) & 15; return (const char*)g.Bt + (size_t)e * exp_bytes + (size_t)u.pn * ((size_t)BM * g.K * 2); }
    __device__ __forceinline__ void prep() const {
        if (threadIdx.x < 16) { const int e = threadIdx.x; int pm = 0; for (int q = 0; q < e; ++q) pm += (int)(cnt[q] + 255u) >> 8;
            const int ce = (int)cnt[e];
            for (int k = 0; k * 256 < ce; ++k) { const int rem = ce - k * 256; tok[MAXU * 256 + pm + k] = e | (k << 4) | ((rem > 256 ? 256 : rem) << 12); } }
        __syncthreads();
        for (int i = 0; i < MAXU; ++i) { Unit u; if (!next(i, u)) break; if (threadIdx.x < 256) { const int w = tok[MAXU * 256 + u.pm]; tok[i * 256 + threadIdx.x] = ((int)threadIdx.x < (w >> 12)) ? rowmap[(w & 15) * ECAP + ((w >> 4) & 255) * 256 + (int)threadIdx.x] : -1; } }
        asm volatile("s_waitcnt vmcnt(0) lgkmcnt(0)" ::: "memory"); __syncthreads();
    }
    __device__ __forceinline__ void aoffs(int ui, int K, int tid, unsigned (&out)[2][2]) const {
#pragma unroll
        for (int h = 0; h < 2; ++h)
#pragma unroll
            for (int i = 0; i < 2; ++i) { int R, C; stage_rc(tid * 16 + i * 8192, R, C); const int a = tok[ui * 256 + h * 128 + R]; out[h][i] = (unsigned)((a < 0 ? 0 : a) >> 1) * (unsigned)(K * 2) + (unsigned)(C * 2); }
    }
    __device__ __forceinline__ void a_ready(const Unit&) const {}
    __device__ __forceinline__ void done(const Unit&) const {}
};
}

struct Args { const float* in[18]; float* out; unsigned char* ws; int ph_lo, ph_hi; };
#ifdef ONLY_PH
#define IN(k) ((k) == ONLY_PH)
#else
#define IN(k) (lo <= (k) && (k) < hi)
#endif
#define BOTH(k) (IN(k) && IN((k) + 1))
#if MK_ONE_LAUNCH
#define SEAM() xcd_barrier(bar)
#else
#define SEAM() do {} while (0)
#endif
#ifndef REP_PH
#define REP_PH (-1)
#endif
#ifndef REP_PH2
#define REP_PH2 (-1)
#endif
#ifdef TS_PROBE
#define TS_STAMP(k) do { if (blockIdx.x == 0 && threadIdx.x == 0) __hip_atomic_store((unsigned long long*)(ws + WS_CTL + 65536) + (k), __builtin_amdgcn_s_memrealtime(), __ATOMIC_RELAXED, __HIP_MEMORY_SCOPE_AGENT); } while (0)
#define PHASE(k, ...) if (IN(k)) { __VA_ARGS__; SEAM(); TS_STAMP((k) + 1); }
#else
#define PHASE(k, ...) if (IN(k)) { __VA_ARGS__; if ((k) == REP_PH || (k) == REP_PH2) { __syncthreads(); __VA_ARGS__; } if (BOTH(k)) SEAM(); }
#endif
#define WSP(T_, off) ((T_*)(ws + (off)))
#ifndef MOE_XCD_ORDER
#define MOE_XCD_ORDER 1
#endif
#if MOE_XCD_ORDER
#define MOE_CU(c) (((c).G % 8 == 0) ? ((c).bid % 8) * ((c).G / 8) + (c).bid / 8 : (c).bid)
#else
#define MOE_CU(c) ((c).bid)
#endif
#define GEMM_STATIC(EPI, A_, B_, N_, K_, ...) do { pg8::Gemm g{A_, B_, T, N_, K_}; pg8::StaticOrder S; S.init(T, N_, c.G, c.bid); EPI E{__VA_ARGS__}; pg8::gemm_phase<EPI, pg8::StaticOrder, GEMM_ALIGN, GEMM_SP2>(c.lds, g, S, E); } while (0)
#define GEMM_MOE(GATH, EPI, A_, B_, N_, K_, ...) do { pg8::Gemm g{A_, B_, MAXROWS, N_, K_}; const unsigned* cnt_ = WSP(unsigned, WS_CTL) + CW_CUR + L * 32; pg8::MoeOrder<GATH> S{(N_) / 256, c.G, MOE_CU(c), __builtin_amdgcn_readfirstlane(pg8::MoeOrder<GATH>::tiles(cnt_)), cnt_, (size_t)(N_) * (K_) * 2, WSP(int, WS_RM2), (LAS int*)(c.lds + LDSCTL_OFF + 5120)}; EPI E{__VA_ARGS__}; pg8::gemm_phase<EPI, pg8::MoeOrder<GATH>, GEMM_ALIGN, true>(c.lds, g, S, E); } while (0)
enum { P_PRO = 0, P_QKV, P_ATTA, P_ATTB, P_WO, P_MOE0, P_WIN = P_MOE0 + 4, P_CONV, P_CELL, P_HN, P_WOUT, P_MOE1, P_END = P_MOE1 + 4 };
static_assert(P_END == NPHASE, "phase count");
constexpr int TAIL_E = 9;
__device__ __forceinline__ bool tail_share(const Ctx& c, int units, int& j, int& n) {
    const int R = (units + c.G - 1) / c.G, nlast = units - (R - 1) * c.G, cu = MOE_CU(c); n = c.G - nlast;
    if (n < 64) { j = c.bid; n = c.G; return true; }
    j = cu - nlast; return cu >= nlast; }
template <int L>
__device__ __forceinline__ void moe_block(const Ctx& c, const Args& args, unsigned char* ws, const int lo, const int hi, const XcdBarrier& bar, const int base) {
    (void)bar; (void)lo; (void)hi;
    PHASE(base + 0, ln_pass<0, 1, false>(c, WSP(bf16, WS_PRE), nullptr, nullptr, WSP(bf16, WS_XB), args.in[9] + L * D, args.in[10] + L * D, args.in[13], 16, 0, args.in[14], WSP(int, WS_RM2), WSP(float, WS_EGATE), WSP(unsigned, WS_CTL) + CW_CUR + L * 32, nullptr))
    PHASE(base + 1, GEMM_MOE(true, pg8::EpiSwiGLU, WSP(bf16, WS_XB), WSP(bf16, WS_WGU), GU_N, D, WSP(bf16, WS_H));
        if (L == 0) { int j_, n_; __syncthreads(); if (tail_share(c, pg8::MoeOrder<true>::tiles(WSP(unsigned, WS_CTL) + CW_CUR) * (GU_N / 256), j_, n_)) {
            conv_moe(c, args.in[15], args.in[16], args.in[17], WSP(bf16, WS_WGU), WSP(bf16, WS_WD), j_ * NWAVES + c.wave, n_ * NWAVES, 2 * NE * 768 + TAIL_E * 768, 2 * NE * 768);
            conv_job(c, args.in[8], D, D, D, WSP(bf16, WS_WOUT), j_ * NWAVES + c.wave, n_ * NWAVES); } })
#ifdef DOWN_NOSTORE_PROBE
    if (IN(base + 2)) { GEMM_MOE(false, pg8::EpiDownT<false>, WSP(bf16, WS_H), WSP(bf16, WS_WD), D, DE, WSP(unsigned char, WS_YB), (const LAS int*)(c.lds + LDSCTL_OFF + 5120)); __syncthreads(); }
#endif
    PHASE(base + 2, GEMM_MOE(false, pg8::EpiDown, WSP(bf16, WS_H), WSP(bf16, WS_WD), D, DE, WSP(unsigned char, WS_YB), (const LAS int*)(c.lds + LDSCTL_OFF + 5120));
        if (L == 0) { int j_, n_; __syncthreads(); if (tail_share(c, pg8::MoeOrder<true>::tiles(WSP(unsigned, WS_CTL) + CW_CUR) * (D / 256), j_, n_))
            conv_job(c, args.in[3], ZLD, D, ZN, WSP(bf16, WS_WIN), j_ * NWAVES + c.wave, n_ * NWAVES); })
    if (L == 0) { PHASE(base + 3, ln_pass<1, 2, false>(c, nullptr, nullptr, WSP(bf16, WS_YB), WSP(bf16, WS_XB), args.in[11], args.in[12], args.in[3], ZLD, ZN, args.in[4], nullptr, WSP(float, WS_EGATE), nullptr, WSP(float, WS_GATES))) }
    else { PHASE(base + 3, ln_pass<1, 0, true>(c, nullptr, args.out, WSP(bf16, WS_YB), WSP(bf16, WS_XB), args.in[11] + D, args.in[12] + D, nullptr, 0, 0, nullptr, nullptr, WSP(float, WS_EGATE), nullptr, nullptr)) }
}
__global__ void __launch_bounds__(NTHR, 2) fwd(Args args) {
    extern __shared__ __attribute__((aligned(16))) unsigned char lds_raw[];
    Ctx c; c.lds = (LAS unsigned char*)lds_raw; c.tid = threadIdx.x; c.lane = c.tid & 63; c.wave = __builtin_amdgcn_readfirstlane(c.tid >> 6);
    c.G = gridDim.x; c.bid = blockIdx.x; c.gw = c.bid * NWAVES + c.wave; c.ngw = c.G * NWAVES; c.gtid = c.bid * NTHR + c.tid; c.ngt = c.G * NTHR;
    unsigned char* ws = args.ws;
    ((LAS unsigned*)(c.lds + LDSCTL_OFF))[c.tid] = 0u;
    __syncthreads();
#if MK_ONE_LAUNCH
    XcdBarrier bar = xcd_barrier_post((unsigned*)(ws + WS_CTL) + CW_BAR, (volatile LAS unsigned*)(c.lds + LDSCTL_OFF + LC_BAR));
#else
    XcdBarrier bar; bar.bar = nullptr; bar.x = 0; bar.st = nullptr;
#endif
    const int lo = args.ph_lo, hi = args.ph_hi; (void)lo; (void)hi;
#ifdef TS_PROBE
    SEAM(); TS_STAMP(0);
#endif
    PHASE(P_PRO, conv_job<true>(c, args.in[1], QKV_N, D, QKV_N, WSP(bf16, WS_WQKV), c.gw, c.ngw); conv_job(c, args.in[2], D, OD, D, WSP(bf16, WS_WO), c.gw, c.ngw);
        conv_moe(c, args.in[15], args.in[16], args.in[17], WSP(bf16, WS_WGU), WSP(bf16, WS_WD), c.gw, c.ngw, 2 * NE * 768);
        conv_moe(c, args.in[15], args.in[16], args.in[17], WSP(bf16, WS_WGU), WSP(bf16, WS_WD), c.gw, c.ngw, 3 * NE * 768, 2 * NE * 768 + TAIL_E * 768);
        x_to_bf16(c, args.in[0], WSP(bf16, WS_XB)))
    PHASE(P_QKV, GEMM_STATIC(pg8::EpiQKV, WSP(bf16, WS_XB), WSP(bf16, WS_WQKV), QKV_N, D, WSP(bf16, WS_QKV), QKV_N))
    PHASE(P_ATTA, att::attn_phase<false>(c, WSP(const bf16, WS_QKV), WSP(bf16, WS_XB), WSP(float, WS_GATES), nullptr))
    PHASE(P_ATTB, att::attn_phase<true>(c, WSP(const bf16, WS_QKV), WSP(bf16, WS_XB), WSP(float, WS_GATES), WSP(bf16, WS_O)))
    PHASE(P_WO, GEMM_STATIC(pg8::EpiRes<true>, WSP(bf16, WS_O), WSP(bf16, WS_WO), D, OD, args.in[0], WSP(bf16, WS_PRE), D, ALPHA))
    moe_block<0>(c, args, ws, lo, hi, bar, P_MOE0);
    PHASE(P_WIN, GEMM_STATIC(pg8::EpiStoreFp8, WSP(bf16, WS_XB), WSP(bf16, WS_WIN), ZN, D, WSP(unsigned char, WS_Z), ZN))
    PHASE(P_CONV, conv_pass(c, WSP(const unsigned char, WS_Z), args.in[5], args.in[6], WSP(bf16, WS_QKC)))
    PHASE(P_CELL,
#if defined(MLS_SKIP)
        mls::mlstm_phase<MLS_SKIP>(c, WSP(const bf16, WS_QKC), WSP(const unsigned char, WS_Z), WSP(const float, WS_GATES), WSP(bf16, WS_HC)); __syncthreads();
#endif
        mls::mlstm_phase<0>(c, WSP(const bf16, WS_QKC), WSP(const unsigned char, WS_Z), WSP(const float, WS_GATES), WSP(bf16, WS_HC));
#if 0
        mls::mlstm_phase<0>(c, WSP(const bf16, WS_QKC), WSP(const unsigned char, WS_Z), WSP(const float, WS_GATES), WSP(bf16, WS_HC));
#endif
        if (c.G > 128) { if (c.bid >= 128) conv_moe(c, args.in[15] + (size_t)NE * D * DE, args.in[16] + (size_t)NE * D * DE, args.in[17] + (size_t)NE * D * DE, WSP(bf16, WS_WGU), WSP(bf16, WS_WD), (c.bid - 128) * NWAVES + c.wave, (c.G - 128) * NWAVES); }
        else conv_moe(c, args.in[15] + (size_t)NE * D * DE, args.in[16] + (size_t)NE * D * DE, args.in[17] + (size_t)NE * D * DE, WSP(bf16, WS_WGU), WSP(bf16, WS_WD), c.gw, c.ngw);
        )
    PHASE(P_HN, headnorm_pass(c, WSP(const bf16, WS_HC), WSP(const unsigned char, WS_Z), args.in[7], WSP(bf16, WS_Y)))
    PHASE(P_WOUT, GEMM_STATIC(pg8::EpiRes<false>, WSP(bf16, WS_Y), WSP(bf16, WS_WOUT), D, D, WSP(bf16, WS_XB), WSP(bf16, WS_PRE), D, ALPHA))
    moe_block<1>(c, args, ws, lo, hi, bar, P_MOE1);
#ifdef TS_PROBE
    {
        SEAM();
        const unsigned long long* ts = (const unsigned long long*)(ws + WS_CTL + 65536);
        const unsigned long long t0 = __hip_atomic_load(ts + TS_PROBE, __ATOMIC_RELAXED, __HIP_MEMORY_SCOPE_AGENT), t1 = __hip_atomic_load(ts + TS_PROBE + 1, __ATOMIC_RELAXED, __HIP_MEMORY_SCOPE_AGENT), t2 = __hip_atomic_load(ts + TS_PROBE + 2, __ATOMIC_RELAXED, __HIP_MEMORY_SCOPE_AGENT);
        const float k1 = (float)(t1 - t0) * 0.001f;
        const float k2 = (TS_PROBE + 2 <= NPHASE) ? (float)(t2 - t1) * 10.0f : 0.f;
        for (size_t i = c.gtid; i < (size_t)T * D; i += c.ngt) args.out[i] = k1;
        SEAM();
        if (c.gtid == 0) args.out[0] = k2;
    }
#endif
}
#undef IN
#undef BOTH

extern "C" void kernel_launch(void* const* d_in, const int* in_sizes, int n_in, void* d_out, int out_size, void* d_ws, size_t ws_size, hipStream_t stream) {
    static int grid = 0;
    if (grid == 0) {
        if (n_in != 18 || in_sizes[0] != T * D || out_size != T * D || ws_size < WS_END) { fprintf(stderr, "kernel_launch: unexpected shapes (n_in %d, in0 %d, out %d, ws %zu)\n", n_in, n_in > 0 ? in_sizes[0] : -1, out_size, ws_size); grid = -1; return; }
        int dev = 0, cus = 0;
        if (hipGetDevice(&dev) != hipSuccess || hipDeviceGetAttribute(&cus, hipDeviceAttributeMultiprocessorCount, dev) != hipSuccess) { grid = -1; return; }
        if (hipFuncSetAttribute((const void*)fwd, hipFuncAttributeMaxDynamicSharedMemorySize, LDS_BYTES) != hipSuccess) { fprintf(stderr, "kernel_launch: hipFuncSetAttribute failed\n"); grid = -1; return; }
        int per_cu = 0;
        if (hipOccupancyMaxActiveBlocksPerMultiprocessor(&per_cu, (const void*)fwd, NTHR, LDS_BYTES) != hipSuccess || per_cu < 1) fprintf(stderr, "kernel_launch: occupancy query says %d\n", per_cu);
        (void)hipGetLastError();
        grid = cus > 256 ? 256 : cus;
    }
    if (grid < 0) return;
    (void)hipMemsetAsync((char*)d_ws + WS_CTL, 0, CTL_ZERO_BYTES, stream);
    Args a{};
    for (int i = 0; i < 18; ++i) a.in[i] = (const float*)d_in[i];
    a.out = (float*)d_out; a.ws = (unsigned char*)d_ws;
#if MK_ONE_LAUNCH
    a.ph_lo = 0; a.ph_hi = NPHASE;
    hipLaunchKernelGGL(fwd, dim3(grid), dim3(NTHR), LDS_BYTES, stream, a);
#else
    for (int p = 0; p < NPHASE; ++p) { a.ph_lo = p; a.ph_hi = p + 1; hipLaunchKernelGGL(fwd, dim3(grid), dim3(NTHR), LDS_BYTES, stream, a); }
#endif
}
```

```cpp
#include <hip/hip_runtime.h>
#include <cstdio>
#include <cstdint>
namespace pg8 {
#define PG8_LAS __attribute__((address_space(3)))
typedef unsigned short bf16_t;
typedef short bf16x8 __attribute__((ext_vector_type(8)));
typedef float f32x4 __attribute__((ext_vector_type(4)));
typedef unsigned u32x4 __attribute__((ext_vector_type(4)));
constexpr int BM = 256, BK = 64, HALF = 128, HTB = HALF * BK * 2  , STAGE_BYTES = 8 * HTB, NXCD = 8, WGM = 8;

__host__ __device__ __forceinline__ int lds_byte(int r, int c) { const int st = (r >> 4) * 2 + (c >> 5), rr = r & 15, cc = c & 31, ob = rr * 64 + cc * 2; return st * 1024 + (ob ^ (((ob >> 9) & 1) << 5)); }
__host__ __device__ __forceinline__ void stage_rc(int b, int& R, int& C) { const int st = b / 1024, sb = b % 1024, swz = sb ^ (((sb >> 9) & 1) << 5); R = (st >> 1) * 16 + swz / 64; C = (st & 1) * 32 + (swz % 64) / 2; }
__host__ __device__ __forceinline__ int perm32(int rho) { const int n = rho >> 4, i = rho & 15; return 8 * (i >> 2) + 4 * n + (i & 3); }

struct Unit { int pm, pn, ui; };
struct Gemm { const bf16_t* A; const bf16_t* Bt; int M, N, K; };

struct StaticOrder {
    int nM, nN, nwg, G, c;
    __host__ __device__ void init(int M, int N, int G_, int c_) { nM = M / BM; nN = N / BM; nwg = nM * nN; G = G_; c = c_; }
    __host__ __device__ bool next(int i, Unit& u) const {
        const long L = (long)i * G + c; if (L >= nwg) return false;
        int wgid = (int)L; { const int q = nwg / NXCD, r = nwg % NXCD, xcd = wgid % NXCD, off = wgid / NXCD; wgid = (xcd < r ? xcd * (q + 1) : r * (q + 1) + (xcd - r) * q) + off; }
        const int nig = WGM * nN, gid = wgid / nig, fm = gid * WGM, gsz = (nM - fm) < WGM ? (nM - fm) : WGM;
        u.pm = fm + ((wgid % nig) % gsz); u.pn = (wgid % nig) / gsz; u.ui = i; return true;
    }
    __device__ __forceinline__ const char* pa(const Gemm& g, const Unit& u) const { return (const char*)g.A + (size_t)u.pm * ((size_t)BM * g.K * 2); }
    __device__ __forceinline__ const char* pb(const Gemm& g, const Unit& u) const { return (const char*)g.Bt + (size_t)u.pn * ((size_t)BM * g.K * 2); }
    static constexpr bool GATHER = false;
    __device__ __forceinline__ void prep() const {}
    __device__ __forceinline__ void aoffs(int, int, int, unsigned (&)[2][2]) const {}
    __device__ __forceinline__ void a_ready(const Unit&) const {}
    __device__ __forceinline__ void done(const Unit&) const {}
};

__device__ __forceinline__ unsigned cvt_pk_bf16(float lo, float hi) { unsigned r; asm volatile("v_cvt_pk_bf16_f32 %0, %1, %2" : "=v"(r) : "v"(lo), "v"(hi)); return r; }
typedef float f32x2 __attribute__((ext_vector_type(2)));
template <class Epi, class Sched, bool ALIGN_EPI = false, bool SP2 = false>
__device__ __forceinline__ void gemm_phase(PG8_LAS unsigned char* lds, const Gemm g, const Sched& S, const Epi& E) {
    const int tid = threadIdx.x, wid = __builtin_amdgcn_readfirstlane(tid >> 6), lane = tid & 63, wr = wid >> 2, wc = wid & 3, fr = lane & 15, fq = lane >> 4;
    const int K = g.K, nt = K / BK;
    unsigned voffA[2], voffB[2];
#pragma unroll
    for (int i = 0; i < 2; ++i) { int R, C; stage_rc(tid * 16 + i * 8192, R, C); const int Rb = Epi::PERM ? ((R & ~31) + perm32(R & 31)) : R;
        voffA[i] = (unsigned)(R * K + C) * 2u; voffB[i] = (unsigned)(((int)Epi::WIDE == 2 ? ((R >> 5) * 64 + 16 * (perm32(R & 31) >> 3) + (perm32(R & 31) & 7)) : (int)Epi::WIDE == 1 ? ((R >> 5) * 64 + perm32(R & 31)) : Rb) * K + C) * 2u; }
    const size_t kstep = (size_t)(BK * 2);
    const size_t hstep = (size_t)HALF * K * 2;
    const size_t hstepB = (int)Epi::WIDE == 2 ? (size_t)8 * K * 2 : (int)Epi::WIDE == 1 ? (size_t)32 * K * 2 : hstep;
    const size_t tstep = 2 * hstep;
    const unsigned ldsw = (unsigned)wid * 1024u;
    const int aoff = lds_byte(wr * 64 + fr, fq * 8), boff = lds_byte(wc * 32 + fr, fq * 8);
#define PG8_SA(b, h) (((b) * 2 + (h)) * HTB)
#define PG8_SB(b, h) ((4 + (b) * 2 + (h)) * HTB)
#define PG8_STAGE(bufoff, gbase, voff) do { _Pragma("unroll") for (int _i = 0; _i < 2; ++_i) \
        __builtin_amdgcn_global_load_lds((const unsigned*)((const char*)(gbase) + (voff)[_i]), (PG8_LAS unsigned*)(lds + (bufoff) + ldsw + _i * 8192), 16, 0, 0); } while (0)
#define PG8_STAGE_A(bufoff, kptr, half, NXT) do { if constexpr (Sched::GATHER) { const unsigned vx_[2] = {(NXT) ? van[half][0] : va[half][0], (NXT) ? van[half][1] : va[half][1]}; PG8_STAGE(bufoff, kptr, vx_); } \
        else { PG8_STAGE(bufoff, (kptr) + ((half) ? hstep : 0), voffA); } } while (0)
#define PG8_LDA(dst, b, h) do { _Pragma("unroll") for (int m = 0; m < 4; ++m) _Pragma("unroll") for (int k = 0; k < 2; ++k) dst[m][k] = *(const PG8_LAS bf16x8*)(lds + PG8_SA(b, h) + aoff + m * 2048 + k * 1024); } while (0)
#define PG8_LDB(dst, b, h) do { _Pragma("unroll") for (int n = 0; n < 2; ++n) _Pragma("unroll") for (int k = 0; k < 2; ++k) dst[n][k] = *(const PG8_LAS bf16x8*)(lds + PG8_SB(b, h) + boff + n * 2048 + k * 1024); } while (0)
#define PG8_MMA(ai, bj, At, Bt) do { __builtin_amdgcn_s_setprio(1); _Pragma("unroll") for (int m = 0; m < 4; ++m) _Pragma("unroll") for (int n = 0; n < 2; ++n) _Pragma("unroll") for (int k = 0; k < 2; ++k) \
        acc[ai][bj][m][n] = __builtin_amdgcn_mfma_f32_16x16x32_bf16(Bt[n][k], At[m][k], acc[ai][bj][m][n], 0, 0, 0); __builtin_amdgcn_s_setprio(0); } while (0)
#define PG8_WAIT_V(n) asm volatile("s_waitcnt vmcnt(" #n ")" ::: "memory")
#define PG8_WAIT_L(n) asm volatile("s_waitcnt lgkmcnt(" #n ")" ::: "memory")
#define PG8_BAR __builtin_amdgcn_s_barrier()
#define PG8_SCHED __builtin_amdgcn_sched_barrier(0)
    Unit cur, nxt; int ui = 0;
    if (!S.next(0, cur)) return;
    S.prep();
    f32x4 acc[2][2][4][2];
#pragma unroll
    for (int a = 0; a < 2; ++a)
#pragma unroll
        for (int b = 0; b < 2; ++b)
#pragma unroll
            for (int m = 0; m < 4; ++m)
#pragma unroll
                for (int n = 0; n < 2; ++n) acc[a][b][m][n] = (f32x4){0.f, 0.f, 0.f, 0.f};
    bf16x8 At[4][2], B0[2][2], B1[2][2];
    const char* cA = S.pa(g, cur); const char* cB = S.pb(g, cur);
    unsigned va[2][2] = {{0u, 0u}, {0u, 0u}}, van[2][2] = {{0u, 0u}, {0u, 0u}};
    static_assert(SP2 || !Epi::WIDE, "WIDE epilogues: SP2 loop only");
    if constexpr (Sched::GATHER) { static_assert(SP2, "gathered A rows: SP2 loop only"); S.aoffs(0, K, tid, va); }
    S.a_ready(cur);
    if constexpr (SP2) {
        PG8_STAGE(PG8_SB(0, 0), cB, voffB); PG8_STAGE(PG8_SB(0, 1), cB + hstepB, voffB); PG8_STAGE_A(PG8_SA(0, 0), cA, 0, false); PG8_STAGE_A(PG8_SA(0, 1), cA, 1, false);
        if (wr == 1) PG8_BAR;
        PG8_WAIT_V(2); PG8_BAR;
        PG8_STAGE(PG8_SB(1, 0), cB + kstep, voffB); PG8_STAGE_A(PG8_SA(1, 0), cA + kstep, 0, false); PG8_STAGE(PG8_SB(1, 1), cB + hstepB + kstep, voffB);
        PG8_WAIT_V(6); PG8_BAR;
    } else {
        PG8_STAGE(PG8_SB(0, 0), cB, voffB); PG8_STAGE(PG8_SA(0, 0), cA, voffA); PG8_STAGE(PG8_SB(0, 1), cB + hstep, voffB); PG8_STAGE(PG8_SA(0, 1), cA + hstep, voffA);
        if (wr == 1) PG8_BAR;
        PG8_WAIT_V(4); PG8_BAR;
        PG8_STAGE(PG8_SB(1, 0), cB + kstep, voffB); PG8_STAGE(PG8_SA(1, 0), cA + kstep, voffA); PG8_STAGE(PG8_SB(1, 1), cB + hstep + kstep, voffB);
        PG8_WAIT_V(6); PG8_BAR;
    }
    for (;;) {
        const bool has_next = S.next(ui + 1, nxt);
        if constexpr (Sched::GATHER) { if (has_next) S.aoffs(ui + 1, K, tid, van); else { van[0][0] = va[0][0]; van[0][1] = va[0][1]; van[1][0] = va[1][0]; van[1][1] = va[1][1]; } }
        const char* nA = has_next ? S.pa(g, nxt) : cA; const char* nB = has_next ? S.pb(g, nxt) : cB;
        for (int t = 0; t < nt; t += 2) {
            const bool last = (t == nt - 2);
            const char* a1 = cA + (size_t)(t + 1) * kstep;
            const char* a2 = last ? nA : cA + (size_t)(t + 2) * kstep; const char* b2 = last ? nB : cB + (size_t)(t + 2) * kstep;
            const char* a3 = a2 + kstep; const char* b3 = b2 + kstep;
            if (last && has_next) S.a_ready(nxt);
            if constexpr (SP2) {
            PG8_LDB(B0, 0, 0); PG8_LDB(B1, 0, 1); PG8_SCHED; PG8_LDA(At, 0, 0); PG8_STAGE_A(PG8_SA(1, 1), a1, 1, false);
            PG8_WAIT_V(8); PG8_WAIT_L(0); PG8_BAR; PG8_MMA(0, 0, At, B0); PG8_MMA(0, 1, At, B1); PG8_BAR; PG8_SCHED;
            PG8_LDA(At, 0, 1); PG8_STAGE(PG8_SB(0, 0), b2, voffB); PG8_STAGE(PG8_SB(0, 1), b2 + hstepB, voffB); PG8_STAGE_A(PG8_SA(0, 0), a2, 0, last);
            PG8_WAIT_V(8); PG8_WAIT_L(0); PG8_BAR; PG8_MMA(1, 0, At, B0); PG8_MMA(1, 1, At, B1); PG8_BAR; PG8_SCHED;
            PG8_LDB(B0, 1, 0); PG8_LDB(B1, 1, 1); PG8_SCHED; PG8_LDA(At, 1, 0); PG8_STAGE_A(PG8_SA(0, 1), a2, 1, last);
            PG8_WAIT_V(8); PG8_WAIT_L(0); PG8_BAR; PG8_MMA(0, 0, At, B0); PG8_MMA(0, 1, At, B1); PG8_BAR; PG8_SCHED;
            PG8_LDA(At, 1, 1); PG8_STAGE(PG8_SB(1, 0), b3, voffB); PG8_STAGE(PG8_SB(1, 1), b3 + hstepB, voffB); PG8_STAGE_A(PG8_SA(1, 0), a3, 0, last);
            PG8_WAIT_V(8); PG8_WAIT_L(0); PG8_BAR; PG8_MMA(1, 0, At, B0); PG8_MMA(1, 1, At, B1); PG8_BAR; PG8_SCHED;
            } else {
            PG8_LDB(B0, 0, 0); PG8_SCHED; PG8_LDA(At, 0, 0); PG8_STAGE(PG8_SA(1, 1), a1 + hstep, voffA);
            PG8_WAIT_L(8); PG8_BAR; PG8_WAIT_L(0); PG8_MMA(0, 0, At, B0); PG8_BAR; PG8_SCHED;
            PG8_LDB(B1, 0, 1); PG8_STAGE(PG8_SB(0, 0), b2, voffB);
            PG8_BAR; PG8_WAIT_L(0); PG8_MMA(0, 1, At, B1); PG8_BAR;
            PG8_LDA(At, 0, 1); PG8_STAGE(PG8_SA(0, 0), a2, voffA);
            PG8_BAR; PG8_WAIT_L(0); PG8_MMA(1, 0, At, B0); PG8_BAR; PG8_SCHED;
            PG8_STAGE(PG8_SB(0, 1), b2 + hstep, voffB);
            PG8_WAIT_V(6); PG8_BAR; PG8_MMA(1, 1, At, B1); PG8_BAR;
            PG8_LDB(B0, 1, 0); PG8_SCHED; PG8_LDA(At, 1, 0); PG8_STAGE(PG8_SA(0, 1), a2 + hstep, voffA);
            PG8_WAIT_L(8); PG8_BAR; PG8_WAIT_L(0); PG8_MMA(0, 0, At, B0); PG8_BAR; PG8_SCHED;
            PG8_LDB(B1, 1, 1); PG8_STAGE(PG8_SB(1, 0), b3, voffB);
            PG8_BAR; PG8_WAIT_L(0); PG8_MMA(0, 1, At, B1); PG8_BAR;
            PG8_LDA(At, 1, 1); PG8_STAGE(PG8_SA(1, 0), a3, voffA);
            PG8_BAR; PG8_WAIT_L(0); PG8_MMA(1, 0, At, B0); PG8_BAR; PG8_SCHED;
            PG8_STAGE(PG8_SB(1, 1), b3 + hstep, voffB);
            PG8_WAIT_V(6); PG8_BAR; PG8_MMA(1, 1, At, B1); PG8_BAR;
            }
        }
        if constexpr (ALIGN_EPI) { if (wr == 0) PG8_BAR; }
        if constexpr (!Epi::AFTER_DRAIN) { E(acc, cur, wr, wc, fr, fq); S.done(cur); }
        if (!has_next) break;
#pragma unroll
        for (int a = 0; a < 2; ++a)
#pragma unroll
            for (int b = 0; b < 2; ++b)
#pragma unroll
                for (int m = 0; m < 4; ++m)
#pragma unroll
                    for (int n = 0; n < 2; ++n) acc[a][b][m][n] = (f32x4){0.f, 0.f, 0.f, 0.f};
        cur = nxt; cA = nA; cB = nB; ++ui;
        if constexpr (Sched::GATHER) { va[0][0] = van[0][0]; va[0][1] = van[0][1]; va[1][0] = van[1][0]; va[1][1] = van[1][1]; }
        if constexpr (ALIGN_EPI) { if (wr == 1) PG8_BAR; }
    }
    PG8_WAIT_V(0);
    if constexpr (!ALIGN_EPI) { if (wr == 0) PG8_BAR; }
    PG8_BAR;
    if constexpr (Epi::AFTER_DRAIN) { E.fused(acc, cur, wr, wc, fr, fq, lds, wid, lane); S.done(cur); }
#undef PG8_SA
#undef PG8_SB
#undef PG8_STAGE
#undef PG8_STAGE_A
#undef PG8_LDA
#undef PG8_LDB
#undef PG8_MMA
#undef PG8_WAIT_V
#undef PG8_WAIT_L
#undef PG8_BAR
#undef PG8_SCHED
}
}

#ifndef MK_ONE_LAUNCH
#define MK_ONE_LAUNCH 1
#endif
constexpr int NWAVES = 8, NTHR = 512;
constexpr int BATCH = 16, SEQ = 2048, T = BATCH * SEQ, D = 2048;
constexpr int QKV_N = 9216, NH = 8, HD = 128, OD = NH * HD;
constexpr int ZN = 6144, ZLD = 6160;
constexpr int NE = 16, DE = 768, GU_N = 2 * DE;
constexpr int MAXTILES = 272, MAXROWS = MAXTILES * 256;
constexpr float ALPHA = 1.41421356237309515f;
constexpr float LN_EPS = 1e-5f;
constexpr int NPHASE = 18;
constexpr int ECAP = 32768;

constexpr size_t MiB = 1u << 20, KiB = 1u << 10;
constexpr size_t WS_CTL = 0, CTL_ZERO_BYTES = 256 * KiB;
constexpr size_t WS_ROPE = 1 * MiB;
constexpr size_t WS_EID = 1 * MiB + 256 * KiB;
constexpr size_t WS_EGATE = 1 * MiB + 512 * KiB;
constexpr size_t WS_ROWMAP = 1 * MiB + 768 * KiB;
constexpr size_t WS_HIST = 2 * MiB + 256 * KiB;
constexpr size_t WS_TILEE = 2 * MiB + 320 * KiB;
constexpr size_t WS_GATES = 3 * MiB;
constexpr size_t WS_WQKV = 6 * MiB, WS_WO = 42 * MiB, WS_WIN = 46 * MiB, WS_WOUT = 70 * MiB, WS_WGU = 78 * MiB, WS_WD = 174 * MiB;
constexpr size_t WS_XB = 222 * MiB;
constexpr size_t WS_R = 350 * MiB;
constexpr size_t WS_QKV = WS_R, WS_O = WS_R + 576 * MiB;
constexpr size_t WS_PRE = WS_R, WS_YB = WS_R;
constexpr size_t WS_XG = WS_R + 256 * MiB, WS_H = WS_R + 528 * MiB;
constexpr size_t WS_Z = WS_R, WS_QKC = WS_R + 384 * MiB, WS_HC = WS_R + 512 * MiB, WS_Y = WS_QKC;
constexpr size_t WS_RM2 = 990 * MiB;
constexpr size_t WS_END = 992 * MiB;
static_assert(WS_ROWMAP + (size_t)MAXROWS * 4 <= WS_HIST && WS_H + (size_t)MAXROWS * DE * 2 <= WS_RM2 && WS_RM2 + (size_t)16 * ECAP * 4 <= WS_END && WS_XG + (size_t)MAXROWS * D * 2 <= WS_H, "ws map");
constexpr int CW_TMO = 0, CW_BAR = 4096, CW_CONVQ = 8192, CW_CUR = 12288;

constexpr int RING_BYTES = 131072, LDSCTL_OFF = RING_BYTES, LDS_BYTES = 147456;
constexpr int LC_HIST = 0, LC_BAR = 64;

#define GAS __attribute__((address_space(1)))
#define LAS __attribute__((address_space(3)))
typedef unsigned short bf16;
typedef unsigned u32x4 __attribute__((ext_vector_type(4)));
typedef unsigned u32x2 __attribute__((ext_vector_type(2)));
typedef float f32x4 __attribute__((ext_vector_type(4)));
typedef float f32x2 __attribute__((ext_vector_type(2)));
#define LDS_WAIT() asm volatile("s_waitcnt lgkmcnt(0)" ::: "memory")
__device__ __forceinline__ unsigned f2bf(float f) { unsigned u = __builtin_bit_cast(unsigned, f); return (u + 0x7fffu + ((u >> 16) & 1u)) >> 16; }
__device__ __forceinline__ unsigned pk2(float lo, float hi) { return pg8::cvt_pk_bf16(lo, hi); }
__device__ __forceinline__ float bflo(unsigned u) { return __builtin_bit_cast(float, u << 16); }
__device__ __forceinline__ float bfhi(unsigned u) { return __builtin_bit_cast(float, u & 0xffff0000u); }
__device__ __forceinline__ float bf1(bf16 b) { return __builtin_bit_cast(float, (unsigned)b << 16); }
template <int CTRL> __device__ __forceinline__ float dpp0(float x) { return __builtin_bit_cast(float, __builtin_amdgcn_update_dpp(0, __builtin_bit_cast(int, x), CTRL, 0xf, 0xf, true)); }
template <int CTRL> __device__ __forceinline__ float dppx(float x) { return __builtin_bit_cast(float, __builtin_amdgcn_mov_dpp(__builtin_bit_cast(int, x), CTRL, 0xf, 0xf, true)); }
template <int CTRL, int ROWMASK> __device__ __forceinline__ float dpps(float x) { return __builtin_bit_cast(float, __builtin_amdgcn_update_dpp(__builtin_bit_cast(int, x), __builtin_bit_cast(int, x), CTRL, ROWMASK, 0xf, false)); }
__device__ __forceinline__ float prefix_sum64(float v) {
    v += dpp0<0x111>(v); v += dpp0<0x112>(v); v += dpp0<0x114>(v); v += dpp0<0x118>(v);
    v += __builtin_bit_cast(float, __builtin_amdgcn_update_dpp(0, __builtin_bit_cast(int, v), 0x142, 0xa, 0xf, false));
    v += __builtin_bit_cast(float, __builtin_amdgcn_update_dpp(0, __builtin_bit_cast(int, v), 0x143, 0xc, 0xf, false));
    return v;
}
__device__ __forceinline__ float prefix_max64(float v) {
    v = fmaxf(v, dpps<0x111, 0xf>(v)); v = fmaxf(v, dpps<0x112, 0xf>(v)); v = fmaxf(v, dpps<0x114, 0xf>(v)); v = fmaxf(v, dpps<0x118, 0xf>(v));
    v = fmaxf(v, dpps<0x142, 0xa>(v)); v = fmaxf(v, dpps<0x143, 0xc>(v));
    return v;
}
__device__ __forceinline__ float lane_bcast(float v, int l) { return __builtin_bit_cast(float, __builtin_amdgcn_readlane(__builtin_bit_cast(int, v), l)); }
__device__ __forceinline__ float wave_sum(float v) { return lane_bcast(prefix_sum64(v), 63); }
__device__ __forceinline__ float row16_sum(float v) { v += dppx<0xB1>(v); v += dppx<0x4E>(v); v += dppx<0x141>(v); v += dppx<0x128>(v); return v; }
__device__ __forceinline__ float lane_xor1(float v) { return dppx<0xB1>(v); }
__device__ __forceinline__ float lane_xor32(float v) { auto r = __builtin_amdgcn_permlane32_swap(__builtin_bit_cast(unsigned, v), __builtin_bit_cast(unsigned, v), false, false);
    return __builtin_bit_cast(float, (threadIdx.x & 32) ? r[0] : r[1]); }

#define XB_TMO      128
#define XB_XCNT(j)  (256  + 64 * (j))
#define XB_XSUB(j)  (1280 + 64 * (j))
#define XB_XGEN(j)  (2304 + 64 * (j))
#define XB_TOP      3328
#define XB_TOPGEN   3392
#define XCD_BAR_WORDS 3456
#define XB_SPIN_CAP (1u << 18)
__device__ __forceinline__ unsigned xb_ld(unsigned* p)              { return __hip_atomic_load(p, __ATOMIC_RELAXED, __HIP_MEMORY_SCOPE_AGENT); }
__device__ __forceinline__ unsigned xb_add(unsigned* p, unsigned v) { return __hip_atomic_fetch_add(p, v, __ATOMIC_RELAXED, __HIP_MEMORY_SCOPE_AGENT); }
__device__ __forceinline__ unsigned xb_xcc_id() { return (unsigned)__builtin_amdgcn_s_getreg((3 << 11) | 20) & 0xFu; }
#define XB_SPIN(cond, bar) do { unsigned _sp = 0; while (cond) { __builtin_amdgcn_s_sleep(1); \
    if ((++_sp & 255u) == 0u) { if (xb_ld(&(bar)[XB_TMO])) break; if (_sp > XB_SPIN_CAP) { atomicAdd(&(bar)[XB_TMO], 1u); break; } } } } while (0)
struct XcdBarrier { unsigned* bar; unsigned x; volatile LAS unsigned* st; };
__device__ __forceinline__ XcdBarrier xcd_barrier_post(unsigned* bar, volatile LAS unsigned* st) {
    XcdBarrier b; b.bar = bar; b.x = xb_xcc_id(); b.st = st;
    if (threadIdx.x == 0) (void)xb_add(&bar[XB_XCNT(b.x)], 1u);
    return b;
}
__device__ __forceinline__ void xcd_barrier_complete(unsigned* bar, unsigned x, unsigned& nloc, unsigned& nx) {
    const unsigned G = gridDim.x * gridDim.y * gridDim.z;
    unsigned sum, cnt, mine, sp = 0u;
    for (;;) {
        sum = 0u; cnt = 0u; mine = 0u;
#pragma unroll
        for (unsigned j = 0; j < 16; ++j) { const unsigned c = xb_ld(&bar[XB_XCNT(j)]); sum += c; cnt += (c > 0u) ? 1u : 0u; mine = (j == x) ? c : mine; }
        if (sum == G) break;
        __builtin_amdgcn_s_sleep(1);
        if ((++sp & 255u) == 0u) { if (xb_ld(&bar[XB_TMO])) break; if (sp > XB_SPIN_CAP) { atomicAdd(&bar[XB_TMO], 1u); break; } }
    }
    nloc = mine > 0u ? mine : 1u; nx = cnt > 0u ? cnt : 1u;
}
__device__ __forceinline__ void xcd_barrier(const XcdBarrier& b) {
    asm volatile("s_waitcnt vmcnt(0)" ::: "memory");
    __syncthreads();
    if (threadIdx.x == 0) {
        unsigned* bar = b.bar;
        __builtin_amdgcn_s_waitcnt(0);
        unsigned nloc = b.st[0], nx = b.st[1];
        if (nloc == 0u) { xcd_barrier_complete(bar, b.x, nloc, nx); b.st[0] = nloc; b.st[1] = nx; }
        const unsigned old = xb_add(&bar[XB_XSUB(b.x)], 1u);
        const unsigned gen = old / nloc;
        if (old + 1u == (gen + 1u) * nloc) {
            __builtin_amdgcn_fence(__ATOMIC_RELEASE, "agent");
            asm volatile("s_waitcnt vmcnt(0)" ::: "memory");
            const unsigned og = xb_add(&bar[XB_TOP], 1u);
            const unsigned tg = og / nx;
            if (og + 1u == (tg + 1u) * nx) xb_add(&bar[XB_TOPGEN], 1u);
            else XB_SPIN(xb_ld(&bar[XB_TOPGEN]) == tg, bar);
            __builtin_amdgcn_fence(__ATOMIC_ACQUIRE, "agent");
            xb_add(&bar[XB_XGEN(b.x)], 1u);
            asm volatile("s_waitcnt vmcnt(0)" ::: "memory");
        } else {
            XB_SPIN(xb_ld(&bar[XB_XGEN(b.x)]) == gen, bar);
            __builtin_amdgcn_fence(__ATOMIC_ACQUIRE, "agent");
            asm volatile("s_waitcnt vmcnt(0)" ::: "memory");
        }
    }
    __syncthreads();
}

struct Ctx { LAS unsigned char* lds; int tid, lane, wave, G, bid, gw, ngw, gtid, ngt; };

struct TrDesc { const float* wp; bf16* dst; int ldw, K, row_mul, n0; };
__device__ __forceinline__ void tr_mk(TrDesc& d, const float* W, int ldw, int K, bf16* WT, int row_off, int row_mul, int kb, int nb, int lane) {
    const int k0 = 64 * kb, n0 = 32 * nb; d.wp = W + (size_t)(k0 + (lane >> 5)) * ldw + n0 + (lane & 31); d.dst = WT + (size_t)(row_off + n0 * row_mul) * K + k0; d.ldw = ldw; d.K = K; d.row_mul = row_mul; d.n0 = n0; }
__device__ __forceinline__ void tr_load(const TrDesc& d, float (&tv)[32]) {
#pragma unroll
    for (int i = 0; i < 32; ++i) tv[i] = d.wp[(size_t)(2 * i) * d.ldw]; }
__device__ __forceinline__ int qk_perm(int n) {
    if ((n % 3072) >= 2048) return n;
    const int d = n & 127; int g, e; if (d < 16) { g = d; e = 0; } else if (d < 32) { g = d - 16; e = 1; } else { const int t = d - 32; g = t / 6; e = t - 6 * g + 2; }
    return (n & ~127) + (g >> 2) * 32 + (g & 3) * 8 + e; }
template <bool PQ>
__device__ __forceinline__ void tr_store(const TrDesc& d, const float (&tv)[32], LAS float* scr, int lane) {
#pragma unroll
    for (int i = 0; i < 32; ++i) scr[(2 * i + (lane >> 5)) * 33 + (lane & 31)] = tv[i];
    LDS_WAIT(); asm volatile("" ::: "memory");
    const int c = lane & 7;
#pragma unroll
    for (int j = 0; j < 4; ++j) { const int n = (lane >> 3) + 8 * j; const LAS float* s_ = scr + (8 * c) * 33 + n;
        u32x4 o; o.x = pk2(s_[0 * 33], s_[1 * 33]); o.y = pk2(s_[2 * 33], s_[3 * 33]); o.z = pk2(s_[4 * 33], s_[5 * 33]); o.w = pk2(s_[6 * 33], s_[7 * 33]);
        if (PQ) *(u32x4*)(d.dst + (ptrdiff_t)(qk_perm(d.n0 + n) - d.n0) * d.K + 8 * c) = o;
        else *(u32x4*)(d.dst + (size_t)(n * d.row_mul) * d.K + 8 * c) = o; }
    LDS_WAIT(); asm volatile("" ::: "memory");
}
#define TR_PIPELINE(first_, stride_, end_, MK_) TR_PIPELINE_X(first_, stride_, end_, MK_, false)
#define TR_PIPELINE_X(first_, stride_, end_, MK_, PQ_) do { LAS float* scr_ = (LAS float*)(c.lds + c.wave * 16384); TrDesc cur_, nxt_; float ta_[32], tb_[32]; int it_ = (first_); \
        if (it_ < (end_)) { MK_(cur_, it_); tr_load(cur_, ta_); } \
        for (; it_ < (end_); it_ += (stride_)) { const int itn_ = it_ + (stride_); const bool hn_ = itn_ < (end_); if (hn_) { MK_(nxt_, itn_); tr_load(nxt_, tb_); } \
            tr_store<PQ_>(cur_, ta_, scr_, c.lane); if (hn_) { cur_ = nxt_; _Pragma("unroll") for (int q_ = 0; q_ < 32; ++q_) ta_[q_] = tb_[q_]; } } } while (0)
template <bool PQ = false>
__device__ __forceinline__ void conv_job(const Ctx& c, const float* W, int ldw, int K, int N, bf16* WT, int gw0, int ngw0) {
    const int nblk = N / 32, items = (K / 64) * nblk;
#define MK_JOB(d_, it2_) tr_mk(d_, W, ldw, K, WT, 0, 1, (it2_) / nblk, (it2_) % nblk, c.lane)
    TR_PIPELINE_X(gw0, ngw0, items, MK_JOB, PQ);
#undef MK_JOB
}
constexpr int CONV_MOE_ITEMS = 3 * NE * 768, CELL_SHARE = 2048;
__device__ __forceinline__ void conv_moe_mk(TrDesc& d, int it, const float* Wg, const float* Wu, const float* Wd, bf16* WGU, bf16* WD, int lane) {
    constexpr int PER = 768; const int kind = it / (NE * PER), r = it % (NE * PER), e = r / PER, q = r % PER;
    if (kind < 2) tr_mk(d, (kind == 0 ? Wg : Wu) + (size_t)e * D * DE, DE, D, WGU + (size_t)e * GU_N * D, kind, 2, q / 24, q % 24, lane);
    else tr_mk(d, Wd + (size_t)e * DE * D, D, DE, WD + (size_t)e * D * DE, 0, 1, q / 64, q % 64, lane);
}
__device__ __forceinline__ void conv_moe(const Ctx& c, const float* Wg, const float* Wu, const float* Wd, bf16* WGU, bf16* WD, int gw0, int ngw0, int end = CONV_MOE_ITEMS, int start = 0) {
#define MK_MOE(d_, it2_) conv_moe_mk(d_, it2_, Wg, Wu, Wd, WGU, WD, c.lane)
    TR_PIPELINE(start + gw0, ngw0, end, MK_MOE);
#undef MK_MOE
}
__device__ __forceinline__ void x_to_bf16(const Ctx& c, const float* x, bf16* XB) {
    for (size_t i = c.gtid; i < (size_t)T * D / 8; i += c.ngt) { const f32x4 a = ((const f32x4*)x)[2 * i], b = ((const f32x4*)x)[2 * i + 1];
        u32x4 o; o.x = pk2(a.x, a.y); o.y = pk2(a.z, a.w); o.z = pk2(b.x, b.y); o.w = pk2(b.z, b.w); ((u32x4*)XB)[i] = o; }
}
__device__ __forceinline__ void rope_table(const Ctx& c, f32x2* tab) {
    for (int i = c.gtid; i < SEQ * 16; i += c.ngt) { const int pos = i >> 4, j = i & 15;
        const float inv = powf(500000.0f, -(float)j / 16.0f); const float ang = (float)pos * inv;
        tab[i] = (f32x2){cosf(ang), sinf(ang)}; }
}

__device__ __forceinline__ void rope_pass(const Ctx& c, bf16* QKV, const f32x2* tab) {
    for (int idx = c.gtid; idx < T * 48; idx += c.ngt) {
        const int h = idx & 7, s = (idx >> 3) & 1, g = (idx >> 4) % 3, tok = idx / 48, pos = tok & (SEQ - 1);
        u32x4* p = (u32x4*)(QKV + (size_t)tok * QKV_N + g * 3072 + s * 1024 + h * HD);
        u32x4 a0 = p[0], a1 = p[1], b0 = p[2], b1 = p[3];
        const f32x2* tb = tab + pos * 16;
        unsigned x1[8] = {a0.x, a0.y, a0.z, a0.w, a1.x, a1.y, a1.z, a1.w}, x2[8] = {b0.x, b0.y, b0.z, b0.w, b1.x, b1.y, b1.z, b1.w};
        unsigned o1[8], o2[8];
#pragma unroll
        for (int k = 0; k < 8; ++k) { const f32x2 cs0 = tb[2 * k], cs1 = tb[2 * k + 1];
            const float u0 = bflo(x1[k]), u1 = bfhi(x1[k]), v0 = bflo(x2[k]), v1 = bfhi(x2[k]);
            o1[k] = pk2(u0 * cs0.x - v0 * cs0.y, u1 * cs1.x - v1 * cs1.y);
            o2[k] = pk2(v0 * cs0.x + u0 * cs0.y, v1 * cs1.x + u1 * cs1.y); }
        p[0] = (u32x4){o1[0], o1[1], o1[2], o1[3]}; p[1] = (u32x4){o1[4], o1[5], o1[6], o1[7]};
        p[2] = (u32x4){o2[0], o2[1], o2[2], o2[3]}; p[3] = (u32x4){o2[4], o2[5], o2[6], o2[7]};
    }
}

__device__ __forceinline__ void attn_naive(const Ctx& c, const bf16* QKV, bf16* O) {
    const int sub = c.gtid & 3;
    for (int q = c.gtid >> 2; q < T * NH; q += c.ngt >> 2) {
        const int tok = q >> 3, h = q & 7, b = tok >> 11, t = tok & (SEQ - 1);
        float m = -1e30f, l = 0.f; float o[32];
#pragma unroll
        for (int i = 0; i < 32; ++i) o[i] = 0.f;
        for (int g = 0; g < 3; ++g) {
            const int dil = g == 0 ? 1 : (g == 1 ? 4 : 16);
            const u32x4* qp = (const u32x4*)(QKV + (size_t)tok * QKV_N + g * 3072 + h * HD + sub * 32);
            float qf[32];
#pragma unroll
            for (int i = 0; i < 4; ++i) { const u32x4 w = qp[i]; qf[8 * i + 0] = bflo(w.x); qf[8 * i + 1] = bfhi(w.x); qf[8 * i + 2] = bflo(w.y); qf[8 * i + 3] = bfhi(w.y);
                qf[8 * i + 4] = bflo(w.z); qf[8 * i + 5] = bfhi(w.z); qf[8 * i + 6] = bflo(w.w); qf[8 * i + 7] = bfhi(w.w); }
            for (int i = 0; i <= 128; ++i) {
                const int pos = t - dil * i; const bool valid = pos >= 0; const int pc = valid ? pos : t;
                const bf16* rowp = QKV + (size_t)(b * SEQ + pc) * QKV_N + g * 3072 + h * HD + sub * 32;
                const u32x4* kp = (const u32x4*)(rowp + 1024); const u32x4* vp = (const u32x4*)(rowp + 2048);
                float dot = 0.f;
#pragma unroll
                for (int j = 0; j < 4; ++j) { const u32x4 w = kp[j];
                    dot += qf[8 * j + 0] * bflo(w.x) + qf[8 * j + 1] * bfhi(w.x) + qf[8 * j + 2] * bflo(w.y) + qf[8 * j + 3] * bfhi(w.y)
                         + qf[8 * j + 4] * bflo(w.z) + qf[8 * j + 5] * bfhi(w.z) + qf[8 * j + 6] * bflo(w.w) + qf[8 * j + 7] * bfhi(w.w); }
                dot += __shfl_xor(dot, 1); dot += __shfl_xor(dot, 2);
                float s = dot * 0.08838834764831845f; if (!valid) s = -__builtin_inff();
                const float mn = fmaxf(m, s), al = __expf(m - mn), p = __expf(s - mn);
                l = l * al + p; m = mn;
#pragma unroll
                for (int j = 0; j < 4; ++j) { const u32x4 w = vp[j];
                    o[8 * j + 0] = o[8 * j + 0] * al + p * bflo(w.x); o[8 * j + 1] = o[8 * j + 1] * al + p * bfhi(w.x);
                    o[8 * j + 2] = o[8 * j + 2] * al + p * bflo(w.y); o[8 * j + 3] = o[8 * j + 3] * al + p * bfhi(w.y);
                    o[8 * j + 4] = o[8 * j + 4] * al + p * bflo(w.z); o[8 * j + 5] = o[8 * j + 5] * al + p * bfhi(w.z);
                    o[8 * j + 6] = o[8 * j + 6] * al + p * bflo(w.w); o[8 * j + 7] = o[8 * j + 7] * al + p * bfhi(w.w); }
            }
        }
        const float rl = 1.f / l;
        u32x4* op = (u32x4*)(O + (size_t)tok * OD + h * HD + sub * 32);
#pragma unroll
        for (int j = 0; j < 4; ++j) op[j] = (u32x4){pk2(o[8 * j] * rl, o[8 * j + 1] * rl), pk2(o[8 * j + 2] * rl, o[8 * j + 3] * rl), pk2(o[8 * j + 4] * rl, o[8 * j + 5] * rl), pk2(o[8 * j + 6] * rl, o[8 * j + 7] * rl)};
    }
}

template <int SRC, bool FINAL>
__device__ __forceinline__ void ln_row(const Ctx& c, int row, f32x4 (&v)[8], const bf16* PRE, float* OUT, const bf16* YB, bf16* XB, const float* lng, const float* lnb, const float* EG) {
    if (SRC == 0) { const u32x2* p = (const u32x2*)(PRE + (size_t)row * D) + c.lane;
#pragma unroll
        for (int j = 0; j < 8; ++j) { const u32x2 a = p[64 * j]; v[j] = (f32x4){bflo(a.x), bfhi(a.x), bflo(a.y), bfhi(a.y)}; } }
    else { const u32x2* p = (const u32x2*)(XB + (size_t)row * D) + c.lane; const unsigned* y0 = (const unsigned*)((const unsigned char*)YB + (size_t)(2 * row) * D) + c.lane; const unsigned* y1 = y0 + D / 4;
        const float g0 = EG[2 * row] * 0.0625f, g1 = EG[2 * row + 1] * 0.0625f;
#pragma unroll
        for (int j = 0; j < 8; ++j) { const u32x2 xf = p[64 * j]; const int a = (int)y0[64 * j], b = (int)y1[64 * j];
            v[j] = (f32x4){ALPHA * bflo(xf.x) + g0 * __builtin_amdgcn_cvt_f32_fp8(a, 0) + g1 * __builtin_amdgcn_cvt_f32_fp8(b, 0), ALPHA * bfhi(xf.x) + g0 * __builtin_amdgcn_cvt_f32_fp8(a, 1) + g1 * __builtin_amdgcn_cvt_f32_fp8(b, 1),
                           ALPHA * bflo(xf.y) + g0 * __builtin_amdgcn_cvt_f32_fp8(a, 2) + g1 * __builtin_amdgcn_cvt_f32_fp8(b, 2), ALPHA * bfhi(xf.y) + g0 * __builtin_amdgcn_cvt_f32_fp8(a, 3) + g1 * __builtin_amdgcn_cvt_f32_fp8(b, 3)}; } }
    float s = 0.f;
#pragma unroll
    for (int j = 0; j < 8; ++j) s += (v[j].x + v[j].y) + (v[j].z + v[j].w);
    const float mean = wave_sum(s) * (1.f / D); float s2 = 0.f;
#pragma unroll
    for (int j = 0; j < 8; ++j) { v[j] = v[j] - mean; s2 += (v[j].x * v[j].x + v[j].y * v[j].y) + (v[j].z * v[j].z + v[j].w * v[j].w); }
    const float rstd = __builtin_amdgcn_rsqf(wave_sum(s2) * (1.f / D) + LN_EPS);
    f32x4* xo = (f32x4*)(OUT + (size_t)row * D) + c.lane; u32x2* bo = (u32x2*)(XB + (size_t)row * D) + c.lane;
#pragma unroll
    for (int j = 0; j < 8; ++j) { const f32x4 g = ((const f32x4*)lng)[64 * j + c.lane], b = ((const f32x4*)lnb)[64 * j + c.lane];
        v[j] = v[j] * rstd * g + b; if (FINAL) xo[64 * j] = v[j]; else bo[64 * j] = (u32x2){pk2(v[j].x, v[j].y), pk2(v[j].z, v[j].w)}; }
}
__device__ __forceinline__ float lane_xor16(float v) { auto r = __builtin_amdgcn_permlane16_swap(__builtin_bit_cast(unsigned, v), __builtin_bit_cast(unsigned, v), false, false);
    return __builtin_bit_cast(float, (threadIdx.x & 16) ? r[0] : r[1]); }
__device__ __forceinline__ float reduce16(float (&d)[16], int lane) {
    float a8[8], a4[4], a2[2];
    { const bool up = lane & 32;
#pragma unroll
      for (int e = 0; e < 8; ++e) { const float keep = up ? d[e + 8] : d[e], send = up ? d[e] : d[e + 8]; a8[e] = keep + lane_xor32(send); } }
    { const bool up = lane & 16;
#pragma unroll
      for (int e = 0; e < 4; ++e) { const float keep = up ? a8[e + 4] : a8[e], send = up ? a8[e] : a8[e + 4]; a4[e] = keep + lane_xor16(send); } }
    { const bool up = lane & 8;
#pragma unroll
      for (int e = 0; e < 2; ++e) { const float keep = up ? a4[e + 2] : a4[e], send = up ? a4[e] : a4[e + 2]; a2[e] = keep + dppx<0x128>(send); } }
    float a1; { const bool up = lane & 4; const float keep = up ? a2[1] : a2[0], send = up ? a2[0] : a2[1]; a1 = keep + dppx<0x141>(send); }
    a1 += dppx<0x4E>(a1); a1 += dppx<0xB1>(a1);
    return a1;
}
template <int SRC, int EXTRA, bool FINAL>
__device__ __forceinline__ void ln_pass(const Ctx& c, const bf16* PRE, float* OUT, const bf16* YB, bf16* XB, const float* lng, const float* lnb,
                                        const float* wsrc, int wld, int woff, const float* wbias, int* rowmap2, float* egate, unsigned* cursor, float* gates_out) {
    LAS char* wl = (LAS char*)c.lds;
    LAS int* lh = (LAS int*)(c.lds + LDSCTL_OFF + LC_HIST);
    LAS float* lg = (LAS float*)(c.lds + LDSCTL_OFF + 5120) + c.wave * 256;
    if (EXTRA) {
#pragma unroll 1
        for (int it = 0; it < 4; ++it) { float wv[16];
#pragma unroll
            for (int q = 0; q < 16; ++q) { const int idx = c.tid + NTHR * (16 * it + q); wv[q] = wsrc[(size_t)(idx >> 4) * wld + woff + (idx & 15)]; }
#pragma unroll
            for (int q = 0; q < 16; ++q) { const int idx = c.tid + NTHR * (16 * it + q), k = idx >> 4, e = idx & 15;
                const unsigned hb = f2bf(wv[q]); const float hf = __builtin_bit_cast(float, hb << 16); const unsigned lb = f2bf(wv[q] - hf);
                const int off = e * 4096 + ((((k >> 3) ^ e) & 255) << 4) + (k & 7) * 2;
                *(LAS unsigned short*)(wl + off) = (unsigned short)hb; *(LAS unsigned short*)(wl + 65536 + off) = (unsigned short)lb; } } }
    const int l15 = c.lane & 15, q4 = c.lane >> 4;
    for (int vb = c.bid; vb < 256; vb += c.G) {
        if (EXTRA == 1) { if (c.tid < 16) lh[c.tid] = 0; }
        __syncthreads();
        const int rowb = vb * 128 + c.wave * 16;
        int rt_e1 = 0, rt_e2 = 0, rt_r1 = 0, rt_r2 = 0;
        if (SRC == 0 && !FINAL) {
            f32x4 gv[8], bv[8];
#pragma unroll
            for (int j = 0; j < 8; ++j) { gv[j] = ((const f32x4*)lng)[64 * j + c.lane]; bv[j] = ((const f32x4*)lnb)[64 * j + c.lane]; }
            u32x2 ra[2][8], rn[2][8];
#pragma unroll
            for (int q = 0; q < 2; ++q) { const u32x2* p = (const u32x2*)(PRE + (size_t)(rowb + q) * D) + c.lane;
#pragma unroll
                for (int j = 0; j < 8; ++j) ra[q][j] = p[64 * j]; }
            for (int i = 0; i < 8; ++i) {
                if (i < 7) {
#pragma unroll
                    for (int q = 0; q < 2; ++q) { const u32x2* p = (const u32x2*)(PRE + (size_t)(rowb + 2 * i + 2 + q) * D) + c.lane;
#pragma unroll
                        for (int j = 0; j < 8; ++j) rn[q][j] = p[64 * j]; } }
#pragma unroll
                for (int q = 0; q < 2; ++q) { const int row = rowb + 2 * i + q; f32x4 v[8]; float s_ = 0.f;
#pragma unroll
                    for (int j = 0; j < 8; ++j) { const u32x2 a = ra[q][j]; v[j] = (f32x4){bflo(a.x), bfhi(a.x), bflo(a.y), bfhi(a.y)}; s_ += (v[j].x + v[j].y) + (v[j].z + v[j].w); }
                    const float mean = wave_sum(s_) * (1.f / D); float s2 = 0.f;
#pragma unroll
                    for (int j = 0; j < 8; ++j) { v[j] = v[j] - mean; s2 += (v[j].x * v[j].x + v[j].y * v[j].y) + (v[j].z * v[j].z + v[j].w * v[j].w); }
                    const float rstd = __builtin_amdgcn_rsqf(wave_sum(s2) * (1.f / D) + LN_EPS);
                    u32x2* bo = (u32x2*)(XB + (size_t)row * D) + c.lane;
#pragma unroll
                    for (int j = 0; j < 8; ++j) { const f32x4 y = v[j] * rstd * gv[j] + bv[j]; bo[64 * j] = (u32x2){pk2(y.x, y.y), pk2(y.z, y.w)}; } }
#pragma unroll
                for (int q = 0; q < 2; ++q)
#pragma unroll
                    for (int j = 0; j < 8; ++j) ra[q][j] = rn[q][j];
            }
        } else if (SRC == 1) {
            f32x4 gv[8], bv[8];
#pragma unroll
            for (int j = 0; j < 8; ++j) { gv[j] = ((const f32x4*)lng)[64 * j + c.lane]; bv[j] = ((const f32x4*)lnb)[64 * j + c.lane]; }
            u32x2 rx[3][8]; unsigned ry0[3][8], ry1[3][8]; float rg0[3], rg1[3];
#define LN_LOAD1(slot_, row_) do { const u32x2* p_ = (const u32x2*)(XB + (size_t)(row_) * D) + c.lane; const unsigned* y0_ = (const unsigned*)((const unsigned char*)YB + (size_t)(2 * (row_)) * D) + c.lane; const unsigned* y1_ = y0_ + D / 4; \
                rg0[slot_] = egate[2 * (row_)] * 0.0625f; rg1[slot_] = egate[2 * (row_) + 1] * 0.0625f; \
                _Pragma("unroll") for (int j = 0; j < 8; ++j) { rx[slot_][j] = p_[64 * j]; ry0[slot_][j] = y0_[64 * j]; ry1[slot_][j] = y1_[64 * j]; } } while (0)
            LN_LOAD1(0, rowb); LN_LOAD1(1, rowb + 1); LN_LOAD1(2, rowb + 2);
            for (int i = 0; i < 16; ++i) { const int row = rowb + i; f32x4 v[8]; float s_ = 0.f; const float g0 = rg0[0], g1 = rg1[0];
#pragma unroll
                for (int j = 0; j < 8; ++j) { const u32x2 xf = rx[0][j]; const int a = (int)ry0[0][j], b = (int)ry1[0][j];
                    v[j] = (f32x4){ALPHA * bflo(xf.x) + g0 * __builtin_amdgcn_cvt_f32_fp8(a, 0) + g1 * __builtin_amdgcn_cvt_f32_fp8(b, 0), ALPHA * bfhi(xf.x) + g0 * __builtin_amdgcn_cvt_f32_fp8(a, 1) + g1 * __builtin_amdgcn_cvt_f32_fp8(b, 1),
                                   ALPHA * bflo(xf.y) + g0 * __builtin_amdgcn_cvt_f32_fp8(a, 2) + g1 * __builtin_amdgcn_cvt_f32_fp8(b, 2), ALPHA * bfhi(xf.y) + g0 * __builtin_amdgcn_cvt_f32_fp8(a, 3) + g1 * __builtin_amdgcn_cvt_f32_fp8(b, 3)};
                    s_ += (v[j].x + v[j].y) + (v[j].z + v[j].w); }
#pragma unroll
                for (int j = 0; j < 8; ++j) { rx[0][j] = rx[1][j]; ry0[0][j] = ry0[1][j]; ry1[0][j] = ry1[1][j]; rx[1][j] = rx[2][j]; ry0[1][j] = ry0[2][j]; ry1[1][j] = ry1[2][j]; }
                rg0[0] = rg0[1]; rg1[0] = rg1[1]; rg0[1] = rg0[2]; rg1[1] = rg1[2];
                if (i + 3 < 16) LN_LOAD1(2, rowb + i + 3);
                const float mean = wave_sum(s_) * (1.f / D); float s2 = 0.f;
#pragma unroll
                for (int j = 0; j < 8; ++j) { v[j] = v[j] - mean; s2 += (v[j].x * v[j].x + v[j].y * v[j].y) + (v[j].z * v[j].z + v[j].w * v[j].w); }
                const float rstd = __builtin_amdgcn_rsqf(wave_sum(s2) * (1.f / D) + LN_EPS);
                f32x4* xo = (f32x4*)(OUT + (size_t)row * D) + c.lane; u32x2* bo = (u32x2*)(XB + (size_t)row * D) + c.lane;
#pragma unroll
                for (int j = 0; j < 8; ++j) { const f32x4 y = v[j] * rstd * gv[j] + bv[j]; if (FINAL) xo[64 * j] = y; else bo[64 * j] = (u32x2){pk2(y.x, y.y), pk2(y.z, y.w)}; } }
#undef LN_LOAD1
        } else
        for (int i = 0; i < 8; ++i) { f32x4 va[8], vc[8];
            ln_row<SRC, FINAL>(c, rowb + 2 * i, va, PRE, OUT, YB, XB, lng, lnb, egate);
            ln_row<SRC, FINAL>(c, rowb + 2 * i + 1, vc, PRE, OUT, YB, XB, lng, lnb, egate); }
        if (EXTRA) {
            asm volatile("s_waitcnt vmcnt(0)" ::: "memory");
            __builtin_amdgcn_fence(__ATOMIC_ACQUIRE, "agent");
            pg8::f32x4 acc = {0.f, 0.f, 0.f, 0.f};
            const bf16* arow = XB + (size_t)(rowb + l15) * D + 8 * q4; const LAS char* wrow = wl + l15 * 4096;
#pragma unroll 16
            for (int kk = 0; kk < 64; ++kk) { const pg8::bf16x8 a = *(const pg8::bf16x8*)(arow + 32 * kk);
                const int ch = (((4 * kk + q4) ^ l15) & 255) << 4;
                const pg8::bf16x8 bh = *(const LAS pg8::bf16x8*)(wrow + ch), bl = *(const LAS pg8::bf16x8*)(wrow + 65536 + ch);
                acc = __builtin_amdgcn_mfma_f32_16x16x32_bf16(a, bh, acc, 0, 0, 0); acc = __builtin_amdgcn_mfma_f32_16x16x32_bf16(a, bl, acc, 0, 0, 0); }
            const float bias = wbias[l15];
            if (EXTRA == 2) {
#pragma unroll
                for (int r = 0; r < 4; ++r) { float val = acc[r] + bias; if (l15 >= 8) val = fminf(val, 0.f) - __logf(1.f + __expf(-fabsf(val)));   gates_out[(size_t)(rowb + 4 * q4 + r) * 16 + l15] = val; }
            } else {
#pragma unroll
                for (int r = 0; r < 4; ++r) lg[(4 * q4 + r) * 16 + l15] = acc[r] + bias;
                LDS_WAIT(); asm volatile("" ::: "memory");
                if (c.lane < 16) { const int row = rowb + c.lane; float dot[16];
#pragma unroll
                    for (int q = 0; q < 4; ++q) { const f32x4 t = *(const LAS f32x4*)(lg + 16 * c.lane + 4 * q); dot[4 * q] = t.x; dot[4 * q + 1] = t.y; dot[4 * q + 2] = t.z; dot[4 * q + 3] = t.w; }
                    float mx = dot[0];
#pragma unroll
                    for (int e = 1; e < 16; ++e) mx = fmaxf(mx, dot[e]);
                    float p[16];
#pragma unroll
                    for (int e = 0; e < 16; ++e) p[e] = __expf(dot[e] - mx);
                    float bestsc = -1.f, bp1 = 0.f, bp2 = 0.f; int be1 = 0, be2 = 0;
#pragma unroll
                    for (int g = 0; g < 4; ++g) { const float a0 = p[4 * g], a1 = p[4 * g + 1], a2 = p[4 * g + 2], a3 = p[4 * g + 3];
                        int i1 = 0; float p1 = a0; if (a1 > p1) { p1 = a1; i1 = 1; } if (a2 > p1) { p1 = a2; i1 = 2; } if (a3 > p1) { p1 = a3; i1 = 3; }
                        int i2 = 0; float p2 = -1.f;
                        if (i1 != 0 && a0 > p2) { p2 = a0; i2 = 0; } if (i1 != 1 && a1 > p2) { p2 = a1; i2 = 1; } if (i1 != 2 && a2 > p2) { p2 = a2; i2 = 2; } if (i1 != 3 && a3 > p2) { p2 = a3; i2 = 3; }
                        const float sc = p1 + p2; if (sc > bestsc) { bestsc = sc; be1 = 4 * g + i1; be2 = 4 * g + i2; bp1 = p1; bp2 = p2; } }
                    const float inv = 1.f / (bp1 + bp2); egate[2 * row] = bp1 * inv; egate[2 * row + 1] = bp2 * inv; rt_e1 = be1; rt_e2 = be2;
                    rt_r1 = __hip_atomic_fetch_add(lh + be1, 1, __ATOMIC_RELAXED, __HIP_MEMORY_SCOPE_WORKGROUP); rt_r2 = __hip_atomic_fetch_add(lh + be2, 1, __ATOMIC_RELAXED, __HIP_MEMORY_SCOPE_WORKGROUP); }
            }
        }
        __syncthreads();
        if (EXTRA == 1) {
            LAS int* lbase = (LAS int*)(c.lds + LDSCTL_OFF + 13312);
            if (c.tid < 16) lbase[c.tid] = (int)__hip_atomic_fetch_add(cursor + c.tid, (unsigned)lh[c.tid], __ATOMIC_RELAXED, __HIP_MEMORY_SCOPE_AGENT);
            __syncthreads();
            if (c.lane < 16) { const int row = rowb + c.lane; rowmap2[rt_e1 * ECAP + lbase[rt_e1] + rt_r1] = 2 * row; rowmap2[rt_e2 * ECAP + lbase[rt_e2] + rt_r2] = 2 * row + 1; }
        }
    }
}

__device__ __forceinline__ void gather_rows(const Ctx& c, const bf16* XB, const int* rowmap, const int* tile_e, bf16* XG) {
    const int nrows = tile_e[MAXTILES] * 256;
    for (int r = c.gw; r < nrows; r += c.ngw) { const int a = rowmap[r]; u32x4* dst = (u32x4*)(XG + (size_t)r * D) + c.lane;
        if (a >= 0) { const u32x4* src = (const u32x4*)(XB + (size_t)(a >> 1) * D) + c.lane;
#pragma unroll
            for (int j = 0; j < 4; ++j) dst[64 * j] = src[64 * j]; }
        else {
#pragma unroll
            for (int j = 0; j < 4; ++j) dst[64 * j] = (u32x4){0u, 0u, 0u, 0u}; } }
}

typedef float f32x2v_ __attribute__((ext_vector_type(2)));
__device__ __forceinline__ void fp8x8_raw(u32x2 w, float (&o)[8]) { const int a = (int)w.x, b = (int)w.y;
    const f32x2v_ p0 = __builtin_amdgcn_cvt_pk_f32_fp8(a, false), p1 = __builtin_amdgcn_cvt_pk_f32_fp8(a, true), p2 = __builtin_amdgcn_cvt_pk_f32_fp8(b, false), p3 = __builtin_amdgcn_cvt_pk_f32_fp8(b, true);
    o[0] = p0.x; o[1] = p0.y; o[2] = p1.x; o[3] = p1.y; o[4] = p2.x; o[5] = p2.y; o[6] = p3.x; o[7] = p3.y; }
__device__ __forceinline__ void fp8x8_to_f32(u32x2 w, float (&o)[8]) { fp8x8_raw(w, o);
#pragma unroll
    for (int k = 0; k < 8; ++k) o[k] *= 0.0625f; }

constexpr int CONV_ROWS = 16;
__device__ __forceinline__ void conv_pass(const Ctx& c, const unsigned char* Z, const float* cw, const float* cb, bf16* QKC) {
    constexpr int NITEMS = (T / CONV_ROWS) * 256;
    const int c0 = (c.gtid & 255) * 8;
    float w[4][8], bias[8];
#pragma unroll
    for (int j = 0; j < 4; ++j) { const f32x4 w0 = *(const f32x4*)(cw + j * 2048 + c0), w1 = *(const f32x4*)(cw + j * 2048 + c0 + 4); w[j][0] = w0.x; w[j][1] = w0.y; w[j][2] = w0.z; w[j][3] = w0.w; w[j][4] = w1.x; w[j][5] = w1.y; w[j][6] = w1.z; w[j][7] = w1.w;
#pragma unroll
        for (int k = 0; k < 8; ++k) w[j][k] *= 0.0625f; }
    { const f32x4 b0 = *(const f32x4*)(cb + c0), b1 = *(const f32x4*)(cb + c0 + 4); bias[0] = b0.x; bias[1] = b0.y; bias[2] = b0.z; bias[3] = b0.w; bias[4] = b1.x; bias[5] = b1.y; bias[6] = b1.z; bias[7] = b1.w; }
    const float sc = c0 >= 1024 ? 0.08838834764831845f : 1.f;
    u32x2 zr[CONV_ROWS + 3], zn[CONV_ROWS + 3];
#define CONV_LOAD(ZR, idx_) do { const int tok0_ = ((idx_) >> 8) * CONV_ROWS, t0_ = tok0_ & (SEQ - 1); _Pragma("unroll") for (int r = 0; r < CONV_ROWS + 3; ++r) { const int tt = t0_ - 3 + r; ZR[r] = tt >= 0 ? *(const u32x2*)(Z + (size_t)(tok0_ - 3 + r) * ZN + c0) : (u32x2){0u, 0u}; } } while (0)
    if (c.gtid < NITEMS) CONV_LOAD(zr, c.gtid);
    for (int idx = c.gtid; idx < NITEMS; idx += c.ngt) { const int tok0 = (idx >> 8) * CONV_ROWS;
        if (idx + c.ngt < NITEMS) CONV_LOAD(zn, idx + c.ngt);
        float zw[3][8]; fp8x8_raw(zr[0], zw[0]); fp8x8_raw(zr[1], zw[1]); fp8x8_raw(zr[2], zw[2]);
#pragma unroll
        for (int r = 0; r < CONV_ROWS; ++r) { float acc[8], zq[8]; fp8x8_raw(zr[r + 3], zq);
#pragma unroll
            for (int k = 0; k < 8; ++k) { acc[k] = bias[k]; acc[k] += zw[0][k] * w[0][k]; acc[k] += zw[1][k] * w[1][k]; acc[k] += zw[2][k] * w[2][k]; acc[k] += zq[k] * w[3][k]; zw[0][k] = zw[1][k]; zw[1][k] = zw[2][k]; zw[2][k] = zq[k]; }
#pragma unroll
            for (int k = 0; k < 8; ++k) acc[k] = acc[k] * __builtin_amdgcn_rcpf(1.f + __expf(-acc[k])) * sc;
            *(u32x4*)(QKC + (size_t)(tok0 + r) * 2048 + c0) = (u32x4){pk2(acc[0], acc[1]), pk2(acc[2], acc[3]), pk2(acc[4], acc[5]), pk2(acc[6], acc[7])}; }
#pragma unroll
        for (int r = 0; r < CONV_ROWS + 3; ++r) zr[r] = zn[r];
    }
#undef CONV_LOAD
}
__device__ __forceinline__ void mlstm_naive(const Ctx& c, const bf16* QKC, const bf16* Z, const float* GATES, bf16* HC) {
    LAS float* Qs = (LAS float*)c.lds; LAS float* Ks = Qs + 2048; LAS float* Vs = Ks + 2048; LAS float* LI = Vs + 2048; LAS float* LF = LI + 16; LAS float* DEN = LF + 16; LAS float* MEX = DEN + 16; LAS float* NUM = MEX + 16;
    const bool colthr = c.tid < 128, nthr = (c.wave == 2);
    for (int u = c.bid; u < 256; u += c.G) {
        const int b = u >> 4, h = (u >> 1) & 7, vh = u & 1;
        float C[128];
#pragma unroll
        for (int d = 0; d < 128; ++d) C[d] = 0.f;
        float m = -1e30f;
        for (int grp = 0; grp < 128; ++grp) {
            const int tok0 = b * SEQ + grp * 16;
#pragma unroll
            for (int k = 0; k < 12; ++k) { const int e = c.tid + NTHR * k, which = e >> 11, r = e & 2047, s = r >> 7, d = r & 127;
                const bf16* src = which == 0 ? QKC + (size_t)(tok0 + s) * 2048 + h * 128 + d : (which == 1 ? QKC + (size_t)(tok0 + s) * 2048 + 1024 + h * 128 + d : Z + (size_t)(tok0 + s) * ZN + 2048 + h * 256 + vh * 128 + d);
                Qs[e] = bf1(*src); }
            if (c.tid < 16) { LI[c.tid] = GATES[(size_t)(tok0 + c.tid) * 16 + h]; LF[c.tid] = GATES[(size_t)(tok0 + c.tid) * 16 + 8 + h]; }
            __syncthreads();
            if (colthr || nthr) {
                for (int s = 0; s < 16; ++s) {
                    const float lf = LF[s], li = LI[s], mn = fmaxf(lf + m, li), fd = __expf(lf + m - mn), iw = __expf(li - mn); m = mn;
                    const float vv = nthr ? 1.f : Vs[s * 128 + (c.tid & 127)]; const float kv = iw * vv; float acc = 0.f;
#pragma unroll
                    for (int d4 = 0; d4 < 32; ++d4) { const f32x4 k4 = *(const LAS f32x4*)(Ks + s * 128 + 4 * d4), q4 = *(const LAS f32x4*)(Qs + s * 128 + 4 * d4);
                        C[4 * d4 + 0] = fd * C[4 * d4 + 0] + kv * k4.x; acc += q4.x * C[4 * d4 + 0];
                        C[4 * d4 + 1] = fd * C[4 * d4 + 1] + kv * k4.y; acc += q4.y * C[4 * d4 + 1];
                        C[4 * d4 + 2] = fd * C[4 * d4 + 2] + kv * k4.z; acc += q4.z * C[4 * d4 + 2];
                        C[4 * d4 + 3] = fd * C[4 * d4 + 3] + kv * k4.w; acc += q4.w * C[4 * d4 + 3]; }
                    if (nthr) { if (c.lane == 0) { DEN[s] = acc; MEX[s] = __expf(-mn); } } else NUM[s * 128 + c.tid] = acc;
                }
            }
            __syncthreads();
            if (colthr) {
                for (int s = 0; s < 16; ++s) { const float hv = NUM[s * 128 + c.tid] / fmaxf(fabsf(DEN[s]), MEX[s]);
                    HC[(size_t)(tok0 + s) * 2048 + h * 256 + vh * 128 + c.tid] = (bf16)f2bf(hv); }
            }
        }
        __syncthreads();
    }
}
__device__ __forceinline__ void headnorm_pass(const Ctx& c, const bf16* HC, const unsigned char* Z, const float* ng, bf16* Y) {
    const int half = c.lane >> 5, l32 = c.lane & 31;
    f32x4 ga[4], gb[4];
#pragma unroll
    for (int p = 0; p < 4; ++p) { const float* gp = ng + (2 * p + half) * 256 + 8 * l32; ga[p] = *(const f32x4*)gp; gb[p] = *(const f32x4*)(gp + 4); }
    u32x4 hw[4], hn[4]; u32x2 ow[4], on[4];
#define HN_LOAD(HW, OW, tok_) do { _Pragma("unroll") for (int p = 0; p < 4; ++p) { HW[p] = *(const u32x4*)(HC + (size_t)(tok_) * 2048 + (2 * p + half) * 256 + 8 * l32); OW[p] = *(const u32x2*)(Z + (size_t)(tok_) * ZN + 4096 + (2 * p + half) * 256 + 8 * l32); } } while (0)
    if (c.gw < T) HN_LOAD(hw, ow, c.gw);
    for (int tok = c.gw; tok < T; tok += c.ngw) {
        if (tok + c.ngw < T) HN_LOAD(hn, on, tok + c.ngw);
#pragma unroll
        for (int p = 0; p < 4; ++p) {
            float x[8] = {bflo(hw[p].x), bfhi(hw[p].x), bflo(hw[p].y), bfhi(hw[p].y), bflo(hw[p].z), bfhi(hw[p].z), bflo(hw[p].w), bfhi(hw[p].w)};
            const float ps = prefix_sum64(((x[0] + x[1]) + (x[2] + x[3])) + ((x[4] + x[5]) + (x[6] + x[7]))); const float lo = lane_bcast(ps, 31), al = lane_bcast(ps, 63);
            const float mean = (half ? al - lo : lo) * (1.f / 256.f); float q = 0.f;
#pragma unroll
            for (int k = 0; k < 8; ++k) { x[k] -= mean; q += x[k] * x[k]; }
            const float pq = prefix_sum64(q); const float qlo = lane_bcast(pq, 31), qal = lane_bcast(pq, 63);
            const float rstd = __builtin_amdgcn_rsqf((half ? qal - qlo : qlo) * (1.f / 256.f) + LN_EPS);
            float o[8]; fp8x8_raw(ow[p], o);
            const float gk[8] = {ga[p].x, ga[p].y, ga[p].z, ga[p].w, gb[p].x, gb[p].y, gb[p].z, gb[p].w}; float y[8];
#pragma unroll
            for (int k = 0; k < 8; ++k) y[k] = x[k] * rstd * gk[k] * __builtin_amdgcn_rcpf(1.f + __builtin_amdgcn_exp2f(o[k] * -0.09016844005556021f));
            *(u32x4*)(Y + (size_t)tok * 2048 + (2 * p + half) * 256 + 8 * l32) = (u32x4){pk2(y[0], y[1]), pk2(y[2], y[3]), pk2(y[4], y[5]), pk2(y[6], y[7])}; }
#pragma unroll
        for (int p = 0; p < 4; ++p) { hw[p] = hn[p]; ow[p] = on[p]; }
    }
#undef HN_LOAD
}

namespace att {
typedef short bf16x8 __attribute__((ext_vector_type(8)));
typedef short s16x4 __attribute__((ext_vector_type(4)));
typedef float f32x16 __attribute__((ext_vector_type(16)));
constexpr float SCALE = 0.08838834764831845f, THR = 8.f;
constexpr int SHM = 16384;
#define KSWZ(row, colB) ((row) * 256 + ((colB) ^ (((row) & 7) << 4)))
#define SBAR() __builtin_amdgcn_sched_barrier(0)
__device__ __forceinline__ int v_st(int k, int c) { const int kk = (k & ~0xC) | ((k & 4) << 1) | ((k & 8) >> 1); return ((kk >> 3) * 4 + (c >> 5)) * 512 + ((kk & 7) * 32 + (c & 31)) * 2; }
__device__ __forceinline__ int v_rd_base(int lane) { return ((lane & 3) << 3) | (((lane >> 2) & 3) << 6) | (((lane >> 4) & 1) << 5) | (((lane >> 5) & 1) << 8); }
constexpr int v_rd_off(int d0, int ks, int half) { return d0 * 512 + ks * 4096 + half * 2048; }
__device__ __forceinline__ int crow(int r, int hi) { return (r & 3) + 8 * (r >> 2) + 4 * hi; }
__device__ __forceinline__ unsigned cvtpk(float lo, float hi) { unsigned r; asm volatile("v_cvt_pk_bf16_f32 %0, %1, %2" : "=v"(r) : "v"(lo), "v"(hi)); return r; }
__device__ __forceinline__ void mask_tile(f32x16& p0, f32x16& p1, int dq, unsigned W) {
    const float NEG = -__builtin_inff();
#pragma unroll
    for (int r = 0; r < 16; ++r) { const int cc = (r & 3) + 8 * (r >> 2);
        if ((unsigned)(dq - cc) >= W) p0[r] = NEG;
        if ((unsigned)(dq - cc - 32) >= W) p1[r] = NEG; }
}
__device__ __forceinline__ void partialSM(f32x16& p0, f32x16& p1, float& m_reg, float& mn, float& alpha) {
    float pmax = p0[0];
#pragma unroll
    for (int r = 1; r < 16; ++r) pmax = fmaxf(pmax, p0[r]);
#pragma unroll
    for (int r = 0; r < 16; ++r) pmax = fmaxf(pmax, p1[r]);
    { auto rr = __builtin_amdgcn_permlane32_swap(__float_as_uint(pmax), __float_as_uint(pmax), false, false);
      pmax = fmaxf(__uint_as_float(rr[0]), __uint_as_float(rr[1])); }
    constexpr float C2 = 1.4426950408889634f * SCALE;
    if (__builtin_expect(__all((pmax - m_reg) * SCALE <= THR), 1)) { mn = m_reg; alpha = 1.f; }
    else { mn = fmaxf(m_reg, pmax); alpha = __builtin_amdgcn_exp2f((m_reg - mn) * C2); m_reg = mn; }
    const float mnL = -mn * C2;
#pragma unroll
    for (int r = 0; r < 16; ++r) p0[r] = fmaf(p0[r], C2, mnL);
#pragma unroll
    for (int r = 0; r < 16; ++r) p1[r] = fmaf(p1[r], C2, mnL);
#pragma unroll
    for (int r = 0; r < 16; ++r) p0[r] = __builtin_amdgcn_exp2f(p0[r]);
}
__device__ __forceinline__ void finishSM(f32x16& p0, f32x16& p1, float alpha, float& l_reg, bf16x8& pa0, bf16x8& pa1, bf16x8& pa2, bf16x8& pa3) {
#pragma unroll
    for (int r = 0; r < 16; ++r) p1[r] = __builtin_amdgcn_exp2f(p1[r]);
    float ps = 0;
#pragma unroll
    for (int r = 0; r < 16; ++r) ps += p0[r];
#pragma unroll
    for (int r = 0; r < 16; ++r) ps += p1[r];
    { auto rr = __builtin_amdgcn_permlane32_swap(__float_as_uint(ps), __float_as_uint(ps), false, false);
      ps = __uint_as_float(rr[0]) + __uint_as_float(rr[1]); }
    l_reg = l_reg * alpha + ps;
#define PK4(P, B_, OUT) do { unsigned a0 = cvtpk(P[B_+0], P[B_+1]), a1 = cvtpk(P[B_+2], P[B_+3]);                          \
        unsigned b0 = cvtpk(P[B_+4], P[B_+5]), b1 = cvtpk(P[B_+6], P[B_+7]);                                             \
        auto r0 = __builtin_amdgcn_permlane32_swap(a0, b0, false, false); auto r1 = __builtin_amdgcn_permlane32_swap(a1, b1, false, false); \
        u32x4 w = {r0[0], r1[0], r0[1], r1[1]}; OUT = *reinterpret_cast<bf16x8*>(&w); } while (0)
    PK4(p0, 0, pa0); PK4(p0, 8, pa1); PK4(p1, 0, pa2); PK4(p1, 8, pa3);
#undef PK4
}
template <int KB>
__device__ __forceinline__ void qkt(f32x16& p0, f32x16& p1, const LAS char* K_lds, int r32, int hi, const bf16x8* qr) {
    p0 = f32x16{}; p1 = f32x16{};
    const LAS char* kb[4];
#pragma unroll
    for (int dd = 0; dd < 4; ++dd) kb[dd] = K_lds + KB * SHM + KSWZ(r32, (dd * 16 + hi * 8) * 2);
#pragma unroll
    for (int d0 = 0; d0 < 8; ++d0) { const LAS char* a = kb[d0 & 3] + (d0 >> 2) * 128;
        bf16x8 b0 = *reinterpret_cast<const LAS bf16x8*>(a);
        bf16x8 b1 = *reinterpret_cast<const LAS bf16x8*>(a + 32 * 256);
        p0 = __builtin_amdgcn_mfma_f32_32x32x16_bf16(b0, qr[d0], p0, 0, 0, 0);
        p1 = __builtin_amdgcn_mfma_f32_32x32x16_bf16(b1, qr[d0], p1, 0, 0, 0); }
}
template <int VB>
__device__ __forceinline__ void pv_tile(f32x16* o, int vb0, bf16x8 pa0, bf16x8 pa1, bf16x8 pa2, bf16x8 pa3) {
#define TRRD(dst, off) asm volatile("ds_read_b64_tr_b16 %0, %1 offset:%2" : "=&v"(dst) : "v"(vb0), "i"(off) : "memory")
#define PV_D0(d0) do { s16x4 l0, l1, l2, l3, h0, h1, h2, h3; constexpr int b_ = VB * SHM + v_rd_off(d0, 0, 0); \
        TRRD(l0, b_); TRRD(h0, b_ + 2048); TRRD(l1, b_ + 4096); TRRD(h1, b_ + 6144); TRRD(l2, b_ + 8192); TRRD(h2, b_ + 10240); TRRD(l3, b_ + 12288); TRRD(h3, b_ + 14336); \
        asm volatile("s_waitcnt lgkmcnt(0)" ::: "memory"); SBAR();   \
        o[d0] = __builtin_amdgcn_mfma_f32_32x32x16_bf16(pa0, (bf16x8){l0[0], l0[1], l0[2], l0[3], h0[0], h0[1], h0[2], h0[3]}, o[d0], 0, 0, 0);   \
        o[d0] = __builtin_amdgcn_mfma_f32_32x32x16_bf16(pa1, (bf16x8){l1[0], l1[1], l1[2], l1[3], h1[0], h1[1], h1[2], h1[3]}, o[d0], 0, 0, 0);   \
        o[d0] = __builtin_amdgcn_mfma_f32_32x32x16_bf16(pa2, (bf16x8){l2[0], l2[1], l2[2], l2[3], h2[0], h2[1], h2[2], h2[3]}, o[d0], 0, 0, 0);   \
        o[d0] = __builtin_amdgcn_mfma_f32_32x32x16_bf16(pa3, (bf16x8){l3[0], l3[1], l3[2], l3[3], h3[0], h3[1], h3[2], h3[3]}, o[d0], 0, 0, 0); } while (0)
    PV_D0(0); PV_D0(1); PV_D0(2); PV_D0(3);
#undef PV_D0
#undef TRRD
}
template <bool FINAL>
__device__ __forceinline__ void attn_phase(const Ctx& c, const bf16* QKV, bf16* OP, float* LSE, bf16* O) {
    const int half = c.wave >> 2, w4 = c.wave & 3, r32 = c.lane & 31, hi = c.lane >> 5, l = c.lane;
    LAS char* Vl = (LAS char*)c.lds + half * 65536; LAS char* Kl = Vl + 2 * SHM;
    LAS float* wl = (LAS float*)(c.lds + LDSCTL_OFF + 1024) + c.wave * 128; LAS float* al_l = wl + 96;
    const LAS float* wl4 = wl + 4 * hi;
    const int vb0 = (int)(unsigned)(uintptr_t)Vl + v_rd_base(c.lane);
    int krow[4], kcol[4], vrow[4], vcol[4];
#pragma unroll
    for (int j = 0; j < 4; ++j) { const int blk = 4 * w4 + j; krow[j] = 4 * blk + (l >> 4); kcol[j] = (((l & 15) ^ (krow[j] & 7)) * 16) + 2048;
        const int sub = 2 * blk + (l >> 5), kk = (sub >> 2) * 8 + ((l & 31) >> 2); vrow[j] = (kk & ~0xC) | ((kk & 4) << 1) | ((kk & 8) >> 1); vcol[j] = ((sub & 3) * 32 + (l & 3) * 8) * 2 + 4096; }
    constexpr int NUNITS = FINAL ? 1024 : 2048;
#define A_UNIT(U_, idx_) do { int hp_, rj_, jb_; (U_).g = FINAL ? 0 : 1 + ((idx_) >> 10); \
        if (c.G == 256 && (U_).g < 2) {     \
            const int w_ = (idx_) & 255, k_ = ((idx_) >> 8) & 3, x_ = w_ & 7, sl_ = w_ >> 3; \
            if (FINAL) { const int cb_ = k_ * 16 + x_ * 2 + (sl_ >> 4); (U_).b = cb_ >> 2; hp_ = cb_ & 3; jb_ = ((sl_ & 15) + 4 * k_) & 15; (U_).r = 0; } \
            else { const int cb_ = k_ * 64 + x_ * 8 + (sl_ >> 2); hp_ = cb_ & 3; (U_).r = (cb_ >> 2) & 3; (U_).b = cb_ >> 4; jb_ = ((sl_ & 3) + k_) & 3; } \
        } else { hp_ = (idx_) & 3; rj_ = ((idx_) >> 2) & 15; (U_).b = ((idx_) >> 6) & 15; const int nbm_ = (16 >> (2 * (U_).g)) - 1; jb_ = ((U_).g == 1 ? rj_ + ((U_).b >> 2) : rj_) & nbm_; (U_).r = rj_ >> (4 - 2 * (U_).g); } \
        (U_).h = 2 * hp_ + half; (U_).dil = 1 << (2 * (U_).g); \
        (U_).rs = (unsigned)(U_).dil * QKV_N * 2u; (U_).base = (const char*)(QKV + ((size_t)(U_).b * SEQ + (U_).r) * QKV_N + (U_).g * 3072 + (U_).h * HD); \
        (U_).q0 = 128 * jb_ + 32 * w4; (U_).kt0 = jb_ == 0 ? 2 : 0; (U_).kb0 = 128 * (jb_ - 1); } while (0)
#define A_QLOAD(U_) do { _Pragma("unroll") for (int d0 = 0; d0 < 8; ++d0) qr[d0] = *(const bf16x8*)((U_).base + ((unsigned)((U_).q0 + r32) * (U_).rs + (unsigned)(d0 * 32 + hi * 16))); } while (0)
#define A_DMA(U_, kb_, bf_) do { _Pragma("unroll") for (int j_ = 0; j_ < 4; ++j_) { \
            __builtin_amdgcn_global_load_lds((const unsigned*)((U_).base + ((unsigned)((kb_) + krow[j_]) * (U_).rs + (unsigned)kcol[j_])), (LAS unsigned*)(Kl + (bf_) * SHM + (4 * w4 + j_) * 1024), 16, 0, 0); \
            __builtin_amdgcn_global_load_lds((const unsigned*)((U_).base + ((unsigned)((kb_) + vrow[j_]) * (U_).rs + (unsigned)vcol[j_])), (LAS unsigned*)(Vl + (bf_) * SHM + (4 * w4 + j_) * 1024), 16, 0, 0); } } while (0)
    struct AUnit { const char* base; unsigned rs; int q0, kt0, kb0, b, r, g, h, dil; };
    AUnit cu, nu; bf16x8 qr[8];
    if (c.bid < NUNITS) { A_UNIT(cu, c.bid); A_QLOAD(cu); A_DMA(cu, cu.kb0 + 64 * cu.kt0, 0); }
    for (int idx = c.bid; idx < NUNITS; idx += c.G) {
        const bool hasn = idx + c.G < NUNITS; nu = cu; if (hasn) A_UNIT(nu, idx + c.G);
        const int b = cu.b, r = cu.r, g = cu.g, h = cu.h, dil = cu.dil, q0 = cu.q0, kt0 = cu.kt0, kb0 = cu.kb0; (void)g;
        float m_reg = -1e30f, l_reg = 0.f; f32x16 o[4] = {};
        asm volatile("s_waitcnt vmcnt(0)" ::: "memory"); __syncthreads();
#define A_STEP(kt_, BUF) do { const int kb_ = kb0 + 64 * (kt_); \
            if ((kt_) < 3) A_DMA(cu, kb_ + 64, (BUF) ^ 1);                                     \
            else if (hasn) A_DMA(nu, nu.kb0 + 64 * nu.kt0, 0); \
            if (kb_ <= q0 + 31 && kb_ + 63 >= q0 - 128) { f32x16 p0, p1; float mn, alpha; bf16x8 pa0, pa1, pa2, pa3; \
                qkt<BUF>(p0, p1, Kl, r32, hi, qr); mask_tile(p0, p1, q0 + r32 - kb_ - 4 * hi, 129u); partialSM(p0, p1, m_reg, mn, alpha); \
                if (__any(alpha < 1.f)) { if (hi == 0) al_l[r32] = alpha; asm volatile("s_waitcnt lgkmcnt(0)" ::: "memory"); \
                    _Pragma("unroll") for (int d_ = 0; d_ < 4; ++d_) _Pragma("unroll") for (int r_ = 0; r_ < 16; ++r_) o[d_][r_] *= al_l[crow(r_, hi)]; } \
                finishSM(p0, p1, alpha, l_reg, pa0, pa1, pa2, pa3); SBAR(); pv_tile<BUF>(o, vb0, pa0, pa1, pa2, pa3); } \
            asm volatile("s_waitcnt vmcnt(0)" ::: "memory"); __syncthreads(); } while (0)
        for (int kt = kt0; kt < 4; kt += 2) { A_STEP(kt, 0); A_STEP(kt + 1, 1); }
#undef A_STEP
        if (hasn) A_QLOAD(nu);
        const float lse = m_reg * SCALE + __logf(l_reg);
        const unsigned tok0 = (unsigned)b * SEQ + r;
        if (hi == 0) { const unsigned tokq = tok0 + (unsigned)(q0 + r32) * dil; float w0 = 1.f / l_reg;
            if (FINAL) { const float l1 = LSE[tokq * 8u + h], l2 = LSE[((unsigned)T + tokq) * 8u + h]; const float M = fmaxf(lse, fmaxf(l1, l2));
                const float e0 = __expf(lse - M), e1 = __expf(l1 - M), e2 = __expf(l2 - M), inv = 1.f / (e0 + e1 + e2); w0 *= e0 * inv; wl[32 + r32] = e1 * inv; wl[64 + r32] = e2 * inv; }
            else LSE[((unsigned)(g - 1) * T + tokq) * 8u + h] = lse;
            wl[r32] = w0; }
        asm volatile("s_waitcnt lgkmcnt(0)" ::: "memory");
        LAS char* tile = Vl + (w4 < 2 ? SHM + w4 * 8192 : 3 * SHM + (w4 - 2) * 8192); LAS char* tile4 = tile + 4 * hi * 256 + r32 * 2;
#pragma unroll
        for (int r_ = 0; r_ < 16; ++r_) { const int orow = (r_ & 3) + 8 * (r_ >> 2); const float w0 = wl4[orow];
#pragma unroll
            for (int d0 = 0; d0 < 4; ++d0) { const float v = o[d0][r_] * w0; const float vn = lane_xor1(v);
                if ((r32 & 1) == 0) *(LAS unsigned*)(tile4 + orow * 256 + d0 * 64) = cvtpk(v, vn); } }
        asm volatile("s_waitcnt lgkmcnt(0)" ::: "memory");
#pragma unroll
        for (int i = 0; i < 8; ++i) { const int p = c.lane + 64 * i, row = p >> 4, ch = p & 15; const unsigned tok = tok0 + (unsigned)(q0 + row) * dil; const unsigned col8 = (unsigned)h * HD + ch * 8;
            const u32x4 x = *(const LAS u32x4*)(tile + row * 256 + ch * 16);
            if (FINAL) { const u32x4 pa = *(const u32x4*)(OP + (tok * (unsigned)OD + col8)), pb = *(const u32x4*)(OP + (((unsigned)T + tok) * (unsigned)OD + col8)); const float w1 = wl[32 + row], w2 = wl[64 + row];
                u32x4 y; y.x = cvtpk(bflo(x.x) + w1 * bflo(pa.x) + w2 * bflo(pb.x), bfhi(x.x) + w1 * bfhi(pa.x) + w2 * bfhi(pb.x)); y.y = cvtpk(bflo(x.y) + w1 * bflo(pa.y) + w2 * bflo(pb.y), bfhi(x.y) + w1 * bfhi(pa.y) + w2 * bfhi(pb.y));
                y.z = cvtpk(bflo(x.z) + w1 * bflo(pa.z) + w2 * bflo(pb.z), bfhi(x.z) + w1 * bfhi(pa.z) + w2 * bfhi(pb.z)); y.w = cvtpk(bflo(x.w) + w1 * bflo(pa.w) + w2 * bflo(pb.w), bfhi(x.w) + w1 * bfhi(pa.w) + w2 * bfhi(pb.w));
                *(u32x4*)(O + (tok * (unsigned)OD + col8)) = y; }
            else *(u32x4*)(OP + (((unsigned)(g - 1) * T + tok) * (unsigned)OD + col8)) = x; }
        cu = nu;
    }
#undef A_DMA
#undef A_QLOAD
#undef A_UNIT
}
#undef KSWZ
#undef SBAR
}

namespace mls {
using att::bf16x8; using att::s16x4; using att::f32x16; using att::v_st; using att::v_rd_base; using att::crow; using att::cvtpk;
constexpr int RSB = 272;
constexpr int L_QP = 0, L_KP = 17408, L_KTR = 34816, L_VTR = 51200, L_AM = 83968, L_RS = 93184, L_QN = 94208, L_WINT = 94464, L_MEXP = 94720, L_HDEN = 94976  , L_NV = 97024  , L_UV = 98048, L_AV = 98560  ;
constexpr int AMB = 144;
#define TRRD(dst, addr, off) asm volatile("ds_read_b64_tr_b16 %0, %1 offset:%2" : "=&v"(dst) : "v"(addr), "i"(off) : "memory")
template <int SKIP>
__device__ __forceinline__ void mlstm_phase(const Ctx& c, const bf16* QKC, const unsigned char* Z, const float* GATES, bf16* HC) {
    const int w = c.wave;
    LAS char* lds = (LAS char*)c.lds;
    LAS float* RS = (LAS float*)(lds + L_RS); LAS float* QN = (LAS float*)(lds + L_QN); LAS float* WINT = (LAS float*)(lds + L_WINT);     LAS float* HDEN = (LAS float*)(lds + L_HDEN);
    LAS float* UV = (LAS float*)(lds + L_UV); LAS float* AV = (LAS float*)(lds + L_AV);
    for (int unit = c.bid; unit < BATCH * 8; unit += c.G) {
        const int b = unit >> 3, h = unit & 7;
        f32x16 Ct[4] = {};
        float n0 = 0.f, n1 = 0.f, m_state = -1e30f;
        bf16x8 sq[2], sk[2]; u32x2 sv[4]; float g_li, g_lf;
#define M_LOAD(tok0_) do { \
            _Pragma("unroll") for (int i_ = 0; i_ < 2; ++i_) { const int p_ = tid_ + 512 * i_, row_ = p_ >> 4, c8_ = (p_ & 15) * 8; const bf16* s_ = QKC + (size_t)((tok0_) + row_) * 2048 + h * 128 + c8_; sq[i_] = *(const bf16x8*)s_; sk[i_] = *(const bf16x8*)(s_ + 1024); } \
            g_li = GATES[(size_t)((tok0_) + (tid_ & 63)) * 16 + h]; g_lf = GATES[(size_t)((tok0_) + (tid_ & 63)) * 16 + 8 + h]; } while (0)
#define M_LOADV(tok0_) do { \
            _Pragma("unroll") for (int i_ = 0; i_ < 4; ++i_) { const int p_ = tid_ + 512 * i_, row_ = p_ >> 5, c8_ = (p_ & 31) * 8; sv[i_] = *(const u32x2*)(Z + (size_t)((tok0_) + row_) * ZN + 2048 + h * 256 + c8_); } } while (0)
        int tid_ = c.tid; asm volatile("" : "+v"(tid_));
        M_LOAD(b * SEQ); M_LOADV(b * SEQ);
        if (w == 5) *(LAS f32x2*)(lds + L_NV + 512 + 8 * c.lane) = (f32x2){0.f, 0.f};
        for (int ch = 0; ch < 32; ++ch) {
            const int tok0 = b * SEQ + ch * 64;
            tid_ = c.tid; asm volatile("" : "+v"(tid_));
            const int l = tid_ & 63, hi = l >> 5, r32 = l & 31, q4 = l >> 4, l15 = l & 15;
            const int vbK = (int)(unsigned)(uintptr_t)(lds + L_KTR) + v_rd_base(l);
            const int vbV = (int)(unsigned)(uintptr_t)(lds + L_VTR) + (w >> 2) * 16384 + (w & 3) * 512 + v_rd_base(l);
            const LAS float* uv_b = UV + 16 * (w & 3) + 4 * q4; const LAS float* as_b = AV + 32 * (w >> 2) + l15;
            LAS char* am_w = lds + L_AM + (16 * (w & 3) + 4 * q4) * AMB + (32 * (w >> 2) + l15) * 2; LAS float* rs_w = RS + 128 * (w >> 2) + 16 * (w & 3) + 4 * q4;
            const LAS float* wint_b = WINT + 4 * hi; const LAS float* hden_b = HDEN + 64 * w + 4 * hi;
            const LAS char* q_b = lds + L_QP + r32 * RSB + 8 * hi; const LAS char* am_b = lds + L_AM + r32 * AMB + 16 * hi;
            const LAS char* sq_b = lds + L_QP + ((16 * (w & 3)) + l15) * RSB + 16 * q4; const LAS char* sk_b = lds + L_KP + l15 * RSB + 16 * q4;
            const int hc_lane = 4 * hi * 2048 + 32 * w + r32;
            const float bc = (SKIP & 64) ? g_lf : prefix_sum64(g_lf);
            const float a = g_li - bc, pm = (SKIP & 64) ? a : prefix_max64(a);
            const float u = fmaxf(m_state, pm), winter = __expf(m_state - u);
            const float blast = lane_bcast(bc, 63), u63 = lane_bcast(u, 63);
            const float wk = __expf(a - u63), decay = __expf(m_state - u63), mexp = __expf(-(bc + u));
            if (!(SKIP & 128)) {
#pragma unroll
            for (int i = 0; i < 2; ++i) { const int p = tid_ + 512 * i, row = p >> 4, c8 = (p & 15) * 8;
                *(LAS bf16x8*)(lds + L_QP + row * RSB + c8 * 2) = sq[i]; *(LAS bf16x8*)(lds + L_KP + row * RSB + c8 * 2) = sk[i];
                const float wr_ = __shfl(wk, row); const u32x4 kw = *reinterpret_cast<const u32x4*>(&sk[i]);
                u32x4 o; o.x = cvtpk(bflo(kw.x) * wr_, bfhi(kw.x) * wr_); o.y = cvtpk(bflo(kw.y) * wr_, bfhi(kw.y) * wr_); o.z = cvtpk(bflo(kw.z) * wr_, bfhi(kw.z) * wr_); o.w = cvtpk(bflo(kw.w) * wr_, bfhi(kw.w) * wr_);
                *(LAS u32x4*)(lds + L_KTR + v_st(row, c8)) = o; }
#pragma unroll
            for (int i = 0; i < 4; ++i) { const int p = tid_ + 512 * i, row = p >> 5, c8 = (p & 31) * 8;
                float vf_[8]; fp8x8_to_f32(sv[i], vf_); *(LAS u32x4*)(lds + L_VTR + (c8 >> 7) * 16384 + v_st(row, c8 & 127)) = (u32x4){cvtpk(vf_[0], vf_[1]), cvtpk(vf_[2], vf_[3]), cvtpk(vf_[4], vf_[5]), cvtpk(vf_[6], vf_[7])}; }
            }
            if (w == 0) { WINT[(ch & 1) * 64 + l] = winter; UV[(ch & 1) * 64 + l] = u; AV[(ch & 1) * 64 + l] = a; }
            if (!(SKIP & 32)) { if (ch + 1 < 32) { M_LOAD(tok0 + 64); M_LOADV(tok0 + 64); } }
            __syncthreads(); __builtin_amdgcn_sched_barrier(0);
            if (!(SKIP & 1)) {
                if (w == 4) { const LAS char* qrow = lds + L_QP + l * RSB; const LAS f32x4* nv = (const LAS f32x4*)(lds + L_NV + ((ch + 1) & 1) * 512);
                    float p0 = 0.f, p1 = 0.f;
#pragma unroll 2
                    for (int d8 = 0; d8 < 16; ++d8) { const u32x4 q = *(const LAS u32x4*)(qrow + 16 * d8); const f32x4 na = nv[2 * d8], nb = nv[2 * d8 + 1];
                        p0 += (bflo(q.x) * na.x + bfhi(q.x) * na.y) + (bflo(q.y) * na.z + bfhi(q.y) * na.w); p1 += (bflo(q.z) * nb.x + bfhi(q.z) * nb.y) + (bflo(q.w) * nb.z + bfhi(q.w) * nb.w); }
                    QN[l] = p0 + p1; }
                if (w == 5) { const LAS char* kb = lds + L_KTR + (l >> 4) * 512 + (l & 15) * 4;
                    float p0 = 0.f, p1 = 0.f;
#pragma unroll 2
                    for (int a_ = 0; a_ < 8; ++a_) {
                        const unsigned k0 = *(const LAS unsigned*)(kb + a_ * 2048 + 0), k1 = *(const LAS unsigned*)(kb + a_ * 2048 + 64), k2 = *(const LAS unsigned*)(kb + a_ * 2048 + 128), k3 = *(const LAS unsigned*)(kb + a_ * 2048 + 192);
                        const unsigned k4 = *(const LAS unsigned*)(kb + a_ * 2048 + 256), k5 = *(const LAS unsigned*)(kb + a_ * 2048 + 320), k6 = *(const LAS unsigned*)(kb + a_ * 2048 + 384), k7 = *(const LAS unsigned*)(kb + a_ * 2048 + 448);
                        p0 += ((bflo(k0) + bflo(k4)) + (bflo(k1) + bflo(k5))) + ((bflo(k2) + bflo(k6)) + (bflo(k3) + bflo(k7))); p1 += ((bfhi(k0) + bfhi(k4)) + (bfhi(k1) + bfhi(k5))) + ((bfhi(k2) + bfhi(k6)) + (bfhi(k3) + bfhi(k7))); }
                    n0 = n0 * decay + p0; n1 = n1 * decay + p1;
                    *(LAS f32x2*)(lds + L_NV + (ch & 1) * 512 + 8 * l) = (f32x2){n0, n1}; }
            }
            __builtin_amdgcn_sched_barrier(0);
            if (!(SKIP & 2)) { const int ti = w & 3, si0 = 2 * (w >> 2);
              const f32x4 ut4 = *(const LAS f32x4*)(uv_b + (ch & 1) * 64);
#pragma unroll
              for (int sj = 0; sj < 2; ++sj) { const int si = si0 + sj; float av[4] = {0.f, 0.f, 0.f, 0.f};
                if (si <= ti) { f32x4 acc = {0.f, 0.f, 0.f, 0.f};
#pragma unroll
                    for (int kk = 0; kk < 4; ++kk) { const bf16x8 af = *(const LAS bf16x8*)(sq_b + 64 * kk), bfr = *(const LAS bf16x8*)(sk_b + (16 * si) * RSB + 64 * kk);
                        acc = __builtin_amdgcn_mfma_f32_16x16x32_bf16(af, bfr, acc, 0, 0, 0); }
                    const float as_ = as_b[(ch & 1) * 64 + 16 * sj]; const int dts = 16 * (ti - si) + 4 * q4 - l15;
#pragma unroll
                    for (int r = 0; r < 4; ++r) av[r] = (dts + r >= 0) ? acc[r] * __expf(as_ - ut4[r]) : 0.f; }
#pragma unroll
                for (int r = 0; r < 4; ++r) { *(LAS unsigned short*)(am_w + r * AMB + sj * 32) = (unsigned short)f2bf(av[r]);
                    const float rs_ = row16_sum(av[r]);
                    if (l15 == 0) rs_w[sj * 64 + r] = rs_; } } }
            __builtin_amdgcn_sched_barrier(0);
            bf16x8 vf[4];
            { s16x4 l0, l1, l2, l3, h0, h1, h2, h3;
              TRRD(l0, vbV, 0); TRRD(h0, vbV, 2048); TRRD(l1, vbV, 4096); TRRD(h1, vbV, 6144); TRRD(l2, vbV, 8192); TRRD(h2, vbV, 10240); TRRD(l3, vbV, 12288); TRRD(h3, vbV, 14336);
              asm volatile("s_waitcnt lgkmcnt(0)" ::: "memory"); __builtin_amdgcn_sched_barrier(0);
              vf[0] = (bf16x8){l0[0], l0[1], l0[2], l0[3], h0[0], h0[1], h0[2], h0[3]}; vf[1] = (bf16x8){l1[0], l1[1], l1[2], l1[3], h1[0], h1[1], h1[2], h1[3]};
              vf[2] = (bf16x8){l2[0], l2[1], l2[2], l2[3], h2[0], h2[1], h2[2], h2[3]}; vf[3] = (bf16x8){l3[0], l3[1], l3[2], l3[3], h3[0], h3[1], h3[2], h3[3]}; }
            f32x16 ac[2] = {};
            if (!(SKIP & 4))
#pragma unroll
            for (int db = 0; db < 4; ++db)
#pragma unroll
                for (int s2 = 0; s2 < 2; ++s2) {
                    u32x4 cw; cw.x = cvtpk(Ct[db][8 * s2 + 0], Ct[db][8 * s2 + 1]); cw.y = cvtpk(Ct[db][8 * s2 + 2], Ct[db][8 * s2 + 3]); cw.z = cvtpk(Ct[db][8 * s2 + 4], Ct[db][8 * s2 + 5]); cw.w = cvtpk(Ct[db][8 * s2 + 6], Ct[db][8 * s2 + 7]);
#pragma unroll
                    for (int th = 0; th < 2; ++th) { const LAS char* qp = q_b + 32 * th * RSB + (32 * db + 16 * s2) * 2; const u32x2 x0 = *(const LAS u32x2*)qp, x1 = *(const LAS u32x2*)(qp + 16);
                        u32x4 o = {x0.x, x0.y, x1.x, x1.y}; ac[th] = __builtin_amdgcn_mfma_f32_32x32x16_bf16(*reinterpret_cast<bf16x8*>(&o), *reinterpret_cast<bf16x8*>(&cw), ac[th], 0, 0, 0); } }
            if (!(SKIP & 8))
#pragma unroll
            for (int db = 0; db < 4; ++db) { s16x4 l0, l1, l2, l3, h0, h1, h2, h3;
                TRRD(l0, vbK, db * 512 + 0); TRRD(h0, vbK, db * 512 + 2048); TRRD(l1, vbK, db * 512 + 4096); TRRD(h1, vbK, db * 512 + 6144); TRRD(l2, vbK, db * 512 + 8192); TRRD(h2, vbK, db * 512 + 10240); TRRD(l3, vbK, db * 512 + 12288); TRRD(h3, vbK, db * 512 + 14336);
#pragma unroll
                for (int r = 0; r < 16; ++r) Ct[db][r] *= decay;
                asm volatile("s_waitcnt lgkmcnt(0)" ::: "memory"); __builtin_amdgcn_sched_barrier(0);
                Ct[db] = __builtin_amdgcn_mfma_f32_32x32x16_bf16((bf16x8){l0[0], l0[1], l0[2], l0[3], h0[0], h0[1], h0[2], h0[3]}, vf[0], Ct[db], 0, 0, 0);
                Ct[db] = __builtin_amdgcn_mfma_f32_32x32x16_bf16((bf16x8){l1[0], l1[1], l1[2], l1[3], h1[0], h1[1], h1[2], h1[3]}, vf[1], Ct[db], 0, 0, 0);
                Ct[db] = __builtin_amdgcn_mfma_f32_32x32x16_bf16((bf16x8){l2[0], l2[1], l2[2], l2[3], h2[0], h2[1], h2[2], h2[3]}, vf[2], Ct[db], 0, 0, 0);
                Ct[db] = __builtin_amdgcn_mfma_f32_32x32x16_bf16((bf16x8){l3[0], l3[1], l3[2], l3[3], h3[0], h3[1], h3[2], h3[3]}, vf[3], Ct[db], 0, 0, 0); }
            m_state = blast + u63;
            __syncthreads(); __builtin_amdgcn_sched_barrier(0);
            if (!(SKIP & 16)) {
            { const float den = ((RS[l] + RS[64 + l]) + (RS[128 + l] + RS[192 + l])) + winter * QN[l]; HDEN[64 * w + l] = 1.f / fmaxf(fabsf(den), mexp); }
            const LAS float* wint_c = wint_b + (ch & 1) * 64;
#pragma unroll
            for (int th = 0; th < 2; ++th) { f32x16 ai = {};
#pragma unroll
                for (int ks = 0; ks < 4; ++ks) { if (th == 0 && ks >= 2) continue; const bf16x8 af = *(const LAS bf16x8*)(am_b + 32 * th * AMB + 32 * ks); ai = __builtin_amdgcn_mfma_f32_32x32x16_bf16(af, vf[ks], ai, 0, 0, 0); }
                unsigned pk[16];
#pragma unroll
                for (int q = 0; q < 4; ++q) { const f32x4 w4 = *(const LAS f32x4*)(wint_c + 32 * th + 8 * q), h4 = *(const LAS f32x4*)(hden_b + 32 * th + 8 * q);
#pragma unroll
                    for (int j = 0; j < 4; ++j) { const int r = 4 * q + j; const float v = (ai[r] + w4[j] * ac[th][r]) * h4[j]; pk[r] = cvtpk(v, lane_xor1(v)); } }
                if ((r32 & 1) == 0) {
#pragma unroll
                    for (int r = 0; r < 16; ++r) { const int tc = 32 * th + (r & 3) + 8 * (r >> 2); *(unsigned*)(HC + (size_t)(tok0 + tc) * 2048 + h * 256 + hc_lane) = pk[r]; } } }
            }
        }
        __syncthreads();
    }
#undef M_LOAD
#undef M_LOADV
}
#undef TRRD
}

#ifndef GEMM_SP2
#define GEMM_SP2 true
#endif
#ifndef GEMM_ALIGN
#define GEMM_ALIGN true
#endif
#define EPI_ST(p, v) (*(p) = (v))
#define EPI_ST_NT(p, v) __builtin_nontemporal_store((v), (p))
namespace pg8 {
struct EpiStoreBf16 { static constexpr bool PERM = true, AFTER_DRAIN = false, WIDE = false; bf16_t* O; int ldc;
    __device__ __forceinline__ void operator()(const f32x4 (&acc)[2][2][4][2], const Unit& u, int wr, int wc, int fr, int fq) const {
        const int row0 = u.pm * BM + wr * 64 + fr, col0 = u.pn * BM + wc * 32 + 8 * fq;
#pragma unroll
        for (int ai = 0; ai < 2; ++ai)
#pragma unroll
            for (int m = 0; m < 4; ++m) { bf16_t* rowp = O + (size_t)(row0 + ai * HALF + m * 16) * ldc + col0;
#pragma unroll
                for (int bj = 0; bj < 2; ++bj) { const f32x4 v0 = acc[ai][bj][m][0], v1 = acc[ai][bj][m][1];
                    u32x4 w; w.x = cvt_pk_bf16(v0[0], v0[1]); w.y = cvt_pk_bf16(v0[2], v0[3]); w.z = cvt_pk_bf16(v1[0], v1[1]); w.w = cvt_pk_bf16(v1[2], v1[3]);
                    EPI_ST((u32x4*)(rowp + bj * HALF), w); } }
    }
};
struct EpiStoreFp8 { static constexpr bool PERM = true, AFTER_DRAIN = false; static constexpr int WIDE = 2; unsigned char* O; int ldc;
    __device__ __forceinline__ void operator()(const f32x4 (&acc)[2][2][4][2], const Unit& u, int wr, int wc, int fr, int fq) const {
        unsigned char* tb = O + (size_t)(u.pm * BM) * ldc + u.pn * BM; const unsigned lo = (unsigned)((wr * 64 + fr) * ldc + wc * 64 + 16 * fq);
#pragma unroll
        for (int ai = 0; ai < 2; ++ai)
#pragma unroll
            for (int m = 0; m < 4; ++m) { u32x4 w; unsigned pw[2][2];
#pragma unroll
                for (int bj = 0; bj < 2; ++bj) { const f32x4 v0 = acc[ai][bj][m][0] * 16.f, v1 = acc[ai][bj][m][1] * 16.f;
                    int t0 = __builtin_amdgcn_cvt_pk_fp8_f32(v0[0], v0[1], 0, false); t0 = __builtin_amdgcn_cvt_pk_fp8_f32(v0[2], v0[3], t0, true);
                    int t1 = __builtin_amdgcn_cvt_pk_fp8_f32(v1[0], v1[1], 0, false); t1 = __builtin_amdgcn_cvt_pk_fp8_f32(v1[2], v1[3], t1, true);
                    pw[bj][0] = (unsigned)t0; pw[bj][1] = (unsigned)t1; }
                w.x = pw[0][0]; w.y = pw[0][1]; w.z = pw[1][0]; w.w = pw[1][1];
                EPI_ST_NT((u32x4*)(tb + (size_t)((ai * HALF + m * 16) * ldc) + lo), w); }
    }
};
struct EpiQKV { static constexpr bool PERM = true, AFTER_DRAIN = false, WIDE = false; bf16_t* O; int ldc;
    __device__ __forceinline__ void operator()(const f32x4 (&acc)[2][2][4][2], const Unit& u, int wr, int wc, int fr, int fq) const {
        const int row0 = u.pm * BM + wr * 64 + fr, col0 = u.pn * BM + wc * 32 + 8 * fq;
        const bool rot = ((u.pn >> 2) % 3) < 2;
        const float frev = __builtin_amdgcn_exp2f(-(float)(4 * wc + fq) * (18.931568569324174f / 16.f)) * 0.15915494309189535f;
        const float r16 = __builtin_amdgcn_fractf(16.f * frev), c16 = __builtin_amdgcn_cosf(r16), s16 = __builtin_amdgcn_sinf(r16);
#pragma unroll
        for (int ai = 0; ai < 2; ++ai) {
            const float r0 = __builtin_amdgcn_fractf((float)((row0 + ai * HALF) & 2047) * frev); float cs = __builtin_amdgcn_cosf(r0), sn = __builtin_amdgcn_sinf(r0);
#pragma unroll
            for (int m = 0; m < 4; ++m) { const int row = row0 + ai * HALF + m * 16; bf16_t* rowp = O + (size_t)row * ldc + col0;
#pragma unroll
                for (int bj = 0; bj < 2; ++bj) { f32x4 v0 = acc[ai][bj][m][0]; const f32x4 v1 = acc[ai][bj][m][1];
                    if (rot) { const float a = v0[0], b = v0[1]; v0[0] = a * cs - b * sn; v0[1] = b * cs + a * sn; }
                    u32x4 w; w.x = cvt_pk_bf16(v0[0], v0[1]); w.y = cvt_pk_bf16(v0[2], v0[3]); w.z = cvt_pk_bf16(v1[0], v1[1]); w.w = cvt_pk_bf16(v1[2], v1[3]);
                    EPI_ST_NT((u32x4*)(rowp + bj * HALF), w); }
                const float cn = cs * c16 - sn * s16; sn = sn * c16 + cs * s16; cs = cn; } }
    }
};
template <bool RES_F32> struct EpiRes { static constexpr bool PERM = true, AFTER_DRAIN = false, WIDE = false; const void* res; bf16_t* out; int ldc; float alpha;
    __device__ __forceinline__ void operator()(const f32x4 (&acc)[2][2][4][2], const Unit& u, int wr, int wc, int fr, int fq) const {
        const int row0 = u.pm * BM + wr * 64 + fr, col0 = u.pn * BM + wc * 32 + 8 * fq;
#pragma unroll
        for (int ai = 0; ai < 2; ++ai)
#pragma unroll
            for (int m = 0; m < 4; ++m) { const size_t off = (size_t)(row0 + ai * HALF + m * 16) * ldc + col0;
#pragma unroll
                for (int bj = 0; bj < 2; ++bj) { f32x4 r0, r1;
                    if (RES_F32) { r0 = *(const f32x4*)((const float*)res + off + bj * HALF); r1 = *(const f32x4*)((const float*)res + off + bj * HALF + 4); }
                    else { const u32x4 rw = *(const u32x4*)((const bf16_t*)res + off + bj * HALF);
                        r0 = (f32x4){__builtin_bit_cast(float, rw.x << 16), __builtin_bit_cast(float, rw.x & 0xffff0000u), __builtin_bit_cast(float, rw.y << 16), __builtin_bit_cast(float, rw.y & 0xffff0000u)};
                        r1 = (f32x4){__builtin_bit_cast(float, rw.z << 16), __builtin_bit_cast(float, rw.z & 0xffff0000u), __builtin_bit_cast(float, rw.w << 16), __builtin_bit_cast(float, rw.w & 0xffff0000u)}; }
                    const f32x4 v0 = r0 * alpha + acc[ai][bj][m][0], v1 = r1 * alpha + acc[ai][bj][m][1];
                    u32x4 w; w.x = cvt_pk_bf16(v0[0], v0[1]); w.y = cvt_pk_bf16(v0[2], v0[3]); w.z = cvt_pk_bf16(v1[0], v1[1]); w.w = cvt_pk_bf16(v1[2], v1[3]);
                    EPI_ST((u32x4*)(out + off + bj * HALF), w); } }
    }
};
struct EpiSwiGLU { static constexpr bool PERM = true, AFTER_DRAIN = false, WIDE = false; bf16_t* H;
    __device__ __forceinline__ void operator()(const f32x4 (&acc)[2][2][4][2], const Unit& u, int wr, int wc, int fr, int fq) const {
        const int row0 = u.pm * BM + wr * 64 + fr, col0 = u.pn * 128 + wc * 16 + 4 * fq;
#pragma unroll
        for (int ai = 0; ai < 2; ++ai)
#pragma unroll
            for (int m = 0; m < 4; ++m) { bf16_t* rowp = H + (size_t)(row0 + ai * HALF + m * 16) * 768 + col0;
#pragma unroll
                for (int bj = 0; bj < 2; ++bj) { const f32x4 v0 = acc[ai][bj][m][0], v1 = acc[ai][bj][m][1];
                    const float h0 = v0[0] * __builtin_amdgcn_rcpf(1.f + __expf(-v0[0])) * v0[1], h1 = v0[2] * __builtin_amdgcn_rcpf(1.f + __expf(-v0[2])) * v0[3], h2 = v1[0] * __builtin_amdgcn_rcpf(1.f + __expf(-v1[0])) * v1[1], h3 = v1[2] * __builtin_amdgcn_rcpf(1.f + __expf(-v1[2])) * v1[3];
                    typedef unsigned u32x2v __attribute__((ext_vector_type(2))); u32x2v w; w.x = cvt_pk_bf16(h0, h1); w.y = cvt_pk_bf16(h2, h3);
                    EPI_ST((u32x2v*)(rowp + bj * 64), w); } }
    }
};
__device__ __forceinline__ unsigned ror8u(unsigned v) { return (unsigned)__builtin_amdgcn_mov_dpp((int)v, 0x128, 0xf, 0xf, true); }
template <bool STORE = true> struct EpiDownT { static constexpr bool PERM = true, AFTER_DRAIN = false, WIDE = true; unsigned char* YB8; const PG8_LAS int* atab;
    __device__ __forceinline__ void operator()(const f32x4 (&acc)[2][2][4][2], const Unit& u, int wr, int wc, int fr, int fq) const {
        typedef unsigned u32x2v __attribute__((ext_vector_type(2)));
        const bool up = fr >= 8; const unsigned ca = (unsigned)(u.pn * BM + wc * 64 + (up ? 32 : 0) + 8 * fq), cb = ca ^ 32u;
        const PG8_LAS int* at = atab + u.ui * 256 + wr * 64 + (fr & 7);
#pragma unroll
        for (int ai = 0; ai < 2; ++ai)
#pragma unroll
            for (int m = 0; m < 4; ++m) { u32x2v p[2];
#pragma unroll
                for (int bj = 0; bj < 2; ++bj) { const f32x4 v0 = acc[ai][bj][m][0] * 16.f, v1 = acc[ai][bj][m][1] * 16.f;
                    int t0 = __builtin_amdgcn_cvt_pk_fp8_f32(v0[0], v0[1], 0, false); t0 = __builtin_amdgcn_cvt_pk_fp8_f32(v0[2], v0[3], t0, true);
                    int t1 = __builtin_amdgcn_cvt_pk_fp8_f32(v1[0], v1[1], 0, false); t1 = __builtin_amdgcn_cvt_pk_fp8_f32(v1[2], v1[3], t1, true);
                    p[bj].x = (unsigned)t0; p[bj].y = (unsigned)t1; }
                const u32x2v x = {ror8u(p[1].x), ror8u(p[1].y)};
                const int aA = at[ai * HALF + m * 16], aB = at[ai * HALF + m * 16 + 8];
                const u32x2v dA = up ? x : p[0], dB = up ? p[0] : x;
                if (STORE) { if (aA >= 0) EPI_ST((u32x2v*)(YB8 + (size_t)aA * 2048 + ca), dA); if (aB >= 0) EPI_ST((u32x2v*)(YB8 + (size_t)aB * 2048 + cb), dB); }
                else asm volatile("" :: "v"(dA.x), "v"(dA.y), "v"(dB.x), "v"(dB.y)); }
    }
};
typedef EpiDownT<true> EpiDown;
template <bool GATHER_> struct MoeOrder { static constexpr bool GATHER = GATHER_; static constexpr int MAXU = 9;
    int nN, G, c, nt; const unsigned* cnt; size_t exp_bytes; const int* rowmap; PG8_LAS int* tok;
    static __device__ __forceinline__ int tiles(const unsigned* cnt) { int n = 0; for (int e = 0; e < 16; ++e) n += (int)(cnt[e] + 255u) >> 8; return n; }
    __device__ __forceinline__ bool next(int i, Unit& u) const { const long L = (long)i * G + c; if (L >= (long)nt * nN) return false; u.pm = (int)(L / nN); u.pn = (int)(L % nN); u.ui = i; return true; }
    __device__ __forceinline__ const char* pa(const Gemm& g, const Unit& u) const { return GATHER_ ? (const char*)g.A : (const char*)g.A + (size_t)u.pm * ((size_t)BM * g.K * 2); }
    __device__ __forceinline__ const char* pb(const Gemm& g, const Unit& u) const { const int e = __builtin_amdgcn_readfirstlane(tok[MAXU * 256 + u.pm]) & 15; return (const char*)g.Bt + (size_t)e * exp_bytes + (size_t)u.pn * ((size_t)BM * g.K * 2); }
    __device__ __forceinline__ void prep() const {
        if (threadIdx.x < 16) { const int e = threadIdx.x; int pm = 0; for (int q = 0; q < e; ++q) pm += (int)(cnt[q] + 255u) >> 8;
            const int ce = (int)cnt[e];
            for (int k = 0; k * 256 < ce; ++k) { const int rem = ce - k * 256; tok[MAXU * 256 + pm + k] = e | (k << 4) | ((rem > 256 ? 256 : rem) << 12); } }
        __syncthreads();
        for (int i = 0; i < MAXU; ++i) { Unit u; if (!next(i, u)) break; if (threadIdx.x < 256) { const int w = tok[MAXU * 256 + u.pm]; tok[i * 256 + threadIdx.x] = ((int)threadIdx.x < (w >> 12)) ? rowmap[(w & 15) * ECAP + ((w >> 4) & 255) * 256 + (int)threadIdx.x] : -1; } }
        asm volatile("s_waitcnt vmcnt(0) lgkmcnt(0)" ::: "memory"); __syncthreads();
    }
    __device__ __forceinline__ void aoffs(int ui, int K, int tid, unsigned (&out)[2][2]) const {
#pragma unroll
        for (int h = 0; h < 2; ++h)
#pragma unroll
            for (int i = 0; i < 2; ++i) { int R, C; stage_rc(tid * 16 + i * 8192, R, C); const int a = tok[ui * 256 + h * 128 + R]; out[h][i] = (unsigned)((a < 0 ? 0 : a) >> 1) * (unsigned)(K * 2) + (unsigned)(C * 2); }
    }
    __device__ __forceinline__ void a_ready(const Unit&) const {}
    __device__ __forceinline__ void done(const Unit&) const {}
};
}

struct Args { const float* in[18]; float* out; unsigned char* ws; int ph_lo, ph_hi; };
#ifdef ONLY_PH
#define IN(k) ((k) == ONLY_PH)
#else
#define IN(k) (lo <= (k) && (k) < hi)
#endif
#define BOTH(k) (IN(k) && IN((k) + 1))
#if MK_ONE_LAUNCH
#define SEAM() xcd_barrier(bar)
#else
#define SEAM() do {} while (0)
#endif
#ifndef REP_PH
#define REP_PH (-1)
#endif
#ifndef REP_PH2
#define REP_PH2 (-1)
#endif
#ifdef TS_PROBE
#define TS_STAMP(k) do { if (blockIdx.x == 0 && threadIdx.x == 0) __hip_atomic_store((unsigned long long*)(ws + WS_CTL + 65536) + (k), __builtin_amdgcn_s_memrealtime(), __ATOMIC_RELAXED, __HIP_MEMORY_SCOPE_AGENT); } while (0)
#define PHASE(k, ...) if (IN(k)) { __VA_ARGS__; SEAM(); TS_STAMP((k) + 1); }
#else
#define PHASE(k, ...) if (IN(k)) { __VA_ARGS__; if ((k) == REP_PH || (k) == REP_PH2) { __syncthreads(); __VA_ARGS__; } if (BOTH(k)) SEAM(); }
#endif
#define WSP(T_, off) ((T_*)(ws + (off)))
#ifndef MOE_XCD_ORDER
#define MOE_XCD_ORDER 1
#endif
#if MOE_XCD_ORDER
#define MOE_CU(c) (((c).G % 8 == 0) ? ((c).bid % 8) * ((c).G / 8) + (c).bid / 8 : (c).bid)
#else
#define MOE_CU(c) ((c).bid)
#endif
#define GEMM_STATIC(EPI, A_, B_, N_, K_, ...) do { pg8::Gemm g{A_, B_, T, N_, K_}; pg8::StaticOrder S; S.init(T, N_, c.G, c.bid); EPI E{__VA_ARGS__}; pg8::gemm_phase<EPI, pg8::StaticOrder, GEMM_ALIGN, GEMM_SP2>(c.lds, g, S, E); } while (0)
#define GEMM_MOE(GATH, EPI, A_, B_, N_, K_, ...) do { pg8::Gemm g{A_, B_, MAXROWS, N_, K_}; const unsigned* cnt_ = WSP(unsigned, WS_CTL) + CW_CUR + L * 32; pg8::MoeOrder<GATH> S{(N_) / 256, c.G, MOE_CU(c), __builtin_amdgcn_readfirstlane(pg8::MoeOrder<GATH>::tiles(cnt_)), cnt_, (size_t)(N_) * (K_) * 2, WSP(int, WS_RM2), (LAS int*)(c.lds + LDSCTL_OFF + 5120)}; EPI E{__VA_ARGS__}; pg8::gemm_phase<EPI, pg8::MoeOrder<GATH>, GEMM_ALIGN, true>(c.lds, g, S, E); } while (0)
enum { P_PRO = 0, P_QKV, P_ATTA, P_ATTB, P_WO, P_MOE0, P_WIN = P_MOE0 + 4, P_CONV, P_CELL, P_HN, P_WOUT, P_MOE1, P_END = P_MOE1 + 4 };
static_assert(P_END == NPHASE, "phase count");
constexpr int TAIL_E = 9;
__device__ __forceinline__ bool tail_share(const Ctx& c, int units, int& j, int& n) {
    const int R = (units + c.G - 1) / c.G, nlast = units - (R - 1) * c.G, cu = MOE_CU(c); n = c.G - nlast;
    if (n < 64) { j = c.bid; n = c.G; return true; }
    j = cu - nlast; return cu >= nlast; }
template <int L>
__device__ __forceinline__ void moe_block(const Ctx& c, const Args& args, unsigned char* ws, const int lo, const int hi, const XcdBarrier& bar, const int base) {
    (void)bar; (void)lo; (void)hi;
    PHASE(base + 0, ln_pass<0, 1, false>(c, WSP(bf16, WS_PRE), nullptr, nullptr, WSP(bf16, WS_XB), args.in[9] + L * D, args.in[10] + L * D, args.in[13], 16, 0, args.in[14], WSP(int, WS_RM2), WSP(float, WS_EGATE), WSP(unsigned, WS_CTL) + CW_CUR + L * 32, nullptr))
    PHASE(base + 1, GEMM_MOE(true, pg8::EpiSwiGLU, WSP(bf16, WS_XB), WSP(bf16, WS_WGU), GU_N, D, WSP(bf16, WS_H));
        if (L == 0) { int j_, n_; __syncthreads(); if (tail_share(c, pg8::MoeOrder<true>::tiles(WSP(unsigned, WS_CTL) + CW_CUR) * (GU_N / 256), j_, n_)) {
            conv_moe(c, args.in[15], args.in[16], args.in[17], WSP(bf16, WS_WGU), WSP(bf16, WS_WD), j_ * NWAVES + c.wave, n_ * NWAVES, 2 * NE * 768 + TAIL_E * 768, 2 * NE * 768);
            conv_job(c, args.in[8], D, D, D, WSP(bf16, WS_WOUT), j_ * NWAVES + c.wave, n_ * NWAVES); } })
#ifdef DOWN_NOSTORE_PROBE
    if (IN(base + 2)) { GEMM_MOE(false, pg8::EpiDownT<false>, WSP(bf16, WS_H), WSP(bf16, WS_WD), D, DE, WSP(unsigned char, WS_YB), (const LAS int*)(c.lds + LDSCTL_OFF + 5120)); __syncthreads(); }
#endif
    PHASE(base + 2, GEMM_MOE(false, pg8::EpiDown, WSP(bf16, WS_H), WSP(bf16, WS_WD), D, DE, WSP(unsigned char, WS_YB), (const LAS int*)(c.lds + LDSCTL_OFF + 5120));
        if (L == 0) { int j_, n_; __syncthreads(); if (tail_share(c, pg8::MoeOrder<true>::tiles(WSP(unsigned, WS_CTL) + CW_CUR) * (D / 256), j_, n_))
            conv_job(c, args.in[3], ZLD, D, ZN, WSP(bf16, WS_WIN), j_ * NWAVES + c.wave, n_ * NWAVES); })
    if (L == 0) { PHASE(base + 3, ln_pass<1, 2, false>(c, nullptr, nullptr, WSP(bf16, WS_YB), WSP(bf16, WS_XB), args.in[11], args.in[12], args.in[3], ZLD, ZN, args.in[4], nullptr, WSP(float, WS_EGATE), nullptr, WSP(float, WS_GATES))) }
    else { PHASE(base + 3, ln_pass<1, 0, true>(c, nullptr, args.out, WSP(bf16, WS_YB), WSP(bf16, WS_XB), args.in[11] + D, args.in[12] + D, nullptr, 0, 0, nullptr, nullptr, WSP(float, WS_EGATE), nullptr, nullptr)) }
}
__global__ void __launch_bounds__(NTHR, 2) fwd(Args args) {
    extern __shared__ __attribute__((aligned(16))) unsigned char lds_raw[];
    Ctx c; c.lds = (LAS unsigned char*)lds_raw; c.tid = threadIdx.x; c.lane = c.tid & 63; c.wave = __builtin_amdgcn_readfirstlane(c.tid >> 6);
    c.G = gridDim.x; c.bid = blockIdx.x; c.gw = c.bid * NWAVES + c.wave; c.ngw = c.G * NWAVES; c.gtid = c.bid * NTHR + c.tid; c.ngt = c.G * NTHR;
    unsigned char* ws = args.ws;
    ((LAS unsigned*)(c.lds + LDSCTL_OFF))[c.tid] = 0u;
    __syncthreads();
#if MK_ONE_LAUNCH
    XcdBarrier bar = xcd_barrier_post((unsigned*)(ws + WS_CTL) + CW_BAR, (volatile LAS unsigned*)(c.lds + LDSCTL_OFF + LC_BAR));
#else
    XcdBarrier bar; bar.bar = nullptr; bar.x = 0; bar.st = nullptr;
#endif
    const int lo = args.ph_lo, hi = args.ph_hi; (void)lo; (void)hi;
#ifdef TS_PROBE
    SEAM(); TS_STAMP(0);
#endif
    PHASE(P_PRO, conv_job<true>(c, args.in[1], QKV_N, D, QKV_N, WSP(bf16, WS_WQKV), c.gw, c.ngw); conv_job(c, args.in[2], D, OD, D, WSP(bf16, WS_WO), c.gw, c.ngw);
        conv_moe(c, args.in[15], args.in[16], args.in[17], WSP(bf16, WS_WGU), WSP(bf16, WS_WD), c.gw, c.ngw, 2 * NE * 768);
        conv_moe(c, args.in[15], args.in[16], args.in[17], WSP(bf16, WS_WGU), WSP(bf16, WS_WD), c.gw, c.ngw, 3 * NE * 768, 2 * NE * 768 + TAIL_E * 768);
        x_to_bf16(c, args.in[0], WSP(bf16, WS_XB)))
    PHASE(P_QKV, GEMM_STATIC(pg8::EpiQKV, WSP(bf16, WS_XB), WSP(bf16, WS_WQKV), QKV_N, D, WSP(bf16, WS_QKV), QKV_N))
    PHASE(P_ATTA, att::attn_phase<false>(c, WSP(const bf16, WS_QKV), WSP(bf16, WS_XB), WSP(float, WS_GATES), nullptr))
    PHASE(P_ATTB, att::attn_phase<true>(c, WSP(const bf16, WS_QKV), WSP(bf16, WS_XB), WSP(float, WS_GATES), WSP(bf16, WS_O)))
    PHASE(P_WO, GEMM_STATIC(pg8::EpiRes<true>, WSP(bf16, WS_O), WSP(bf16, WS_WO), D, OD, args.in[0], WSP(bf16, WS_PRE), D, ALPHA))
    moe_block<0>(c, args, ws, lo, hi, bar, P_MOE0);
    PHASE(P_WIN, GEMM_STATIC(pg8::EpiStoreFp8, WSP(bf16, WS_XB), WSP(bf16, WS_WIN), ZN, D, WSP(unsigned char, WS_Z), ZN))
    PHASE(P_CONV, conv_pass(c, WSP(const unsigned char, WS_Z), args.in[5], args.in[6], WSP(bf16, WS_QKC)))
    PHASE(P_CELL,
#if defined(MLS_SKIP)
        mls::mlstm_phase<MLS_SKIP>(c, WSP(const bf16, WS_QKC), WSP(const unsigned char, WS_Z), WSP(const float, WS_GATES), WSP(bf16, WS_HC)); __syncthreads();
#endif
        mls::mlstm_phase<0>(c, WSP(const bf16, WS_QKC), WSP(const unsigned char, WS_Z), WSP(const float, WS_GATES), WSP(bf16, WS_HC));
#if 0
        mls::mlstm_phase<0>(c, WSP(const bf16, WS_QKC), WSP(const unsigned char, WS_Z), WSP(const float, WS_GATES), WSP(bf16, WS_HC));
#endif
        if (c.G > 128) { if (c.bid >= 128) conv_moe(c, args.in[15] + (size_t)NE * D * DE, args.in[16] + (size_t)NE * D * DE, args.in[17] + (size_t)NE * D * DE, WSP(bf16, WS_WGU), WSP(bf16, WS_WD), (c.bid - 128) * NWAVES + c.wave, (c.G - 128) * NWAVES, CONV_MOE_ITEMS - CELL_SHARE);
            else conv_moe(c, args.in[15] + (size_t)NE * D * DE, args.in[16] + (size_t)NE * D * DE, args.in[17] + (size_t)NE * D * DE, WSP(bf16, WS_WGU), WSP(bf16, WS_WD), c.bid * NWAVES + c.wave, 128 * NWAVES, CONV_MOE_ITEMS, CONV_MOE_ITEMS - CELL_SHARE); }
        else conv_moe(c, args.in[15] + (size_t)NE * D * DE, args.in[16] + (size_t)NE * D * DE, args.in[17] + (size_t)NE * D * DE, WSP(bf16, WS_WGU), WSP(bf16, WS_WD), c.gw, c.ngw);
        )
    PHASE(P_HN, headnorm_pass(c, WSP(const bf16, WS_HC), WSP(const unsigned char, WS_Z), args.in[7], WSP(bf16, WS_Y)))
    PHASE(P_WOUT, GEMM_STATIC(pg8::EpiRes<false>, WSP(bf16, WS_Y), WSP(bf16, WS_WOUT), D, D, WSP(bf16, WS_XB), WSP(bf16, WS_PRE), D, ALPHA))
    moe_block<1>(c, args, ws, lo, hi, bar, P_MOE1);
#ifdef TS_PROBE
    {
        SEAM();
        const unsigned long long* ts = (const unsigned long long*)(ws + WS_CTL + 65536);
        const unsigned long long t0 = __hip_atomic_load(ts + TS_PROBE, __ATOMIC_RELAXED, __HIP_MEMORY_SCOPE_AGENT), t1 = __hip_atomic_load(ts + TS_PROBE + 1, __ATOMIC_RELAXED, __HIP_MEMORY_SCOPE_AGENT), t2 = __hip_atomic_load(ts + TS_PROBE + 2, __ATOMIC_RELAXED, __HIP_MEMORY_SCOPE_AGENT);
        const float k1 = (float)(t1 - t0) * 0.001f;
        const float k2 = (TS_PROBE + 2 <= NPHASE) ? (float)(t2 - t1) * 10.0f : 0.f;
        for (size_t i = c.gtid; i < (size_t)T * D; i += c.ngt) args.out[i] = k1;
        SEAM();
        if (c.gtid == 0) args.out[0] = k2;
    }
#endif
}
#undef IN
#undef BOTH

extern "C" void kernel_launch(void* const* d_in, const int* in_sizes, int n_in, void* d_out, int out_size, void* d_ws, size_t ws_size, hipStream_t stream) {
    static int grid = 0;
    if (grid == 0) {
        if (n_in != 18 || in_sizes[0] != T * D || out_size != T * D || ws_size < WS_END) { fprintf(stderr, "kernel_launch: unexpected shapes (n_in %d, in0 %d, out %d, ws %zu)\n", n_in, n_in > 0 ? in_sizes[0] : -1, out_size, ws_size); grid = -1; return; }
        int dev = 0, cus = 0;
        if (hipGetDevice(&dev) != hipSuccess || hipDeviceGetAttribute(&cus, hipDeviceAttributeMultiprocessorCount, dev) != hipSuccess) { grid = -1; return; }
        if (hipFuncSetAttribute((const void*)fwd, hipFuncAttributeMaxDynamicSharedMemorySize, LDS_BYTES) != hipSuccess) { fprintf(stderr, "kernel_launch: hipFuncSetAttribute failed\n"); grid = -1; return; }
        int per_cu = 0;
        if (hipOccupancyMaxActiveBlocksPerMultiprocessor(&per_cu, (const void*)fwd, NTHR, LDS_BYTES) != hipSuccess || per_cu < 1) fprintf(stderr, "kernel_launch: occupancy query says %d\n", per_cu);
        (void)hipGetLastError();
        grid = cus > 256 ? 256 : cus;
    }
    if (grid < 0) return;
    (void)hipMemsetAsync((char*)d_ws + WS_CTL, 0, CTL_ZERO_BYTES, stream);
    Args a{};
    for (int i = 0; i < 18; ++i) a.in[i] = (const float*)d_in[i];
    a.out = (float*)d_out; a.ws = (unsigned char*)d_ws;
#if MK_ONE_LAUNCH
    a.ph_lo = 0; a.ph_hi = NPHASE;
    hipLaunchKernelGGL(fwd, dim3(grid), dim3(NTHR), LDS_BYTES, stream, a);
#else
    for (int p = 0; p < NPHASE; ++p) { a.ph_lo = p; a.ph_hi = p + 1; hipLaunchKernelGGL(fwd, dim3(grid), dim3(NTHR), LDS_BYTES, stream, a); }
#endif
}
```
